# Optimizing an MI355X kernel written in HIP

```python
import jax
import jax.numpy as jnp
from jax import lax
import numpy as np

D_MODEL = 1024
BATCH = 8
SEQ = 2048
DEPTH = 2

GRID_W = 64
CTX_LEN = 256
N_MOD = 6
RMS_EPS = 1e-6
NEG_INF = -1e30
NA_HEADS = 8
NA_HEAD_DIM = 64
NA_WIDTH = NA_HEADS * NA_HEAD_DIM
NA_WIN_R = 8
NA_WIN_C = 16
SC_WIDTH = 512
CONV_W = 3
GLA_HEADS = 4
GLA_KEY_WIDTH = D_MODEL // 2
GLA_VAL_WIDTH = D_MODEL
GLA_DK = GLA_KEY_WIDTH // GLA_HEADS
GLA_DV = GLA_VAL_WIDTH // GLA_HEADS
GLA_GATE_RANK = 16
GLA_GATE_TAU = 16.0
GLA_CHUNK = 64
N_BRANCH = 3
N_EXPERTS = 64
N_EXPERT_GROUPS = 8
TOPK_GROUPS = 4
TOP_K = 8
EXPERT_FF = 256
ROUTED_SCALE = 2.5
MOE_BLOCK = 256
KV_COLS = (NA_WIDTH, NA_WIDTH, GLA_KEY_WIDTH, GLA_VAL_WIDTH, 2 * GLA_GATE_RANK)
LAT_COLS = (NA_WIDTH, SC_WIDTH, SC_WIDTH, SC_WIDTH, GLA_KEY_WIDTH, GLA_VAL_WIDTH, N_BRANCH * D_MODEL)
IN_COLS = KV_COLS + LAT_COLS
N_KV = sum(KV_COLS)
N_IN = sum(IN_COLS)
COL_NAMES = ('k_na', 'v_na', 'k_gla', 'v_gla', 'gate_gla', 'q_na', 'b_sc', 'c_sc', 'x_sc', 'q_gla', 'r_gla', 'merge')

kernel_name = 'hybrid_natten_conv_gla_moe_prefix_dit'


def _rmsnorm(x, g):
    x32 = x.astype(jnp.float32)
    y = x32 * lax.rsqrt(jnp.mean(x32 * x32, axis=-1, keepdims=True) + RMS_EPS)
    return (y * g.astype(jnp.float32)).astype(x.dtype)


def _modulate(x, g, shift, scale):
    return _rmsnorm(x, g) * (1 + scale) + shift


def _heads(t, n):
    return t.reshape(t.shape[:-1] + (n, t.shape[-1] // n))


def _split_cols(z, sizes):
    return dict(zip(COL_NAMES, jnp.split(z, np.cumsum(sizes)[:-1].tolist(), axis=-1)))


def _attend_dense(q, k, v):
    s = jnp.einsum('bqhd,bkhd->bhqk', q, k).astype(jnp.float32) * (q.shape[-1] ** -0.5)
    p = jax.nn.softmax(s, axis=-1).astype(q.dtype)
    o = jnp.einsum('bhqk,bkhd->bqhd', p, v)
    return o.reshape(o.shape[:2] + (-1,))


def _na_latent(q, k, v, k_ctx, v_ctx, rpb):
    b, s, h, d = q.shape
    rows = s // GRID_W
    kr = min(NA_WIN_R, rows)
    row_start = np.clip(np.arange(rows) - kr // 2, 0, rows - kr)
    row_idx = row_start[:, None] + np.arange(kr)
    col = np.arange(GRID_W)
    col_start = np.clip(col - NA_WIN_C // 2, 0, GRID_W - NA_WIN_C)
    col_ok = (col[None, :] >= col_start[:, None]) & (col[None, :] < col_start[:, None] + NA_WIN_C)
    d_row = row_idx - np.arange(rows)[:, None] + NA_WIN_R - 1
    d_col = np.clip(col[None, :] - col[:, None], -(NA_WIN_C - 1), NA_WIN_C - 1) + NA_WIN_C - 1
    bias = rpb.astype(jnp.float32)[:, d_row[:, None, :, None], d_col[None, :, None, :]]
    bias = jnp.where(col_ok[None, None, :, None, :], bias, NEG_INF)
    scale = d ** -0.5
    qg = q.reshape(b, rows, GRID_W, h, d)
    kg = k.reshape(b, rows, GRID_W, h, d)[:, row_idx]
    vg = v.reshape(b, rows, GRID_W, h, d)[:, row_idx]
    s_win = jnp.einsum('brqhd,brjkhd->bhrqjk', qg, kg).astype(jnp.float32) * scale + bias[None]
    s_ctx = jnp.einsum('brqhd,bchd->bhrqc', qg, k_ctx).astype(jnp.float32) * scale
    n_win = kr * GRID_W
    scores = jnp.concatenate([s_win.reshape(b, h, rows, GRID_W, n_win), s_ctx], axis=-1)
    p = jax.nn.softmax(scores, axis=-1).astype(q.dtype)
    p_win = p[..., :n_win].reshape(b, h, rows, GRID_W, kr, GRID_W)
    p_ctx = p[..., n_win:]
    o = jnp.einsum('bhrqjk,brjkhd->brqhd', p_win, vg) + jnp.einsum('bhrqc,bchd->brqhd', p_ctx, v_ctx)
    return o.reshape(b, s, h * d)


def _short_conv(b_gate, c_gate, x_in, w):
    u = c_gate * x_in
    up = jnp.pad(u, ((0, 0), (1, 1), (0, 0)))
    return b_gate * (up[:, :-2] * w[0] + up[:, 1:-1] * w[1] + up[:, 2:] * w[2])


def _gla_decay(gate_lr, w2, b2):
    outs = []
    for dr, lr in enumerate(jnp.split(gate_lr, 2, axis=-1)):
        logit = (lr @ w2[dr] + b2[dr]).astype(jnp.float32)
        outs.append(_heads(jax.nn.log_sigmoid(logit) / GLA_GATE_TAU, GLA_HEADS))
    return outs[0], outs[1]


def _gla_scan(q, k, v, g, s0, emit):
    b, l, h, _ = k.shape
    dv = v.shape[-1]
    n = l // GLA_CHUNK

    def chunks(t):
        return t.reshape(b, n, GLA_CHUNK, h, t.shape[-1]).transpose(1, 0, 3, 2, 4).astype(jnp.float32)

    lower = np.tril(np.ones((GLA_CHUNK, GLA_CHUNK), dtype=bool))

    def step(state, inp):
        kc, vc, gc = inp[0], inp[1], inp[2]
        cum = jnp.cumsum(gc, axis=2)
        last = cum[:, :, -1:, :]
        new_state = (jnp.exp(last[:, :, 0, :])[..., None] * state
                     + jnp.einsum('bhsd,bhsv->bhdv', kc * jnp.exp(last - cum), vc))
        if not emit:
            return new_state, None
        qc = inp[3]
        inter = jnp.einsum('bhtd,bhdv->bhtv', qc * jnp.exp(cum), state)
        diff = cum[:, :, :, None, :] - cum[:, :, None, :, :]
        decay = jnp.exp(jnp.where(lower[:, :, None], diff, -jnp.inf))
        attn = jnp.einsum('bhtd,bhsd,bhtsd->bhts', qc, kc, decay)
        intra = jnp.einsum('bhts,bhsv->bhtv', attn, vc)
        return new_state, inter + intra

    xs = (chunks(k), chunks(v), chunks(g)) + ((chunks(q),) if emit else ())
    state, o = lax.scan(step, s0, xs)
    if emit:
        o = o.transpose(1, 0, 3, 2, 4).reshape(b, l, h, dv)
    return o, state


def _gla_bidir(q, k, v, g_f, g_b, s_f, s_b, emit):
    o_f, st_f = _gla_scan(q, k, v, g_f, s_f, emit)
    rev = lambda t: None if t is None else jnp.flip(t, axis=1)
    o_b, st_b = _gla_scan(rev(q), rev(k), rev(v), rev(g_b), s_b, emit)
    o = o_f + jnp.flip(o_b, axis=1) if emit else None
    return o, st_f, st_b


def _gla_out(o, r, g):
    on = o * lax.rsqrt(jnp.mean(o * o, axis=-1, keepdims=True) + RMS_EPS) * g.astype(jnp.float32)
    y = on * jax.nn.silu(_heads(r, GLA_HEADS).astype(jnp.float32))
    return y.reshape(r.shape).astype(r.dtype)


def _merge(o_na, o_sc, o_gla, gates, w_na, w_sc, w_gla, w_out):
    g_na, g_sc, g_gla = jnp.split(jax.nn.sigmoid(gates), N_BRANCH, axis=-1)
    y = g_na * (o_na @ w_na) + g_sc * (o_sc @ w_sc) + g_gla * (o_gla @ w_gla)
    return y @ w_out


def _moe(h, w_router, b_router, w_gate, w_up, w_down, ws_gate, ws_up, ws_down):
    t, d = h.shape
    scores = jax.nn.sigmoid((h @ w_router).astype(jnp.float32))
    sel = scores + b_router.astype(jnp.float32)
    group_score = lax.top_k(sel.reshape(t, N_EXPERT_GROUPS, N_EXPERTS // N_EXPERT_GROUPS), 2)[0].sum(-1)
    _, top_groups = lax.top_k(group_score, TOPK_GROUPS)
    group_mask = (top_groups[:, :, None] == jnp.arange(N_EXPERT_GROUPS)[None, None, :]).any(axis=1)
    sel = jnp.where(jnp.repeat(group_mask, N_EXPERTS // N_EXPERT_GROUPS, axis=1), sel, -jnp.inf)
    _, eidx = lax.top_k(sel, TOP_K)
    gate_w = jnp.take_along_axis(scores, eidx, axis=1)
    gate_w = gate_w / gate_w.sum(-1, keepdims=True) * ROUTED_SCALE
    a = t * TOP_K
    e_flat = eidx.reshape(-1).astype(jnp.int32)
    tok_flat = jnp.repeat(jnp.arange(t, dtype=jnp.int32), TOP_K)
    w_flat = gate_w.reshape(-1)
    order = jnp.argsort(e_flat)
    e_sorted = e_flat[order]
    counts = jnp.zeros((N_EXPERTS,), jnp.int32).at[e_flat].add(1)
    padded = (counts + MOE_BLOCK - 1) // MOE_BLOCK * MOE_BLOCK
    pad_end = jnp.cumsum(padded)
    pad_start = pad_end - padded
    grp_start = jnp.cumsum(counts) - counts
    dest = pad_start[e_sorted] + jnp.arange(a, dtype=jnp.int32) - grp_start[e_sorted]
    n_blocks = -(-(a + N_EXPERTS * (MOE_BLOCK - 1)) // MOE_BLOCK)
    slots = n_blocks * MOE_BLOCK
    slot_tok = jnp.full((slots,), t, jnp.int32).at[dest].set(tok_flat[order])
    slot_w = jnp.zeros((slots,), h.dtype).at[dest].set(w_flat[order].astype(h.dtype))
    blk_e = jnp.minimum(jnp.searchsorted(pad_end, jnp.arange(n_blocks, dtype=jnp.int32) * MOE_BLOCK, side='right'), N_EXPERTS - 1)
    h_pad = jnp.concatenate([h, jnp.zeros((1, d), h.dtype)], axis=0)

    def step(acc, blk):
        tok, w, e = blk
        xb = h_pad[tok]
        hid = jax.nn.silu(xb @ w_gate[e]) * (xb @ w_up[e])
        return acc.at[tok].add((hid @ w_down[e]) * w[:, None]), None

    routed, _ = lax.scan(step, jnp.zeros((t + 1, d), h.dtype),
                         (slot_tok.reshape(n_blocks, MOE_BLOCK), slot_w.reshape(n_blocks, MOE_BLOCK), blk_e))
    shared = (jax.nn.silu(h @ ws_gate) * (h @ ws_up)) @ ws_down
    return shared + routed[:t]


def _layer(x, ctx_s, c, c_ctx, w_mod, b_mod, g_norm1, g_norm2, w_in, na_rpb, w_branch_na, conv_w, w_branch_sc,
           gla_gate_w, gla_gate_b, gla_norm_g, w_branch_gla, w_out, w_router, b_router, w_exp_gate, w_exp_up,
           w_exp_down, w_sh_gate, w_sh_up, w_sh_down, ctx_out):
    sh1, sc1, gt1, sh2, sc2, gt2 = jnp.split((jax.nn.silu(c) @ w_mod + b_mod)[:, None, :], N_MOD, axis=-1)
    csh1, csc1, cgt1, csh2, csc2, cgt2 = jnp.split(jax.nn.silu(c_ctx) @ w_mod + b_mod, N_MOD, axis=-1)

    lat = _split_cols(_modulate(x, g_norm1, sh1, sc1) @ w_in, IN_COLS)
    hc = _modulate(ctx_s, g_norm1, csh1, csc1)
    cx = _split_cols(hc @ w_in, IN_COLS) if ctx_out else _split_cols(hc @ w_in[:, :N_KV], KV_COLS)

    k_na_c = _heads(cx['k_na'], NA_HEADS)
    v_na_c = _heads(cx['v_na'], NA_HEADS)
    o_na = _na_latent(_heads(lat['q_na'], NA_HEADS), _heads(lat['k_na'], NA_HEADS), _heads(lat['v_na'], NA_HEADS),
                      k_na_c, v_na_c, na_rpb)
    o_sc = _short_conv(lat['b_sc'], lat['c_sc'], lat['x_sc'], conv_w)
    q_scale = GLA_DK ** -0.5
    s0 = jnp.zeros((x.shape[0], GLA_HEADS, GLA_DK, GLA_DV), jnp.float32)
    gcf, gcb = _gla_decay(cx['gate_gla'], gla_gate_w, gla_gate_b)
    q_gla_c = _heads(cx['q_gla'], GLA_HEADS) * q_scale if ctx_out else None
    o_gla_c, st_f, st_b = _gla_bidir(q_gla_c, _heads(cx['k_gla'], GLA_HEADS), _heads(cx['v_gla'], GLA_HEADS),
                                     gcf, gcb, s0, s0, ctx_out)
    glf, glb = _gla_decay(lat['gate_gla'], gla_gate_w, gla_gate_b)
    o_gla, _, _ = _gla_bidir(_heads(lat['q_gla'], GLA_HEADS) * q_scale, _heads(lat['k_gla'], GLA_HEADS),
                             _heads(lat['v_gla'], GLA_HEADS), glf, glb, st_f, st_b, True)
    o_gla = _gla_out(o_gla, lat['r_gla'], gla_norm_g)
    x = x + gt1 * _merge(o_na, o_sc, o_gla, lat['merge'], w_branch_na, w_branch_sc, w_branch_gla, w_out)
    if ctx_out:
        o_na_c = _attend_dense(_heads(cx['q_na'], NA_HEADS), k_na_c, v_na_c)
        o_sc_c = _short_conv(cx['b_sc'], cx['c_sc'], cx['x_sc'], conv_w)
        o_gla_c = _gla_out(o_gla_c, cx['r_gla'], gla_norm_g)
        ctx_s = ctx_s + cgt1 * _merge(o_na_c, o_sc_c, o_gla_c, cx['merge'], w_branch_na, w_branch_sc, w_branch_gla, w_out)

    d = x.shape[-1]
    tokens = _modulate(x, g_norm2, sh2, sc2).reshape(-1, d)
    if ctx_out:
        tokens = jnp.concatenate([tokens, _modulate(ctx_s, g_norm2, csh2, csc2).reshape(-1, d)], axis=0)
    y = _moe(tokens, w_router, b_router, w_exp_gate, w_exp_up, w_exp_down, w_sh_gate, w_sh_up, w_sh_down)
    n_lat = x.shape[0] * x.shape[1]
    x = x + gt2 * y[:n_lat].reshape(x.shape)
    if ctx_out:
        ctx_s = ctx_s + cgt2 * y[n_lat:].reshape(ctx_s.shape)
    return x, ctx_s


def setup_inputs(seed: int = 0) -> dict:
    key = jax.random.key(seed)
    ks = jax.random.split(key, 28)
    nrm = lambda k, shape, s: jax.random.normal(k, shape, jnp.float32) * s
    L = DEPTH
    return {
        'x': nrm(ks[0], (BATCH, SEQ, D_MODEL), 1.0),
        'c': nrm(ks[1], (BATCH, D_MODEL), 1.0),
        'ctx': nrm(ks[2], (BATCH, CTX_LEN, D_MODEL), 1.0),
        'c_ctx': nrm(ks[3], (D_MODEL,), 1.0),
        'w_mod': nrm(ks[4], (L, D_MODEL, N_MOD * D_MODEL), 0.5 * D_MODEL ** -0.5),
        'b_mod': nrm(ks[5], (L, N_MOD * D_MODEL), 0.02),
        'g_norm1': 1.0 + nrm(ks[6], (L, D_MODEL), 0.02),
        'g_norm2': 1.0 + nrm(ks[7], (L, D_MODEL), 0.02),
        'w_in': nrm(ks[8], (L, D_MODEL, N_IN), D_MODEL ** -0.5),
        'na_rpb': nrm(ks[9], (L, NA_HEADS, 2 * NA_WIN_R - 1, 2 * NA_WIN_C - 1), 0.1),
        'w_branch_na': nrm(ks[10], (L, NA_WIDTH, D_MODEL), NA_WIDTH ** -0.5),
        'conv_w': nrm(ks[11], (L, CONV_W, SC_WIDTH), CONV_W ** -0.5),
        'w_branch_sc': nrm(ks[12], (L, SC_WIDTH, D_MODEL), SC_WIDTH ** -0.5),
        'gla_gate_w': nrm(ks[13], (L, 2, GLA_GATE_RANK, GLA_KEY_WIDTH), GLA_GATE_RANK ** -0.5),
        'gla_gate_b': nrm(ks[14], (L, 2, GLA_KEY_WIDTH), 0.1),
        'gla_norm_g': 1.0 + nrm(ks[15], (L, GLA_DV), 0.02),
        'w_branch_gla': nrm(ks[16], (L, GLA_VAL_WIDTH, D_MODEL), GLA_VAL_WIDTH ** -0.5),
        'w_out': nrm(ks[17], (L, D_MODEL, D_MODEL), D_MODEL ** -0.5),
        'w_router': nrm(ks[18], (L, D_MODEL, N_EXPERTS), D_MODEL ** -0.5),
        'b_router': nrm(ks[19], (L, N_EXPERTS), 0.01),
        'w_exp_gate': nrm(ks[20], (L, N_EXPERTS, D_MODEL, EXPERT_FF), D_MODEL ** -0.5),
        'w_exp_up': nrm(ks[21], (L, N_EXPERTS, D_MODEL, EXPERT_FF), D_MODEL ** -0.5),
        'w_exp_down': nrm(ks[22], (L, N_EXPERTS, EXPERT_FF, D_MODEL), EXPERT_FF ** -0.5),
        'w_sh_gate': nrm(ks[23], (L, D_MODEL, EXPERT_FF), D_MODEL ** -0.5),
        'w_sh_up': nrm(ks[24], (L, D_MODEL, EXPERT_FF), D_MODEL ** -0.5),
        'w_sh_down': nrm(ks[25], (L, EXPERT_FF, D_MODEL), EXPERT_FF ** -0.5),
        'g_final': 1.0 + nrm(ks[26], (D_MODEL,), 0.02),
    }


def reference(x, c, ctx, c_ctx, w_mod, b_mod, g_norm1, g_norm2, w_in, na_rpb, w_branch_na, conv_w, w_branch_sc,
              gla_gate_w, gla_gate_b, gla_norm_g, w_branch_gla, w_out, w_router, b_router, w_exp_gate, w_exp_up,
              w_exp_down, w_sh_gate, w_sh_up, w_sh_down, g_final):
    ctx_s = ctx
    for i in range(DEPTH):
        x, ctx_s = _layer(x, ctx_s, c, c_ctx, w_mod[i], b_mod[i], g_norm1[i], g_norm2[i], w_in[i], na_rpb[i],
                          w_branch_na[i], conv_w[i], w_branch_sc[i], gla_gate_w[i], gla_gate_b[i], gla_norm_g[i],
                          w_branch_gla[i], w_out[i], w_router[i], b_router[i], w_exp_gate[i], w_exp_up[i],
                          w_exp_down[i], w_sh_gate[i], w_sh_up[i], w_sh_down[i], i < DEPTH - 1)
    return _rmsnorm(x, g_final)
```

```cpp
#include <hip/hip_runtime.h>
#include <cstdio>
#include <cstdint>

#define DBG_NROUTED 8
#ifndef MK_ONE_LAUNCH
#define MK_ONE_LAUNCH 1
#endif

#define LAS __attribute__((address_space(3)))
#define DI __device__ __forceinline__
typedef unsigned short bf16_t;
typedef short bf16x8 __attribute__((ext_vector_type(8)));
typedef short s16x4 __attribute__((ext_vector_type(4)));
typedef float f32x4 __attribute__((ext_vector_type(4)));
typedef float f32x16 __attribute__((ext_vector_type(16)));
typedef unsigned u32x4 __attribute__((ext_vector_type(4)));
typedef unsigned u32x2 __attribute__((ext_vector_type(2)));
typedef __bf16 bf16x2_t __attribute__((ext_vector_type(2)));
typedef float f32x2_t __attribute__((ext_vector_type(2)));

DI unsigned pk2(float lo, float hi) { f32x2_t v = {lo, hi}; bf16x2_t b = __builtin_convertvector(v, bf16x2_t); return __builtin_bit_cast(unsigned, b); }
DI float bf_lo(unsigned u) { return __uint_as_float(u << 16); }
DI float bf_hi(unsigned u) { return __uint_as_float(u & 0xffff0000u); }
DI float bf2f(bf16_t b) { return __uint_as_float(((unsigned)b) << 16); }
DI bf16_t f2bf(float f) { return (bf16_t)(pk2(f, 0.f) & 0xffffu); }
DI float wave_sum(float v) {
#pragma unroll
    for (int o = 1; o < 64; o <<= 1) v += __shfl_xor(v, o);
    return v;
}
DI float sigmoidf_(float x) { return 1.0f / (1.0f + __expf(-x)); }
DI float siluf_(float x) { return x / (1.0f + __expf(-x)); }

constexpr int D = 1024, NB = 8, SEQ = 2048, CTXL = 256, TL = NB * SEQ, TC = NB * CTXL, TA = TL + TC;
constexpr int NIN = 9248, ZS = 9472  , NKV = 2592;
constexpr int C_KNA = 0, C_VNA = 512, C_KGLA = 1024, C_VGLA = 1536, C_GATE = 2560, C_QNA = 2592, C_BSC = 3104, C_CSC = 3616, C_XSC = 4128, C_QGLA = 4640, C_RGLA = 5152, C_MERGE = 6176;
constexpr int OS = 2048;
constexpr int NE = 64, NEX = 65  , FF = 256, TOPK = 8;
constexpr float RMS_EPS = 1e-6f;

enum { I_X = 0, I_C, I_CTX, I_CCTX, I_WMOD, I_BMOD, I_G1, I_G2, I_WIN, I_RPB, I_WNA, I_CONVW, I_WSC, I_GGW, I_GGB, I_GNG, I_WGLA, I_WOUT, I_WR, I_BR, I_WEG, I_WEU, I_WED, I_WSG, I_WSU, I_WSD, I_GF, N_INPUTS };

constexpr size_t WS_CTL = 0;
constexpr size_t CTL_BYTES = 65536;
constexpr int CW_BAR = 0, CW_CNT = 8192;
constexpr size_t WS_MOD = WS_CTL + CTL_BYTES;
constexpr size_t MOD_BYTES = 2 * 9 * 6 * 1024 * 4;
constexpr size_t ZERO_BYTES = CTL_BYTES + 458752;
constexpr size_t WS_CTXS = WS_CTL + ZERO_BYTES;
constexpr size_t WS_TOKE = WS_CTXS + (size_t)TC * D * 4;
constexpr size_t WS_TOKP = WS_TOKE + (size_t)TA * 8 * 4;
constexpr size_t WS_TOKW = WS_TOKP + (size_t)TA * 8 * 4;
constexpr size_t WS_TOKR = WS_TOKW + (size_t)TA * 8 * 4;
constexpr size_t WS_ROWL = WS_TOKR + (size_t)TA * 8 * 4;
constexpr size_t ROWL_BYTES = ((size_t)TA * 9 + 256) * 4;
constexpr size_t WS_WBS = (WS_ROWL + ROWL_BYTES + 255) & ~(size_t)255;
constexpr size_t WB_WIN = 0, WB_WNA = WB_WIN + (size_t)ZS * D * 2, WB_WSC = WB_WNA + (size_t)D * 512 * 2, WB_WGLA = WB_WSC + (size_t)D * 512 * 2,
                 WB_WOUT = WB_WGLA + (size_t)D * D * 2, WB_WD = WB_WOUT + (size_t)D * D * 2, WBS_BYTES = WB_WD + (size_t)NEX * D * FF * 2;
constexpr size_t WS_R2 = WS_WBS + WBS_BYTES;
constexpr size_t HID_ROWS = (size_t)TA * 9 + 256;
constexpr size_t R2_BYTES = HID_ROWS * FF * 2;
constexpr size_t R2_OB = (size_t)TA * D * 2;
constexpr size_t WS_R1 = WS_R2 + R2_BYTES;
constexpr size_t R1_O = (size_t)TA * ZS * 2;
constexpr size_t R1_BYTES = R1_O + (size_t)TA * OS * 2;
constexpr size_t R1_H2 = R1_O;
constexpr size_t WS_END = WS_R1 + R1_BYTES;
static_assert(HID_ROWS * D * 2 <= R1_O + 0, "out_slot must fit below H2");
static_assert((size_t)NEX * 512 * D * 2 <= R1_O, "WguT fits");

constexpr int LDS_BYTES = 147456, MISC_OFF = 143360;
constexpr int GRID = 256;

#define XB_TMO      128
#define XB_XCNT(j)  (256  + 64 * (j))
#define XB_XSUB(j)  (1280 + 64 * (j))
#define XB_XGEN(j)  (2304 + 64 * (j))
#define XB_TOP      3328
#define XB_TOPGEN   3392
#define XCD_BAR_WORDS 3456
#define XB_SPIN_CAP (1u << 22)
DI unsigned xb_ld(unsigned* p)              { return __hip_atomic_load(p, __ATOMIC_RELAXED, __HIP_MEMORY_SCOPE_AGENT); }
DI unsigned xb_add(unsigned* p, unsigned v) { return __hip_atomic_fetch_add(p, v, __ATOMIC_RELAXED, __HIP_MEMORY_SCOPE_AGENT); }
DI unsigned xb_xcc_id() { return (unsigned)__builtin_amdgcn_s_getreg((3 << 11) | 20) & 0xFu; }
#define XB_SPIN(cond, bar) do { unsigned _sp = 0; while (cond) { __builtin_amdgcn_s_sleep(1); \
    if ((++_sp & 255u) == 0u) { if (xb_ld(&(bar)[XB_TMO])) break; if (_sp > XB_SPIN_CAP) { atomicAdd(&(bar)[XB_TMO], 1u); break; } } } } while (0)
struct XcdBarrier { unsigned* bar; unsigned x; volatile LAS unsigned* st; };
DI XcdBarrier xcd_barrier_post(unsigned* bar, volatile LAS unsigned* st) {
    XcdBarrier b; b.bar = bar; b.x = xb_xcc_id(); b.st = st;
    if (threadIdx.x == 0) (void)xb_add(&bar[XB_XCNT(b.x)], 1u);
    return b;
}
DI void xcd_barrier_complete(unsigned* bar, unsigned x, unsigned& nloc, unsigned& nx) {
    const unsigned G = gridDim.x * gridDim.y * gridDim.z;
    unsigned sum, cnt, mine, sp = 0u;
    for (;;) {
        sum = 0u; cnt = 0u; mine = 0u;
#pragma unroll
        for (unsigned j = 0; j < 16; ++j) { const unsigned c = xb_ld(&bar[XB_XCNT(j)]); sum += c; cnt += (c > 0u) ? 1u : 0u; mine = (j == x) ? c : mine; }
        if (sum == G) break;
        __builtin_amdgcn_s_sleep(1);
        if ((++sp & 255u) == 0u) { if (xb_ld(&bar[XB_TMO])) break; if (sp > XB_SPIN_CAP) { atomicAdd(&bar[XB_TMO], 1u); break; } }
    }
    nloc = mine > 0u ? mine : 1u; nx = cnt > 0u ? cnt : 1u;
}
DI void xcd_barrier(const XcdBarrier& b) {
    asm volatile("s_waitcnt vmcnt(0)" ::: "memory");
    __syncthreads();
    if (threadIdx.x == 0) {
        unsigned* bar = b.bar;
        __builtin_amdgcn_s_waitcnt(0);
        const unsigned bx = xb_xcc_id();
        unsigned nloc = b.st[0], nx = b.st[1];
        if (nloc == 0u) { xcd_barrier_complete(bar, bx, nloc, nx); b.st[0] = nloc; b.st[1] = nx; }
        const unsigned old = xb_add(&bar[XB_XSUB(bx)], 1u);
        const unsigned gen = old / nloc;
        if (old + 1u == (gen + 1u) * nloc) {
            __builtin_amdgcn_fence(__ATOMIC_RELEASE, "agent");
            asm volatile("s_waitcnt vmcnt(0)" ::: "memory");
            const unsigned og = xb_add(&bar[XB_TOP], 1u);
            const unsigned tg = og / nx;
            if (og + 1u == (tg + 1u) * nx) xb_add(&bar[XB_TOPGEN], 1u);
            else XB_SPIN(xb_ld(&bar[XB_TOPGEN]) == tg, bar);
            __builtin_amdgcn_fence(__ATOMIC_ACQUIRE, "agent");
            xb_add(&bar[XB_XGEN(bx)], 1u);
            asm volatile("s_waitcnt vmcnt(0)" ::: "memory");
        } else {
            XB_SPIN(xb_ld(&bar[XB_XGEN(bx)]) == gen, bar);
            __builtin_amdgcn_fence(__ATOMIC_ACQUIRE, "agent");
            asm volatile("s_waitcnt vmcnt(0)" ::: "memory");
        }
    }
    __syncthreads();
}

namespace pg8 {
constexpr int BM = 256, BK = 64, HALF = 128, HTB = HALF * BK * 2, STAGE_BYTES = 8 * HTB;
DI int lds_byte(int r, int c) { const int st = (r >> 4) * 2 + (c >> 5), rr = r & 15, cc = c & 31, ob = rr * 64 + cc * 2; return st * 1024 + (ob ^ (((ob >> 9) & 1) << 5)); }
DI void stage_rc(int b, int& R, int& C) { const int st = b / 1024, sb = b % 1024, swz = sb ^ (((sb >> 9) & 1) << 5); R = (st >> 1) * 16 + swz / 64; C = (st & 1) * 32 + (swz % 64) / 2; }
DI int perm32(int rho) { const int n = rho >> 4, i = rho & 15; return 8 * (i >> 2) + 4 * n + (i & 3); }

struct GUnit {
    const char* A;
    const char* B;
    const int* rows;
    int pm, pn;
    int valid;
    int aux;
};

template <bool GATHER, class Epi, class Sched>
DI void gemm_phase(LAS unsigned char* lds, const int K_, const int lda, const int ldb, const Sched& S, const Epi& E) {
    int K = K_; asm volatile("" : "+s"(K));
    int tid = threadIdx.x; asm volatile("" : "+v"(tid));
    const int wid = __builtin_amdgcn_readfirstlane(tid >> 6), lane = tid & 63, wr = wid >> 2, wc = wid & 3, fr = lane & 15, fq = lane >> 4;
    const int nt = K / BK;
    unsigned voffA[2], voffB[2], cc2[2]; int Rr[2];
#pragma unroll
    for (int i = 0; i < 2; ++i) { int R, C; stage_rc(tid * 16 + i * 8192, R, C); Rr[i] = R; cc2[i] = (unsigned)C * 2u; const int Rb = Epi::PERM ? ((R & ~31) + perm32(R & 31)) : R;
        voffA[i] = (unsigned)(R * lda + C) * 2u; voffB[i] = (unsigned)(Rb * ldb + C) * 2u; }
    const size_t hstepA = (size_t)HALF * lda * 2;
    const unsigned rowb = (unsigned)lda * 2u;
    const size_t kstep = (size_t)(BK * 2);
    const size_t hstepB = (size_t)HALF * ldb * 2;
    const unsigned ldsw = (unsigned)wid * 1024u;
    const int aoff = lds_byte(wr * 64 + fr, fq * 8), boff = lds_byte(wc * 32 + fr, fq * 8);
#define PG8_SA(b, h) (((b) * 2 + (h)) * HTB)
#define PG8_SB(b, h) ((4 + (b) * 2 + (h)) * HTB)
#define PG8_STAGE2(bufoff, gbase, o0, o1) do { \
        __builtin_amdgcn_global_load_lds((const unsigned*)((const char*)(gbase) + (o0)), (LAS unsigned*)(lds + (bufoff) + ldsw), 16, 0, 0); \
        __builtin_amdgcn_global_load_lds((const unsigned*)((const char*)(gbase) + (o1)), (LAS unsigned*)(lds + (bufoff) + ldsw + 8192), 16, 0, 0); } while (0)
#define PG8_STAGEB(bufoff, gbase) PG8_STAGE2(bufoff, gbase, voffB[0], voffB[1])
#define PG8_LDA(dst, b, h) do { _Pragma("unroll") for (int m = 0; m < 4; ++m) _Pragma("unroll") for (int k = 0; k < 2; ++k) dst[m][k] = *(const LAS bf16x8*)(lds + PG8_SA(b, h) + aoff + m * 2048 + k * 1024); } while (0)
#define PG8_LDB(dst, b, h) do { _Pragma("unroll") for (int n = 0; n < 2; ++n) _Pragma("unroll") for (int k = 0; k < 2; ++k) dst[n][k] = *(const LAS bf16x8*)(lds + PG8_SB(b, h) + boff + n * 2048 + k * 1024); } while (0)
#define PG8_MMA(ai, bj, At, Bt) do { __builtin_amdgcn_s_setprio(1); _Pragma("unroll") for (int m = 0; m < 4; ++m) _Pragma("unroll") for (int n = 0; n < 2; ++n) _Pragma("unroll") for (int k = 0; k < 2; ++k) \
        acc[ai][bj][m][n] = __builtin_amdgcn_mfma_f32_16x16x32_bf16(Bt[n][k], At[m][k], acc[ai][bj][m][n], 0, 0, 0); __builtin_amdgcn_s_setprio(0); } while (0)
#define PG8_WAIT_V(n) asm volatile("s_waitcnt vmcnt(" #n ")" ::: "memory")
#define PG8_WAIT_L(n) asm volatile("s_waitcnt lgkmcnt(" #n ")" ::: "memory")
#define PG8_BAR __builtin_amdgcn_s_barrier()
#define PG8_SCHED __builtin_amdgcn_sched_barrier(0)
#define PG8_RIDX(u, p0, p1) do { if (GATHER) { p0 = (unsigned)(u).rows[Rr[0]] | ((unsigned)(u).rows[Rr[0] + HALF] << 16); p1 = (unsigned)(u).rows[Rr[1]] | ((unsigned)(u).rows[Rr[1] + HALF] << 16); } } while (0)
#define PG8_STAGEA(bufoff, gbase, h, p0, p1) do { if (GATHER) { const unsigned _o0 = (((p0) >> (16 * (h))) & 0xffffu) * rowb + cc2[0], _o1 = (((p1) >> (16 * (h))) & 0xffffu) * rowb + cc2[1]; PG8_STAGE2(bufoff, gbase, _o0, _o1); } \
        else { PG8_STAGE2(bufoff, (gbase) + (h) * hstepA, voffA[0], voffA[1]); } } while (0)
    GUnit cur, nxt; int ui = 0;
    if (!S.next(0, cur)) return;
    f32x4 acc[2][2][4][2];
#pragma unroll
    for (int a = 0; a < 2; ++a)
#pragma unroll
        for (int b = 0; b < 2; ++b)
#pragma unroll
            for (int m = 0; m < 4; ++m)
#pragma unroll
                for (int n = 0; n < 2; ++n) acc[a][b][m][n] = (f32x4){0.f, 0.f, 0.f, 0.f};
    bf16x8 At[4][2], B0[2][2], B1[2][2];
    const char* cA = cur.A; const char* cB = cur.B;
    unsigned cp0 = 0u, cp1 = 0u; PG8_RIDX(cur, cp0, cp1);
    PG8_STAGEB(PG8_SB(0, 0), cB); PG8_STAGEA(PG8_SA(0, 0), cA, 0, cp0, cp1); PG8_STAGEB(PG8_SB(0, 1), cB + hstepB); PG8_STAGEA(PG8_SA(0, 1), cA, 1, cp0, cp1);
    if (wr == 1) PG8_BAR;
    PG8_WAIT_V(4); PG8_BAR;
    PG8_STAGEB(PG8_SB(1, 0), cB + kstep); PG8_STAGEA(PG8_SA(1, 0), cA + kstep, 0, cp0, cp1); PG8_STAGEB(PG8_SB(1, 1), cB + hstepB + kstep);
    PG8_WAIT_V(6); PG8_BAR;
    for (;;) {
        const bool has_next = S.next(ui + 1, nxt);
        const char* nA = has_next ? nxt.A : cA; const char* nB = has_next ? nxt.B : cB;
        unsigned np0 = cp0, np1 = cp1;
        if (has_next) PG8_RIDX(nxt, np0, np1);
        for (int t = 0; t < nt; t += 2) {
            const bool last = (t == nt - 2);
            const char* a1 = cA + (size_t)(t + 1) * kstep;
            const char* a2 = last ? nA : cA + (size_t)(t + 2) * kstep; const char* b2 = last ? nB : cB + (size_t)(t + 2) * kstep;
            const char* a3 = a2 + kstep; const char* b3 = b2 + kstep;
            const unsigned xp0 = last ? np0 : cp0, xp1 = last ? np1 : cp1;
            PG8_LDB(B0, 0, 0); PG8_SCHED; PG8_LDA(At, 0, 0); PG8_STAGEA(PG8_SA(1, 1), a1, 1, cp0, cp1);
            PG8_WAIT_L(8); PG8_BAR; PG8_WAIT_L(0); PG8_MMA(0, 0, At, B0); PG8_BAR; PG8_SCHED;
            PG8_LDB(B1, 0, 1); PG8_STAGEB(PG8_SB(0, 0), b2);
            PG8_BAR; PG8_WAIT_L(0); PG8_MMA(0, 1, At, B1); PG8_BAR;
            PG8_LDA(At, 0, 1); PG8_STAGEA(PG8_SA(0, 0), a2, 0, xp0, xp1);
            PG8_BAR; PG8_WAIT_L(0); PG8_MMA(1, 0, At, B0); PG8_BAR; PG8_SCHED;
            PG8_STAGEB(PG8_SB(0, 1), b2 + hstepB);
            PG8_WAIT_V(6); PG8_BAR; PG8_MMA(1, 1, At, B1); PG8_BAR;
            PG8_LDB(B0, 1, 0); PG8_SCHED; PG8_LDA(At, 1, 0); PG8_STAGEA(PG8_SA(0, 1), a2, 1, xp0, xp1);
            PG8_WAIT_L(8); PG8_BAR; PG8_WAIT_L(0); PG8_MMA(0, 0, At, B0); PG8_BAR; PG8_SCHED;
            PG8_LDB(B1, 1, 1); PG8_STAGEB(PG8_SB(1, 0), b3);
            PG8_BAR; PG8_WAIT_L(0); PG8_MMA(0, 1, At, B1); PG8_BAR;
            PG8_LDA(At, 1, 1); PG8_STAGEA(PG8_SA(1, 0), a3, 0, xp0, xp1);
            PG8_BAR; PG8_WAIT_L(0); PG8_MMA(1, 0, At, B0); PG8_BAR; PG8_SCHED;
            PG8_STAGEB(PG8_SB(1, 1), b3 + hstepB);
            PG8_WAIT_V(6); PG8_BAR; PG8_MMA(1, 1, At, B1); PG8_BAR;
        }
        E(acc, cur, wr, wc, fr, fq);
        if (!has_next) break;
#pragma unroll
        for (int a = 0; a < 2; ++a)
#pragma unroll
            for (int b = 0; b < 2; ++b)
#pragma unroll
                for (int m = 0; m < 4; ++m)
#pragma unroll
                    for (int n = 0; n < 2; ++n) acc[a][b][m][n] = (f32x4){0.f, 0.f, 0.f, 0.f};
        cur = nxt; cA = nA; cB = nB; cp0 = np0; cp1 = np1; ++ui;
    }
    PG8_WAIT_V(0);
    if (wr == 0) PG8_BAR;
    PG8_BAR;
#undef PG8_SA
#undef PG8_SB
#undef PG8_STAGE2
#undef PG8_STAGEB
#undef PG8_LDA
#undef PG8_LDB
#undef PG8_MMA
#undef PG8_WAIT_V
#undef PG8_WAIT_L
#undef PG8_BAR
#undef PG8_SCHED
#undef PG8_RIDX
#undef PG8_STAGEA
}

struct EpiStoreBf16 {
    static constexpr bool PERM = true;
    bf16_t* O; int ldc;
    DI void operator()(const f32x4 (&acc)[2][2][4][2], const GUnit& u, int wr, int wc, int fr, int fq) const {
        const int row0 = u.pm * BM + wr * 64 + fr, col0 = u.pn * BM + wc * 32 + 8 * fq;
#pragma unroll
        for (int ai = 0; ai < 2; ++ai)
#pragma unroll
            for (int m = 0; m < 4; ++m) { bf16_t* rowp = O + (size_t)(row0 + ai * HALF + m * 16) * ldc + col0;
#pragma unroll
                for (int bj = 0; bj < 2; ++bj) { const f32x4 v0 = acc[ai][bj][m][0], v1 = acc[ai][bj][m][1];
                    u32x4 w; w.x = pk2(v0[0], v0[1]); w.y = pk2(v0[2], v0[3]); w.z = pk2(v1[0], v1[1]); w.w = pk2(v1[2], v1[3]);
                    *(u32x4*)(rowp + bj * HALF) = w; } }
    }
};
template <int MODE> struct EpiGate {
    static constexpr bool PERM = true;
    bf16_t* Y; const bf16_t* Zg; int gcol0;
    DI void operator()(const f32x4 (&acc)[2][2][4][2], const GUnit& u, int wr, int wc, int fr, int fq) const {
        const int row0 = u.pm * BM + wr * 64 + fr, col0 = u.pn * BM + wc * 32 + 8 * fq;
#pragma unroll
        for (int ai = 0; ai < 2; ++ai)
#pragma unroll
            for (int m = 0; m < 4; ++m) { const size_t row = (size_t)(row0 + ai * HALF + m * 16); bf16_t* rowp = Y + row * D + col0; const bf16_t* gp = Zg + row * ZS + gcol0 + col0;
#pragma unroll
                for (int bj = 0; bj < 2; ++bj) { const f32x4 v0 = acc[ai][bj][m][0], v1 = acc[ai][bj][m][1];
                    const u32x4 g = *(const u32x4*)(gp + bj * HALF);
                    float r[8];
                    r[0] = v0[0] * sigmoidf_(bf_lo(g.x)); r[1] = v0[1] * sigmoidf_(bf_hi(g.x)); r[2] = v0[2] * sigmoidf_(bf_lo(g.y)); r[3] = v0[3] * sigmoidf_(bf_hi(g.y));
                    r[4] = v1[0] * sigmoidf_(bf_lo(g.z)); r[5] = v1[1] * sigmoidf_(bf_hi(g.z)); r[6] = v1[2] * sigmoidf_(bf_lo(g.w)); r[7] = v1[3] * sigmoidf_(bf_hi(g.w));
                    if (MODE == 1) { const u32x4 o = *(const u32x4*)(rowp + bj * HALF);
                        r[0] += bf_lo(o.x); r[1] += bf_hi(o.x); r[2] += bf_lo(o.y); r[3] += bf_hi(o.y); r[4] += bf_lo(o.z); r[5] += bf_hi(o.z); r[6] += bf_lo(o.w); r[7] += bf_hi(o.w); }
                    u32x4 w; w.x = pk2(r[0], r[1]); w.y = pk2(r[2], r[3]); w.z = pk2(r[4], r[5]); w.w = pk2(r[6], r[7]);
                    *(u32x4*)(rowp + bj * HALF) = w; } }
    }
};
struct EpiResid {
    static constexpr bool PERM = false;
    const float* xsrc; float* xdst; const float* csrc; float* cdst; const float* gate;
    DI void operator()(const f32x4 (&acc)[2][2][4][2], const GUnit& u, int wr, int wc, int fr, int fq) const {
        const int row0 = u.pm * BM + wr * 64 + fr, col0 = u.pn * BM + wc * 32 + 4 * fq;
        const bool isctx = (u.pm * BM) >= TL;
        const int mrow = isctx ? 8 : (u.pm * BM) / SEQ;
        const float* gp = gate + (size_t)mrow * 6144 + col0;
        f32x4 gv[2][2];
#pragma unroll
        for (int bj = 0; bj < 2; ++bj)
#pragma unroll
            for (int n = 0; n < 2; ++n) gv[bj][n] = *(const f32x4*)(gp + bj * HALF + n * 16);
        const float* sb = isctx ? csrc - (size_t)TL * D : xsrc; float* db = isctx ? cdst - (size_t)TL * D : xdst;
#pragma unroll
        for (int ai = 0; ai < 2; ++ai)
#pragma unroll
            for (int m = 0; m < 4; ++m) { const size_t off = (size_t)(row0 + ai * HALF + m * 16) * D + col0;
#pragma unroll
                for (int bj = 0; bj < 2; ++bj)
#pragma unroll
                    for (int n = 0; n < 2; ++n) { const f32x4 s = *(const f32x4*)(sb + off + bj * HALF + n * 16);
                        *(f32x4*)(db + off + bj * HALF + n * 16) = s + gv[bj][n] * acc[ai][bj][m][n]; } }
    }
};
struct EpiSwiGLU {
    static constexpr bool PERM = true;
    bf16_t* Hd;
    DI void operator()(const f32x4 (&acc)[2][2][4][2], const GUnit& u, int wr, int wc, int fr, int fq) const {
        const int r0 = wr * 64 + fr, col0 = u.pn * HALF + wc * 32 + 8 * fq;
#pragma unroll
        for (int ai = 0; ai < 2; ++ai)
#pragma unroll
            for (int m = 0; m < 4; ++m) { const int r = r0 + ai * HALF + m * 16;
                const f32x4 g0 = acc[ai][0][m][0], g1 = acc[ai][0][m][1], u0 = acc[ai][1][m][0], u1 = acc[ai][1][m][1];
                u32x4 w; w.x = pk2(siluf_(g0[0]) * u0[0], siluf_(g0[1]) * u0[1]); w.y = pk2(siluf_(g0[2]) * u0[2], siluf_(g0[3]) * u0[3]);
                w.z = pk2(siluf_(g1[0]) * u1[0], siluf_(g1[1]) * u1[1]); w.w = pk2(siluf_(g1[2]) * u1[2], siluf_(g1[3]) * u1[3]);
                if (r < u.valid) *(u32x4*)(Hd + (size_t)(u.aux + r) * FF + col0) = w; }
    }
};
struct EpiDown {
    static constexpr bool PERM = true;
    bf16_t* Os;
    DI void operator()(const f32x4 (&acc)[2][2][4][2], const GUnit& u, int wr, int wc, int fr, int fq) const {
        const int r0 = wr * 64 + fr, col0 = u.pn * BM + wc * 32 + 8 * fq;
#pragma unroll
        for (int ai = 0; ai < 2; ++ai)
#pragma unroll
            for (int m = 0; m < 4; ++m) { const int r = r0 + ai * HALF + m * 16; bf16_t* rowp = Os + (size_t)(u.aux + r) * D + col0;
#pragma unroll
                for (int bj = 0; bj < 2; ++bj) { const f32x4 v0 = acc[ai][bj][m][0], v1 = acc[ai][bj][m][1];
                    u32x4 w; w.x = pk2(v0[0], v0[1]); w.y = pk2(v0[2], v0[3]); w.z = pk2(v1[0], v1[1]); w.w = pk2(v1[2], v1[3]);
                    if (r < u.valid) *(u32x4*)(rowp + bj * HALF) = w; } }
    }
};

template <int nN> struct RectSched {
    const char* A; const char* B; int lda, ldb; int nM, exM, exN, exPm0, G, c;
    DI bool next(int i, GUnit& u) const {
        const int L = i * G + c; const int nmain = nM * nN;
        int pm, pn;
        if (L < nmain) { const int grp = L / (8 * nN), rem = L % (8 * nN); pm = grp * 8 + (rem & 7); pn = rem >> 3; }
        else { const int L2 = L - nmain; if (L2 >= exM * exN) return false; pm = exPm0 + (L2 & 7); pn = L2 >> 3; }
        u.A = A + (size_t)pm * BM * lda * 2; u.B = B + (size_t)pn * BM * ldb * 2; u.rows = nullptr; u.pm = pm; u.pn = pn; u.valid = BM; u.aux = 0; return true;
    }
};
template <bool GATHER, int npn> struct MoeSched {
    const LAS int* tb; const LAS int* rb; const LAS int* cn;
    const char* A; const int* rowl; const char* B; size_t bstride; int lda, ldb, G, c;
    DI bool next(int i, GUnit& u) const {
        const int L = i * G + c; const int ntile = __builtin_amdgcn_readfirstlane(tb[NEX]);
        if (L >= ntile * npn) return false;
        const int T = L / npn, pn = L % npn;
        int e = 0;
#pragma unroll 1
        for (int j = 1; j < NEX; ++j) e += (__builtin_amdgcn_readfirstlane(tb[j]) <= T) ? 1 : 0;
        const int ti = T - __builtin_amdgcn_readfirstlane(tb[e]), row0 = __builtin_amdgcn_readfirstlane(rb[e]) + ti * BM;
        u.B = B + (size_t)e * bstride + (size_t)pn * BM * ldb * 2;
        if (GATHER) { u.A = A; u.rows = rowl + row0; } else { u.A = A + (size_t)row0 * lda * 2; u.rows = nullptr; }
        u.pm = T; u.pn = pn; const int rem = __builtin_amdgcn_readfirstlane(cn[e]) - ti * BM; u.valid = rem < BM ? rem : BM; u.aux = row0; return true;
    }
};
}

struct Args { const float* in[N_INPUTS]; float* out; unsigned char* ws; int ph_lo, ph_hi; };
struct Frame {
    LAS unsigned char* lds; unsigned char* ws; const float* const* in; float* out;
    int tid, lane, wave, G, bid;
};
DI const float* modp(const Frame& F, int l, int r, int which) { return (const float*)(F.ws + WS_MOD) + ((size_t)(l * 9 + r) * 6 + which) * 1024; }

DI void tr_item(const float* W, int ldw, bf16_t* WT, int ldt, int k0, int n0, int drow0, LAS float* scr, int lane) {
#pragma unroll 8
    for (int i = 0; i < 32; ++i) { const int kk = 2 * i + (lane >> 5); scr[kk * 33 + (lane & 31)] = W[(size_t)(k0 + kk) * ldw + n0 + (lane & 31)]; }
    asm volatile("s_waitcnt lgkmcnt(0)" ::: "memory");
    const int c = lane & 7;
#pragma unroll
    for (int j = 0; j < 4; ++j) { const int n = (lane >> 3) + 8 * j; const LAS float* s = scr + (8 * c) * 33 + n;
        u32x4 o; o.x = pk2(s[0 * 33], s[1 * 33]); o.y = pk2(s[2 * 33], s[3 * 33]); o.z = pk2(s[4 * 33], s[5 * 33]); o.w = pk2(s[6 * 33], s[7 * 33]);
        *(u32x4*)(WT + (size_t)(drow0 + n) * ldt + k0 + 8 * c) = o; }
    asm volatile("s_waitcnt lgkmcnt(0)" ::: "memory");
}
template <int K, int N> DI void conv_plain(const Frame& F, const float* W, bf16_t* WT, int rot) {
    LAS float* scr = (LAS float*)(F.lds + F.wave * 16384);
    const int NGW = F.G * 8, gw = (F.bid * 8 + F.wave + rot) % NGW;
    constexpr int nblk = N / 32, nit = (K / 64) * nblk;
    for (int it = gw; it < nit; it += NGW) { const int kb = it / nblk, nb = it % nblk; tr_item(W, N, WT, K, kb * 64, nb * 32, nb * 32, scr, F.lane); }
}
DI void conv_gu(const Frame& F, int l, bf16_t* WT) {
    LAS float* scr = (LAS float*)(F.lds + F.wave * 16384);
    const int NGW = F.G * 8, gw = F.bid * 8 + F.wave;
    const int nit = NEX * 2 * 128;
    for (int it = gw; it < nit; it += NGW) {
        const int e = it / 256, r = it % 256, isup = r / 128, r2 = r % 128, kb = r2 / 8, nb = r2 % 8, n0 = nb * 32;
        const float* W = (e < NE) ? F.in[isup ? I_WEU : I_WEG] + ((size_t)l * NE + e) * D * FF : F.in[isup ? I_WSU : I_WSG] + (size_t)l * D * FF;
        const int drow0 = ((n0 >> 7) << 8) + (n0 & 127) + (isup ? 128 : 0);
        tr_item(W, FF, WT + (size_t)e * 512 * D, D, kb * 64, n0, drow0, scr, F.lane);
    }
}
DI void conv_down(const Frame& F, int l, bf16_t* WT) {
    LAS float* scr = (LAS float*)(F.lds + F.wave * 16384);
    const int NGW = F.G * 8, gw = F.bid * 8 + F.wave;
    const int nit = NEX * 128;
    for (int it = gw; it < nit; it += NGW) {
        const int e = it / 128, r = it % 128, kb = r / 32, nb = r % 32;
        const float* W = (e < NE) ? F.in[I_WED] + ((size_t)l * NE + e) * FF * D : F.in[I_WSD] + (size_t)l * FF * D;
        tr_item(W, D, WT + (size_t)e * D * FF, FF, kb * 64, nb * 32, nb * 32, scr, F.lane);
    }
}
DI void conv_small(const Frame& F, int l) {
    bf16_t* wb = (bf16_t*)(F.ws + WS_WBS);
    conv_plain<D, NIN>(F, F.in[I_WIN] + (size_t)l * D * NIN, (bf16_t*)((char*)wb + WB_WIN), 0);
    conv_plain<512, D>(F, F.in[I_WNA] + (size_t)l * 512 * D, (bf16_t*)((char*)wb + WB_WNA), 600);
    conv_plain<512, D>(F, F.in[I_WSC] + (size_t)l * 512 * D, (bf16_t*)((char*)wb + WB_WSC), 900);
    conv_plain<D, D>(F, F.in[I_WGLA] + (size_t)l * D * D, (bf16_t*)((char*)wb + WB_WGLA), 1200);
    conv_plain<D, D>(F, F.in[I_WOUT] + (size_t)l * D * D, (bf16_t*)((char*)wb + WB_WOUT), 1700);
    u32x4* z = (u32x4*)((char*)wb + WB_WIN + (size_t)NIN * D * 2);
    const int nz = (ZS - NIN) * D * 2 / 16;
    for (int i = F.bid * 512 + F.tid; i < nz; i += F.G * 512) z[i] = (u32x4){0u, 0u, 0u, 0u};
}
DI void mod_vectors(const Frame& F) {
    float* mod = (float*)(F.ws + WS_MOD);
    LAS float* SL = (LAS float*)F.lds;
    LAS float* PART = SL + 9 * 1024;
    __syncthreads();
    for (int i = F.tid; i < 9 * 1024; i += 512) { const float c = (i < 8 * 1024) ? F.in[I_C][i] : F.in[I_CCTX][i - 8 * 1024]; SL[i] = siluf_(c); }
    __syncthreads();
    for (int it = F.bid; it < 2 * 96; it += F.G) {
        const int l = it / 96, cb = it % 96, j = cb * 64 + F.lane;
        const float* W = F.in[I_WMOD] + (size_t)l * D * 6144 + j;
        float acc[9];
#pragma unroll
        for (int q = 0; q < 9; ++q) acc[q] = 0.f;
#pragma unroll 8
        for (int k = F.wave * 128; k < F.wave * 128 + 128; ++k) {
            const float w = W[(size_t)k * 6144];
#pragma unroll
            for (int q = 0; q < 9; ++q) acc[q] += SL[q * 1024 + k] * w;
        }
#pragma unroll
        for (int q = 0; q < 9; ++q) PART[(F.wave * 9 + q) * 64 + F.lane] = acc[q];
        __syncthreads();
        for (int q = F.wave; q < 9; q += 8) {
            float s = F.in[I_BMOD][l * 6144 + j];
#pragma unroll
            for (int w = 0; w < 8; ++w) s += PART[(w * 9 + q) * 64 + F.lane];
            mod[((size_t)(l * 9 + q)) * 6144 + j] = s;
        }
        __syncthreads();
    }
}

DI void load_row_f32(const float* p, int lane, float (&v)[16]) {
#pragma unroll
    for (int i = 0; i < 2; ++i) { const f32x4 a = *(const f32x4*)(p + 8 * lane + 512 * i), b = *(const f32x4*)(p + 8 * lane + 512 * i + 4);
        v[8 * i + 0] = a[0]; v[8 * i + 1] = a[1]; v[8 * i + 2] = a[2]; v[8 * i + 3] = a[3]; v[8 * i + 4] = b[0]; v[8 * i + 5] = b[1]; v[8 * i + 6] = b[2]; v[8 * i + 7] = b[3]; }
}
DI void store_row_f32(float* p, int lane, const float (&v)[16]) {
#pragma unroll
    for (int i = 0; i < 2; ++i) { *(f32x4*)(p + 8 * lane + 512 * i) = (f32x4){v[8 * i], v[8 * i + 1], v[8 * i + 2], v[8 * i + 3]}; *(f32x4*)(p + 8 * lane + 512 * i + 4) = (f32x4){v[8 * i + 4], v[8 * i + 5], v[8 * i + 6], v[8 * i + 7]}; }
}
DI void load_row_bf16(const bf16_t* p, int lane, float (&v)[16]) {
#pragma unroll
    for (int i = 0; i < 2; ++i) { const u32x4 a = *(const u32x4*)(p + 8 * lane + 512 * i);
        v[8 * i + 0] = bf_lo(a.x); v[8 * i + 1] = bf_hi(a.x); v[8 * i + 2] = bf_lo(a.y); v[8 * i + 3] = bf_hi(a.y); v[8 * i + 4] = bf_lo(a.z); v[8 * i + 5] = bf_hi(a.z); v[8 * i + 6] = bf_lo(a.w); v[8 * i + 7] = bf_hi(a.w); }
}
DI void store_row_bf16(bf16_t* p, int lane, const float (&v)[16]) {
#pragma unroll
    for (int i = 0; i < 2; ++i) { u32x4 w; w.x = pk2(v[8 * i], v[8 * i + 1]); w.y = pk2(v[8 * i + 2], v[8 * i + 3]); w.z = pk2(v[8 * i + 4], v[8 * i + 5]); w.w = pk2(v[8 * i + 6], v[8 * i + 7]);
        *(u32x4*)(p + 8 * lane + 512 * i) = w; }
}
DI void norm_mod(const float (&x)[16], const float* g, const float* shift, const float* scale, int lane, float (&h)[16]) {
    float ss = 0.f;
#pragma unroll
    for (int i = 0; i < 16; ++i) ss += x[i] * x[i];
    const float rstd = rsqrtf(wave_sum(ss) * (1.0f / D) + RMS_EPS);
    float gg[16], sh[16], sc[16]; load_row_f32(g, lane, gg); load_row_f32(shift, lane, sh); load_row_f32(scale, lane, sc);
#pragma unroll
    for (int i = 0; i < 16; ++i) h[i] = x[i] * rstd * gg[i] * (1.0f + sc[i]) + sh[i];
}

DI void phase_norm1_first(const Frame& F) {
    const int NGW = F.G * 8, gw = F.bid * 8 + F.wave;
    bf16_t* H = (bf16_t*)(F.ws + WS_R2);
    for (int t = gw; t < TA; t += NGW) {
        const bool isctx = t >= TL; const int r = isctx ? 8 : t / SEQ;
        const float* xr = isctx ? F.in[I_CTX] + (size_t)(t - TL) * D : F.in[I_X] + (size_t)t * D;
        float x[16], h[16]; load_row_f32(xr, F.lane, x);
        norm_mod(x, F.in[I_G1], modp(F, 0, r, 0), modp(F, 0, r, 1), F.lane, h);
        store_row_bf16(H + (size_t)t * D, F.lane, h);
    }
}

DI void phase_conv(const Frame& F, int l, int M) {
    const bf16_t* Z = (const bf16_t*)(F.ws + WS_R1); bf16_t* O = (bf16_t*)(F.ws + WS_R1 + R1_O);
    const float* cw = F.in[I_CONVW] + (size_t)l * 3 * 512;
    for (int it = F.bid * 512 + F.tid; it < M * 64; it += F.G * 512) {
        const int t = it >> 6, c0 = (it & 63) * 8;
        const int L = (t >= TL) ? CTXL : SEQ, pos = (t >= TL) ? (t - TL) % CTXL : t % SEQ;
        const bf16_t* zr = Z + (size_t)t * ZS;
        float u0[8], u1[8], u2[8], bb[8];
        { const u32x4 c = *(const u32x4*)(zr + C_CSC + c0), x = *(const u32x4*)(zr + C_XSC + c0), b = *(const u32x4*)(zr + C_BSC + c0);
          u1[0] = bf_lo(c.x) * bf_lo(x.x); u1[1] = bf_hi(c.x) * bf_hi(x.x); u1[2] = bf_lo(c.y) * bf_lo(x.y); u1[3] = bf_hi(c.y) * bf_hi(x.y);
          u1[4] = bf_lo(c.z) * bf_lo(x.z); u1[5] = bf_hi(c.z) * bf_hi(x.z); u1[6] = bf_lo(c.w) * bf_lo(x.w); u1[7] = bf_hi(c.w) * bf_hi(x.w);
          bb[0] = bf_lo(b.x); bb[1] = bf_hi(b.x); bb[2] = bf_lo(b.y); bb[3] = bf_hi(b.y); bb[4] = bf_lo(b.z); bb[5] = bf_hi(b.z); bb[6] = bf_lo(b.w); bb[7] = bf_hi(b.w); }
        if (pos > 0) { const u32x4 c = *(const u32x4*)(zr - ZS + C_CSC + c0), x = *(const u32x4*)(zr - ZS + C_XSC + c0);
          u0[0] = bf_lo(c.x) * bf_lo(x.x); u0[1] = bf_hi(c.x) * bf_hi(x.x); u0[2] = bf_lo(c.y) * bf_lo(x.y); u0[3] = bf_hi(c.y) * bf_hi(x.y);
          u0[4] = bf_lo(c.z) * bf_lo(x.z); u0[5] = bf_hi(c.z) * bf_hi(x.z); u0[6] = bf_lo(c.w) * bf_lo(x.w); u0[7] = bf_hi(c.w) * bf_hi(x.w); }
        else {
#pragma unroll
            for (int j = 0; j < 8; ++j) u0[j] = 0.f; }
        if (pos < L - 1) { const u32x4 c = *(const u32x4*)(zr + ZS + C_CSC + c0), x = *(const u32x4*)(zr + ZS + C_XSC + c0);
          u2[0] = bf_lo(c.x) * bf_lo(x.x); u2[1] = bf_hi(c.x) * bf_hi(x.x); u2[2] = bf_lo(c.y) * bf_lo(x.y); u2[3] = bf_hi(c.y) * bf_hi(x.y);
          u2[4] = bf_lo(c.z) * bf_lo(x.z); u2[5] = bf_hi(c.z) * bf_hi(x.z); u2[6] = bf_lo(c.w) * bf_lo(x.w); u2[7] = bf_hi(c.w) * bf_hi(x.w); }
        else {
#pragma unroll
            for (int j = 0; j < 8; ++j) u2[j] = 0.f; }
        float o[8];
#pragma unroll
        for (int j = 0; j < 8; ++j) o[j] = bb[j] * (u0[j] * cw[c0 + j] + u1[j] * cw[512 + c0 + j] + u2[j] * cw[1024 + c0 + j]);
        u32x4 w; w.x = pk2(o[0], o[1]); w.y = pk2(o[2], o[3]); w.z = pk2(o[4], o[5]); w.w = pk2(o[6], o[7]);
        *(u32x4*)(O + (size_t)t * OS + 512 + c0) = w;
    }
}

#define MFMA32(a, b, c) __builtin_amdgcn_mfma_f32_32x32x16_bf16((a), (b), (c), 0, 0, 0)
DI int crow(int reg, int h) { return (reg & 3) + 8 * (reg >> 2) + 4 * h; }
DI bf16x8 pack_step(const f32x16& x, int s) {
    u32x4 p; p.x = pk2(x[8 * s], x[8 * s + 1]); p.y = pk2(x[8 * s + 2], x[8 * s + 3]); p.z = pk2(x[8 * s + 4], x[8 * s + 5]); p.w = pk2(x[8 * s + 6], x[8 * s + 7]);
    return __builtin_bit_cast(bf16x8, p);
}
DI bf16x8 cat4(u32x2 a, u32x2 b) { u32x4 p; p.x = a.x; p.y = a.y; p.z = b.x; p.w = b.y; return __builtin_bit_cast(bf16x8, p); }

constexpr int NA_VT_STRIDE = 72;
DI void na_wave_unit(const Frame& F, const bf16_t* Z, bf16_t* O, const LAS float* rpb, LAS bf16_t* vt,
                     int qrow0, int head, int nwin, int winrow0  , int ctxrow0, int qgrid_row, int krow_first, int qcol0) {
    const int lane = F.lane, r = lane & 31, h = lane >> 5;
    bf16x8 qf[4];
    { const bf16_t* qp = Z + (size_t)(qrow0 + r) * ZS + C_QNA + head * 64 + 8 * h;
#pragma unroll
      for (int ks = 0; ks < 4; ++ks) qf[ks] = *(const bf16x8*)(qp + 16 * ks); }
    f32x16 o0, o1;
#pragma unroll
    for (int i = 0; i < 16; ++i) { o0[i] = 0.f; o1[i] = 0.f; }
    float mrun = -1e30f, lrun = 0.f;
    const int qc = qcol0 + r;
    int cs = qc - 8; cs = cs < 0 ? 0 : (cs > 48 ? 48 : cs);
    const int ntile = nwin + 4;
    for (int j = 0; j < ntile; ++j) {
        const bool isw = j < nwin;
        const int krow0 = isw ? winrow0 + j * 64 : ctxrow0 + (j - nwin) * 64;
        f32x16 s0, s1;
#pragma unroll
        for (int i = 0; i < 16; ++i) { s0[i] = 0.f; s1[i] = 0.f; }
        { const bf16_t* kp0 = Z + (size_t)(krow0 + r) * ZS + C_KNA + head * 64 + 8 * h; const bf16_t* kp1 = kp0 + (size_t)32 * ZS;
#pragma unroll
          for (int ks = 0; ks < 4; ++ks) { const bf16x8 k0 = *(const bf16x8*)(kp0 + 16 * ks), k1 = *(const bf16x8*)(kp1 + 16 * ks);
              s0 = MFMA32(k0, qf[ks], s0); s1 = MFMA32(k1, qf[ks], s1); } }
#pragma unroll
        for (int i = 0; i < 8; ++i) { const int p = lane + 64 * i, key = p >> 3, ds = p & 7;
            const u32x4 v = *(const u32x4*)(Z + (size_t)(krow0 + key) * ZS + C_VNA + head * 64 + 8 * ds);
            LAS bf16_t* w = vt + (8 * ds) * NA_VT_STRIDE + key;
            w[0 * NA_VT_STRIDE] = (bf16_t)(v.x & 0xffffu); w[1 * NA_VT_STRIDE] = (bf16_t)(v.x >> 16); w[2 * NA_VT_STRIDE] = (bf16_t)(v.y & 0xffffu); w[3 * NA_VT_STRIDE] = (bf16_t)(v.y >> 16);
            w[4 * NA_VT_STRIDE] = (bf16_t)(v.z & 0xffffu); w[5 * NA_VT_STRIDE] = (bf16_t)(v.z >> 16); w[6 * NA_VT_STRIDE] = (bf16_t)(v.w & 0xffffu); w[7 * NA_VT_STRIDE] = (bf16_t)(v.w >> 16); }
        float tmax = -1e30f;
        const int drow = isw ? (krow_first + j - qgrid_row + 7) : 0;
#pragma unroll
        for (int i = 0; i < 16; ++i) {
            const int kc0 = crow(i, h), kc1 = 32 + kc0;
            float a = s0[i] * 0.125f, b = s1[i] * 0.125f;
            if (isw) {
                int d0 = kc0 - qc; d0 = d0 < -15 ? -15 : (d0 > 15 ? 15 : d0); int d1 = kc1 - qc; d1 = d1 < -15 ? -15 : (d1 > 15 ? 15 : d1);
                a += rpb[(head * 15 + drow) * 31 + d0 + 15]; b += rpb[(head * 15 + drow) * 31 + d1 + 15];
                if (kc0 < cs || kc0 >= cs + 16) a = -1e30f;
                if (kc1 < cs || kc1 >= cs + 16) b = -1e30f;
            }
            s0[i] = a; s1[i] = b; tmax = fmaxf(tmax, fmaxf(a, b));
        }
        tmax = fmaxf(tmax, __shfl_xor(tmax, 32));
        const float mnew = fmaxf(mrun, tmax), alpha = __expf(mrun - mnew);
        float psum = 0.f;
#pragma unroll
        for (int i = 0; i < 16; ++i) { const float a = __expf(s0[i] - mnew), b = __expf(s1[i] - mnew); s0[i] = a; s1[i] = b; psum += a + b; }
        psum += __shfl_xor(psum, 32);
        lrun = lrun * alpha + psum; mrun = mnew;
#pragma unroll
        for (int i = 0; i < 16; ++i) { o0[i] *= alpha; o1[i] *= alpha; }
        asm volatile("s_waitcnt lgkmcnt(0)" ::: "memory");
#pragma unroll
        for (int nb = 0; nb < 2; ++nb)
#pragma unroll
            for (int s = 0; s < 2; ++s) {
                const bf16x8 pf = pack_step(nb ? s1 : s0, s);
                const int k0 = 32 * nb + 16 * s + 4 * h;
                const LAS bf16_t* v0p = vt + r * NA_VT_STRIDE + k0; const LAS bf16_t* v1p = vt + (32 + r) * NA_VT_STRIDE + k0;
                const bf16x8 va = cat4(*(const LAS u32x2*)v0p, *(const LAS u32x2*)(v0p + 8));
                const bf16x8 vb = cat4(*(const LAS u32x2*)v1p, *(const LAS u32x2*)(v1p + 8));
                o0 = MFMA32(va, pf, o0); o1 = MFMA32(vb, pf, o1);
            }
        asm volatile("s_waitcnt lgkmcnt(0)" ::: "memory");
    }
    const float inv = 1.0f / lrun;
    bf16_t* op = O + (size_t)(qrow0 + r) * OS + head * 64 + 4 * h;
#pragma unroll
    for (int g = 0; g < 4; ++g) {
        u32x2 w0, w1; w0.x = pk2(o0[4 * g] * inv, o0[4 * g + 1] * inv); w0.y = pk2(o0[4 * g + 2] * inv, o0[4 * g + 3] * inv);
        w1.x = pk2(o1[4 * g] * inv, o1[4 * g + 1] * inv); w1.y = pk2(o1[4 * g + 2] * inv, o1[4 * g + 3] * inv);
        *(u32x2*)(op + 8 * g) = w0; *(u32x2*)(op + 32 + 8 * g) = w1;
    }
}
DI void phase_na(const Frame& F, int l, bool ctx_out) {
    const bf16_t* Z = (const bf16_t*)(F.ws + WS_R1); bf16_t* O = (bf16_t*)(F.ws + WS_R1 + R1_O);
    LAS float* rpb = (LAS float*)(F.lds + 8 * NA_VT_STRIDE * 64 * 2);
    for (int i = F.tid; i < 8 * 15 * 31; i += 512) rpb[i] = F.in[I_RPB][(size_t)l * 8 * 15 * 31 + i];
    __syncthreads();
    LAS bf16_t* vt = (LAS bf16_t*)(F.lds + F.wave * NA_VT_STRIDE * 64 * 2);
    const int nlat = NB * 32 * 2, ntot = nlat + (ctx_out ? NB * 8 : 0);
#pragma unroll 1
    for (int u = F.bid; u < ntot; u += F.G) {
        int qrow0, nwin, winrow0, ctxrow0, qgr, kfirst, qcol0;
        if (u < nlat) { const int b = u >> 6, rr = (u >> 1) & 31, half = u & 1;
            int rs = rr - 4; rs = rs < 0 ? 0 : (rs > 24 ? 24 : rs);
            qrow0 = b * SEQ + rr * 64 + half * 32; nwin = 8; winrow0 = b * SEQ + rs * 64; ctxrow0 = TL + b * CTXL; qgr = rr; kfirst = rs; qcol0 = half * 32;
        } else { const int v = u - nlat, b = v >> 3, qb = v & 7;
            qrow0 = TL + b * CTXL + qb * 32; nwin = 0; winrow0 = 0; ctxrow0 = TL + b * CTXL; qgr = 0; kfirst = 0; qcol0 = 0;
        }
        na_wave_unit(F, Z, O, rpb, vt, qrow0, F.wave, nwin, winrow0, ctxrow0, qgr, kfirst, qcol0);
    }
    __syncthreads();
}

constexpr int GL_CUM = 0, GL_CUMS = 132, GL_QS = 33792, GL_KS = 51200, GL_RS = 136, GL_KDT = 68608, GL_TS = 72, GL_VT = 87040, GL_ST0 = 96256, GL_ST1 = 113664,
              GL_W2 = 131072, GL_B2 = 139264, GL_SEG = 139776;
DI void gla_chain(const Frame& F, int l, int chain, bool ctx_out) {
    const int vs = chain & 3, dir = (chain >> 2) & 1, hd = (chain >> 3) & 3, b = chain >> 5;
    const bf16_t* Z = (const bf16_t*)(F.ws + WS_R1);
    bf16_t* OD = (bf16_t*)(F.ws + WS_R2 + (dir ? R2_OB : 0));
    LAS float* CUM = (LAS float*)(F.lds + GL_CUM); LAS bf16_t* QS = (LAS bf16_t*)(F.lds + GL_QS); LAS bf16_t* KS = (LAS bf16_t*)(F.lds + GL_KS);
    LAS bf16_t* KDT = (LAS bf16_t*)(F.lds + GL_KDT); LAS bf16_t* VT = (LAS bf16_t*)(F.lds + GL_VT);
    LAS float* W2 = (LAS float*)(F.lds + GL_W2); LAS float* B2 = (LAS float*)(F.lds + GL_B2); LAS float* SEG = (LAS float*)(F.lds + GL_SEG);
    const int tid = F.tid, lane = F.lane, wave = F.wave, r = lane & 31, h = lane >> 5;
    __syncthreads();
    for (int i = tid; i < 16 * 128; i += 512) W2[i] = F.in[I_GGW][((size_t)(l * 2 + dir) * 16 + (i >> 7)) * 512 + hd * 128 + (i & 127)];
    if (tid < 128) B2[tid] = F.in[I_GGB][(size_t)(l * 2 + dir) * 512 + hd * 128 + tid];
    for (int i = tid; i < 64 * GL_RS / 2; i += 512) ((LAS unsigned*)(F.lds + GL_ST0))[i] = 0u;
    f32x16 S0, S1;
#pragma unroll
    for (int i = 0; i < 16; ++i) { S0[i] = 0.f; S1[i] = 0.f; }
    const int tau = tid >> 3, seg = tid & 7, d0 = seg * 16;
    __syncthreads();
    for (int s = 0; s < 36; ++s) {
        const bool isctx = s < 4;
        const int cc = isctx ? (dir ? 3 - s : s) : (dir ? 31 - (s - 4) : (s - 4));
        const int seq0 = isctx ? TL + b * CTXL : b * SEQ;
        const bool emit = !isctx || ctx_out;
        LAS bf16_t* STo = (LAS bf16_t*)(F.lds + ((s & 1) ? GL_ST1 : GL_ST0)); LAS bf16_t* STn = (LAS bf16_t*)(F.lds + ((s & 1) ? GL_ST0 : GL_ST1));
        const int trow = seq0 + cc * 64 + (dir ? 63 - tau : tau);
        const bf16_t* zr = Z + (size_t)trow * ZS;
        const u32x4 q0 = *(const u32x4*)(zr + C_QGLA + hd * 128 + d0), q1 = *(const u32x4*)(zr + C_QGLA + hd * 128 + d0 + 8);
        const u32x4 k0 = *(const u32x4*)(zr + C_KGLA + hd * 128 + d0), k1 = *(const u32x4*)(zr + C_KGLA + hd * 128 + d0 + 8);
        const u32x4 l0 = *(const u32x4*)(zr + C_GATE + dir * 16), l1 = *(const u32x4*)(zr + C_GATE + dir * 16 + 8);
        const u32x4 vv = *(const u32x4*)(zr + C_VGLA + hd * 256 + vs * 64 + seg * 8);
        {
            float lr[16];
            lr[0] = bf_lo(l0.x); lr[1] = bf_hi(l0.x); lr[2] = bf_lo(l0.y); lr[3] = bf_hi(l0.y); lr[4] = bf_lo(l0.z); lr[5] = bf_hi(l0.z); lr[6] = bf_lo(l0.w); lr[7] = bf_hi(l0.w);
            lr[8] = bf_lo(l1.x); lr[9] = bf_hi(l1.x); lr[10] = bf_lo(l1.y); lr[11] = bf_hi(l1.y); lr[12] = bf_lo(l1.z); lr[13] = bf_hi(l1.z); lr[14] = bf_lo(l1.w); lr[15] = bf_hi(l1.w);
            f32x4 a[4];
#pragma unroll
            for (int j = 0; j < 4; ++j) a[j] = *(const LAS f32x4*)(B2 + d0 + 4 * j);
#pragma unroll
            for (int i = 0; i < 16; ++i)
#pragma unroll
                for (int j = 0; j < 4; ++j) a[j] += lr[i] * *(const LAS f32x4*)(W2 + i * 128 + d0 + 4 * j);
#pragma unroll
            for (int j = 0; j < 4; ++j) { f32x4 g;
#pragma unroll
                for (int e = 0; e < 4; ++e) { const float x = a[j][e]; g[e] = (fminf(x, 0.f) - __logf(1.0f + __expf(-fabsf(x)))) * (1.0f / 16.0f); }
                *(LAS f32x4*)(CUM + tau * GL_CUMS + d0 + 4 * j) = g; }
        }
        __syncthreads();
        { const int d = tid & 127, sg = tid >> 7; float run = 0.f;
#pragma unroll
          for (int i = 0; i < 16; ++i) { LAS float* p = CUM + (sg * 16 + i) * GL_CUMS + d; run += *p; *p = run; }
          SEG[sg * 128 + d] = run; }
        __syncthreads();
        {
            float qv[16], kv[16];
            qv[0] = bf_lo(q0.x); qv[1] = bf_hi(q0.x); qv[2] = bf_lo(q0.y); qv[3] = bf_hi(q0.y); qv[4] = bf_lo(q0.z); qv[5] = bf_hi(q0.z); qv[6] = bf_lo(q0.w); qv[7] = bf_hi(q0.w);
            qv[8] = bf_lo(q1.x); qv[9] = bf_hi(q1.x); qv[10] = bf_lo(q1.y); qv[11] = bf_hi(q1.y); qv[12] = bf_lo(q1.z); qv[13] = bf_hi(q1.z); qv[14] = bf_lo(q1.w); qv[15] = bf_hi(q1.w);
            kv[0] = bf_lo(k0.x); kv[1] = bf_hi(k0.x); kv[2] = bf_lo(k0.y); kv[3] = bf_hi(k0.y); kv[4] = bf_lo(k0.z); kv[5] = bf_hi(k0.z); kv[6] = bf_lo(k0.w); kv[7] = bf_hi(k0.w);
            kv[8] = bf_lo(k1.x); kv[9] = bf_hi(k1.x); kv[10] = bf_lo(k1.y); kv[11] = bf_hi(k1.y); kv[12] = bf_lo(k1.z); kv[13] = bf_hi(k1.z); kv[14] = bf_lo(k1.w); kv[15] = bf_hi(k1.w);
            const int sgt = tau >> 4;
            float qs[16], ks[16];
#pragma unroll
            for (int j = 0; j < 4; ++j) {
                const f32x4 e0 = *(const LAS f32x4*)(SEG + d0 + 4 * j), e1 = *(const LAS f32x4*)(SEG + 128 + d0 + 4 * j), e2 = *(const LAS f32x4*)(SEG + 256 + d0 + 4 * j), e3 = *(const LAS f32x4*)(SEG + 384 + d0 + 4 * j);
                const f32x4 cl = *(const LAS f32x4*)(CUM + tau * GL_CUMS + d0 + 4 * j);
#pragma unroll
                for (int e = 0; e < 4; ++e) {
                    const float off = (sgt > 0 ? e0[e] : 0.f) + (sgt > 1 ? e1[e] : 0.f) + (sgt > 2 ? e2[e] : 0.f);
                    const float cum = cl[e] + off, last = (e0[e] + e1[e]) + (e2[e] + e3[e]);
                    const int jj = 4 * j + e;
                    qs[jj] = qv[jj] * 0.08838834764831845f * __expf(cum);
                    ks[jj] = kv[jj] * __expf(-cum);
                    KDT[(d0 + jj) * GL_TS + tau] = f2bf(kv[jj] * __expf(last - cum));
                }
            }
            u32x4 w;
            w.x = pk2(qs[0], qs[1]); w.y = pk2(qs[2], qs[3]); w.z = pk2(qs[4], qs[5]); w.w = pk2(qs[6], qs[7]); *(LAS u32x4*)(QS + tau * GL_RS + d0) = w;
            w.x = pk2(qs[8], qs[9]); w.y = pk2(qs[10], qs[11]); w.z = pk2(qs[12], qs[13]); w.w = pk2(qs[14], qs[15]); *(LAS u32x4*)(QS + tau * GL_RS + d0 + 8) = w;
            w.x = pk2(ks[0], ks[1]); w.y = pk2(ks[2], ks[3]); w.z = pk2(ks[4], ks[5]); w.w = pk2(ks[6], ks[7]); *(LAS u32x4*)(KS + tau * GL_RS + d0) = w;
            w.x = pk2(ks[8], ks[9]); w.y = pk2(ks[10], ks[11]); w.z = pk2(ks[12], ks[13]); w.w = pk2(ks[14], ks[15]); *(LAS u32x4*)(KS + tau * GL_RS + d0 + 8) = w;
            LAS bf16_t* vp = VT + (seg * 8) * GL_TS + tau;
            vp[0 * GL_TS] = (bf16_t)(vv.x & 0xffffu); vp[1 * GL_TS] = (bf16_t)(vv.x >> 16); vp[2 * GL_TS] = (bf16_t)(vv.y & 0xffffu); vp[3 * GL_TS] = (bf16_t)(vv.y >> 16);
            vp[4 * GL_TS] = (bf16_t)(vv.z & 0xffffu); vp[5 * GL_TS] = (bf16_t)(vv.z >> 16); vp[6 * GL_TS] = (bf16_t)(vv.w & 0xffffu); vp[7 * GL_TS] = (bf16_t)(vv.w >> 16);
        }
        __syncthreads();
        if (wave < 4) {
            if (emit) {
                const int vb = wave & 1, tb = wave >> 1;
                f32x16 a0, a1, oo;
#pragma unroll
                for (int i = 0; i < 16; ++i) { a0[i] = 0.f; a1[i] = 0.f; oo[i] = 0.f; }
#pragma unroll
                for (int kk = 0; kk < 8; ++kk) {
                    const bf16x8 qf = *(const LAS bf16x8*)(QS + (32 * tb + r) * GL_RS + 16 * kk + 8 * h);
                    const bf16x8 kf0 = *(const LAS bf16x8*)(KS + r * GL_RS + 16 * kk + 8 * h);
                    a0 = MFMA32(kf0, qf, a0);
                    if (tb == 1) { const bf16x8 kf1 = *(const LAS bf16x8*)(KS + (32 + r) * GL_RS + 16 * kk + 8 * h); a1 = MFMA32(kf1, qf, a1); }
                }
                const int tt = 32 * tb + r;
#pragma unroll
                for (int i = 0; i < 16; ++i) { const int sg0 = crow(i, h); if (sg0 > tt) a0[i] = 0.f; if (32 + sg0 > tt) a1[i] = 0.f; }
#pragma unroll
                for (int sb = 0; sb < 2; ++sb)
#pragma unroll
                    for (int st = 0; st < 2; ++st) {
                        if (sb == 1 && tb == 0) continue;
                        const bf16x8 pf = pack_step(sb ? a1 : a0, st);
                        const LAS bf16_t* vp = VT + (32 * vb + r) * GL_TS + 32 * sb + 16 * st + 4 * h;
                        const bf16x8 va = cat4(*(const LAS u32x2*)vp, *(const LAS u32x2*)(vp + 8));
                        oo = MFMA32(va, pf, oo);
                    }
#pragma unroll
                for (int kk = 0; kk < 8; ++kk) {
                    const bf16x8 sf = *(const LAS bf16x8*)(STo + (32 * vb + r) * GL_RS + 16 * kk + 8 * h);
                    const bf16x8 qf = *(const LAS bf16x8*)(QS + (32 * tb + r) * GL_RS + 16 * kk + 8 * h);
                    oo = MFMA32(sf, qf, oo);
                }
                const int orow = seq0 + cc * 64 + (dir ? 63 - tt : tt);
                bf16_t* op = OD + (size_t)orow * D + hd * 256 + vs * 64 + 32 * vb + 4 * h;
#pragma unroll
                for (int g = 0; g < 4; ++g) { u32x2 w; w.x = pk2(oo[4 * g], oo[4 * g + 1]); w.y = pk2(oo[4 * g + 2], oo[4 * g + 3]); *(u32x2*)(op + 8 * g) = w; }
            }
        } else {
            const int db = wave - 4, dd = 32 * db + r;
            const float dec = __expf((SEG[dd] + SEG[128 + dd]) + (SEG[256 + dd] + SEG[384 + dd]));
#pragma unroll
            for (int i = 0; i < 16; ++i) { S0[i] *= dec; S1[i] *= dec; }
#pragma unroll
            for (int kk = 0; kk < 4; ++kk) {
                const bf16x8 kf = *(const LAS bf16x8*)(KDT + dd * GL_TS + 16 * kk + 8 * h);
                const bf16x8 v0 = *(const LAS bf16x8*)(VT + r * GL_TS + 16 * kk + 8 * h);
                const bf16x8 v1 = *(const LAS bf16x8*)(VT + (32 + r) * GL_TS + 16 * kk + 8 * h);
                S0 = MFMA32(v0, kf, S0); S1 = MFMA32(v1, kf, S1);
            }
#pragma unroll
            for (int i = 0; i < 16; ++i) { const int v = crow(i, h); STn[v * GL_RS + dd] = f2bf(S0[i]); STn[(32 + v) * GL_RS + dd] = f2bf(S1[i]); }
        }
        __syncthreads();
    }
}
DI void phase_gla_fin(const Frame& F, int l, int M) {
    const int NGW = F.G * 8, gw = F.bid * 8 + F.wave, lane = F.lane;
    const bf16_t* Z = (const bf16_t*)(F.ws + WS_R1); bf16_t* O = (bf16_t*)(F.ws + WS_R1 + R1_O);
    const bf16_t* OFp = (const bf16_t*)(F.ws + WS_R2); const bf16_t* OBp = (const bf16_t*)(F.ws + WS_R2 + R2_OB);
    const float* gn = F.in[I_GNG] + (size_t)l * 256;
    for (int t = gw; t < M; t += NGW) {
        const u32x4 a0 = *(const u32x4*)(OFp + (size_t)t * D + 16 * lane), a1 = *(const u32x4*)(OFp + (size_t)t * D + 16 * lane + 8);
        const u32x4 b0 = *(const u32x4*)(OBp + (size_t)t * D + 16 * lane), b1 = *(const u32x4*)(OBp + (size_t)t * D + 16 * lane + 8);
        const u32x4 r0 = *(const u32x4*)(Z + (size_t)t * ZS + C_RGLA + 16 * lane), r1 = *(const u32x4*)(Z + (size_t)t * ZS + C_RGLA + 16 * lane + 8);
        float o[16], rr[16];
        o[0] = bf_lo(a0.x) + bf_lo(b0.x); o[1] = bf_hi(a0.x) + bf_hi(b0.x); o[2] = bf_lo(a0.y) + bf_lo(b0.y); o[3] = bf_hi(a0.y) + bf_hi(b0.y);
        o[4] = bf_lo(a0.z) + bf_lo(b0.z); o[5] = bf_hi(a0.z) + bf_hi(b0.z); o[6] = bf_lo(a0.w) + bf_lo(b0.w); o[7] = bf_hi(a0.w) + bf_hi(b0.w);
        o[8] = bf_lo(a1.x) + bf_lo(b1.x); o[9] = bf_hi(a1.x) + bf_hi(b1.x); o[10] = bf_lo(a1.y) + bf_lo(b1.y); o[11] = bf_hi(a1.y) + bf_hi(b1.y);
        o[12] = bf_lo(a1.z) + bf_lo(b1.z); o[13] = bf_hi(a1.z) + bf_hi(b1.z); o[14] = bf_lo(a1.w) + bf_lo(b1.w); o[15] = bf_hi(a1.w) + bf_hi(b1.w);
        rr[0] = bf_lo(r0.x); rr[1] = bf_hi(r0.x); rr[2] = bf_lo(r0.y); rr[3] = bf_hi(r0.y); rr[4] = bf_lo(r0.z); rr[5] = bf_hi(r0.z); rr[6] = bf_lo(r0.w); rr[7] = bf_hi(r0.w);
        rr[8] = bf_lo(r1.x); rr[9] = bf_hi(r1.x); rr[10] = bf_lo(r1.y); rr[11] = bf_hi(r1.y); rr[12] = bf_lo(r1.z); rr[13] = bf_hi(r1.z); rr[14] = bf_lo(r1.w); rr[15] = bf_hi(r1.w);
        float ss = 0.f;
#pragma unroll
        for (int i = 0; i < 16; ++i) ss += o[i] * o[i];
        ss += __shfl_xor(ss, 1); ss += __shfl_xor(ss, 2); ss += __shfl_xor(ss, 4); ss += __shfl_xor(ss, 8);
        const float rstd = rsqrtf(ss * (1.0f / 256.0f) + RMS_EPS);
        const int v0 = (lane & 15) * 16;
        float y[16];
#pragma unroll
        for (int i = 0; i < 16; ++i) y[i] = o[i] * rstd * gn[v0 + i] * siluf_(rr[i]);
        u32x4 w0, w1; w0.x = pk2(y[0], y[1]); w0.y = pk2(y[2], y[3]); w0.z = pk2(y[4], y[5]); w0.w = pk2(y[6], y[7]);
        w1.x = pk2(y[8], y[9]); w1.y = pk2(y[10], y[11]); w1.z = pk2(y[12], y[13]); w1.w = pk2(y[14], y[15]);
        *(u32x4*)(O + (size_t)t * OS + 1024 + 16 * lane) = w0; *(u32x4*)(O + (size_t)t * OS + 1024 + 16 * lane + 8) = w1;
    }
}

DI void phase_router(const Frame& F, int l, int M) {
    LAS float* H2F = (LAS float*)F.lds;
    bf16_t* H2 = (bf16_t*)(F.ws + WS_R1 + R1_H2);
    const float* xres = F.out; const float* cres = (const float*)(F.ws + WS_CTXS);
    const float* WR = F.in[I_WR] + (size_t)l * D * NE;
    int* toke = (int*)(F.ws + WS_TOKE); int* tokp = (int*)(F.ws + WS_TOKP); float* tokw = (float*)(F.ws + WS_TOKW);
    unsigned* cnt = (unsigned*)(F.ws + WS_CTL) + CW_CNT + 128 * l;
    const int lane = F.lane, wave = F.wave;
    const float brt = F.in[I_BR][l * NE + lane];
    const int npass = (M + 31) / 32;
    for (int ps = F.bid; ps < npass; ps += F.G) {
        __syncthreads();
        for (int rr = 0; rr < 4; ++rr) {
            const int row = 4 * wave + rr, t = ps * 32 + row;
            float h[16];
            if (t < M) {
                const bool isctx = t >= TL; const int mr = isctx ? 8 : t / SEQ;
                float x[16]; load_row_f32(isctx ? cres + (size_t)(t - TL) * D : xres + (size_t)t * D, lane, x);
                norm_mod(x, F.in[I_G2] + (size_t)l * D, modp(F, l, mr, 3), modp(F, l, mr, 4), lane, h);
                store_row_bf16(H2 + (size_t)t * D, lane, h);
            } else {
#pragma unroll
                for (int i = 0; i < 16; ++i) h[i] = 0.f; }
#pragma unroll
            for (int i = 0; i < 2; ++i) { *(LAS f32x4*)(H2F + row * 1024 + 8 * lane + 512 * i) = (f32x4){h[8 * i], h[8 * i + 1], h[8 * i + 2], h[8 * i + 3]};
                *(LAS f32x4*)(H2F + row * 1024 + 8 * lane + 512 * i + 4) = (f32x4){h[8 * i + 4], h[8 * i + 5], h[8 * i + 6], h[8 * i + 7]}; }
        }
        __syncthreads();
        float acc[32];
#pragma unroll
        for (int i = 0; i < 32; ++i) acc[i] = 0.f;
        for (int k = 128 * wave; k < 128 * wave + 128; k += 4) {
            const float w0 = WR[(size_t)k * NE + lane], w1 = WR[(size_t)(k + 1) * NE + lane], w2 = WR[(size_t)(k + 2) * NE + lane], w3 = WR[(size_t)(k + 3) * NE + lane];
#pragma unroll
            for (int t = 0; t < 32; ++t) { const f32x4 hv = *(const LAS f32x4*)(H2F + t * 1024 + k); acc[t] += hv[0] * w0 + hv[1] * w1 + hv[2] * w2 + hv[3] * w3; }
        }
        __syncthreads();
#pragma unroll
        for (int t = 0; t < 32; ++t) H2F[(wave * 32 + t) * 64 + lane] = acc[t];
        __syncthreads();
        for (int rr = 0; rr < 4; ++rr) {
            const int row = 4 * wave + rr, t = ps * 32 + row;
            if (t >= M) continue;
            float logit = 0.f;
#pragma unroll
            for (int w = 0; w < 8; ++w) logit += H2F[(w * 32 + row) * 64 + lane];
            const float score = sigmoidf_(logit), sel = score + brt;
            float g1 = sel; g1 = fmaxf(g1, __shfl_xor(g1, 1)); g1 = fmaxf(g1, __shfl_xor(g1, 2)); g1 = fmaxf(g1, __shfl_xor(g1, 4));
            const unsigned long long bm = __ballot(sel == g1);
            const unsigned gm = (unsigned)((bm >> (lane & ~7)) & 0xffull);
            const int first = __builtin_ctz(gm);
            float g2 = ((lane & 7) == first) ? -INFINITY : sel; g2 = fmaxf(g2, __shfl_xor(g2, 1)); g2 = fmaxf(g2, __shfl_xor(g2, 2)); g2 = fmaxf(g2, __shfl_xor(g2, 4));
            const float gs = g1 + g2; const int g = lane >> 3;
            int grank = 0;
#pragma unroll
            for (int j = 0; j < 8; ++j) { const float o = __shfl(gs, 8 * j); grank += (o > gs || (o == gs && j < g)) ? 1 : 0; }
            const bool gsel = grank < 4;
            const float ms = gsel ? sel : -INFINITY;
            int rank = 0;
#pragma unroll 4
            for (int j = 0; j < 64; ++j) { const float o = __int_as_float(__builtin_amdgcn_readlane(__float_as_int(ms), j)); rank += (o > ms || (o == ms && j < lane)) ? 1 : 0; }
            const bool chosen = gsel && rank < 8;
            const unsigned long long cb = __ballot(chosen);
            const float ssum = wave_sum(chosen ? score : 0.f);
            if (chosen) {
                const int j = __builtin_popcountll(cb & ((1ull << lane) - 1ull));
                const unsigned p = atomicAdd(cnt + lane, 1u);
                if (j < 8) { toke[(size_t)t * 8 + j] = lane; tokp[(size_t)t * 8 + j] = (int)p; tokw[(size_t)t * 8 + j] = score / ssum * 2.5f; }
            }
        }
    }
    __syncthreads();
}
DI void moe_tables(const Frame& F, int l, int M) {
    LAS int* tb = (LAS int*)(F.lds + MISC_OFF + 64); LAS int* rb = tb + 72; LAS int* cn = rb + 72;
    const unsigned* cnt = (const unsigned*)(F.ws + WS_CTL) + CW_CNT + 128 * l;
    __syncthreads();
    if (F.tid < NE) cn[F.tid] = (int)__hip_atomic_load(cnt + F.tid, __ATOMIC_RELAXED, __HIP_MEMORY_SCOPE_AGENT);
    if (F.tid == NE) cn[NE] = M;
    __syncthreads();
    if (F.tid == 0) { int t = 0, r = 0; for (int e = 0; e < NEX; ++e) { tb[e] = t; rb[e] = r; t += (cn[e] + 255) >> 8; r += cn[e]; } tb[NEX] = t; }
    __syncthreads();
}
DI void phase_route_tables(const Frame& F, int l, int M) {
    moe_tables(F, l, M);
    const LAS int* rb = (const LAS int*)(F.lds + MISC_OFF + 64) + 72;
    const int* toke = (const int*)(F.ws + WS_TOKE); const int* tokp = (const int*)(F.ws + WS_TOKP);
    int* tokr = (int*)(F.ws + WS_TOKR); int* rowl = (int*)(F.ws + WS_ROWL);
    for (int i = F.bid * 512 + F.tid; i < M * 8; i += F.G * 512) { const int row = rb[toke[i]] + tokp[i]; tokr[i] = row; rowl[row] = i >> 3; }
    const int shb = rb[NE];
    for (int i = F.bid * 512 + F.tid; i < M + 256; i += F.G * 512) rowl[shb + i] = (i < M) ? i : 0;
}
DI void phase_combine(const Frame& F, int l, int M) {
    moe_tables(F, l, M);
    const LAS int* rb = (const LAS int*)(F.lds + MISC_OFF + 64) + 72;
    const int shb = rb[NE];
    const int NGW = F.G * 8, gw = F.bid * 8 + F.wave, lane = F.lane;
    const bf16_t* OS_ = (const bf16_t*)(F.ws + WS_R1);
    const int* tokr = (const int*)(F.ws + WS_TOKR); const float* tokw = (const float*)(F.ws + WS_TOKW);
    float* xres = F.out; float* cres = (float*)(F.ws + WS_CTXS);
    bf16_t* H = (bf16_t*)(F.ws + WS_R2);
    for (int t = gw; t < M; t += NGW) {
        const bool isctx = t >= TL; const int mr = isctx ? 8 : t / SEQ;
        float y[16]; load_row_bf16(OS_ + (size_t)(shb + t) * D, lane, y);
#pragma unroll
        for (int j = 0; j < DBG_NROUTED; ++j) { const int row = tokr[(size_t)t * 8 + j]; const float w = tokw[(size_t)t * 8 + j]; float v[16]; load_row_bf16(OS_ + (size_t)row * D, lane, v);
#pragma unroll
            for (int i = 0; i < 16; ++i) y[i] += w * v[i]; }
        float* xr = isctx ? cres + (size_t)(t - TL) * D : xres + (size_t)t * D;
        float x[16], g[16]; load_row_f32(xr, lane, x); load_row_f32(modp(F, l, mr, 5), lane, g);
#pragma unroll
        for (int i = 0; i < 16; ++i) x[i] += g[i] * y[i];
        if (l == 0) {
            store_row_f32(xr, lane, x);
            float h[16]; norm_mod(x, F.in[I_G1] + D, modp(F, 1, mr, 0), modp(F, 1, mr, 1), lane, h);
            store_row_bf16(H + (size_t)t * D, lane, h);
        } else {
            float ss = 0.f;
#pragma unroll
            for (int i = 0; i < 16; ++i) ss += x[i] * x[i];
            const float rstd = rsqrtf(wave_sum(ss) * (1.0f / D) + RMS_EPS);
            float gf[16]; load_row_f32(F.in[I_GF], lane, gf);
#pragma unroll
            for (int i = 0; i < 16; ++i) x[i] = x[i] * rstd * gf[i];
            store_row_f32(xr, lane, x);
        }
    }
}

constexpr int PH_PER_LAYER = 10, N_PHASES = 2 + 2 * PH_PER_LAYER;
template <class T> DI T* opaque_ptr(T* p) {
    unsigned long long v = (unsigned long long)p; unsigned lo = (unsigned)v, hi = (unsigned)(v >> 32);
    asm volatile("" : "+s"(lo), "+s"(hi)); return (T*)(__attribute__((address_space(1))) T*)(((unsigned long long)hi << 32) | lo);
}
template <int KIND> DI void run_phase(const Frame& F0, const int l0) {
    Frame F = F0; int l = l0; asm volatile("" : "+s"(l));
    F.ws = opaque_ptr(F0.ws); F.out = opaque_ptr(F0.out);
    { int t = F0.tid; asm volatile("" : "+v"(t)); F.tid = t; F.lane = t & 63; F.wave = __builtin_amdgcn_readfirstlane(t >> 6); }
    unsigned char* const ws = F.ws;
    const bool ctx_out = (l == 0);
    const int M = ctx_out ? TA : TL;
    if constexpr (KIND == 0) { mod_vectors(F); conv_small(F, 0); conv_down(F, 0, (bf16_t*)(ws + WS_WBS + WB_WD)); }
    if constexpr (KIND == 1) { phase_norm1_first(F); }
    if constexpr (KIND == 2) {
        pg8::RectSched<37> S{(const char*)(ws + WS_R2), (const char*)(ws + WS_WBS + WB_WIN), D, D, ctx_out ? 72 : 64, ctx_out ? 0 : 8, ctx_out ? 0 : 11, 64, F.G, F.bid};
        pg8::EpiStoreBf16 E{(bf16_t*)(ws + WS_R1), ZS};
        pg8::gemm_phase<false>(F.lds, D, D, D, S, E);
    }
    if constexpr (KIND == 3) {
        for (int ch = F.bid; ch < 256; ch += F.G) gla_chain(F, l, ch, ctx_out);
        phase_na(F, l, ctx_out);
        phase_conv(F, l, M);
    }
    if constexpr (KIND == 4) { phase_gla_fin(F, l, M); }
    if constexpr (KIND == 5) {
        const char* Ob = (const char*)(ws + WS_R1 + R1_O); bf16_t* Y = (bf16_t*)(ws + WS_R2); const bf16_t* Zb = (const bf16_t*)(ws + WS_R1);
        { pg8::RectSched<4> S{Ob, (const char*)(ws + WS_WBS + WB_WNA), OS, 512, M / 256, 0, 0, 0, F.G, F.bid}; pg8::EpiGate<0> E{Y, Zb, C_MERGE}; pg8::gemm_phase<false>(F.lds, 512, OS, 512, S, E); }
        { pg8::RectSched<4> S{Ob + 512 * 2, (const char*)(ws + WS_WBS + WB_WSC), OS, 512, M / 256, 0, 0, 0, F.G, F.bid}; pg8::EpiGate<1> E{Y, Zb, C_MERGE + 1024}; pg8::gemm_phase<false>(F.lds, 512, OS, 512, S, E); }
        { pg8::RectSched<4> S{Ob + 1024 * 2, (const char*)(ws + WS_WBS + WB_WGLA), OS, D, M / 256, 0, 0, 0, F.G, F.bid}; pg8::EpiGate<1> E{Y, Zb, C_MERGE + 2048}; pg8::gemm_phase<false>(F.lds, D, OS, D, S, E); }
    }
    if constexpr (KIND == 6) {
        pg8::RectSched<4> S{(const char*)(ws + WS_R2), (const char*)(ws + WS_WBS + WB_WOUT), D, D, M / 256, 0, 0, 0, F.G, F.bid};
        pg8::EpiResid E{l == 0 ? F.in[I_X] : F.out, F.out, l == 0 ? F.in[I_CTX] : (const float*)(ws + WS_CTXS), (float*)(ws + WS_CTXS), modp(F, l, 0, 2)};
        pg8::gemm_phase<false>(F.lds, D, D, D, S, E);
    }
    if constexpr (KIND == 7) { phase_router(F, l, M); conv_gu(F, l, (bf16_t*)(ws + WS_R1)); }
    if constexpr (KIND == 8) { phase_route_tables(F, l, M); if (l == 0) conv_small(F, 1); }
    if constexpr (KIND == 9) {
        moe_tables(F, l, M);
        const LAS int* tb = (const LAS int*)(F.lds + MISC_OFF + 64);
        pg8::MoeSched<true, 2> S{tb, tb + 72, tb + 144, (const char*)(ws + WS_R1 + R1_H2), (const int*)(ws + WS_ROWL), (const char*)(ws + WS_R1), (size_t)512 * D * 2, D, D, F.G, F.bid};
        pg8::EpiSwiGLU E{(bf16_t*)(ws + WS_R2)};
        pg8::gemm_phase<true>(F.lds, D, D, D, S, E);
    }
    if constexpr (KIND == 10) {
        moe_tables(F, l, M);
        const LAS int* tb = (const LAS int*)(F.lds + MISC_OFF + 64);
        pg8::MoeSched<false, 4> S{tb, tb + 72, tb + 144, (const char*)(ws + WS_R2), nullptr, (const char*)(ws + WS_WBS + WB_WD), (size_t)D * FF * 2, FF, FF, F.G, F.bid};
        pg8::EpiDown E{(bf16_t*)(ws + WS_R1)};
        pg8::gemm_phase<false>(F.lds, FF, FF, FF, S, E);
    }
    if constexpr (KIND == 11) { phase_combine(F, l, M); if (l == 0) conv_down(F, 1, (bf16_t*)(ws + WS_WBS + WB_WD)); }
}
DI void make_frame(Frame& F, const Args& args, unsigned char* lds_raw) {
    F.lds = (LAS unsigned char*)lds_raw; F.ws = args.ws; F.in = args.in; F.out = args.out;
    F.tid = threadIdx.x; F.lane = F.tid & 63; F.wave = __builtin_amdgcn_readfirstlane(F.tid >> 6); F.G = GRID; F.bid = blockIdx.x;
}
template <int KIND> __global__ void __launch_bounds__(512, 2) fwd_k(Args args) {
    extern __shared__ __attribute__((aligned(16))) unsigned char lds_raw[];
    Frame F; make_frame(F, args, lds_raw);
    run_phase<KIND>(F, args.ph_lo);
}
#if MK_ONE_LAUNCH
__global__ void __launch_bounds__(512, 2) fwd(Args args) {
    extern __shared__ __attribute__((aligned(16))) unsigned char lds_raw[];
    Frame F; make_frame(F, args, lds_raw);
    volatile LAS unsigned* MISC = (volatile LAS unsigned*)(F.lds + MISC_OFF);
    if (F.tid < 4) MISC[F.tid] = 0u;
    __syncthreads();
    XcdBarrier bar = xcd_barrier_post((unsigned*)(F.ws + WS_CTL) + CW_BAR, MISC);
    run_phase<0>(F, 0); xcd_barrier(bar);
    run_phase<1>(F, 0); xcd_barrier(bar);
#pragma unroll 1
    for (int l = 0; l < 2; ++l) {
        run_phase<2>(F, l); xcd_barrier(bar);
        run_phase<3>(F, l); xcd_barrier(bar);
        run_phase<4>(F, l); xcd_barrier(bar);
        run_phase<5>(F, l); xcd_barrier(bar);
        run_phase<6>(F, l); xcd_barrier(bar);
        run_phase<7>(F, l); xcd_barrier(bar);
        run_phase<8>(F, l); xcd_barrier(bar);
        run_phase<9>(F, l); xcd_barrier(bar);
        run_phase<10>(F, l); xcd_barrier(bar);
        run_phase<11>(F, l); xcd_barrier(bar);
    }
}
#endif

template <int KIND> static bool prep_kernel() { return hipFuncSetAttribute((const void*)fwd_k<KIND>, hipFuncAttributeMaxDynamicSharedMemorySize, LDS_BYTES) == hipSuccess; }
template <int KIND> static void launch_k(int grid, hipStream_t stream, Args a, int l) { a.ph_lo = l; a.ph_hi = KIND; hipLaunchKernelGGL(fwd_k<KIND>, dim3(grid), dim3(512), LDS_BYTES, stream, a); }
extern "C" void kernel_launch(void* const* d_in, const int* in_sizes, int n_in, void* d_out, int out_size, void* d_ws, size_t ws_size, hipStream_t stream) {
    static int grid = 0;
    if (grid == 0) {
        if (n_in != N_INPUTS || ws_size < WS_END) { fprintf(stderr, "kernel_launch: need %d inputs and %zu bytes of workspace; got %d, %zu\n", N_INPUTS, (size_t)WS_END, n_in, ws_size); grid = -1; return; }
        int dev = 0, cus = 0;
        if (hipGetDevice(&dev) != hipSuccess || hipDeviceGetAttribute(&cus, hipDeviceAttributeMultiprocessorCount, dev) != hipSuccess) { grid = -1; return; }
#if MK_ONE_LAUNCH
        if (hipFuncSetAttribute((const void*)fwd, hipFuncAttributeMaxDynamicSharedMemorySize, LDS_BYTES) != hipSuccess) { grid = -1; return; }
#else
        bool ok = prep_kernel<0>() && prep_kernel<1>() && prep_kernel<2>() && prep_kernel<3>() && prep_kernel<4>() && prep_kernel<5>() && prep_kernel<6>() && prep_kernel<7>() && prep_kernel<8>() && prep_kernel<9>() && prep_kernel<10>() && prep_kernel<11>();
        if (!ok) { fprintf(stderr, "kernel_launch: hipFuncSetAttribute failed\n"); grid = -1; return; }
#endif
        (void)hipGetLastError();
        if (cus < GRID) { fprintf(stderr, "kernel_launch: built for a %d-CU device, found %d CUs\n", GRID, cus); grid = -1; return; }
        grid = GRID;
    }
    if (grid < 0) return;
    if (hipMemsetAsync((char*)d_ws + WS_CTL, 0, ZERO_BYTES, stream) != hipSuccess) return;
    Args a{};
    for (int i = 0; i < N_INPUTS; ++i) a.in[i] = (const float*)d_in[i];
    a.out = (float*)d_out; a.ws = (unsigned char*)d_ws;
#if MK_ONE_LAUNCH
    a.ph_lo = 0; a.ph_hi = N_PHASES;
    hipLaunchKernelGGL(fwd, dim3(grid), dim3(512), LDS_BYTES, stream, a);
#else
    launch_k<0>(grid, stream, a, 0); launch_k<1>(grid, stream, a, 0);
    for (int l = 0; l < 2; ++l) {
        launch_k<2>(grid, stream, a, l); launch_k<3>(grid, stream, a, l); launch_k<4>(grid, stream, a, l); launch_k<5>(grid, stream, a, l); launch_k<6>(grid, stream, a, l);
#ifdef DBG_STOP6
        break;
#endif
        launch_k<7>(grid, stream, a, l); launch_k<8>(grid, stream, a, l); launch_k<9>(grid, stream, a, l); launch_k<10>(grid, stream, a, l); launch_k<11>(grid, stream, a, l);
#ifdef DBG_STOP11
        break;
#endif
    }
#endif
}
```

```cpp
#include <hip/hip_runtime.h>
#include <cstdio>
#include <cstdint>

#define DBG_NROUTED 8
#ifndef REPEAT_KIND
#define REPEAT_KIND -1
#endif
#ifndef MK_ONE_LAUNCH
#define MK_ONE_LAUNCH 1
#endif

#define LAS __attribute__((address_space(3)))
#define DI __device__ __forceinline__
typedef unsigned short bf16_t;
typedef short bf16x8 __attribute__((ext_vector_type(8)));
typedef short s16x4 __attribute__((ext_vector_type(4)));
typedef float f32x4 __attribute__((ext_vector_type(4)));
typedef float f32x16 __attribute__((ext_vector_type(16)));
typedef unsigned u32x4 __attribute__((ext_vector_type(4)));
typedef unsigned u32x2 __attribute__((ext_vector_type(2)));
typedef __bf16 bf16x2_t __attribute__((ext_vector_type(2)));
typedef float f32x2_t __attribute__((ext_vector_type(2)));

DI unsigned pk2(float lo, float hi) { f32x2_t v = {lo, hi}; bf16x2_t b = __builtin_convertvector(v, bf16x2_t); return __builtin_bit_cast(unsigned, b); }
DI float bf_lo(unsigned u) { return __uint_as_float(u << 16); }
DI float bf_hi(unsigned u) { return __uint_as_float(u & 0xffff0000u); }
DI float bf2f(bf16_t b) { return __uint_as_float(((unsigned)b) << 16); }
DI bf16_t f2bf(float f) { return (bf16_t)(pk2(f, 0.f) & 0xffffu); }
DI float wave_sum(float v) {
#pragma unroll
    for (int o = 1; o < 64; o <<= 1) v += __shfl_xor(v, o);
    return v;
}
DI float sigmoidf_(float x) { return 1.0f / (1.0f + __expf(-x)); }
DI float siluf_(float x) { return x / (1.0f + __expf(-x)); }

constexpr int D = 1024, NB = 8, SEQ = 2048, CTXL = 256, TL = NB * SEQ, TC = NB * CTXL, TA = TL + TC;
constexpr int NIN = 9248, ZS = 9472  , NKV = 2592;
constexpr int C_KNA = 0, C_VNA = 512, C_KGLA = 1024, C_VGLA = 1536, C_GATE = 2560, C_QNA = 2592, C_BSC = 3104, C_CSC = 3616, C_XSC = 4128, C_QGLA = 4640, C_RGLA = 5152, C_MERGE = 6176;
constexpr int OS = 2048;
constexpr int NE = 64, NEX = 65  , FF = 256, TOPK = 8;
constexpr float RMS_EPS = 1e-6f;

enum { I_X = 0, I_C, I_CTX, I_CCTX, I_WMOD, I_BMOD, I_G1, I_G2, I_WIN, I_RPB, I_WNA, I_CONVW, I_WSC, I_GGW, I_GGB, I_GNG, I_WGLA, I_WOUT, I_WR, I_BR, I_WEG, I_WEU, I_WED, I_WSG, I_WSU, I_WSD, I_GF, N_INPUTS };

constexpr size_t WS_CTL = 0;
constexpr size_t CTL_BYTES = 65536;
constexpr int CW_BAR = 0, CW_CNT = 8192;
constexpr size_t WS_MOD = WS_CTL + CTL_BYTES;
constexpr size_t MOD_BYTES = 2 * 9 * 6 * 1024 * 4;
constexpr size_t ZERO_BYTES = CTL_BYTES + 458752;
constexpr size_t WS_CTXS = WS_CTL + ZERO_BYTES;
constexpr size_t WS_TOKE = WS_CTXS + (size_t)TC * D * 4;
constexpr size_t WS_TOKP = WS_TOKE + (size_t)TA * 8 * 4;
constexpr size_t WS_TOKW = WS_TOKP + (size_t)TA * 8 * 4;
constexpr size_t WS_TOKR = WS_TOKW + (size_t)TA * 8 * 4;
constexpr size_t WS_ROWL = WS_TOKR + (size_t)TA * 8 * 4;
constexpr size_t ROWL_BYTES = ((size_t)TA * 9 + 256) * 4;
constexpr size_t WS_WRT = (WS_ROWL + ROWL_BYTES + 255) & ~(size_t)255;
constexpr size_t WRT_BYTES = (size_t)2 * 2 * NE * D * 2;
constexpr size_t WS_WBS = WS_WRT + WRT_BYTES;
constexpr size_t WB_WIN = 0, WB_WNA = WB_WIN + (size_t)ZS * D * 2, WB_WSC = WB_WNA + (size_t)D * 512 * 2, WB_WGLA = WB_WSC + (size_t)D * 512 * 2,
                 WB_WOUT = WB_WGLA + (size_t)D * D * 2, WB_WD = WB_WOUT + (size_t)D * D * 2, WBS_BYTES = WB_WD + (size_t)NEX * D * FF * 2;
constexpr size_t WS_R2 = WS_WBS + WBS_BYTES;
constexpr size_t HID_ROWS = (size_t)TA * 9 + 256;
constexpr size_t R2_BYTES = HID_ROWS * FF * 2;
constexpr size_t R2_OB = (size_t)TA * D * 2;
constexpr size_t WS_R1 = WS_R2 + R2_BYTES;
constexpr size_t R1_O = (size_t)TA * ZS * 2;
constexpr size_t R1_BYTES = R1_O + (size_t)TA * OS * 2;
constexpr size_t R1_H2 = R1_O;
constexpr size_t WS_END = WS_R1 + R1_BYTES;
static_assert(HID_ROWS * D * 2 <= R1_O + 0, "out_slot must fit below H2");
static_assert((size_t)NEX * 512 * D * 2 <= R1_O, "WguT fits");

constexpr int LDS_BYTES = 147456, MISC_OFF = 143360;
constexpr int GRID = 256;

#define XB_TMO      128
#define XB_XCNT(j)  (256  + 64 * (j))
#define XB_XSUB(j)  (1280 + 64 * (j))
#define XB_XGEN(j)  (2304 + 64 * (j))
#define XB_TOP      3328
#define XB_TOPGEN   3392
#define XCD_BAR_WORDS 3456
#define XB_SPIN_CAP (1u << 22)
DI unsigned xb_ld(unsigned* p)              { return __hip_atomic_load(p, __ATOMIC_RELAXED, __HIP_MEMORY_SCOPE_AGENT); }
DI unsigned xb_add(unsigned* p, unsigned v) { return __hip_atomic_fetch_add(p, v, __ATOMIC_RELAXED, __HIP_MEMORY_SCOPE_AGENT); }
DI unsigned xb_xcc_id() { return (unsigned)__builtin_amdgcn_s_getreg((3 << 11) | 20) & 0xFu; }
#define XB_SPIN(cond, bar) do { unsigned _sp = 0; while (cond) { __builtin_amdgcn_s_sleep(1); \
    if ((++_sp & 255u) == 0u) { if (xb_ld(&(bar)[XB_TMO])) break; if (_sp > XB_SPIN_CAP) { atomicAdd(&(bar)[XB_TMO], 1u); break; } } } } while (0)
struct XcdBarrier { unsigned* bar; unsigned x; volatile LAS unsigned* st; };
DI XcdBarrier xcd_barrier_post(unsigned* bar, volatile LAS unsigned* st) {
    XcdBarrier b; b.bar = bar; b.x = xb_xcc_id(); b.st = st;
    if (threadIdx.x == 0) (void)xb_add(&bar[XB_XCNT(b.x)], 1u);
    return b;
}
DI void xcd_barrier_complete(unsigned* bar, unsigned x, unsigned& nloc, unsigned& nx) {
    const unsigned G = gridDim.x * gridDim.y * gridDim.z;
    unsigned sum, cnt, mine, sp = 0u;
    for (;;) {
        sum = 0u; cnt = 0u; mine = 0u;
#pragma unroll
        for (unsigned j = 0; j < 16; ++j) { const unsigned c = xb_ld(&bar[XB_XCNT(j)]); sum += c; cnt += (c > 0u) ? 1u : 0u; mine = (j == x) ? c : mine; }
        if (sum == G) break;
        __builtin_amdgcn_s_sleep(1);
        if ((++sp & 255u) == 0u) { if (xb_ld(&bar[XB_TMO])) break; if (sp > XB_SPIN_CAP) { atomicAdd(&bar[XB_TMO], 1u); break; } }
    }
    nloc = mine > 0u ? mine : 1u; nx = cnt > 0u ? cnt : 1u;
}
DI void xcd_barrier(const XcdBarrier& b) {
    asm volatile("s_waitcnt vmcnt(0)" ::: "memory");
    __syncthreads();
    if (threadIdx.x == 0) {
        unsigned* bar = b.bar;
        __builtin_amdgcn_s_waitcnt(0);
        const unsigned bx = xb_xcc_id();
        unsigned nloc = b.st[0], nx = b.st[1];
        if (nloc == 0u) { xcd_barrier_complete(bar, bx, nloc, nx); b.st[0] = nloc; b.st[1] = nx; }
        const unsigned old = xb_add(&bar[XB_XSUB(bx)], 1u);
        const unsigned gen = old / nloc;
        if (old + 1u == (gen + 1u) * nloc) {
            __builtin_amdgcn_fence(__ATOMIC_RELEASE, "agent");
            asm volatile("s_waitcnt vmcnt(0)" ::: "memory");
            const unsigned og = xb_add(&bar[XB_TOP], 1u);
            const unsigned tg = og / nx;
            if (og + 1u == (tg + 1u) * nx) xb_add(&bar[XB_TOPGEN], 1u);
            else XB_SPIN(xb_ld(&bar[XB_TOPGEN]) == tg, bar);
            __builtin_amdgcn_fence(__ATOMIC_ACQUIRE, "agent");
            xb_add(&bar[XB_XGEN(bx)], 1u);
            asm volatile("s_waitcnt vmcnt(0)" ::: "memory");
        } else {
            XB_SPIN(xb_ld(&bar[XB_XGEN(bx)]) == gen, bar);
            __builtin_amdgcn_fence(__ATOMIC_ACQUIRE, "agent");
            asm volatile("s_waitcnt vmcnt(0)" ::: "memory");
        }
    }
    __syncthreads();
}

namespace pg8 {
constexpr int BM = 256, BK = 64, HALF = 128, HTB = HALF * BK * 2, STAGE_BYTES = 8 * HTB;
DI int lds_byte(int r, int c) { const int st = (r >> 4) * 2 + (c >> 5), rr = r & 15, cc = c & 31, ob = rr * 64 + cc * 2; return st * 1024 + (ob ^ (((ob >> 9) & 1) << 5)); }
DI void stage_rc(int b, int& R, int& C) { const int st = b / 1024, sb = b % 1024, swz = sb ^ (((sb >> 9) & 1) << 5); R = (st >> 1) * 16 + swz / 64; C = (st & 1) * 32 + (swz % 64) / 2; }
DI int perm32(int rho) { const int n = rho >> 4, i = rho & 15; return 8 * (i >> 2) + 4 * n + (i & 3); }

struct GUnit {
    const char* A;
    const char* B;
    const int* rows;
    int pm, pn;
    int valid;
    int aux;
};

template <bool GATHER, class Epi, class Sched>
DI void gemm_phase(LAS unsigned char* lds, const int tid_, const int K_, const int lda, const int ldb, const Sched& S, const Epi& E) {
    int K = K_; asm volatile("" : "+s"(K));
    int tid = tid_; asm volatile("" : "+v"(tid));
    const int wid = __builtin_amdgcn_readfirstlane(tid >> 6), lane = tid & 63, wr = wid >> 2, wc = wid & 3, fr = lane & 15, fq = lane >> 4;
    const int nt = K / BK;
    unsigned voffA, voffB, cc2, ro;
    { int R, C; stage_rc(tid * 16, R, C); ro = (unsigned)R * 4u; cc2 = (unsigned)C * 2u; const int Rb = Epi::PERM ? ((R & ~31) + perm32(R & 31)) : R;
      voffA = (unsigned)(R * lda + C) * 2u; voffB = (unsigned)(Rb * ldb + C) * 2u; }
    const size_t hstepA = (size_t)HALF * lda * 2, qstepA = (size_t)64 * lda * 2, qstepB = (size_t)64 * ldb * 2;
    const unsigned rowb = (unsigned)lda * 2u;
    const size_t kstep = (size_t)(BK * 2);
    const size_t hstepB = (size_t)HALF * ldb * 2;
    const unsigned ldsw = (unsigned)wid * 1024u;
    const int aoff = lds_byte(wr * 64 + fr, fq * 8), boff = lds_byte(wc * 32 + fr, fq * 8);
#define PG8_SA(b, h) (((b) * 2 + (h)) * HTB)
#define PG8_SB(b, h) ((4 + (b) * 2 + (h)) * HTB)
#define PG8_STAGE2(bufoff, gbase, o0, o1) do { \
        __builtin_amdgcn_global_load_lds((const unsigned*)((const char*)(gbase) + (o0)), (LAS unsigned*)(lds + (bufoff) + ldsw), 16, 0, 0); \
        __builtin_amdgcn_global_load_lds((const unsigned*)((const char*)(gbase) + (o1)), (LAS unsigned*)(lds + (bufoff) + ldsw + 8192), 16, 0, 0); } while (0)
#define PG8_STAGEB(bufoff, gbase) do { \
        __builtin_amdgcn_global_load_lds((const unsigned*)((const char*)(gbase) + voffB), (LAS unsigned*)(lds + (bufoff) + ldsw), 16, 0, 0); \
        __builtin_amdgcn_global_load_lds((const unsigned*)((const char*)(gbase) + qstepB + voffB), (LAS unsigned*)(lds + (bufoff) + ldsw + 8192), 16, 0, 0); } while (0)
#define PG8_LDA(dst, b, h) do { _Pragma("unroll") for (int m = 0; m < 4; ++m) _Pragma("unroll") for (int k = 0; k < 2; ++k) dst[m][k] = *(const LAS bf16x8*)(lds + PG8_SA(b, h) + aoff + m * 2048 + k * 1024); } while (0)
#define PG8_LDB(dst, b, h) do { _Pragma("unroll") for (int n = 0; n < 2; ++n) _Pragma("unroll") for (int k = 0; k < 2; ++k) dst[n][k] = *(const LAS bf16x8*)(lds + PG8_SB(b, h) + boff + n * 2048 + k * 1024); } while (0)
#define PG8_MMA(ai, bj, At, Bt) do { __builtin_amdgcn_s_setprio(1); _Pragma("unroll") for (int m = 0; m < 4; ++m) _Pragma("unroll") for (int n = 0; n < 2; ++n) _Pragma("unroll") for (int k = 0; k < 2; ++k) \
        acc[ai][bj][m][n] = __builtin_amdgcn_mfma_f32_16x16x32_bf16(Bt[n][k], At[m][k], acc[ai][bj][m][n], 0, 0, 0); __builtin_amdgcn_s_setprio(0); } while (0)
#define PG8_WAIT_V(n) asm volatile("s_waitcnt vmcnt(" #n ")" ::: "memory")
#define PG8_WAIT_L(n) asm volatile("s_waitcnt lgkmcnt(" #n ")" ::: "memory")
#define PG8_BAR __builtin_amdgcn_s_barrier()
#define PG8_SCHED __builtin_amdgcn_sched_barrier(0)
#define PG8_RIDX(u, p0, p1) do { if (GATHER) { const char* _rb = (const char*)(u).rows; \
        p0 = (unsigned)*(const int*)(_rb + ro) | ((unsigned)*(const int*)(_rb + ro + HALF * 4) << 16); p1 = (unsigned)*(const int*)(_rb + ro + 64 * 4) | ((unsigned)*(const int*)(_rb + ro + (64 + HALF) * 4) << 16); } } while (0)
#define PG8_STAGEA(bufoff, gbase, h, p0, p1) do { if (GATHER) { const unsigned _o0 = (((p0) >> (16 * (h))) & 0xffffu) * rowb + cc2, _o1 = (((p1) >> (16 * (h))) & 0xffffu) * rowb + cc2; PG8_STAGE2(bufoff, gbase, _o0, _o1); } \
        else { __builtin_amdgcn_global_load_lds((const unsigned*)((const char*)(gbase) + (h) * hstepA + voffA), (LAS unsigned*)(lds + (bufoff) + ldsw), 16, 0, 0); \
               __builtin_amdgcn_global_load_lds((const unsigned*)((const char*)(gbase) + (h) * hstepA + qstepA + voffA), (LAS unsigned*)(lds + (bufoff) + ldsw + 8192), 16, 0, 0); } } while (0)
    GUnit cur, nxt; int ui = 0;
    if (!S.next(0, cur)) return;
    f32x4 acc[2][2][4][2];
#pragma unroll
    for (int a = 0; a < 2; ++a)
#pragma unroll
        for (int b = 0; b < 2; ++b)
#pragma unroll
            for (int m = 0; m < 4; ++m)
#pragma unroll
                for (int n = 0; n < 2; ++n) acc[a][b][m][n] = (f32x4){0.f, 0.f, 0.f, 0.f};
    bf16x8 At[4][2], B0[2][2], B1[2][2];
    const char* cA = cur.A; const char* cB = cur.B;
    unsigned cp0 = 0u, cp1 = 0u; PG8_RIDX(cur, cp0, cp1);
    PG8_STAGEB(PG8_SB(0, 0), cB); PG8_STAGEA(PG8_SA(0, 0), cA, 0, cp0, cp1); PG8_STAGEB(PG8_SB(0, 1), cB + hstepB); PG8_STAGEA(PG8_SA(0, 1), cA, 1, cp0, cp1);
    if (wr == 1) PG8_BAR;
    PG8_WAIT_V(4); PG8_BAR;
    PG8_STAGEB(PG8_SB(1, 0), cB + kstep); PG8_STAGEA(PG8_SA(1, 0), cA + kstep, 0, cp0, cp1); PG8_STAGEB(PG8_SB(1, 1), cB + hstepB + kstep);
    PG8_WAIT_V(6); PG8_BAR;
    for (;;) {
        const bool has_next = S.next(ui + 1, nxt);
        const char* nA = has_next ? nxt.A : cA; const char* nB = has_next ? nxt.B : cB;
        unsigned np0 = cp0, np1 = cp1;
        if (has_next) PG8_RIDX(nxt, np0, np1);
        for (int t = 0; t < nt; t += 2) {
            const bool last = (t == nt - 2);
            const char* a1 = cA + (size_t)(t + 1) * kstep;
            const char* a2 = last ? nA : cA + (size_t)(t + 2) * kstep; const char* b2 = last ? nB : cB + (size_t)(t + 2) * kstep;
            const char* a3 = a2 + kstep; const char* b3 = b2 + kstep;
            const unsigned xp0 = last ? np0 : cp0, xp1 = last ? np1 : cp1;
            PG8_LDB(B0, 0, 0); PG8_SCHED; PG8_LDA(At, 0, 0); PG8_STAGEA(PG8_SA(1, 1), a1, 1, cp0, cp1);
            PG8_WAIT_L(8); PG8_BAR; PG8_WAIT_L(0); PG8_MMA(0, 0, At, B0); PG8_BAR; PG8_SCHED;
            PG8_LDB(B1, 0, 1); PG8_STAGEB(PG8_SB(0, 0), b2);
            PG8_BAR; PG8_WAIT_L(0); PG8_MMA(0, 1, At, B1); PG8_BAR;
            PG8_LDA(At, 0, 1); PG8_STAGEA(PG8_SA(0, 0), a2, 0, xp0, xp1);
            PG8_BAR; PG8_WAIT_L(0); PG8_MMA(1, 0, At, B0); PG8_BAR; PG8_SCHED;
            PG8_STAGEB(PG8_SB(0, 1), b2 + hstepB);
            PG8_WAIT_V(6); PG8_BAR; PG8_MMA(1, 1, At, B1); PG8_BAR;
            PG8_LDB(B0, 1, 0); PG8_SCHED; PG8_LDA(At, 1, 0); PG8_STAGEA(PG8_SA(0, 1), a2, 1, xp0, xp1);
            PG8_WAIT_L(8); PG8_BAR; PG8_WAIT_L(0); PG8_MMA(0, 0, At, B0); PG8_BAR; PG8_SCHED;
            PG8_LDB(B1, 1, 1); PG8_STAGEB(PG8_SB(1, 0), b3);
            PG8_BAR; PG8_WAIT_L(0); PG8_MMA(0, 1, At, B1); PG8_BAR;
            PG8_LDA(At, 1, 1); PG8_STAGEA(PG8_SA(1, 0), a3, 0, xp0, xp1);
            PG8_BAR; PG8_WAIT_L(0); PG8_MMA(1, 0, At, B0); PG8_BAR; PG8_SCHED;
            PG8_STAGEB(PG8_SB(1, 1), b3 + hstepB);
            PG8_WAIT_V(6); PG8_BAR; PG8_MMA(1, 1, At, B1); PG8_BAR;
        }
        E(acc, cur, wr, wc, fr, fq);
        if (!has_next) break;
#pragma unroll
        for (int a = 0; a < 2; ++a)
#pragma unroll
            for (int b = 0; b < 2; ++b)
#pragma unroll
                for (int m = 0; m < 4; ++m)
#pragma unroll
                    for (int n = 0; n < 2; ++n) acc[a][b][m][n] = (f32x4){0.f, 0.f, 0.f, 0.f};
        cur = nxt; cA = nA; cB = nB; cp0 = np0; cp1 = np1; ++ui;
    }
    PG8_WAIT_V(0);
    if (wr == 0) PG8_BAR;
    PG8_BAR;
#undef PG8_SA
#undef PG8_SB
#undef PG8_STAGE2
#undef PG8_STAGEB
#undef PG8_LDA
#undef PG8_LDB
#undef PG8_MMA
#undef PG8_WAIT_V
#undef PG8_WAIT_L
#undef PG8_BAR
#undef PG8_SCHED
#undef PG8_RIDX
#undef PG8_STAGEA
}

struct EpiStoreBf16 {
    static constexpr bool PERM = true;
    bf16_t* O; int ldc;
    DI void operator()(const f32x4 (&acc)[2][2][4][2], const GUnit& u, int wr, int wc, int fr, int fq) const {
        const int row0 = u.pm * BM + wr * 64 + fr, col0 = u.pn * BM + wc * 32 + 8 * fq;
#pragma unroll
        for (int ai = 0; ai < 2; ++ai)
#pragma unroll
            for (int m = 0; m < 4; ++m) { bf16_t* rowp = O + (size_t)(row0 + ai * HALF + m * 16) * ldc + col0;
#pragma unroll
                for (int bj = 0; bj < 2; ++bj) { const f32x4 v0 = acc[ai][bj][m][0], v1 = acc[ai][bj][m][1];
                    u32x4 w; w.x = pk2(v0[0], v0[1]); w.y = pk2(v0[2], v0[3]); w.z = pk2(v1[0], v1[1]); w.w = pk2(v1[2], v1[3]);
                    *(u32x4*)(rowp + bj * HALF) = w; } }
    }
};
template <int MODE> struct EpiGate {
    static constexpr bool PERM = true;
    bf16_t* Y; const bf16_t* Zg; int gcol0;
    DI void operator()(const f32x4 (&acc)[2][2][4][2], const GUnit& u, int wr, int wc, int fr, int fq) const {
        const int row0 = u.pm * BM + wr * 64 + fr, col0 = u.pn * BM + wc * 32 + 8 * fq;
#pragma unroll
        for (int ai = 0; ai < 2; ++ai)
#pragma unroll
            for (int m = 0; m < 4; ++m) { const size_t row = (size_t)(row0 + ai * HALF + m * 16); bf16_t* rowp = Y + row * D + col0; const bf16_t* gp = Zg + row * ZS + gcol0 + col0;
#pragma unroll
                for (int bj = 0; bj < 2; ++bj) { const f32x4 v0 = acc[ai][bj][m][0], v1 = acc[ai][bj][m][1];
                    const u32x4 g = *(const u32x4*)(gp + bj * HALF);
                    float r[8];
                    r[0] = v0[0] * sigmoidf_(bf_lo(g.x)); r[1] = v0[1] * sigmoidf_(bf_hi(g.x)); r[2] = v0[2] * sigmoidf_(bf_lo(g.y)); r[3] = v0[3] * sigmoidf_(bf_hi(g.y));
                    r[4] = v1[0] * sigmoidf_(bf_lo(g.z)); r[5] = v1[1] * sigmoidf_(bf_hi(g.z)); r[6] = v1[2] * sigmoidf_(bf_lo(g.w)); r[7] = v1[3] * sigmoidf_(bf_hi(g.w));
                    if (MODE == 1) { const u32x4 o = *(const u32x4*)(rowp + bj * HALF);
                        r[0] += bf_lo(o.x); r[1] += bf_hi(o.x); r[2] += bf_lo(o.y); r[3] += bf_hi(o.y); r[4] += bf_lo(o.z); r[5] += bf_hi(o.z); r[6] += bf_lo(o.w); r[7] += bf_hi(o.w); }
                    u32x4 w; w.x = pk2(r[0], r[1]); w.y = pk2(r[2], r[3]); w.z = pk2(r[4], r[5]); w.w = pk2(r[6], r[7]);
                    *(u32x4*)(rowp + bj * HALF) = w; } }
    }
};
struct EpiResid {
    static constexpr bool PERM = false;
    const float* xsrc; float* xdst; const float* csrc; float* cdst; const float* gate;
    DI void operator()(const f32x4 (&acc)[2][2][4][2], const GUnit& u, int wr, int wc, int fr, int fq) const {
        const int row0 = u.pm * BM + wr * 64 + fr, col0 = u.pn * BM + wc * 32 + 4 * fq;
        const bool isctx = (u.pm * BM) >= TL;
        const int mrow = isctx ? 8 : (u.pm * BM) / SEQ;
        const float* gp = gate + (size_t)mrow * 6144 + col0;
        f32x4 gv[2][2];
#pragma unroll
        for (int bj = 0; bj < 2; ++bj)
#pragma unroll
            for (int n = 0; n < 2; ++n) gv[bj][n] = *(const f32x4*)(gp + bj * HALF + n * 16);
        const float* sb = isctx ? csrc - (size_t)TL * D : xsrc; float* db = isctx ? cdst - (size_t)TL * D : xdst;
#pragma unroll
        for (int ai = 0; ai < 2; ++ai)
#pragma unroll
            for (int m = 0; m < 4; ++m) { const size_t off = (size_t)(row0 + ai * HALF + m * 16) * D + col0;
#pragma unroll
                for (int bj = 0; bj < 2; ++bj)
#pragma unroll
                    for (int n = 0; n < 2; ++n) { const f32x4 s = *(const f32x4*)(sb + off + bj * HALF + n * 16);
                        *(f32x4*)(db + off + bj * HALF + n * 16) = s + gv[bj][n] * acc[ai][bj][m][n]; } }
    }
};
struct EpiSwiGLU {
    static constexpr bool PERM = true;
    bf16_t* Hd;
    DI void operator()(const f32x4 (&acc)[2][2][4][2], const GUnit& u, int wr, int wc, int fr, int fq) const {
        const int r0 = wr * 64 + fr, col0 = u.pn * HALF + wc * 32 + 8 * fq;
#pragma unroll
        for (int ai = 0; ai < 2; ++ai)
#pragma unroll
            for (int m = 0; m < 4; ++m) { const int r = r0 + ai * HALF + m * 16;
                const f32x4 g0 = acc[ai][0][m][0], g1 = acc[ai][0][m][1], u0 = acc[ai][1][m][0], u1 = acc[ai][1][m][1];
                u32x4 w; w.x = pk2(siluf_(g0[0]) * u0[0], siluf_(g0[1]) * u0[1]); w.y = pk2(siluf_(g0[2]) * u0[2], siluf_(g0[3]) * u0[3]);
                w.z = pk2(siluf_(g1[0]) * u1[0], siluf_(g1[1]) * u1[1]); w.w = pk2(siluf_(g1[2]) * u1[2], siluf_(g1[3]) * u1[3]);
                if (r < u.valid) *(u32x4*)(Hd + (size_t)(u.aux + r) * FF + col0) = w; }
    }
};
struct EpiDown {
    static constexpr bool PERM = true;
    bf16_t* Os;
    DI void operator()(const f32x4 (&acc)[2][2][4][2], const GUnit& u, int wr, int wc, int fr, int fq) const {
        const int r0 = wr * 64 + fr, col0 = u.pn * BM + wc * 32 + 8 * fq;
#pragma unroll
        for (int ai = 0; ai < 2; ++ai)
#pragma unroll
            for (int m = 0; m < 4; ++m) { const int r = r0 + ai * HALF + m * 16; bf16_t* rowp = Os + (size_t)(u.aux + r) * D + col0;
#pragma unroll
                for (int bj = 0; bj < 2; ++bj) { const f32x4 v0 = acc[ai][bj][m][0], v1 = acc[ai][bj][m][1];
                    u32x4 w; w.x = pk2(v0[0], v0[1]); w.y = pk2(v0[2], v0[3]); w.z = pk2(v1[0], v1[1]); w.w = pk2(v1[2], v1[3]);
                    if (r < u.valid) *(u32x4*)(rowp + bj * HALF) = w; } }
    }
};

template <int nN> struct RectSched {
    const char* A; const char* B; int lda, ldb; int nM, exM, exN, exPm0, G, c;
    DI bool next(int i, GUnit& u) const {
        const int L = i * G + c; const int nmain = nM * nN;
        int pm, pn;
        if (L < nmain) { const int grp = L / (8 * nN), rem = L % (8 * nN); pm = grp * 8 + (rem & 7); pn = rem >> 3; }
        else { const int L2 = L - nmain; if (L2 >= exM * exN) return false; pm = exPm0 + (L2 & 7); pn = L2 >> 3; }
        u.A = A + (size_t)pm * BM * lda * 2; u.B = B + (size_t)pn * BM * ldb * 2; u.rows = nullptr; u.pm = pm; u.pn = pn; u.valid = BM; u.aux = 0; return true;
    }
};
template <bool GATHER, int npn> struct MoeSched {
    const LAS int* tb; const LAS int* rb; const LAS int* cn;
    const char* A; const int* rowl; const char* B; size_t bstride; int lda, ldb, G, c;
    DI bool next(int i, GUnit& u) const {
        const int L = i * G + c; const int ntile = __builtin_amdgcn_readfirstlane(tb[NEX]);
        if (L >= ntile * npn) return false;
        const int T = L / npn, pn = L % npn;
        const int e = __builtin_amdgcn_readfirstlane((int)((const LAS unsigned char*)(tb + 216))[T]);
        const int ti = T - __builtin_amdgcn_readfirstlane(tb[e]), row0 = __builtin_amdgcn_readfirstlane(rb[e]) + ti * BM;
        u.B = B + (size_t)e * bstride + (size_t)pn * BM * ldb * 2;
        if (GATHER) { u.A = A; u.rows = rowl + row0; } else { u.A = A + (size_t)row0 * lda * 2; u.rows = nullptr; }
        u.pm = T; u.pn = pn; const int rem = __builtin_amdgcn_readfirstlane(cn[e]) - ti * BM; u.valid = rem < BM ? rem : BM; u.aux = row0; return true;
    }
};
}

struct Args { const float* in[N_INPUTS]; float* out; unsigned char* ws; int ph_lo, ph_hi; };
struct Frame {
    LAS unsigned char* lds; unsigned char* ws; const float* const* in; float* out;
    int tid, lane, wave, G, bid;
};
DI const float* modp(const Frame& F, int l, int r, int which) { return (const float*)(F.ws + WS_MOD) + ((size_t)(l * 9 + r) * 6 + which) * 1024; }

DI void tr_item(const float* W, int ldw, bf16_t* WT, int ldt, int k0, int n0, int drow0, LAS float* scr, int lane) {
#pragma unroll 8
    for (int i = 0; i < 32; ++i) { const int kk = 2 * i + (lane >> 5); scr[kk * 33 + (lane & 31)] = W[(size_t)(k0 + kk) * ldw + n0 + (lane & 31)]; }
    asm volatile("s_waitcnt lgkmcnt(0)" ::: "memory");
    const int c = lane & 7;
#pragma unroll
    for (int j = 0; j < 4; ++j) { const int n = (lane >> 3) + 8 * j; const LAS float* s = scr + (8 * c) * 33 + n;
        u32x4 o; o.x = pk2(s[0 * 33], s[1 * 33]); o.y = pk2(s[2 * 33], s[3 * 33]); o.z = pk2(s[4 * 33], s[5 * 33]); o.w = pk2(s[6 * 33], s[7 * 33]);
        *(u32x4*)(WT + (size_t)(drow0 + n) * ldt + k0 + 8 * c) = o; }
    asm volatile("s_waitcnt lgkmcnt(0)" ::: "memory");
}
template <int K, int N> DI void conv_plain(const Frame& F, const float* W, bf16_t* WT, int rot) {
    LAS float* scr = (LAS float*)(F.lds + F.wave * 16384);
    const int NGW = F.G * 8, gw = (F.bid * 8 + F.wave + rot) % NGW;
    constexpr int nblk = N / 32, nit = (K / 64) * nblk;
    for (int it = gw; it < nit; it += NGW) { const int kb = it / nblk, nb = it % nblk; tr_item(W, N, WT, K, kb * 64, nb * 32, nb * 32, scr, F.lane); }
}
DI void conv_gu(const Frame& F, int l, bf16_t* WT) {
    LAS float* scr = (LAS float*)(F.lds + F.wave * 16384);
    const int NGW = F.G * 8, gw = F.bid * 8 + F.wave;
    const int nit = NEX * 2 * 128;
    for (int it = gw; it < nit; it += NGW) {
        const int e = it / 256, r = it % 256, isup = r / 128, r2 = r % 128, kb = r2 / 8, nb = r2 % 8, n0 = nb * 32;
        const float* W = (e < NE) ? F.in[isup ? I_WEU : I_WEG] + ((size_t)l * NE + e) * D * FF : F.in[isup ? I_WSU : I_WSG] + (size_t)l * D * FF;
        const int drow0 = ((n0 >> 7) << 8) + (n0 & 127) + (isup ? 128 : 0);
        tr_item(W, FF, WT + (size_t)e * 512 * D, D, kb * 64, n0, drow0, scr, F.lane);
    }
}
DI void conv_down(const Frame& F, int l, bf16_t* WT) {
    LAS float* scr = (LAS float*)(F.lds + F.wave * 16384);
    const int NGW = F.G * 8, gw = F.bid * 8 + F.wave;
    const int nit = NEX * 128;
    for (int it = gw; it < nit; it += NGW) {
        const int e = it / 128, r = it % 128, kb = r / 32, nb = r % 32;
        const float* W = (e < NE) ? F.in[I_WED] + ((size_t)l * NE + e) * FF * D : F.in[I_WSD] + (size_t)l * FF * D;
        tr_item(W, D, WT + (size_t)e * D * FF, FF, kb * 64, nb * 32, nb * 32, scr, F.lane);
    }
}
DI void conv_small(const Frame& F, int l) {
    bf16_t* wb = (bf16_t*)(F.ws + WS_WBS);
    conv_plain<D, NIN>(F, F.in[I_WIN] + (size_t)l * D * NIN, (bf16_t*)((char*)wb + WB_WIN), 0);
    conv_plain<512, D>(F, F.in[I_WNA] + (size_t)l * 512 * D, (bf16_t*)((char*)wb + WB_WNA), 600);
    conv_plain<512, D>(F, F.in[I_WSC] + (size_t)l * 512 * D, (bf16_t*)((char*)wb + WB_WSC), 900);
    conv_plain<D, D>(F, F.in[I_WGLA] + (size_t)l * D * D, (bf16_t*)((char*)wb + WB_WGLA), 1200);
    conv_plain<D, D>(F, F.in[I_WOUT] + (size_t)l * D * D, (bf16_t*)((char*)wb + WB_WOUT), 1700);
    u32x4* z = (u32x4*)((char*)wb + WB_WIN + (size_t)NIN * D * 2);
    const int nz = (ZS - NIN) * D * 2 / 16;
    unsigned zz = 0u; asm volatile("" : "+v"(zz));
    for (int i = F.bid * 512 + F.tid; i < nz; i += F.G * 512) z[i] = (u32x4){zz, zz, zz, zz};
}
DI void conv_router(const Frame& F) {
    bf16_t* wrt = (bf16_t*)(F.ws + WS_WRT);
    for (int i = F.bid * 512 + F.tid; i < 2 * NE * D; i += F.G * 512) {
        const int l = i / (NE * D), r = i % (NE * D), e = r / D, k = r % D;
        const float w = F.in[I_WR][(size_t)l * D * NE + (size_t)k * NE + e];
        const bf16_t hi = f2bf(w); const bf16_t lo = f2bf(w - bf2f(hi));
        wrt[((size_t)(l * 2 + 0) * NE + e) * D + k] = hi; wrt[((size_t)(l * 2 + 1) * NE + e) * D + k] = lo;
    }
}
DI void mod_vectors(const Frame& F) {
    float* mod = (float*)(F.ws + WS_MOD);
    LAS float* SL = (LAS float*)F.lds;
    LAS float* PART = SL + 9 * 1024;
    __syncthreads();
    for (int i = F.tid; i < 9 * 1024; i += 512) { const float c = (i < 8 * 1024) ? F.in[I_C][i] : F.in[I_CCTX][i - 8 * 1024]; SL[i] = siluf_(c); }
    __syncthreads();
    for (int it = F.bid; it < 2 * 96; it += F.G) {
        const int l = it / 96, cb = it % 96, j = cb * 64 + F.lane;
        const float* W = F.in[I_WMOD] + (size_t)l * D * 6144 + j;
        float acc[9];
#pragma unroll
        for (int q = 0; q < 9; ++q) acc[q] = 0.f;
#pragma unroll 8
        for (int k = F.wave * 128; k < F.wave * 128 + 128; ++k) {
            const float w = W[(size_t)k * 6144];
#pragma unroll
            for (int q = 0; q < 9; ++q) acc[q] += SL[q * 1024 + k] * w;
        }
#pragma unroll
        for (int q = 0; q < 9; ++q) PART[(F.wave * 9 + q) * 64 + F.lane] = acc[q];
        __syncthreads();
        for (int q = F.wave; q < 9; q += 8) {
            float s = F.in[I_BMOD][l * 6144 + j];
#pragma unroll
            for (int w = 0; w < 8; ++w) s += PART[(w * 9 + q) * 64 + F.lane];
            mod[((size_t)(l * 9 + q)) * 6144 + j] = s;
        }
        __syncthreads();
    }
}

DI void load_row_f32(const float* p, int lane, float (&v)[16]) {
#pragma unroll
    for (int i = 0; i < 2; ++i) { const f32x4 a = *(const f32x4*)(p + 8 * lane + 512 * i), b = *(const f32x4*)(p + 8 * lane + 512 * i + 4);
        v[8 * i + 0] = a[0]; v[8 * i + 1] = a[1]; v[8 * i + 2] = a[2]; v[8 * i + 3] = a[3]; v[8 * i + 4] = b[0]; v[8 * i + 5] = b[1]; v[8 * i + 6] = b[2]; v[8 * i + 7] = b[3]; }
}
DI void store_row_f32(float* p, int lane, const float (&v)[16]) {
#pragma unroll
    for (int i = 0; i < 2; ++i) { *(f32x4*)(p + 8 * lane + 512 * i) = (f32x4){v[8 * i], v[8 * i + 1], v[8 * i + 2], v[8 * i + 3]}; *(f32x4*)(p + 8 * lane + 512 * i + 4) = (f32x4){v[8 * i + 4], v[8 * i + 5], v[8 * i + 6], v[8 * i + 7]}; }
}
DI void load_row_bf16(const bf16_t* p, int lane, float (&v)[16]) {
#pragma unroll
    for (int i = 0; i < 2; ++i) { const u32x4 a = *(const u32x4*)(p + 8 * lane + 512 * i);
        v[8 * i + 0] = bf_lo(a.x); v[8 * i + 1] = bf_hi(a.x); v[8 * i + 2] = bf_lo(a.y); v[8 * i + 3] = bf_hi(a.y); v[8 * i + 4] = bf_lo(a.z); v[8 * i + 5] = bf_hi(a.z); v[8 * i + 6] = bf_lo(a.w); v[8 * i + 7] = bf_hi(a.w); }
}
DI void store_row_bf16(bf16_t* p, int lane, const float (&v)[16]) {
#pragma unroll
    for (int i = 0; i < 2; ++i) { u32x4 w; w.x = pk2(v[8 * i], v[8 * i + 1]); w.y = pk2(v[8 * i + 2], v[8 * i + 3]); w.z = pk2(v[8 * i + 4], v[8 * i + 5]); w.w = pk2(v[8 * i + 6], v[8 * i + 7]);
        *(u32x4*)(p + 8 * lane + 512 * i) = w; }
}
DI void norm_mod(const float (&x)[16], const float* g, const float* shift, const float* scale, int lane, float (&h)[16]) {
    float ss = 0.f;
#pragma unroll
    for (int i = 0; i < 16; ++i) ss += x[i] * x[i];
    const float rstd = rsqrtf(wave_sum(ss) * (1.0f / D) + RMS_EPS);
    float gg[16], sh[16], sc[16]; load_row_f32(g, lane, gg); load_row_f32(shift, lane, sh); load_row_f32(scale, lane, sc);
#pragma unroll
    for (int i = 0; i < 16; ++i) h[i] = x[i] * rstd * gg[i] * (1.0f + sc[i]) + sh[i];
}

DI void phase_norm1_first(const Frame& F) {
    const int NGW = F.G * 8, gw = F.bid * 8 + F.wave;
    bf16_t* H = (bf16_t*)(F.ws + WS_R2);
    for (int t = gw; t < TA; t += NGW) {
        const bool isctx = t >= TL; const int r = isctx ? 8 : t / SEQ;
        const float* xr = isctx ? F.in[I_CTX] + (size_t)(t - TL) * D : F.in[I_X] + (size_t)t * D;
        float x[16], h[16]; load_row_f32(xr, F.lane, x);
        norm_mod(x, F.in[I_G1], modp(F, 0, r, 0), modp(F, 0, r, 1), F.lane, h);
        store_row_bf16(H + (size_t)t * D, F.lane, h);
    }
}

DI void phase_conv(const Frame& F, int l, int M) {
    const bf16_t* Z = (const bf16_t*)(F.ws + WS_R1); bf16_t* O = (bf16_t*)(F.ws + WS_R1 + R1_O);
    const float* cw = F.in[I_CONVW] + (size_t)l * 3 * 512;
    for (int it = F.bid * 512 + F.tid; it < M * 64; it += F.G * 512) {
        const int t = it >> 6, c0 = (it & 63) * 8;
        const int L = (t >= TL) ? CTXL : SEQ, pos = (t >= TL) ? (t - TL) % CTXL : t % SEQ;
        const bf16_t* zr = Z + (size_t)t * ZS;
        float u0[8], u1[8], u2[8], bb[8];
        { const u32x4 c = *(const u32x4*)(zr + C_CSC + c0), x = *(const u32x4*)(zr + C_XSC + c0), b = *(const u32x4*)(zr + C_BSC + c0);
          u1[0] = bf_lo(c.x) * bf_lo(x.x); u1[1] = bf_hi(c.x) * bf_hi(x.x); u1[2] = bf_lo(c.y) * bf_lo(x.y); u1[3] = bf_hi(c.y) * bf_hi(x.y);
          u1[4] = bf_lo(c.z) * bf_lo(x.z); u1[5] = bf_hi(c.z) * bf_hi(x.z); u1[6] = bf_lo(c.w) * bf_lo(x.w); u1[7] = bf_hi(c.w) * bf_hi(x.w);
          bb[0] = bf_lo(b.x); bb[1] = bf_hi(b.x); bb[2] = bf_lo(b.y); bb[3] = bf_hi(b.y); bb[4] = bf_lo(b.z); bb[5] = bf_hi(b.z); bb[6] = bf_lo(b.w); bb[7] = bf_hi(b.w); }
        if (pos > 0) { const u32x4 c = *(const u32x4*)(zr - ZS + C_CSC + c0), x = *(const u32x4*)(zr - ZS + C_XSC + c0);
          u0[0] = bf_lo(c.x) * bf_lo(x.x); u0[1] = bf_hi(c.x) * bf_hi(x.x); u0[2] = bf_lo(c.y) * bf_lo(x.y); u0[3] = bf_hi(c.y) * bf_hi(x.y);
          u0[4] = bf_lo(c.z) * bf_lo(x.z); u0[5] = bf_hi(c.z) * bf_hi(x.z); u0[6] = bf_lo(c.w) * bf_lo(x.w); u0[7] = bf_hi(c.w) * bf_hi(x.w); }
        else {
#pragma unroll
            for (int j = 0; j < 8; ++j) u0[j] = 0.f; }
        if (pos < L - 1) { const u32x4 c = *(const u32x4*)(zr + ZS + C_CSC + c0), x = *(const u32x4*)(zr + ZS + C_XSC + c0);
          u2[0] = bf_lo(c.x) * bf_lo(x.x); u2[1] = bf_hi(c.x) * bf_hi(x.x); u2[2] = bf_lo(c.y) * bf_lo(x.y); u2[3] = bf_hi(c.y) * bf_hi(x.y);
          u2[4] = bf_lo(c.z) * bf_lo(x.z); u2[5] = bf_hi(c.z) * bf_hi(x.z); u2[6] = bf_lo(c.w) * bf_lo(x.w); u2[7] = bf_hi(c.w) * bf_hi(x.w); }
        else {
#pragma unroll
            for (int j = 0; j < 8; ++j) u2[j] = 0.f; }
        float o[8];
#pragma unroll
        for (int j = 0; j < 8; ++j) o[j] = bb[j] * (u0[j] * cw[c0 + j] + u1[j] * cw[512 + c0 + j] + u2[j] * cw[1024 + c0 + j]);
        u32x4 w; w.x = pk2(o[0], o[1]); w.y = pk2(o[2], o[3]); w.z = pk2(o[4], o[5]); w.w = pk2(o[6], o[7]);
        *(u32x4*)(O + (size_t)t * OS + 512 + c0) = w;
    }
}

#define MFMA32(a, b, c) __builtin_amdgcn_mfma_f32_32x32x16_bf16((a), (b), (c), 0, 0, 0)
DI int crow(int reg, int h) { return (reg & 3) + 8 * (reg >> 2) + 4 * h; }
DI bf16x8 pack_step(const f32x16& x, int s) {
    u32x4 p; p.x = pk2(x[8 * s], x[8 * s + 1]); p.y = pk2(x[8 * s + 2], x[8 * s + 3]); p.z = pk2(x[8 * s + 4], x[8 * s + 5]); p.w = pk2(x[8 * s + 6], x[8 * s + 7]);
    return __builtin_bit_cast(bf16x8, p);
}
DI bf16x8 cat4(u32x2 a, u32x2 b) { u32x4 p; p.x = a.x; p.y = a.y; p.z = b.x; p.w = b.y; return __builtin_bit_cast(bf16x8, p); }

typedef __attribute__((address_space(3))) s16x4 lds_s16x4;
DI bf16x8 tr8(const LAS bf16_t* p0, const LAS bf16_t* p1) {
    const s16x4 a = __builtin_amdgcn_ds_read_tr16_b64_v4i16((lds_s16x4*)p0), b = __builtin_amdgcn_ds_read_tr16_b64_v4i16((lds_s16x4*)p1);
    return (bf16x8){a[0], a[1], a[2], a[3], b[0], b[1], b[2], b[3]};
}
constexpr int NA_VS = 72;
constexpr int NA_TAB = 8 * NA_VS * 64 * 2;
constexpr float NA_L2E = 1.4426950408889634f;
DI void na_wave_unit(const Frame& F, const bf16_t* Z, bf16_t* O, const LAS float* tab, LAS bf16_t* vt,
                     int qrow0, int head, int nwin, int winrow0  , int ctxrow0, int qgrid_row, int krow_first, int qcol0) {
    const int lane = F.lane, r = lane & 31, h = lane >> 5;
    const int trq = (lane & 15) >> 2, trc = 16 * ((lane >> 4) & 1) + 4 * (lane & 3);
    bf16x8 qf[4];
    { const bf16_t* qp = Z + (size_t)(qrow0 + r) * ZS + C_QNA + head * 64 + 8 * h;
#pragma unroll
      for (int ks = 0; ks < 4; ++ks) qf[ks] = *(const bf16x8*)(qp + 16 * ks); }
    unsigned ix0[4], ix1[4];
    { const int qc = qcol0 + r; int cs = qc - 8; cs = cs < 0 ? 0 : (cs > 48 ? 48 : cs);
#pragma unroll
      for (int g = 0; g < 4; ++g) { unsigned p0 = 0u, p1 = 0u;
#pragma unroll
          for (int e = 0; e < 4; ++e) { const int kc0 = crow(4 * g + e, h), kc1 = 32 + kc0;
              int d0 = kc0 - qc; d0 = d0 < -15 ? -15 : (d0 > 15 ? 15 : d0); int d1 = kc1 - qc; d1 = d1 < -15 ? -15 : (d1 > 15 ? 15 : d1);
              const unsigned c0 = (kc0 < cs || kc0 >= cs + 16) ? 31u : (unsigned)(d0 + 15), c1 = (kc1 < cs || kc1 >= cs + 16) ? 31u : (unsigned)(d1 + 15);
              p0 |= c0 << (8 * e); p1 |= c1 << (8 * e); }
          ix0[g] = p0; ix1[g] = p1; } }
    f32x16 o0, o1;
#pragma unroll
    for (int i = 0; i < 16; ++i) { o0[i] = 0.f; o1[i] = 0.f; }
    float mrun = -1e30f, lrun = 0.f;
    const int ntile = nwin + 4;
    bf16x8 kc[2][4]; u32x4 vr[8];
    const unsigned klane = (unsigned)(r * ZS + 8 * h) * 2u, vlane = (unsigned)((lane >> 3) * ZS + 8 * (lane & 7)) * 2u;
    { const int krow0 = nwin > 0 ? winrow0 : ctxrow0;
      const char* kb = (const char*)Z + ((size_t)krow0 * ZS + C_KNA + head * 64) * 2; const char* vb = (const char*)Z + ((size_t)krow0 * ZS + C_VNA + head * 64) * 2;
#pragma unroll
      for (int ks = 0; ks < 4; ++ks) { kc[0][ks] = *(const bf16x8*)(kb + 32 * ks + klane); kc[1][ks] = *(const bf16x8*)(kb + (size_t)32 * ZS * 2 + 32 * ks + klane); }
#pragma unroll
      for (int i = 0; i < 8; ++i) vr[i] = *(const u32x4*)(vb + (size_t)i * 8 * ZS * 2 + vlane); }
#pragma unroll 1
    for (int j = 0; j < ntile; ++j) {
        const bool isw = j < nwin;
#pragma unroll
        for (int i = 0; i < 8; ++i) { const int p = lane + 64 * i; *(LAS u32x4*)(vt + (p >> 3) * NA_VS + 8 * (p & 7)) = vr[i]; }
        const int jn = (j + 1 < ntile) ? j + 1 : j;
        const int krown = (jn < nwin) ? winrow0 + jn * 64 : ctxrow0 + (jn - nwin) * 64;
        { const char* vb = (const char*)Z + ((size_t)krown * ZS + C_VNA + head * 64) * 2;
#pragma unroll
          for (int i = 0; i < 8; ++i) vr[i] = *(const u32x4*)(vb + (size_t)i * 8 * ZS * 2 + vlane); }
        f32x16 s0, s1;
#pragma unroll
        for (int i = 0; i < 16; ++i) { s0[i] = 0.f; s1[i] = 0.f; }
#pragma unroll
        for (int ks = 0; ks < 4; ++ks) { s0 = MFMA32(kc[0][ks], qf[ks], s0); s1 = MFMA32(kc[1][ks], qf[ks], s1); }
        { const char* kb = (const char*)Z + ((size_t)krown * ZS + C_KNA + head * 64) * 2;
#pragma unroll
          for (int ks = 0; ks < 4; ++ks) { kc[0][ks] = *(const bf16x8*)(kb + 32 * ks + klane); kc[1][ks] = *(const bf16x8*)(kb + (size_t)32 * ZS * 2 + 32 * ks + klane); } }
        const int drow = isw ? (krow_first + j - qgrid_row + 7) : 15;
        const LAS float* trow = tab + (head * 16 + drow) * 32;
#pragma unroll
        for (int g = 0; g < 4; ++g) asm volatile("" : "+v"(ix0[g]), "+v"(ix1[g]));
        float tmax = -1e30f;
#pragma unroll
        for (int i = 0; i < 16; ++i) {
            const float a = s0[i] * (0.125f * NA_L2E) + trow[(ix0[i >> 2] >> (8 * (i & 3))) & 0xffu];
            const float b = s1[i] * (0.125f * NA_L2E) + trow[(ix1[i >> 2] >> (8 * (i & 3))) & 0xffu];
            s0[i] = a; s1[i] = b; tmax = fmaxf(tmax, fmaxf(a, b));
        }
        tmax = fmaxf(tmax, __shfl_xor(tmax, 32));
        const float mnew = fmaxf(mrun, tmax), alpha = __builtin_amdgcn_exp2f(mrun - mnew);
        float psum = 0.f;
#pragma unroll
        for (int i = 0; i < 16; ++i) { const float a = __builtin_amdgcn_exp2f(s0[i] - mnew), b = __builtin_amdgcn_exp2f(s1[i] - mnew); s0[i] = a; s1[i] = b; psum += a + b; }
        psum += __shfl_xor(psum, 32);
        lrun = lrun * alpha + psum; mrun = mnew;
#pragma unroll
        for (int i = 0; i < 16; ++i) { o0[i] *= alpha; o1[i] *= alpha; }
#pragma unroll
        for (int nb = 0; nb < 2; ++nb)
#pragma unroll
            for (int s = 0; s < 2; ++s) {
                const bf16x8 pf = pack_step(nb ? s1 : s0, s);
                const LAS bf16_t* vp = vt + (32 * nb + 16 * s + 4 * h + trq) * NA_VS + trc;
                o0 = MFMA32(tr8(vp, vp + 8 * NA_VS), pf, o0); o1 = MFMA32(tr8(vp + 32, vp + 32 + 8 * NA_VS), pf, o1);
            }
        asm volatile("s_waitcnt lgkmcnt(0)" ::: "memory");
    }
    const float inv = 1.0f / lrun;
    bf16_t* op = O + (size_t)(qrow0 + r) * OS + head * 64 + 4 * h;
#pragma unroll
    for (int g = 0; g < 4; ++g) {
        u32x2 w0, w1; w0.x = pk2(o0[4 * g] * inv, o0[4 * g + 1] * inv); w0.y = pk2(o0[4 * g + 2] * inv, o0[4 * g + 3] * inv);
        w1.x = pk2(o1[4 * g] * inv, o1[4 * g + 1] * inv); w1.y = pk2(o1[4 * g + 2] * inv, o1[4 * g + 3] * inv);
        *(u32x2*)(op + 8 * g) = w0; *(u32x2*)(op + 32 + 8 * g) = w1;
    }
}
DI void phase_na(const Frame& F, int l, bool ctx_out) {
    const bf16_t* Z = (const bf16_t*)(F.ws + WS_R1); bf16_t* O = (bf16_t*)(F.ws + WS_R1 + R1_O);
    LAS float* tab = (LAS float*)(F.lds + NA_TAB);
    for (int i = F.tid; i < 8 * 16 * 32; i += 512) { const int hh = i >> 9, dr = (i >> 5) & 15, dc = i & 31;
        tab[i] = (dr == 15) ? 0.f : ((dc == 31) ? -1e30f : F.in[I_RPB][(size_t)l * 8 * 15 * 31 + (hh * 15 + dr) * 31 + dc] * NA_L2E); }
    __syncthreads();
    LAS bf16_t* vt = (LAS bf16_t*)(F.lds + F.wave * NA_VS * 64 * 2);
    const int nlat = NB * 32 * 2, ntot = nlat + (ctx_out ? NB * 8 : 0);
#pragma unroll 1
    for (int u = F.bid; u < ntot; u += F.G) {
        int qrow0, nwin, winrow0, ctxrow0, qgr, kfirst, qcol0;
        if (u < nlat) { const int b = u >> 6, rr = (u >> 1) & 31, half = u & 1;
            int rs = rr - 4; rs = rs < 0 ? 0 : (rs > 24 ? 24 : rs);
            qrow0 = b * SEQ + rr * 64 + half * 32; nwin = 8; winrow0 = b * SEQ + rs * 64; ctxrow0 = TL + b * CTXL; qgr = rr; kfirst = rs; qcol0 = half * 32;
        } else { const int v = u - nlat, b = v >> 3, qb = v & 7;
            qrow0 = TL + b * CTXL + qb * 32; nwin = 0; winrow0 = 0; ctxrow0 = TL + b * CTXL; qgr = 0; kfirst = 0; qcol0 = 0;
        }
        na_wave_unit(F, Z, O, tab, vt, qrow0, F.wave, nwin, winrow0, ctxrow0, qgr, kfirst, qcol0);
    }
    __syncthreads();
}

constexpr int GL_CUM = 0, GL_CUMS = 132, GL_QS = 33792, GL_KS = 51200, GL_KD = 68608, GL_RS = 136, GL_V = 86016, GL_VS = 72, GL_ST0 = 95232, GL_ST1 = 113664,
              GL_W2T = 132096, GL_B2 = 138240, GL_SEG = 138752, GL_DEC = 139776;
DI void gla_chain(const Frame& F, int l, int chain, bool ctx_out) {
    const int vs = chain & 3, dir = (chain >> 2) & 1, hd = (chain >> 3) & 3, b = chain >> 5;
    const bf16_t* Z = (const bf16_t*)(F.ws + WS_R1);
    bf16_t* OD = (bf16_t*)(F.ws + WS_R2 + (dir ? R2_OB : 0));
    LAS float* CUM = (LAS float*)(F.lds + GL_CUM); LAS bf16_t* QS = (LAS bf16_t*)(F.lds + GL_QS); LAS bf16_t* KS = (LAS bf16_t*)(F.lds + GL_KS);
    LAS bf16_t* KD = (LAS bf16_t*)(F.lds + GL_KD); LAS bf16_t* VV = (LAS bf16_t*)(F.lds + GL_V);
    LAS bf16_t* W2T = (LAS bf16_t*)(F.lds + GL_W2T); LAS float* B2 = (LAS float*)(F.lds + GL_B2); LAS float* SEG = (LAS float*)(F.lds + GL_SEG); LAS float* DEC = (LAS float*)(F.lds + GL_DEC);
    const int tid = F.tid, lane = F.lane, wave = F.wave, r = lane & 31, h = lane >> 5;
    const int trq = (lane & 15) >> 2, trc = 16 * ((lane >> 4) & 1) + 4 * (lane & 3);
    __syncthreads();
    for (int i = tid; i < 16 * 128; i += 512) { const int ii = i >> 7, d = i & 127; W2T[d * 24 + ii] = f2bf(F.in[I_GGW][((size_t)(l * 2 + dir) * 16 + ii) * 512 + hd * 128 + d]); }
    if (tid < 128) B2[tid] = F.in[I_GGB][(size_t)(l * 2 + dir) * 512 + hd * 128 + tid];
    for (int i = tid; i < 128 * GL_VS / 2; i += 512) ((LAS unsigned*)(F.lds + GL_ST0))[i] = 0u;
    f32x16 S0, S1;
#pragma unroll
    for (int i = 0; i < 16; ++i) { S0[i] = 0.f; S1[i] = 0.f; }
    const int tau = tid >> 3, seg = tid & 7, d0 = seg * 16;
    const int atb = wave & 1, adb = wave >> 1;
    __syncthreads();
    const bf16x8 w2f = *(const LAS bf16x8*)(W2T + (32 * adb + r) * 24 + 8 * h);
    const float b2v = B2[32 * adb + r];
#define GL_ROW(s_, t_) ( ((s_) < 4 ? TL + b * CTXL + (dir ? 3 - (s_) : (s_)) * 64 : b * SEQ + (dir ? 31 - ((s_) - 4) : ((s_) - 4)) * 64) + (dir ? 63 - (t_) : (t_)) )
    u32x4 nq0, nq1, nk0, nk1, nvv; bf16x8 nlr;
    { const bf16_t* zr = Z + (size_t)GL_ROW(0, tau) * ZS;
      nq0 = *(const u32x4*)(zr + C_QGLA + hd * 128 + d0); nq1 = *(const u32x4*)(zr + C_QGLA + hd * 128 + d0 + 8);
      nk0 = *(const u32x4*)(zr + C_KGLA + hd * 128 + d0); nk1 = *(const u32x4*)(zr + C_KGLA + hd * 128 + d0 + 8);
      nvv = *(const u32x4*)(zr + C_VGLA + hd * 256 + vs * 64 + seg * 8);
      nlr = *(const bf16x8*)(Z + (size_t)GL_ROW(0, 32 * atb + r) * ZS + C_GATE + dir * 16 + 8 * h); }
#pragma unroll 1
    for (int s = 0; s < 36; ++s) {
        const bool isctx = s < 4;
        const bool emit = !isctx || ctx_out;
        LAS bf16_t* STo = (LAS bf16_t*)(F.lds + ((s & 1) ? GL_ST1 : GL_ST0)); LAS bf16_t* STn = (LAS bf16_t*)(F.lds + ((s & 1) ? GL_ST0 : GL_ST1));
        const u32x4 q0 = nq0, q1 = nq1, k0 = nk0, k1 = nk1, vv = nvv; const bf16x8 lrf = nlr;
        { const int sn = s < 35 ? s + 1 : 35;
          const bf16_t* zr = Z + (size_t)GL_ROW(sn, tau) * ZS;
          nq0 = *(const u32x4*)(zr + C_QGLA + hd * 128 + d0); nq1 = *(const u32x4*)(zr + C_QGLA + hd * 128 + d0 + 8);
          nk0 = *(const u32x4*)(zr + C_KGLA + hd * 128 + d0); nk1 = *(const u32x4*)(zr + C_KGLA + hd * 128 + d0 + 8);
          nvv = *(const u32x4*)(zr + C_VGLA + hd * 256 + vs * 64 + seg * 8);
          nlr = *(const bf16x8*)(Z + (size_t)GL_ROW(sn, 32 * atb + r) * ZS + C_GATE + dir * 16 + 8 * h); }
        {
            f32x16 ga;
#pragma unroll
            for (int i = 0; i < 16; ++i) ga[i] = 0.f;
            ga = MFMA32(lrf, w2f, ga);
            float sg[4];
#pragma unroll
            for (int g = 0; g < 4; ++g) {
                float run = 0.f;
#pragma unroll
                for (int e = 0; e < 4; ++e) { const float x = ga[4 * g + e] + b2v; run += (fminf(x, 0.f) - __logf(1.0f + __expf(-fabsf(x)))) * (1.0f / 16.0f); ga[4 * g + e] = run; }
                sg[g] = run;
            }
            float off = 0.f;
#pragma unroll
            for (int g = 0; g < 4; ++g) { const float ps = __shfl_xor(sg[g], 32); const float o = off + (h ? ps : 0.f);
#pragma unroll
                for (int e = 0; e < 4; ++e) CUM[(32 * atb + 8 * g + 4 * h + e) * GL_CUMS + 32 * adb + r] = ga[4 * g + e] + o;
                off += sg[g] + ps; }
            if (h == 0) SEG[atb * 128 + 32 * adb + r] = off;
        }
        __syncthreads();
        {
            float qv[16], kv[16];
            qv[0] = bf_lo(q0.x); qv[1] = bf_hi(q0.x); qv[2] = bf_lo(q0.y); qv[3] = bf_hi(q0.y); qv[4] = bf_lo(q0.z); qv[5] = bf_hi(q0.z); qv[6] = bf_lo(q0.w); qv[7] = bf_hi(q0.w);
            qv[8] = bf_lo(q1.x); qv[9] = bf_hi(q1.x); qv[10] = bf_lo(q1.y); qv[11] = bf_hi(q1.y); qv[12] = bf_lo(q1.z); qv[13] = bf_hi(q1.z); qv[14] = bf_lo(q1.w); qv[15] = bf_hi(q1.w);
            kv[0] = bf_lo(k0.x); kv[1] = bf_hi(k0.x); kv[2] = bf_lo(k0.y); kv[3] = bf_hi(k0.y); kv[4] = bf_lo(k0.z); kv[5] = bf_hi(k0.z); kv[6] = bf_lo(k0.w); kv[7] = bf_hi(k0.w);
            kv[8] = bf_lo(k1.x); kv[9] = bf_hi(k1.x); kv[10] = bf_lo(k1.y); kv[11] = bf_hi(k1.y); kv[12] = bf_lo(k1.z); kv[13] = bf_hi(k1.z); kv[14] = bf_lo(k1.w); kv[15] = bf_hi(k1.w);
            float qs[16], ks[16], kd[16];
#pragma unroll
            for (int j = 0; j < 4; ++j) {
                const f32x4 e0 = *(const LAS f32x4*)(SEG + d0 + 4 * j), e1 = *(const LAS f32x4*)(SEG + 128 + d0 + 4 * j);
                const f32x4 cl = *(const LAS f32x4*)(CUM + tau * GL_CUMS + d0 + 4 * j);
#pragma unroll
                for (int e = 0; e < 4; ++e) {
                    const float cum = cl[e] + (tau >= 32 ? e0[e] : 0.f), last = e0[e] + e1[e];
                    const int jj = 4 * j + e;
                    const float ex = __expf(cum), inv = __builtin_amdgcn_rcpf(ex);
                    qs[jj] = qv[jj] * 0.08838834764831845f * ex;
                    ks[jj] = kv[jj] * inv;
                    kd[jj] = kv[jj] * __expf(last - cum);
                    if (tau == 0) DEC[d0 + jj] = __expf(last);
                }
            }
            u32x4 w;
            w.x = pk2(qs[0], qs[1]); w.y = pk2(qs[2], qs[3]); w.z = pk2(qs[4], qs[5]); w.w = pk2(qs[6], qs[7]); *(LAS u32x4*)(QS + tau * GL_RS + d0) = w;
            w.x = pk2(qs[8], qs[9]); w.y = pk2(qs[10], qs[11]); w.z = pk2(qs[12], qs[13]); w.w = pk2(qs[14], qs[15]); *(LAS u32x4*)(QS + tau * GL_RS + d0 + 8) = w;
            w.x = pk2(ks[0], ks[1]); w.y = pk2(ks[2], ks[3]); w.z = pk2(ks[4], ks[5]); w.w = pk2(ks[6], ks[7]); *(LAS u32x4*)(KS + tau * GL_RS + d0) = w;
            w.x = pk2(ks[8], ks[9]); w.y = pk2(ks[10], ks[11]); w.z = pk2(ks[12], ks[13]); w.w = pk2(ks[14], ks[15]); *(LAS u32x4*)(KS + tau * GL_RS + d0 + 8) = w;
            w.x = pk2(kd[0], kd[1]); w.y = pk2(kd[2], kd[3]); w.z = pk2(kd[4], kd[5]); w.w = pk2(kd[6], kd[7]); *(LAS u32x4*)(KD + tau * GL_RS + d0) = w;
            w.x = pk2(kd[8], kd[9]); w.y = pk2(kd[10], kd[11]); w.z = pk2(kd[12], kd[13]); w.w = pk2(kd[14], kd[15]); *(LAS u32x4*)(KD + tau * GL_RS + d0 + 8) = w;
            *(LAS u32x4*)(VV + tau * GL_VS + seg * 8) = vv;
        }
        __syncthreads();
        if (wave < 4) {
            if (emit) {
                const int vb = wave & 1, tb = wave >> 1;
                f32x16 a0, a1, oo;
#pragma unroll
                for (int i = 0; i < 16; ++i) { a0[i] = 0.f; a1[i] = 0.f; oo[i] = 0.f; }
#pragma unroll
                for (int kk = 0; kk < 8; ++kk) {
                    const bf16x8 qf = *(const LAS bf16x8*)(QS + (32 * tb + r) * GL_RS + 16 * kk + 8 * h);
                    const bf16x8 kf0 = *(const LAS bf16x8*)(KS + r * GL_RS + 16 * kk + 8 * h);
                    a0 = MFMA32(kf0, qf, a0);
                    if (tb == 1) { const bf16x8 kf1 = *(const LAS bf16x8*)(KS + (32 + r) * GL_RS + 16 * kk + 8 * h); a1 = MFMA32(kf1, qf, a1); }
                }
                const int tt = 32 * tb + r;
#pragma unroll
                for (int i = 0; i < 16; ++i) { const int sg0 = crow(i, h); if (sg0 > tt) a0[i] = 0.f; if (32 + sg0 > tt) a1[i] = 0.f; }
#pragma unroll
                for (int sb = 0; sb < 2; ++sb)
#pragma unroll
                    for (int st = 0; st < 2; ++st) {
                        if (sb == 1 && tb == 0) continue;
                        const bf16x8 pf = pack_step(sb ? a1 : a0, st);
                        const LAS bf16_t* vp = VV + (32 * sb + 16 * st + 4 * h + trq) * GL_VS + 32 * vb + trc;
                        oo = MFMA32(tr8(vp, vp + 8 * GL_VS), pf, oo);
                    }
#pragma unroll
                for (int kk = 0; kk < 8; ++kk) {
                    const LAS bf16_t* sp = STo + (16 * kk + 8 * h + trq) * GL_VS + 32 * vb + trc;
                    const bf16x8 qf = *(const LAS bf16x8*)(QS + (32 * tb + r) * GL_RS + 16 * kk + 8 * h);
                    oo = MFMA32(tr8(sp, sp + 4 * GL_VS), qf, oo);
                }
                const int orow = GL_ROW(s, tt);
                bf16_t* op = OD + (size_t)orow * D + hd * 256 + vs * 64 + 32 * vb + 4 * h;
#pragma unroll
                for (int g = 0; g < 4; ++g) { u32x2 w; w.x = pk2(oo[4 * g], oo[4 * g + 1]); w.y = pk2(oo[4 * g + 2], oo[4 * g + 3]); *(u32x2*)(op + 8 * g) = w; }
            }
        } else {
            const int db = wave - 4, dd = 32 * db + r;
            const float dec = DEC[dd];
#pragma unroll
            for (int i = 0; i < 16; ++i) { S0[i] *= dec; S1[i] *= dec; }
#pragma unroll
            for (int kk = 0; kk < 4; ++kk) {
                const LAS bf16_t* kp = KD + (16 * kk + 8 * h + trq) * GL_RS + 32 * db + trc;
                const LAS bf16_t* v0p = VV + (16 * kk + 8 * h + trq) * GL_VS + trc;
                const bf16x8 kf = tr8(kp, kp + 4 * GL_RS);
                S0 = MFMA32(tr8(v0p, v0p + 4 * GL_VS), kf, S0); S1 = MFMA32(tr8(v0p + 32, v0p + 32 + 4 * GL_VS), kf, S1);
            }
#pragma unroll
            for (int g = 0; g < 4; ++g) {
                u32x2 w0, w1; w0.x = pk2(S0[4 * g], S0[4 * g + 1]); w0.y = pk2(S0[4 * g + 2], S0[4 * g + 3]); w1.x = pk2(S1[4 * g], S1[4 * g + 1]); w1.y = pk2(S1[4 * g + 2], S1[4 * g + 3]);
                *(LAS u32x2*)(STn + dd * GL_VS + 8 * g + 4 * h) = w0; *(LAS u32x2*)(STn + dd * GL_VS + 32 + 8 * g + 4 * h) = w1;
            }
        }
    }
#undef GL_ROW
    __syncthreads();
}
DI void phase_gla_fin(const Frame& F, int l, int M) {
    const int NGW = F.G * 8, gw = F.bid * 8 + F.wave, lane = F.lane;
    const bf16_t* Z = (const bf16_t*)(F.ws + WS_R1); bf16_t* O = (bf16_t*)(F.ws + WS_R1 + R1_O);
    const bf16_t* OFp = (const bf16_t*)(F.ws + WS_R2); const bf16_t* OBp = (const bf16_t*)(F.ws + WS_R2 + R2_OB);
    const float* gn = F.in[I_GNG] + (size_t)l * 256;
    for (int t = gw; t < M; t += NGW) {
        const u32x4 a0 = *(const u32x4*)(OFp + (size_t)t * D + 16 * lane), a1 = *(const u32x4*)(OFp + (size_t)t * D + 16 * lane + 8);
        const u32x4 b0 = *(const u32x4*)(OBp + (size_t)t * D + 16 * lane), b1 = *(const u32x4*)(OBp + (size_t)t * D + 16 * lane + 8);
        const u32x4 r0 = *(const u32x4*)(Z + (size_t)t * ZS + C_RGLA + 16 * lane), r1 = *(const u32x4*)(Z + (size_t)t * ZS + C_RGLA + 16 * lane + 8);
        float o[16], rr[16];
        o[0] = bf_lo(a0.x) + bf_lo(b0.x); o[1] = bf_hi(a0.x) + bf_hi(b0.x); o[2] = bf_lo(a0.y) + bf_lo(b0.y); o[3] = bf_hi(a0.y) + bf_hi(b0.y);
        o[4] = bf_lo(a0.z) + bf_lo(b0.z); o[5] = bf_hi(a0.z) + bf_hi(b0.z); o[6] = bf_lo(a0.w) + bf_lo(b0.w); o[7] = bf_hi(a0.w) + bf_hi(b0.w);
        o[8] = bf_lo(a1.x) + bf_lo(b1.x); o[9] = bf_hi(a1.x) + bf_hi(b1.x); o[10] = bf_lo(a1.y) + bf_lo(b1.y); o[11] = bf_hi(a1.y) + bf_hi(b1.y);
        o[12] = bf_lo(a1.z) + bf_lo(b1.z); o[13] = bf_hi(a1.z) + bf_hi(b1.z); o[14] = bf_lo(a1.w) + bf_lo(b1.w); o[15] = bf_hi(a1.w) + bf_hi(b1.w);
        rr[0] = bf_lo(r0.x); rr[1] = bf_hi(r0.x); rr[2] = bf_lo(r0.y); rr[3] = bf_hi(r0.y); rr[4] = bf_lo(r0.z); rr[5] = bf_hi(r0.z); rr[6] = bf_lo(r0.w); rr[7] = bf_hi(r0.w);
        rr[8] = bf_lo(r1.x); rr[9] = bf_hi(r1.x); rr[10] = bf_lo(r1.y); rr[11] = bf_hi(r1.y); rr[12] = bf_lo(r1.z); rr[13] = bf_hi(r1.z); rr[14] = bf_lo(r1.w); rr[15] = bf_hi(r1.w);
        float ss = 0.f;
#pragma unroll
        for (int i = 0; i < 16; ++i) ss += o[i] * o[i];
        ss += __shfl_xor(ss, 1); ss += __shfl_xor(ss, 2); ss += __shfl_xor(ss, 4); ss += __shfl_xor(ss, 8);
        const float rstd = rsqrtf(ss * (1.0f / 256.0f) + RMS_EPS);
        const int v0 = (lane & 15) * 16;
        float y[16];
#pragma unroll
        for (int i = 0; i < 16; ++i) y[i] = o[i] * rstd * gn[v0 + i] * siluf_(rr[i]);
        u32x4 w0, w1; w0.x = pk2(y[0], y[1]); w0.y = pk2(y[2], y[3]); w0.z = pk2(y[4], y[5]); w0.w = pk2(y[6], y[7]);
        w1.x = pk2(y[8], y[9]); w1.y = pk2(y[10], y[11]); w1.z = pk2(y[12], y[13]); w1.w = pk2(y[14], y[15]);
        *(u32x4*)(O + (size_t)t * OS + 1024 + 16 * lane) = w0; *(u32x4*)(O + (size_t)t * OS + 1024 + 16 * lane + 8) = w1;
    }
}

constexpr int RT_HS = 1032;
template <bool DRY = false> DI void phase_router(const Frame& F, int l, int M) {
    LAS bf16_t* HH = (LAS bf16_t*)F.lds;
    LAS bf16_t* HL = HH + 32 * RT_HS;
    LAS float* H2F = (LAS float*)F.lds;
    bf16_t* H2 = (bf16_t*)(F.ws + WS_R1 + R1_H2);
    const float* xres = F.out; const float* cres = (const float*)(F.ws + WS_CTXS);
    const bf16_t* WRH = (const bf16_t*)(F.ws + WS_WRT) + (size_t)(l * 2) * NE * D; const bf16_t* WRL = WRH + (size_t)NE * D;
    int* toke = (int*)(F.ws + WS_TOKE); int* tokp = (int*)(F.ws + (DRY ? WS_TOKR : WS_TOKP)); float* tokw = (float*)(F.ws + WS_TOKW);
    unsigned* cnt = (unsigned*)(F.ws + WS_CTL) + CW_CNT + 128 * l + (DRY ? 1024 : 0);
    const int lane = F.lane, wave = F.wave, r = lane & 31, hh = lane >> 5;
    const float brt = F.in[I_BR][l * NE + lane];
    const int npass = (M + 31) / 32;
    float xr[4][16];
#pragma unroll
    for (int rr = 0; rr < 4; ++rr) { const int t = F.bid * 32 + 4 * wave + rr;
        if (F.bid < npass && t < M) load_row_f32(t >= TL ? cres + (size_t)(t - TL) * D : xres + (size_t)t * D, lane, xr[rr]);
        else {
#pragma unroll
            for (int i = 0; i < 16; ++i) xr[rr][i] = 0.f; } }
    float gg[16]; load_row_f32(F.in[I_G2] + (size_t)l * D, lane, gg);
#pragma unroll 1
    for (int ps = F.bid; ps < npass; ps += F.G) {
        __syncthreads();
        { const int t0 = ps * 32; const int mr = t0 >= TL ? 8 : t0 / SEQ;
          float sh[16], sc[16]; load_row_f32(modp(F, l, mr, 3), lane, sh); load_row_f32(modp(F, l, mr, 4), lane, sc);
#pragma unroll
          for (int rr = 0; rr < 4; ++rr) {
            const int row = 4 * wave + rr, t = ps * 32 + row;
            float h[16]; float ss = 0.f;
#pragma unroll
            for (int i = 0; i < 16; ++i) ss += xr[rr][i] * xr[rr][i];
            const float rstd = rsqrtf(wave_sum(ss) * (1.0f / D) + RMS_EPS);
#pragma unroll
            for (int i = 0; i < 16; ++i) h[i] = (t < M) ? xr[rr][i] * rstd * gg[i] * (1.0f + sc[i]) + sh[i] : 0.f;
            if (t < M) store_row_bf16(H2 + (size_t)t * D, lane, h);
#pragma unroll
            for (int i = 0; i < 2; ++i) {
                u32x4 whi; whi.x = pk2(h[8 * i], h[8 * i + 1]); whi.y = pk2(h[8 * i + 2], h[8 * i + 3]); whi.z = pk2(h[8 * i + 4], h[8 * i + 5]); whi.w = pk2(h[8 * i + 6], h[8 * i + 7]);
                u32x4 wlo; wlo.x = pk2(h[8 * i] - bf_lo(whi.x), h[8 * i + 1] - bf_hi(whi.x)); wlo.y = pk2(h[8 * i + 2] - bf_lo(whi.y), h[8 * i + 3] - bf_hi(whi.y));
                wlo.z = pk2(h[8 * i + 4] - bf_lo(whi.z), h[8 * i + 5] - bf_hi(whi.z)); wlo.w = pk2(h[8 * i + 6] - bf_lo(whi.w), h[8 * i + 7] - bf_hi(whi.w));
                *(LAS u32x4*)(HH + row * RT_HS + 8 * lane + 512 * i) = whi; *(LAS u32x4*)(HL + row * RT_HS + 8 * lane + 512 * i) = wlo; }
          }
          const int pn = ps + F.G;
#pragma unroll
          for (int rr = 0; rr < 4; ++rr) { const int t = pn * 32 + 4 * wave + rr;
              if (pn < npass && t < M) load_row_f32(t >= TL ? cres + (size_t)(t - TL) * D : xres + (size_t)t * D, lane, xr[rr]); }
        }
        __syncthreads();
        f32x16 a0, a1;
#pragma unroll
        for (int i = 0; i < 16; ++i) { a0[i] = 0.f; a1[i] = 0.f; }
        {
            const LAS bf16_t* hp = HH + r * RT_HS + 128 * wave + 8 * hh; const LAS bf16_t* lp = HL + r * RT_HS + 128 * wave + 8 * hh;
            const bf16_t* w0h = WRH + (size_t)r * D + 128 * wave + 8 * hh; const bf16_t* w1h = w0h + (size_t)32 * D;
            const bf16_t* w0l = WRL + (size_t)r * D + 128 * wave + 8 * hh; const bf16_t* w1l = w0l + (size_t)32 * D;
#pragma unroll
            for (int ks = 0; ks < 8; ++ks) {
                const bf16x8 ah = *(const LAS bf16x8*)(hp + 16 * ks), al = *(const LAS bf16x8*)(lp + 16 * ks);
                const bf16x8 b0h = *(const bf16x8*)(w0h + 16 * ks), b1h = *(const bf16x8*)(w1h + 16 * ks), b0l = *(const bf16x8*)(w0l + 16 * ks), b1l = *(const bf16x8*)(w1l + 16 * ks);
                a0 = MFMA32(ah, b0h, a0); a1 = MFMA32(ah, b1h, a1);
                a0 = MFMA32(al, b0h, a0); a1 = MFMA32(al, b1h, a1);
                a0 = MFMA32(ah, b0l, a0); a1 = MFMA32(ah, b1l, a1);
            }
        }
        __syncthreads();
#pragma unroll
        for (int i = 0; i < 16; ++i) { const int tk = crow(i, hh); H2F[(wave * 32 + tk) * 64 + r] = a0[i]; H2F[(wave * 32 + tk) * 64 + 32 + r] = a1[i]; }
        __syncthreads();
        for (int rr = 0; rr < 4; ++rr) {
            const int row = 4 * wave + rr, t = ps * 32 + row;
            if (t >= M) continue;
            float logit = 0.f;
#pragma unroll
            for (int w = 0; w < 8; ++w) logit += H2F[(w * 32 + row) * 64 + lane];
            const float score = sigmoidf_(logit), sel = score + brt;
            float g1 = sel; g1 = fmaxf(g1, __shfl_xor(g1, 1)); g1 = fmaxf(g1, __shfl_xor(g1, 2)); g1 = fmaxf(g1, __shfl_xor(g1, 4));
            const unsigned long long bm = __ballot(sel == g1);
            const unsigned gm = (unsigned)((bm >> (lane & ~7)) & 0xffull);
            const int first = __builtin_ctz(gm);
            float g2 = ((lane & 7) == first) ? -INFINITY : sel; g2 = fmaxf(g2, __shfl_xor(g2, 1)); g2 = fmaxf(g2, __shfl_xor(g2, 2)); g2 = fmaxf(g2, __shfl_xor(g2, 4));
            const float gs = g1 + g2; const int g = lane >> 3;
            int grank = 0;
#pragma unroll
            for (int j = 0; j < 8; ++j) { const float o = __shfl(gs, 8 * j); grank += (o > gs || (o == gs && j < g)) ? 1 : 0; }
            const bool gsel = grank < 4;
            const float ms = gsel ? sel : -INFINITY;
            int rank = 0;
#pragma unroll 4
            for (int j = 0; j < 64; ++j) { const float o = __int_as_float(__builtin_amdgcn_readlane(__float_as_int(ms), j)); rank += (o > ms || (o == ms && j < lane)) ? 1 : 0; }
            const bool chosen = gsel && rank < 8;
            const unsigned long long cb = __ballot(chosen);
            const float ssum = wave_sum(chosen ? score : 0.f);
            if (chosen) {
                const int j = __builtin_popcountll(cb & ((1ull << lane) - 1ull));
                const unsigned p = atomicAdd(cnt + lane, 1u);
                if (j < 8) { toke[(size_t)t * 8 + j] = lane; tokp[(size_t)t * 8 + j] = (int)p; tokw[(size_t)t * 8 + j] = score / ssum * 2.5f; }
            }
        }
    }
    __syncthreads();
}
DI void moe_tables(const Frame& F, int l, int M) {
    LAS int* tb = (LAS int*)(F.lds + MISC_OFF + 64); LAS int* rb = tb + 72; LAS int* cn = rb + 72;
    const unsigned* cnt = (const unsigned*)(F.ws + WS_CTL) + CW_CNT + 128 * l;
    __syncthreads();
    if (F.tid < NE) cn[F.tid] = (int)__hip_atomic_load(cnt + F.tid, __ATOMIC_RELAXED, __HIP_MEMORY_SCOPE_AGENT);
    if (F.tid == NE) cn[NE] = M;
    __syncthreads();
    if (F.tid == 0) { int t = 0, r = 0; for (int e = 0; e < NEX; ++e) { tb[e] = t; rb[e] = r; t += (cn[e] + 255) >> 8; r += cn[e]; } tb[NEX] = t; }
    __syncthreads();
    LAS unsigned char* te = (LAS unsigned char*)(cn + 72);
    if (F.tid < NEX) { const int t0 = tb[F.tid], t1 = tb[F.tid + 1]; for (int t = t0; t < t1; ++t) te[t] = (unsigned char)F.tid; }
    __syncthreads();
}
DI void phase_route_tables(const Frame& F, int l, int M) {
    moe_tables(F, l, M);
    const LAS int* rb = (const LAS int*)(F.lds + MISC_OFF + 64) + 72;
    const int* toke = (const int*)(F.ws + WS_TOKE); const int* tokp = (const int*)(F.ws + WS_TOKP);
    int* tokr = (int*)(F.ws + WS_TOKR); int* rowl = (int*)(F.ws + WS_ROWL);
    for (int i = F.bid * 512 + F.tid; i < M * 8; i += F.G * 512) { const int row = rb[toke[i]] + tokp[i]; tokr[i] = row; rowl[row] = i >> 3; }
    const int shb = rb[NE];
    for (int i = F.bid * 512 + F.tid; i < M + 256; i += F.G * 512) rowl[shb + i] = (i < M) ? i : 0;
}
template <bool DRY = false> DI void phase_combine(const Frame& F, int l, int M) {
    moe_tables(F, l, M);
    const LAS int* rb = (const LAS int*)(F.lds + MISC_OFF + 64) + 72;
    const int shb = rb[NE];
    const int NGW = F.G * 8, gw = F.bid * 8 + F.wave, lane = F.lane;
    const bf16_t* OS_ = (const bf16_t*)(F.ws + WS_R1);
    const int* tokr = (const int*)(F.ws + WS_TOKR); const float* tokw = (const float*)(F.ws + WS_TOKW);
    float* xres = F.out; float* cres = (float*)(F.ws + WS_CTXS);
    bf16_t* H = (bf16_t*)(F.ws + WS_R2 + (DRY ? (size_t)40 * 1024 * 1024 : 0));
    for (int t = gw; t < M; t += NGW) {
        const bool isctx = t >= TL; const int mr = isctx ? 8 : t / SEQ;
        float y[16]; load_row_bf16(OS_ + (size_t)(shb + t) * D, lane, y);
#pragma unroll
        for (int j = 0; j < DBG_NROUTED; ++j) { const int row = tokr[(size_t)t * 8 + j]; const float w = tokw[(size_t)t * 8 + j]; float v[16]; load_row_bf16(OS_ + (size_t)row * D, lane, v);
#pragma unroll
            for (int i = 0; i < 16; ++i) y[i] += w * v[i]; }
        float* xr = isctx ? cres + (size_t)(t - TL) * D : xres + (size_t)t * D;
        float x[16], g[16]; load_row_f32(xr, lane, x); load_row_f32(modp(F, l, mr, 5), lane, g);
#pragma unroll
        for (int i = 0; i < 16; ++i) x[i] += g[i] * y[i];
        if (l == 0) {
            if (!DRY) store_row_f32(xr, lane, x);
            float h[16]; norm_mod(x, F.in[I_G1] + D, modp(F, 1, mr, 0), modp(F, 1, mr, 1), lane, h);
            store_row_bf16(H + (size_t)t * D, lane, h);
        } else {
            float ss = 0.f;
#pragma unroll
            for (int i = 0; i < 16; ++i) ss += x[i] * x[i];
            const float rstd = rsqrtf(wave_sum(ss) * (1.0f / D) + RMS_EPS);
            float gf[16]; load_row_f32(F.in[I_GF], lane, gf);
#pragma unroll
            for (int i = 0; i < 16; ++i) x[i] = x[i] * rstd * gf[i];
            if (!DRY) store_row_f32(xr, lane, x); else store_row_bf16(H + (size_t)t * D, lane, x);
        }
    }
}

constexpr int PH_PER_LAYER = 10, N_PHASES = 2 + 2 * PH_PER_LAYER;
template <class T> DI T* opaque_ptr(T* p) {
    unsigned long long v = (unsigned long long)p; unsigned lo = (unsigned)v, hi = (unsigned)(v >> 32);
    asm volatile("" : "+s"(lo), "+s"(hi)); return (T*)(__attribute__((address_space(1))) T*)(((unsigned long long)hi << 32) | lo);
}
template <int KIND> DI void run_phase(const Frame& F0, const int l0) {
    Frame F = F0; int l = l0; asm volatile("" : "+s"(l));
    F.ws = opaque_ptr(F0.ws); F.out = opaque_ptr(F0.out);
    { int t = F0.tid; asm volatile("" : "+v"(t)); F.tid = t; F.lane = t & 63; F.wave = __builtin_amdgcn_readfirstlane(t >> 6); }
    unsigned char* const ws = F.ws;
    const bool ctx_out = (l == 0);
    const int M = ctx_out ? TA : TL;
    if constexpr (KIND == 0) { mod_vectors(F); conv_router(F); conv_small(F, 0); conv_down(F, 0, (bf16_t*)(ws + WS_WBS + WB_WD)); }
    if constexpr (KIND == 1) { phase_norm1_first(F); }
    if constexpr (KIND == 2) {
        pg8::RectSched<37> S{(const char*)(ws + WS_R2), (const char*)(ws + WS_WBS + WB_WIN), D, D, ctx_out ? 72 : 64, ctx_out ? 0 : 8, ctx_out ? 0 : 11, 64, F.G, F.bid};
        pg8::EpiStoreBf16 E{(bf16_t*)(ws + WS_R1), ZS};
        pg8::gemm_phase<false>(F.lds, F.tid, D, D, D, S, E);
    }
    if constexpr (KIND == 3) {
        for (int ch = F.bid; ch < 256; ch += F.G) gla_chain(F, l, ch, ctx_out);
#if REPEAT_KIND == 31
        for (int ch = F.bid; ch < 256; ch += F.G) gla_chain(F, l, ch, ctx_out);
#endif
#if REPEAT_KIND == 32
        phase_na(F, l, ctx_out);
#endif
        phase_na(F, l, ctx_out);
        phase_conv(F, l, M);
    }
    if constexpr (KIND == 4) { phase_gla_fin(F, l, M); }
    if constexpr (KIND == 5) {
        const char* Ob = (const char*)(ws + WS_R1 + R1_O); bf16_t* Y = (bf16_t*)(ws + WS_R2); const bf16_t* Zb = (const bf16_t*)(ws + WS_R1);
        { pg8::RectSched<4> S{Ob, (const char*)(ws + WS_WBS + WB_WNA), OS, 512, M / 256, 0, 0, 0, F.G, F.bid}; pg8::EpiGate<0> E{Y, Zb, C_MERGE}; pg8::gemm_phase<false>(F.lds, F.tid, 512, OS, 512, S, E); }
        { pg8::RectSched<4> S{Ob + 512 * 2, (const char*)(ws + WS_WBS + WB_WSC), OS, 512, M / 256, 0, 0, 0, F.G, F.bid}; pg8::EpiGate<1> E{Y, Zb, C_MERGE + 1024}; pg8::gemm_phase<false>(F.lds, F.tid, 512, OS, 512, S, E); }
        { pg8::RectSched<4> S{Ob + 1024 * 2, (const char*)(ws + WS_WBS + WB_WGLA), OS, D, M / 256, 0, 0, 0, F.G, F.bid}; pg8::EpiGate<1> E{Y, Zb, C_MERGE + 2048}; pg8::gemm_phase<false>(F.lds, F.tid, D, OS, D, S, E); }
    }
    if constexpr (KIND == 6) {
        pg8::RectSched<4> S{(const char*)(ws + WS_R2), (const char*)(ws + WS_WBS + WB_WOUT), D, D, M / 256, 0, 0, 0, F.G, F.bid};
        pg8::EpiResid E{l == 0 ? F.in[I_X] : F.out, F.out, l == 0 ? F.in[I_CTX] : (const float*)(ws + WS_CTXS), (float*)(ws + WS_CTXS), modp(F, l, 0, 2)};
        pg8::gemm_phase<false>(F.lds, F.tid, D, D, D, S, E);
    }
    if constexpr (KIND == 7) {
#if REPEAT_KIND == 71
        phase_router<true>(F, l, M);
#endif
        phase_router(F, l, M); conv_gu(F, l, (bf16_t*)(ws + WS_R1));
#if REPEAT_KIND == 72
        conv_gu(F, l, (bf16_t*)(ws + WS_R1));
#endif
    }
    if constexpr (KIND == 8) { phase_route_tables(F, l, M); if (l == 0) conv_small(F, 1); }
    if constexpr (KIND == 9) {
        moe_tables(F, l, M);
        const LAS int* tb = (const LAS int*)(F.lds + MISC_OFF + 64);
        pg8::MoeSched<true, 2> S{tb, tb + 72, tb + 144, (const char*)(ws + WS_R1 + R1_H2), (const int*)(ws + WS_ROWL), (const char*)(ws + WS_R1), (size_t)512 * D * 2, D, D, F.G, F.bid};
        pg8::EpiSwiGLU E{(bf16_t*)(ws + WS_R2)};
        pg8::gemm_phase<true>(F.lds, F.tid, D, D, D, S, E);
    }
    if constexpr (KIND == 10) {
        moe_tables(F, l, M);
        const LAS int* tb = (const LAS int*)(F.lds + MISC_OFF + 64);
        pg8::MoeSched<false, 4> S{tb, tb + 72, tb + 144, (const char*)(ws + WS_R2), nullptr, (const char*)(ws + WS_WBS + WB_WD), (size_t)D * FF * 2, FF, FF, F.G, F.bid};
        pg8::EpiDown E{(bf16_t*)(ws + WS_R1)};
        pg8::gemm_phase<false>(F.lds, F.tid, FF, FF, FF, S, E);
    }
    if constexpr (KIND == 11) {
#if REPEAT_KIND == 111
        phase_combine<true>(F, l, M);
#endif
        phase_combine(F, l, M); if (l == 0) conv_down(F, 1, (bf16_t*)(ws + WS_WBS + WB_WD));
    }
}
DI void make_frame(Frame& F, const Args& args, unsigned char* lds_raw) {
    F.lds = (LAS unsigned char*)lds_raw; F.ws = args.ws; F.in = args.in; F.out = args.out;
    F.tid = threadIdx.x; F.lane = F.tid & 63; F.wave = __builtin_amdgcn_readfirstlane(F.tid >> 6); F.G = GRID; F.bid = blockIdx.x;
}
template <int KIND> __global__ void __launch_bounds__(512, 2) fwd_k(Args args) {
    extern __shared__ __attribute__((aligned(16))) unsigned char lds_raw[];
    Frame F; make_frame(F, args, lds_raw);
    run_phase<KIND>(F, args.ph_lo);
}
#if MK_ONE_LAUNCH
__global__ void __launch_bounds__(512, 2) fwd(Args args) {
    extern __shared__ __attribute__((aligned(16))) unsigned char lds_raw[];
    Frame F; make_frame(F, args, lds_raw);
    volatile LAS unsigned* MISC = (volatile LAS unsigned*)(F.lds + MISC_OFF);
    if (F.tid < 4) MISC[F.tid] = 0u;
    __syncthreads();
    XcdBarrier bar = xcd_barrier_post((unsigned*)(F.ws + WS_CTL) + CW_BAR, MISC);
    run_phase<0>(F, 0); xcd_barrier(bar); if (REPEAT_KIND == 0) { run_phase<0>(F, 0); xcd_barrier(bar); }
    run_phase<1>(F, 0); xcd_barrier(bar); if (REPEAT_KIND == 1) { run_phase<1>(F, 0); xcd_barrier(bar); }
#pragma unroll 1
    for (int l = 0; l < 2; ++l) {
        run_phase<2>(F, l); xcd_barrier(bar); if (REPEAT_KIND == 2) { run_phase<2>(F, l); xcd_barrier(bar); }
        run_phase<3>(F, l); xcd_barrier(bar); if (REPEAT_KIND == 3) { run_phase<3>(F, l); xcd_barrier(bar); }
        run_phase<4>(F, l); xcd_barrier(bar); if (REPEAT_KIND == 4) { run_phase<4>(F, l); xcd_barrier(bar); }
        run_phase<5>(F, l); xcd_barrier(bar); if (REPEAT_KIND == 5) { run_phase<5>(F, l); xcd_barrier(bar); }
        run_phase<6>(F, l); xcd_barrier(bar); if (REPEAT_KIND == 6) { run_phase<6>(F, l); xcd_barrier(bar); }
        run_phase<7>(F, l); xcd_barrier(bar); if (REPEAT_KIND == 7) { run_phase<7>(F, l); xcd_barrier(bar); }
        run_phase<8>(F, l); xcd_barrier(bar); if (REPEAT_KIND == 8) { run_phase<8>(F, l); xcd_barrier(bar); }
        run_phase<9>(F, l); xcd_barrier(bar); if (REPEAT_KIND == 9) { run_phase<9>(F, l); xcd_barrier(bar); }
        run_phase<10>(F, l); xcd_barrier(bar); if (REPEAT_KIND == 10) { run_phase<10>(F, l); xcd_barrier(bar); }
        run_phase<11>(F, l); xcd_barrier(bar); if (REPEAT_KIND == 11) { run_phase<11>(F, l); xcd_barrier(bar); }
    }
}
#endif

template <int KIND> static bool prep_kernel() { return hipFuncSetAttribute((const void*)fwd_k<KIND>, hipFuncAttributeMaxDynamicSharedMemorySize, LDS_BYTES) == hipSuccess; }
template <int KIND> static void launch_k(int grid, hipStream_t stream, Args a, int l) { a.ph_lo = l; a.ph_hi = KIND; hipLaunchKernelGGL(fwd_k<KIND>, dim3(grid), dim3(512), LDS_BYTES, stream, a); }
extern "C" void kernel_launch(void* const* d_in, const int* in_sizes, int n_in, void* d_out, int out_size, void* d_ws, size_t ws_size, hipStream_t stream) {
    static int grid = 0;
    if (grid == 0) {
        if (n_in != N_INPUTS || ws_size < WS_END) { fprintf(stderr, "kernel_launch: need %d inputs and %zu bytes of workspace; got %d, %zu\n", N_INPUTS, (size_t)WS_END, n_in, ws_size); grid = -1; return; }
        int dev = 0, cus = 0;
        if (hipGetDevice(&dev) != hipSuccess || hipDeviceGetAttribute(&cus, hipDeviceAttributeMultiprocessorCount, dev) != hipSuccess) { grid = -1; return; }
#if MK_ONE_LAUNCH
        if (hipFuncSetAttribute((const void*)fwd, hipFuncAttributeMaxDynamicSharedMemorySize, LDS_BYTES) != hipSuccess) { grid = -1; return; }
#else
        bool ok = prep_kernel<0>() && prep_kernel<1>() && prep_kernel<2>() && prep_kernel<3>() && prep_kernel<4>() && prep_kernel<5>() && prep_kernel<6>() && prep_kernel<7>() && prep_kernel<8>() && prep_kernel<9>() && prep_kernel<10>() && prep_kernel<11>();
        if (!ok) { fprintf(stderr, "kernel_launch: hipFuncSetAttribute failed\n"); grid = -1; return; }
#endif
        (void)hipGetLastError();
        if (cus < GRID) { fprintf(stderr, "kernel_launch: built for a %d-CU device, found %d CUs\n", GRID, cus); grid = -1; return; }
        grid = GRID;
    }
    if (grid < 0) return;
    if (hipMemsetAsync((char*)d_ws + WS_CTL, 0, ZERO_BYTES, stream) != hipSuccess) return;
    Args a{};
    for (int i = 0; i < N_INPUTS; ++i) a.in[i] = (const float*)d_in[i];
    a.out = (float*)d_out; a.ws = (unsigned char*)d_ws;
#if MK_ONE_LAUNCH
    a.ph_lo = 0; a.ph_hi = N_PHASES;
    hipLaunchKernelGGL(fwd, dim3(grid), dim3(512), LDS_BYTES, stream, a);
#else
    launch_k<0>(grid, stream, a, 0); launch_k<1>(grid, stream, a, 0);
    for (int l = 0; l < 2; ++l) {
        launch_k<2>(grid, stream, a, l); launch_k<3>(grid, stream, a, l); launch_k<4>(grid, stream, a, l); launch_k<5>(grid, stream, a, l); launch_k<6>(grid, stream, a, l);
#ifdef DBG_STOP6
        break;
#endif
        launch_k<7>(grid, stream, a, l); launch_k<8>(grid, stream, a, l); launch_k<9>(grid, stream, a, l); launch_k<10>(grid, stream, a, l); launch_k<11>(grid, stream, a, l);
#ifdef DBG_STOP11
        break;
#endif
    }
#endif
}
```

```cpp
#include <hip/hip_runtime.h>
#include <cstdio>
#include <cstdint>

#define DBG_NROUTED 8
#ifndef REPEAT_KIND
#define REPEAT_KIND -1
#endif
#ifndef MK_ONE_LAUNCH
#define MK_ONE_LAUNCH 1
#endif

#define LAS __attribute__((address_space(3)))
#define DI __device__ __forceinline__
typedef unsigned short bf16_t;
typedef short bf16x8 __attribute__((ext_vector_type(8)));
typedef short s16x4 __attribute__((ext_vector_type(4)));
typedef float f32x4 __attribute__((ext_vector_type(4)));
typedef float f32x16 __attribute__((ext_vector_type(16)));
typedef unsigned u32x4 __attribute__((ext_vector_type(4)));
typedef unsigned u32x2 __attribute__((ext_vector_type(2)));
typedef __bf16 bf16x2_t __attribute__((ext_vector_type(2)));
typedef float f32x2_t __attribute__((ext_vector_type(2)));

DI unsigned pk2(float lo, float hi) { f32x2_t v = {lo, hi}; bf16x2_t b = __builtin_convertvector(v, bf16x2_t); return __builtin_bit_cast(unsigned, b); }
DI float bf_lo(unsigned u) { return __uint_as_float(u << 16); }
DI float bf_hi(unsigned u) { return __uint_as_float(u & 0xffff0000u); }
DI float bf2f(bf16_t b) { return __uint_as_float(((unsigned)b) << 16); }
DI bf16_t f2bf(float f) { return (bf16_t)(pk2(f, 0.f) & 0xffffu); }
DI float wave_sum(float v) {
#pragma unroll
    for (int o = 1; o < 64; o <<= 1) v += __shfl_xor(v, o);
    return v;
}
DI float sigmoidf_(float x) { return __builtin_amdgcn_rcpf(1.0f + __builtin_amdgcn_exp2f(-1.4426950408889634f * x)); }
DI float siluf_(float x) { return x * __builtin_amdgcn_rcpf(1.0f + __builtin_amdgcn_exp2f(-1.4426950408889634f * x)); }

constexpr int D = 1024, NB = 8, SEQ = 2048, CTXL = 256, TL = NB * SEQ, TC = NB * CTXL, TA = TL + TC;
constexpr int NIN = 9248, ZS = 9472  , NKV = 2592;
constexpr int C_KNA = 0, C_VNA = 512, C_KGLA = 1024, C_VGLA = 1536, C_GATE = 2560, C_QNA = 2592, C_BSC = 3104, C_CSC = 3616, C_XSC = 4128, C_QGLA = 4640, C_RGLA = 5152, C_MERGE = 6176;
constexpr int OS = 2048;
constexpr int NE = 64, NEX = 65  , FF = 256, TOPK = 8;
constexpr float RMS_EPS = 1e-6f;

enum { I_X = 0, I_C, I_CTX, I_CCTX, I_WMOD, I_BMOD, I_G1, I_G2, I_WIN, I_RPB, I_WNA, I_CONVW, I_WSC, I_GGW, I_GGB, I_GNG, I_WGLA, I_WOUT, I_WR, I_BR, I_WEG, I_WEU, I_WED, I_WSG, I_WSU, I_WSD, I_GF, N_INPUTS };

constexpr size_t WS_CTL = 0;
constexpr size_t CTL_BYTES = 65536;
constexpr int CW_BAR = 0, CW_CNT = 8192;
constexpr size_t WS_MOD = WS_CTL + CTL_BYTES;
constexpr size_t MOD_BYTES = 2 * 9 * 6 * 1024 * 4;
constexpr size_t ZERO_BYTES = CTL_BYTES + 458752;
constexpr size_t WS_CTXS = WS_CTL + ZERO_BYTES;
constexpr size_t WS_TOKE = WS_CTXS + (size_t)TC * D * 4;
constexpr size_t WS_TOKP = WS_TOKE + (size_t)TA * 8 * 4;
constexpr size_t WS_TOKW = WS_TOKP + (size_t)TA * 8 * 4;
constexpr size_t WS_TOKR = WS_TOKW + (size_t)TA * 8 * 4;
constexpr size_t WS_ROWL = WS_TOKR + (size_t)TA * 8 * 4;
constexpr size_t ROWL_BYTES = ((size_t)TA * 9 + 256) * 4;
constexpr size_t WS_WRT = (WS_ROWL + ROWL_BYTES + 255) & ~(size_t)255;
constexpr size_t WRT_BYTES = (size_t)2 * 2 * NE * D * 2;
constexpr size_t WS_WBS = WS_WRT + WRT_BYTES;
constexpr size_t WB_WIN = 0, WB_WNA = WB_WIN + (size_t)ZS * D * 2, WB_WSC = WB_WNA + (size_t)D * 512 * 2, WB_WGLA = WB_WSC + (size_t)D * 512 * 2,
                 WB_WOUT = WB_WGLA + (size_t)D * D * 2, WB_WD = WB_WOUT + (size_t)D * D * 2, WBS_BYTES = WB_WD + (size_t)NEX * D * FF * 2;
constexpr size_t WS_R2 = WS_WBS + WBS_BYTES;
constexpr size_t HID_ROWS = (size_t)TA * 9 + 256;
constexpr size_t R2_BYTES = HID_ROWS * FF * 2;
constexpr size_t R2_OB = (size_t)TA * D * 2;
constexpr size_t WS_R1 = WS_R2 + R2_BYTES;
constexpr size_t R1_O = (size_t)TA * ZS * 2;
constexpr size_t R1_BYTES = R1_O + (size_t)TA * OS * 2;
constexpr size_t R1_H2 = R1_O;
constexpr size_t WS_WBS1 = WS_R1 + R1_BYTES;
constexpr size_t WS_END = WS_WBS1 + WB_WD;
static_assert(HID_ROWS * D * 2 <= R1_O + 0, "out_slot must fit below H2");
static_assert((size_t)NEX * 512 * D * 2 <= R1_O, "WguT fits");

constexpr int LDS_BYTES = 147456, MISC_OFF = 143360;
constexpr int GRID = 256;

#define XB_TMO      128
#define XB_XCNT(j)  (256  + 64 * (j))
#define XB_XSUB(j)  (1280 + 64 * (j))
#define XB_XGEN(j)  (2304 + 64 * (j))
#define XB_TOP      3328
#define XB_TOPGEN   3392
#define XCD_BAR_WORDS 3456
#define XB_SPIN_CAP (1u << 22)
DI unsigned xb_ld(unsigned* p)              { return __hip_atomic_load(p, __ATOMIC_RELAXED, __HIP_MEMORY_SCOPE_AGENT); }
DI unsigned xb_add(unsigned* p, unsigned v) { return __hip_atomic_fetch_add(p, v, __ATOMIC_RELAXED, __HIP_MEMORY_SCOPE_AGENT); }
DI unsigned xb_xcc_id() { return (unsigned)__builtin_amdgcn_s_getreg((3 << 11) | 20) & 0xFu; }
#define XB_SPIN(cond, bar) do { unsigned _sp = 0; while (cond) { __builtin_amdgcn_s_sleep(1); \
    if ((++_sp & 255u) == 0u) { if (xb_ld(&(bar)[XB_TMO])) break; if (_sp > XB_SPIN_CAP) { atomicAdd(&(bar)[XB_TMO], 1u); break; } } } } while (0)
struct XcdBarrier { unsigned* bar; unsigned x; volatile LAS unsigned* st; };
DI XcdBarrier xcd_barrier_post(unsigned* bar, volatile LAS unsigned* st) {
    XcdBarrier b; b.bar = bar; b.x = xb_xcc_id(); b.st = st;
    if (threadIdx.x == 0) (void)xb_add(&bar[XB_XCNT(b.x)], 1u);
    return b;
}
DI void xcd_barrier_complete(unsigned* bar, unsigned x, unsigned& nloc, unsigned& nx) {
    const unsigned G = gridDim.x * gridDim.y * gridDim.z;
    unsigned sum, cnt, mine, sp = 0u;
    for (;;) {
        sum = 0u; cnt = 0u; mine = 0u;
#pragma unroll
        for (unsigned j = 0; j < 16; ++j) { const unsigned c = xb_ld(&bar[XB_XCNT(j)]); sum += c; cnt += (c > 0u) ? 1u : 0u; mine = (j == x) ? c : mine; }
        if (sum == G) break;
        __builtin_amdgcn_s_sleep(1);
        if ((++sp & 255u) == 0u) { if (xb_ld(&bar[XB_TMO])) break; if (sp > XB_SPIN_CAP) { atomicAdd(&bar[XB_TMO], 1u); break; } }
    }
    nloc = mine > 0u ? mine : 1u; nx = cnt > 0u ? cnt : 1u;
}
DI void xcd_barrier(const XcdBarrier& b) {
    asm volatile("s_waitcnt vmcnt(0)" ::: "memory");
    __syncthreads();
    if (threadIdx.x == 0) {
        unsigned* bar = b.bar;
        __builtin_amdgcn_s_waitcnt(0);
        const unsigned bx = xb_xcc_id();
        unsigned nloc = b.st[0], nx = b.st[1];
        if (nloc == 0u) { xcd_barrier_complete(bar, bx, nloc, nx); b.st[0] = nloc; b.st[1] = nx; }
        const unsigned old = xb_add(&bar[XB_XSUB(bx)], 1u);
        const unsigned gen = old / nloc;
        if (old + 1u == (gen + 1u) * nloc) {
            __builtin_amdgcn_fence(__ATOMIC_RELEASE, "agent");
            asm volatile("s_waitcnt vmcnt(0)" ::: "memory");
            const unsigned og = xb_add(&bar[XB_TOP], 1u);
            const unsigned tg = og / nx;
            if (og + 1u == (tg + 1u) * nx) xb_add(&bar[XB_TOPGEN], 1u);
            else XB_SPIN(xb_ld(&bar[XB_TOPGEN]) == tg, bar);
            __builtin_amdgcn_fence(__ATOMIC_ACQUIRE, "agent");
            xb_add(&bar[XB_XGEN(bx)], 1u);
            asm volatile("s_waitcnt vmcnt(0)" ::: "memory");
        } else {
            XB_SPIN(xb_ld(&bar[XB_XGEN(bx)]) == gen, bar);
            __builtin_amdgcn_fence(__ATOMIC_ACQUIRE, "agent");
            asm volatile("s_waitcnt vmcnt(0)" ::: "memory");
        }
    }
    __syncthreads();
}

namespace pg8 {
constexpr int BM = 256, BK = 64, HALF = 128, HTB = HALF * BK * 2, STAGE_BYTES = 8 * HTB;
DI int lds_byte(int r, int c) { const int st = (r >> 4) * 2 + (c >> 5), rr = r & 15, cc = c & 31, ob = rr * 64 + cc * 2; return st * 1024 + (ob ^ (((ob >> 9) & 1) << 5)); }
DI void stage_rc(int b, int& R, int& C) { const int st = b / 1024, sb = b % 1024, swz = sb ^ (((sb >> 9) & 1) << 5); R = (st >> 1) * 16 + swz / 64; C = (st & 1) * 32 + (swz % 64) / 2; }
DI int perm32(int rho) { const int n = rho >> 4, i = rho & 15; return 8 * (i >> 2) + 4 * n + (i & 3); }

struct GUnit {
    const char* A;
    const char* B;
    const int* rows;
    int pm, pn;
    int valid;
    int aux;
};

template <bool GATHER, class Epi, class Sched>
DI void gemm_phase(LAS unsigned char* lds, const int tid_, const int K_, const int lda, const int ldb, const Sched& S, const Epi& E) {
    int K = K_; asm volatile("" : "+s"(K));
    int tid = tid_; asm volatile("" : "+v"(tid));
    const int wid = __builtin_amdgcn_readfirstlane(tid >> 6), lane = tid & 63, wr = wid >> 2, wc = wid & 3, fr = lane & 15, fq = lane >> 4;
    const int nt = K / BK;
    unsigned voffA, voffB, cc2, ro;
    { int R, C; stage_rc(tid * 16, R, C); ro = (unsigned)R * 4u; cc2 = (unsigned)C * 2u; const int Rb = Epi::PERM ? ((R & ~31) + perm32(R & 31)) : R;
      voffA = (unsigned)(R * lda + C) * 2u; voffB = (unsigned)(Rb * ldb + C) * 2u; }
    const size_t hstepA = (size_t)HALF * lda * 2, qstepA = (size_t)64 * lda * 2, qstepB = (size_t)64 * ldb * 2;
    const unsigned rowb = (unsigned)lda * 2u;
    const size_t kstep = (size_t)(BK * 2);
    const size_t hstepB = (size_t)HALF * ldb * 2;
    const unsigned ldsw = (unsigned)wid * 1024u;
    const int aoff = lds_byte(wr * 64 + fr, fq * 8), boff = lds_byte(wc * 32 + fr, fq * 8);
#define PG8_SA(b, h) (((b) * 2 + (h)) * HTB)
#define PG8_SB(b, h) ((4 + (b) * 2 + (h)) * HTB)
#define PG8_STAGE2(bufoff, gbase, o0, o1) do { \
        __builtin_amdgcn_global_load_lds((const unsigned*)((const char*)(gbase) + (o0)), (LAS unsigned*)(lds + (bufoff) + ldsw), 16, 0, 0); \
        __builtin_amdgcn_global_load_lds((const unsigned*)((const char*)(gbase) + (o1)), (LAS unsigned*)(lds + (bufoff) + ldsw + 8192), 16, 0, 0); } while (0)
#define PG8_STAGEB(bufoff, gbase) do { \
        __builtin_amdgcn_global_load_lds((const unsigned*)((const char*)(gbase) + voffB), (LAS unsigned*)(lds + (bufoff) + ldsw), 16, 0, 0); \
        __builtin_amdgcn_global_load_lds((const unsigned*)((const char*)(gbase) + qstepB + voffB), (LAS unsigned*)(lds + (bufoff) + ldsw + 8192), 16, 0, 0); } while (0)
#define PG8_LDA(dst, b, h) do { _Pragma("unroll") for (int m = 0; m < 4; ++m) _Pragma("unroll") for (int k = 0; k < 2; ++k) dst[m][k] = *(const LAS bf16x8*)(lds + PG8_SA(b, h) + aoff + m * 2048 + k * 1024); } while (0)
#define PG8_LDB(dst, b, h) do { _Pragma("unroll") for (int n = 0; n < 2; ++n) _Pragma("unroll") for (int k = 0; k < 2; ++k) dst[n][k] = *(const LAS bf16x8*)(lds + PG8_SB(b, h) + boff + n * 2048 + k * 1024); } while (0)
#define PG8_MMA(ai, bj, At, Bt) do { __builtin_amdgcn_s_setprio(1); _Pragma("unroll") for (int m = 0; m < 4; ++m) _Pragma("unroll") for (int n = 0; n < 2; ++n) _Pragma("unroll") for (int k = 0; k < 2; ++k) \
        acc[ai][bj][m][n] = __builtin_amdgcn_mfma_f32_16x16x32_bf16(Bt[n][k], At[m][k], acc[ai][bj][m][n], 0, 0, 0); __builtin_amdgcn_s_setprio(0); } while (0)
#define PG8_WAIT_V(n) asm volatile("s_waitcnt vmcnt(" #n ")" ::: "memory")
#define PG8_WAIT_L(n) asm volatile("s_waitcnt lgkmcnt(" #n ")" ::: "memory")
#define PG8_BAR __builtin_amdgcn_s_barrier()
#define PG8_SCHED __builtin_amdgcn_sched_barrier(0)
#define PG8_RIDX(u, p0, p1) do { if (GATHER) { const char* _rb = (const char*)(u).rows; \
        p0 = (unsigned)*(const int*)(_rb + ro) | ((unsigned)*(const int*)(_rb + ro + HALF * 4) << 16); p1 = (unsigned)*(const int*)(_rb + ro + 64 * 4) | ((unsigned)*(const int*)(_rb + ro + (64 + HALF) * 4) << 16); } } while (0)
#define PG8_STAGEA(bufoff, gbase, h, p0, p1) do { if (GATHER) { const unsigned _o0 = (((p0) >> (16 * (h))) & 0xffffu) * rowb + cc2, _o1 = (((p1) >> (16 * (h))) & 0xffffu) * rowb + cc2; PG8_STAGE2(bufoff, gbase, _o0, _o1); } \
        else { __builtin_amdgcn_global_load_lds((const unsigned*)((const char*)(gbase) + (h) * hstepA + voffA), (LAS unsigned*)(lds + (bufoff) + ldsw), 16, 0, 0); \
               __builtin_amdgcn_global_load_lds((const unsigned*)((const char*)(gbase) + (h) * hstepA + qstepA + voffA), (LAS unsigned*)(lds + (bufoff) + ldsw + 8192), 16, 0, 0); } } while (0)
    GUnit cur, nxt; int ui = 0;
    if (!S.next(0, cur)) return;
    f32x4 acc[2][2][4][2];
#pragma unroll
    for (int a = 0; a < 2; ++a)
#pragma unroll
        for (int b = 0; b < 2; ++b)
#pragma unroll
            for (int m = 0; m < 4; ++m)
#pragma unroll
                for (int n = 0; n < 2; ++n) acc[a][b][m][n] = (f32x4){0.f, 0.f, 0.f, 0.f};
    bf16x8 At[4][2], B0[2][2], B1[2][2];
    const char* cA = cur.A; const char* cB = cur.B;
    unsigned cp0 = 0u, cp1 = 0u; PG8_RIDX(cur, cp0, cp1);
    PG8_STAGEB(PG8_SB(0, 0), cB); PG8_STAGEA(PG8_SA(0, 0), cA, 0, cp0, cp1); PG8_STAGEB(PG8_SB(0, 1), cB + hstepB); PG8_STAGEA(PG8_SA(0, 1), cA, 1, cp0, cp1);
    if (wr == 1) PG8_BAR;
    PG8_WAIT_V(4); PG8_BAR;
    PG8_STAGEB(PG8_SB(1, 0), cB + kstep); PG8_STAGEA(PG8_SA(1, 0), cA + kstep, 0, cp0, cp1); PG8_STAGEB(PG8_SB(1, 1), cB + hstepB + kstep);
    PG8_WAIT_V(6); PG8_BAR;
    for (;;) {
        const bool has_next = S.next(ui + 1, nxt);
        const char* nA = has_next ? nxt.A : cA; const char* nB = has_next ? nxt.B : cB;
        unsigned np0 = cp0, np1 = cp1;
        if (has_next) PG8_RIDX(nxt, np0, np1);
        for (int t = 0; t < nt; t += 2) {
            const bool last = (t == nt - 2);
            const char* a1 = cA + (size_t)(t + 1) * kstep;
            const char* a2 = last ? nA : cA + (size_t)(t + 2) * kstep; const char* b2 = last ? nB : cB + (size_t)(t + 2) * kstep;
            const char* a3 = a2 + kstep; const char* b3 = b2 + kstep;
            unsigned xp0 = cp0, xp1 = cp1;
            if (GATHER && last) { asm volatile("" : "+v"(np0), "+v"(np1)); xp0 = np0; xp1 = np1; }
            PG8_LDB(B0, 0, 0); PG8_SCHED; PG8_LDA(At, 0, 0); PG8_STAGEA(PG8_SA(1, 1), a1, 1, cp0, cp1);
            PG8_WAIT_L(8); PG8_BAR; PG8_WAIT_L(0); PG8_MMA(0, 0, At, B0); PG8_BAR; PG8_SCHED;
            PG8_LDB(B1, 0, 1); PG8_STAGEB(PG8_SB(0, 0), b2);
            PG8_BAR; PG8_WAIT_L(0); PG8_MMA(0, 1, At, B1); PG8_BAR;
            PG8_LDA(At, 0, 1); PG8_STAGEA(PG8_SA(0, 0), a2, 0, xp0, xp1);
            PG8_BAR; PG8_WAIT_L(0); PG8_MMA(1, 0, At, B0); PG8_BAR; PG8_SCHED;
            PG8_STAGEB(PG8_SB(0, 1), b2 + hstepB);
            PG8_WAIT_V(6); PG8_BAR; PG8_MMA(1, 1, At, B1); PG8_BAR;
            PG8_LDB(B0, 1, 0); PG8_SCHED; PG8_LDA(At, 1, 0); PG8_STAGEA(PG8_SA(0, 1), a2, 1, xp0, xp1);
            PG8_WAIT_L(8); PG8_BAR; PG8_WAIT_L(0); PG8_MMA(0, 0, At, B0); PG8_BAR; PG8_SCHED;
            PG8_LDB(B1, 1, 1); PG8_STAGEB(PG8_SB(1, 0), b3);
            PG8_BAR; PG8_WAIT_L(0); PG8_MMA(0, 1, At, B1); PG8_BAR;
            PG8_LDA(At, 1, 1); PG8_STAGEA(PG8_SA(1, 0), a3, 0, xp0, xp1);
            PG8_BAR; PG8_WAIT_L(0); PG8_MMA(1, 0, At, B0); PG8_BAR; PG8_SCHED;
            PG8_STAGEB(PG8_SB(1, 1), b3 + hstepB);
            PG8_WAIT_V(6); PG8_BAR; PG8_MMA(1, 1, At, B1); PG8_BAR;
        }
        E(acc, cur, wr, wc, fr, fq);
        if (!has_next) break;
#pragma unroll
        for (int a = 0; a < 2; ++a)
#pragma unroll
            for (int b = 0; b < 2; ++b)
#pragma unroll
                for (int m = 0; m < 4; ++m)
#pragma unroll
                    for (int n = 0; n < 2; ++n) acc[a][b][m][n] = (f32x4){0.f, 0.f, 0.f, 0.f};
        cur = nxt; cA = nA; cB = nB; cp0 = np0; cp1 = np1; ++ui;
    }
    PG8_WAIT_V(0);
    if (wr == 0) PG8_BAR;
    PG8_BAR;
#undef PG8_SA
#undef PG8_SB
#undef PG8_STAGE2
#undef PG8_STAGEB
#undef PG8_LDA
#undef PG8_LDB
#undef PG8_MMA
#undef PG8_WAIT_V
#undef PG8_WAIT_L
#undef PG8_BAR
#undef PG8_SCHED
#undef PG8_RIDX
#undef PG8_STAGEA
}

struct EpiStoreBf16 {
    static constexpr bool PERM = true;
    bf16_t* O; int ldc;
    DI void operator()(const f32x4 (&acc)[2][2][4][2], const GUnit& u, int wr, int wc, int fr, int fq) const {
        const int row0 = u.pm * BM + wr * 64 + fr, col0 = u.pn * BM + wc * 32 + 8 * fq;
#pragma unroll
        for (int ai = 0; ai < 2; ++ai)
#pragma unroll
            for (int m = 0; m < 4; ++m) { bf16_t* rowp = O + (size_t)(row0 + ai * HALF + m * 16) * ldc + col0;
#pragma unroll
                for (int bj = 0; bj < 2; ++bj) { const f32x4 v0 = acc[ai][bj][m][0], v1 = acc[ai][bj][m][1];
                    u32x4 w; w.x = pk2(v0[0], v0[1]); w.y = pk2(v0[2], v0[3]); w.z = pk2(v1[0], v1[1]); w.w = pk2(v1[2], v1[3]);
                    *(u32x4*)(rowp + bj * HALF) = w; } }
    }
};
template <int MODE> struct EpiGate {
    static constexpr bool PERM = true;
    bf16_t* Y; const bf16_t* Zg; int gcol0;
    DI void operator()(const f32x4 (&acc)[2][2][4][2], const GUnit& u, int wr, int wc, int fr, int fq) const {
        const int row0 = u.pm * BM + wr * 64 + fr, col0 = u.pn * BM + wc * 32 + 8 * fq;
#pragma unroll
        for (int ai = 0; ai < 2; ++ai) {
            u32x4 g[4][2], o[4][2];
#pragma unroll
            for (int m = 0; m < 4; ++m) { const size_t row = (size_t)(row0 + ai * HALF + m * 16);
#pragma unroll
                for (int bj = 0; bj < 2; ++bj) { g[m][bj] = *(const u32x4*)(Zg + row * ZS + gcol0 + col0 + bj * HALF); if (MODE == 1) o[m][bj] = *(const u32x4*)(Y + row * D + col0 + bj * HALF); } }
#pragma unroll
            for (int m = 0; m < 4; ++m) { const size_t row = (size_t)(row0 + ai * HALF + m * 16); bf16_t* rowp = Y + row * D + col0;
#pragma unroll
                for (int bj = 0; bj < 2; ++bj) { const f32x4 v0 = acc[ai][bj][m][0], v1 = acc[ai][bj][m][1]; const u32x4 gg = g[m][bj];
                    float r[8];
                    r[0] = v0[0] * sigmoidf_(bf_lo(gg.x)); r[1] = v0[1] * sigmoidf_(bf_hi(gg.x)); r[2] = v0[2] * sigmoidf_(bf_lo(gg.y)); r[3] = v0[3] * sigmoidf_(bf_hi(gg.y));
                    r[4] = v1[0] * sigmoidf_(bf_lo(gg.z)); r[5] = v1[1] * sigmoidf_(bf_hi(gg.z)); r[6] = v1[2] * sigmoidf_(bf_lo(gg.w)); r[7] = v1[3] * sigmoidf_(bf_hi(gg.w));
                    if (MODE == 1) { const u32x4 oo = o[m][bj];
                        r[0] += bf_lo(oo.x); r[1] += bf_hi(oo.x); r[2] += bf_lo(oo.y); r[3] += bf_hi(oo.y); r[4] += bf_lo(oo.z); r[5] += bf_hi(oo.z); r[6] += bf_lo(oo.w); r[7] += bf_hi(oo.w); }
                    u32x4 w; w.x = pk2(r[0], r[1]); w.y = pk2(r[2], r[3]); w.z = pk2(r[4], r[5]); w.w = pk2(r[6], r[7]);
                    *(u32x4*)(rowp + bj * HALF) = w; } }
        }
    }
};
struct EpiResid {
    static constexpr bool PERM = false;
    const float* xsrc; float* xdst; const float* csrc; float* cdst; const float* gate;
    DI void operator()(const f32x4 (&acc)[2][2][4][2], const GUnit& u, int wr, int wc, int fr, int fq) const {
        const int row0 = u.pm * BM + wr * 64 + fr, col0 = u.pn * BM + wc * 32 + 4 * fq;
        const bool isctx = (u.pm * BM) >= TL;
        const int mrow = isctx ? 8 : (u.pm * BM) / SEQ;
        const float* gp = gate + (size_t)mrow * 6144 + col0;
        f32x4 gv[2][2];
#pragma unroll
        for (int bj = 0; bj < 2; ++bj)
#pragma unroll
            for (int n = 0; n < 2; ++n) gv[bj][n] = *(const f32x4*)(gp + bj * HALF + n * 16);
        const float* sb = isctx ? csrc - (size_t)TL * D : xsrc; float* db = isctx ? cdst - (size_t)TL * D : xdst;
#pragma unroll
        for (int ai = 0; ai < 2; ++ai) {
            f32x4 s[4][2][2];
#pragma unroll
            for (int m = 0; m < 4; ++m) { const size_t off = (size_t)(row0 + ai * HALF + m * 16) * D + col0;
#pragma unroll
                for (int bj = 0; bj < 2; ++bj)
#pragma unroll
                    for (int n = 0; n < 2; ++n) s[m][bj][n] = *(const f32x4*)(sb + off + bj * HALF + n * 16); }
#pragma unroll
            for (int m = 0; m < 4; ++m) { const size_t off = (size_t)(row0 + ai * HALF + m * 16) * D + col0;
#pragma unroll
                for (int bj = 0; bj < 2; ++bj)
#pragma unroll
                    for (int n = 0; n < 2; ++n) *(f32x4*)(db + off + bj * HALF + n * 16) = s[m][bj][n] + gv[bj][n] * acc[ai][bj][m][n]; }
        }
    }
};
struct EpiSwiGLU {
    static constexpr bool PERM = true;
    bf16_t* Hd;
    DI void operator()(const f32x4 (&acc)[2][2][4][2], const GUnit& u, int wr, int wc, int fr, int fq) const {
        const int r0 = wr * 64 + fr, col0 = u.pn * HALF + wc * 32 + 8 * fq;
#pragma unroll
        for (int ai = 0; ai < 2; ++ai)
#pragma unroll
            for (int m = 0; m < 4; ++m) { const int r = r0 + ai * HALF + m * 16;
                const f32x4 g0 = acc[ai][0][m][0], g1 = acc[ai][0][m][1], u0 = acc[ai][1][m][0], u1 = acc[ai][1][m][1];
                u32x4 w; w.x = pk2(siluf_(g0[0]) * u0[0], siluf_(g0[1]) * u0[1]); w.y = pk2(siluf_(g0[2]) * u0[2], siluf_(g0[3]) * u0[3]);
                w.z = pk2(siluf_(g1[0]) * u1[0], siluf_(g1[1]) * u1[1]); w.w = pk2(siluf_(g1[2]) * u1[2], siluf_(g1[3]) * u1[3]);
                if (r < u.valid) *(u32x4*)(Hd + (size_t)(u.aux + r) * FF + col0) = w; }
    }
};
struct EpiDown {
    static constexpr bool PERM = true;
    bf16_t* Os;
    DI void operator()(const f32x4 (&acc)[2][2][4][2], const GUnit& u, int wr, int wc, int fr, int fq) const {
        const int r0 = wr * 64 + fr, col0 = u.pn * BM + wc * 32 + 8 * fq;
#pragma unroll
        for (int ai = 0; ai < 2; ++ai)
#pragma unroll
            for (int m = 0; m < 4; ++m) { const int r = r0 + ai * HALF + m * 16; bf16_t* rowp = Os + (size_t)(u.aux + r) * D + col0;
#pragma unroll
                for (int bj = 0; bj < 2; ++bj) { const f32x4 v0 = acc[ai][bj][m][0], v1 = acc[ai][bj][m][1];
                    u32x4 w; w.x = pk2(v0[0], v0[1]); w.y = pk2(v0[2], v0[3]); w.z = pk2(v1[0], v1[1]); w.w = pk2(v1[2], v1[3]);
                    if (r < u.valid) *(u32x4*)(rowp + bj * HALF) = w; } }
    }
};

template <int nN> struct RectSched {
    const char* A; const char* B; int lda, ldb; int nM, exM, exN, exPm0, G, c;
    DI bool next(int i, GUnit& u) const {
        const int L = i * G + c; const int nmain = nM * nN;
        int pm, pn;
        if (L < nmain) { const int W = (L & 7) * (nmain >> 3) + (L >> 3);
            const int grp = W / (8 * nN), rem = W % (8 * nN); pm = grp * 8 + (rem & 7); pn = rem >> 3; }
        else { const int L2 = L - nmain; if (L2 >= exM * exN) return false; pm = exPm0 + (L2 & 7); pn = L2 >> 3; }
        u.A = A + (size_t)pm * BM * lda * 2; u.B = B + (size_t)pn * BM * ldb * 2; u.rows = nullptr; u.pm = pm; u.pn = pn; u.valid = BM; u.aux = 0; return true;
    }
};
template <bool GATHER, int npn> struct MoeSched {
    const LAS int* tb; const LAS int* rb; const LAS int* cn;
    const char* A; const int* rowl; const char* B; size_t bstride; int lda, ldb, G, c;
    DI bool next(int i, GUnit& u) const {
        const int L0 = i * G + c; const int ntile = __builtin_amdgcn_readfirstlane(tb[NEX]); const int nwg = ntile * npn;
        if (L0 >= nwg) return false;
        const int q = nwg >> 3, rr = nwg & 7, xcd = L0 & 7, off = L0 >> 3;
        const int L = (xcd < rr ? xcd * (q + 1) : rr * (q + 1) + (xcd - rr) * q) + off;
        const int T = L / npn, pn = L % npn;
        const int e = __builtin_amdgcn_readfirstlane((int)((const LAS unsigned char*)(tb + 216))[T]);
        const int ti = T - __builtin_amdgcn_readfirstlane(tb[e]), row0 = __builtin_amdgcn_readfirstlane(rb[e]) + ti * BM;
        u.B = B + (size_t)e * bstride + (size_t)pn * BM * ldb * 2;
        if (GATHER) { u.A = A; u.rows = rowl + row0; } else { u.A = A + (size_t)row0 * lda * 2; u.rows = nullptr; }
        u.pm = T; u.pn = pn; const int rem = __builtin_amdgcn_readfirstlane(cn[e]) - ti * BM; u.valid = rem < BM ? rem : BM; u.aux = row0; return true;
    }
};
}

struct Args { const float* in[N_INPUTS]; float* out; unsigned char* ws; int ph_lo, ph_hi; };
struct Frame {
    LAS unsigned char* lds; unsigned char* ws; const float* const* in; float* out;
    int tid, lane, wave, G, bid;
};
DI const float* modp(const Frame& F, int l, int r, int which) { return (const float*)(F.ws + WS_MOD) + ((size_t)(l * 9 + r) * 6 + which) * 1024; }

DI void tr_item(const float* W, int ldw, bf16_t* WT, int ldt, int k0, int n0, int drow0, LAS float* scr, int lane) {
    float tmp[32];
#pragma unroll
    for (int i = 0; i < 32; ++i) { const int kk = 2 * i + (lane >> 5); tmp[i] = W[(size_t)(k0 + kk) * ldw + n0 + (lane & 31)]; }
#pragma unroll
    for (int i = 0; i < 32; ++i) { const int kk = 2 * i + (lane >> 5); scr[kk * 33 + (lane & 31)] = tmp[i]; }
    asm volatile("s_waitcnt lgkmcnt(0)" ::: "memory");
    const int c = lane & 7;
#pragma unroll
    for (int j = 0; j < 4; ++j) { const int n = (lane >> 3) + 8 * j; const LAS float* s = scr + (8 * c) * 33 + n;
        u32x4 o; o.x = pk2(s[0 * 33], s[1 * 33]); o.y = pk2(s[2 * 33], s[3 * 33]); o.z = pk2(s[4 * 33], s[5 * 33]); o.w = pk2(s[6 * 33], s[7 * 33]);
        *(u32x4*)(WT + (size_t)(drow0 + n) * ldt + k0 + 8 * c) = o; }
    asm volatile("s_waitcnt lgkmcnt(0)" ::: "memory");
}
template <int K, int N> DI void conv_plain(const Frame& F, const float* W, bf16_t* WT, int rot, int blk0 = 0) {
    LAS float* scr = (LAS float*)(F.lds + F.wave * 16384);
    const int NGW = (F.G - blk0) * 8, gw = ((F.bid - blk0) * 8 + F.wave + rot) % NGW;
    constexpr int nblk = N / 32, nit = (K / 64) * nblk;
    for (int it = gw; it < nit; it += NGW) { const int kb = it / nblk, nb = it % nblk; tr_item(W, N, WT, K, kb * 64, nb * 32, nb * 32, scr, F.lane); }
}
DI void conv_gu(const Frame& F, int l, bf16_t* WT) {
    LAS float* scr = (LAS float*)(F.lds + F.wave * 16384);
    const int NGW = F.G * 8, gw = F.bid * 8 + F.wave;
    const int nit = NEX * 2 * 128;
    for (int it = gw; it < nit; it += NGW) {
        const int e = it / 256, r = it % 256, isup = r / 128, r2 = r % 128, kb = r2 / 8, nb = r2 % 8, n0 = nb * 32;
        const float* W = (e < NE) ? F.in[isup ? I_WEU : I_WEG] + ((size_t)l * NE + e) * D * FF : F.in[isup ? I_WSU : I_WSG] + (size_t)l * D * FF;
        const int drow0 = ((n0 >> 7) << 8) + (n0 & 127) + (isup ? 128 : 0);
        tr_item(W, FF, WT + (size_t)e * 512 * D, D, kb * 64, n0, drow0, scr, F.lane);
    }
}
DI void conv_down(const Frame& F, int l, bf16_t* WT) {
    LAS float* scr = (LAS float*)(F.lds + F.wave * 16384);
    const int NGW = F.G * 8, gw = F.bid * 8 + F.wave;
    const int nit = NEX * 128;
    for (int it = gw; it < nit; it += NGW) {
        const int e = it / 128, r = it % 128, kb = r / 32, nb = r % 32;
        const float* W = (e < NE) ? F.in[I_WED] + ((size_t)l * NE + e) * FF * D : F.in[I_WSD] + (size_t)l * FF * D;
        tr_item(W, D, WT + (size_t)e * D * FF, FF, kb * 64, nb * 32, nb * 32, scr, F.lane);
    }
}
DI size_t wbs_base(int l) { return l == 0 ? WS_WBS : WS_WBS1; }
DI void conv_small(const Frame& F, int l, int blk0 = 0) {
    if (F.bid < blk0) return;
    bf16_t* wb = (bf16_t*)(F.ws + wbs_base(l));
    conv_plain<D, NIN>(F, F.in[I_WIN] + (size_t)l * D * NIN, (bf16_t*)((char*)wb + WB_WIN), 0, blk0);
    conv_plain<512, D>(F, F.in[I_WNA] + (size_t)l * 512 * D, (bf16_t*)((char*)wb + WB_WNA), 600, blk0);
    conv_plain<512, D>(F, F.in[I_WSC] + (size_t)l * 512 * D, (bf16_t*)((char*)wb + WB_WSC), 900, blk0);
    conv_plain<D, D>(F, F.in[I_WGLA] + (size_t)l * D * D, (bf16_t*)((char*)wb + WB_WGLA), 1200, blk0);
    conv_plain<D, D>(F, F.in[I_WOUT] + (size_t)l * D * D, (bf16_t*)((char*)wb + WB_WOUT), 1700, blk0);
    u32x4* z = (u32x4*)((char*)wb + WB_WIN + (size_t)NIN * D * 2);
    const int nz = (ZS - NIN) * D * 2 / 16;
    unsigned zz = 0u; asm volatile("" : "+v"(zz));
    for (int i = (F.bid - blk0) * 512 + F.tid; i < nz; i += (F.G - blk0) * 512) z[i] = (u32x4){zz, zz, zz, zz};
}
DI void conv_router(const Frame& F) {
    bf16_t* wrt = (bf16_t*)(F.ws + WS_WRT);
    for (int i = F.bid * 512 + F.tid; i < 2 * NE * D; i += F.G * 512) {
        const int l = i / (NE * D), r = i % (NE * D), e = r / D, k = r % D;
        const float w = F.in[I_WR][(size_t)l * D * NE + (size_t)k * NE + e];
        const bf16_t hi = f2bf(w); const bf16_t lo = f2bf(w - bf2f(hi));
        wrt[((size_t)(l * 2 + 0) * NE + e) * D + k] = hi; wrt[((size_t)(l * 2 + 1) * NE + e) * D + k] = lo;
    }
}
DI void mod_vectors(const Frame& F) {
    float* mod = (float*)(F.ws + WS_MOD);
    LAS float* SL = (LAS float*)F.lds;
    LAS float* PART = SL + 9 * 1024;
    __syncthreads();
    for (int i = F.tid; i < 9 * 1024; i += 512) { const float c = (i < 8 * 1024) ? F.in[I_C][i] : F.in[I_CCTX][i - 8 * 1024]; SL[i] = siluf_(c); }
    __syncthreads();
    for (int it = F.bid; it < 2 * 96; it += F.G) {
        const int l = it / 96, cb = it % 96, j = cb * 64 + F.lane;
        const float* W = F.in[I_WMOD] + (size_t)l * D * 6144 + j;
        float acc[9];
#pragma unroll
        for (int q = 0; q < 9; ++q) acc[q] = 0.f;
#pragma unroll 8
        for (int k = F.wave * 128; k < F.wave * 128 + 128; ++k) {
            const float w = W[(size_t)k * 6144];
#pragma unroll
            for (int q = 0; q < 9; ++q) acc[q] += SL[q * 1024 + k] * w;
        }
#pragma unroll
        for (int q = 0; q < 9; ++q) PART[(F.wave * 9 + q) * 64 + F.lane] = acc[q];
        __syncthreads();
        for (int q = F.wave; q < 9; q += 8) {
            float s = F.in[I_BMOD][l * 6144 + j];
#pragma unroll
            for (int w = 0; w < 8; ++w) s += PART[(w * 9 + q) * 64 + F.lane];
            mod[((size_t)(l * 9 + q)) * 6144 + j] = s;
        }
        __syncthreads();
    }
}

DI void load_row_f32(const float* p, int lane, float (&v)[16]) {
#pragma unroll
    for (int i = 0; i < 2; ++i) { const f32x4 a = *(const f32x4*)(p + 8 * lane + 512 * i), b = *(const f32x4*)(p + 8 * lane + 512 * i + 4);
        v[8 * i + 0] = a[0]; v[8 * i + 1] = a[1]; v[8 * i + 2] = a[2]; v[8 * i + 3] = a[3]; v[8 * i + 4] = b[0]; v[8 * i + 5] = b[1]; v[8 * i + 6] = b[2]; v[8 * i + 7] = b[3]; }
}
DI void store_row_f32(float* p, int lane, const float (&v)[16]) {
#pragma unroll
    for (int i = 0; i < 2; ++i) { *(f32x4*)(p + 8 * lane + 512 * i) = (f32x4){v[8 * i], v[8 * i + 1], v[8 * i + 2], v[8 * i + 3]}; *(f32x4*)(p + 8 * lane + 512 * i + 4) = (f32x4){v[8 * i + 4], v[8 * i + 5], v[8 * i + 6], v[8 * i + 7]}; }
}
DI void load_row_bf16(const bf16_t* p, int lane, float (&v)[16]) {
#pragma unroll
    for (int i = 0; i < 2; ++i) { const u32x4 a = *(const u32x4*)(p + 8 * lane + 512 * i);
        v[8 * i + 0] = bf_lo(a.x); v[8 * i + 1] = bf_hi(a.x); v[8 * i + 2] = bf_lo(a.y); v[8 * i + 3] = bf_hi(a.y); v[8 * i + 4] = bf_lo(a.z); v[8 * i + 5] = bf_hi(a.z); v[8 * i + 6] = bf_lo(a.w); v[8 * i + 7] = bf_hi(a.w); }
}
DI void store_row_bf16(bf16_t* p, int lane, const float (&v)[16]) {
#pragma unroll
    for (int i = 0; i < 2; ++i) { u32x4 w; w.x = pk2(v[8 * i], v[8 * i + 1]); w.y = pk2(v[8 * i + 2], v[8 * i + 3]); w.z = pk2(v[8 * i + 4], v[8 * i + 5]); w.w = pk2(v[8 * i + 6], v[8 * i + 7]);
        *(u32x4*)(p + 8 * lane + 512 * i) = w; }
}
DI void norm_mod(const float (&x)[16], const float* g, const float* shift, const float* scale, int lane, float (&h)[16]) {
    float ss = 0.f;
#pragma unroll
    for (int i = 0; i < 16; ++i) ss += x[i] * x[i];
    const float rstd = rsqrtf(wave_sum(ss) * (1.0f / D) + RMS_EPS);
    float gg[16], sh[16], sc[16]; load_row_f32(g, lane, gg); load_row_f32(shift, lane, sh); load_row_f32(scale, lane, sc);
#pragma unroll
    for (int i = 0; i < 16; ++i) h[i] = x[i] * rstd * gg[i] * (1.0f + sc[i]) + sh[i];
}

DI void phase_norm1_first(const Frame& F) {
    const int NGW = F.G * 8, gw = F.bid * 8 + F.wave;
    bf16_t* H = (bf16_t*)(F.ws + WS_R2);
    for (int t = gw; t < TA; t += NGW) {
        const bool isctx = t >= TL; const int r = isctx ? 8 : t / SEQ;
        const float* xr = isctx ? F.in[I_CTX] + (size_t)(t - TL) * D : F.in[I_X] + (size_t)t * D;
        float x[16], h[16]; load_row_f32(xr, F.lane, x);
        norm_mod(x, F.in[I_G1], modp(F, 0, r, 0), modp(F, 0, r, 1), F.lane, h);
        store_row_bf16(H + (size_t)t * D, F.lane, h);
    }
}

DI void phase_conv(const Frame& F, int l, int M) {
    const bf16_t* Z = (const bf16_t*)(F.ws + WS_R1); bf16_t* O = (bf16_t*)(F.ws + WS_R1 + R1_O);
    const float* cw = F.in[I_CONVW] + (size_t)l * 3 * 512;
    for (int it = F.bid * 512 + F.tid; it < M * 64; it += F.G * 512) {
        const int t = it >> 6, c0 = (it & 63) * 8;
        const int L = (t >= TL) ? CTXL : SEQ, pos = (t >= TL) ? (t - TL) % CTXL : t % SEQ;
        const bf16_t* zr = Z + (size_t)t * ZS;
        float u0[8], u1[8], u2[8], bb[8];
        { const u32x4 c = *(const u32x4*)(zr + C_CSC + c0), x = *(const u32x4*)(zr + C_XSC + c0), b = *(const u32x4*)(zr + C_BSC + c0);
          u1[0] = bf_lo(c.x) * bf_lo(x.x); u1[1] = bf_hi(c.x) * bf_hi(x.x); u1[2] = bf_lo(c.y) * bf_lo(x.y); u1[3] = bf_hi(c.y) * bf_hi(x.y);
          u1[4] = bf_lo(c.z) * bf_lo(x.z); u1[5] = bf_hi(c.z) * bf_hi(x.z); u1[6] = bf_lo(c.w) * bf_lo(x.w); u1[7] = bf_hi(c.w) * bf_hi(x.w);
          bb[0] = bf_lo(b.x); bb[1] = bf_hi(b.x); bb[2] = bf_lo(b.y); bb[3] = bf_hi(b.y); bb[4] = bf_lo(b.z); bb[5] = bf_hi(b.z); bb[6] = bf_lo(b.w); bb[7] = bf_hi(b.w); }
        if (pos > 0) { const u32x4 c = *(const u32x4*)(zr - ZS + C_CSC + c0), x = *(const u32x4*)(zr - ZS + C_XSC + c0);
          u0[0] = bf_lo(c.x) * bf_lo(x.x); u0[1] = bf_hi(c.x) * bf_hi(x.x); u0[2] = bf_lo(c.y) * bf_lo(x.y); u0[3] = bf_hi(c.y) * bf_hi(x.y);
          u0[4] = bf_lo(c.z) * bf_lo(x.z); u0[5] = bf_hi(c.z) * bf_hi(x.z); u0[6] = bf_lo(c.w) * bf_lo(x.w); u0[7] = bf_hi(c.w) * bf_hi(x.w); }
        else {
#pragma unroll
            for (int j = 0; j < 8; ++j) u0[j] = 0.f; }
        if (pos < L - 1) { const u32x4 c = *(const u32x4*)(zr + ZS + C_CSC + c0), x = *(const u32x4*)(zr + ZS + C_XSC + c0);
          u2[0] = bf_lo(c.x) * bf_lo(x.x); u2[1] = bf_hi(c.x) * bf_hi(x.x); u2[2] = bf_lo(c.y) * bf_lo(x.y); u2[3] = bf_hi(c.y) * bf_hi(x.y);
          u2[4] = bf_lo(c.z) * bf_lo(x.z); u2[5] = bf_hi(c.z) * bf_hi(x.z); u2[6] = bf_lo(c.w) * bf_lo(x.w); u2[7] = bf_hi(c.w) * bf_hi(x.w); }
        else {
#pragma unroll
            for (int j = 0; j < 8; ++j) u2[j] = 0.f; }
        float o[8];
#pragma unroll
        for (int j = 0; j < 8; ++j) o[j] = bb[j] * (u0[j] * cw[c0 + j] + u1[j] * cw[512 + c0 + j] + u2[j] * cw[1024 + c0 + j]);
        u32x4 w; w.x = pk2(o[0], o[1]); w.y = pk2(o[2], o[3]); w.z = pk2(o[4], o[5]); w.w = pk2(o[6], o[7]);
        *(u32x4*)(O + (size_t)t * OS + 512 + c0) = w;
    }
}

#define MFMA32(a, b, c) __builtin_amdgcn_mfma_f32_32x32x16_bf16((a), (b), (c), 0, 0, 0)
DI int crow(int reg, int h) { return (reg & 3) + 8 * (reg >> 2) + 4 * h; }
DI bf16x8 pack_step(const f32x16& x, int s) {
    u32x4 p; p.x = pk2(x[8 * s], x[8 * s + 1]); p.y = pk2(x[8 * s + 2], x[8 * s + 3]); p.z = pk2(x[8 * s + 4], x[8 * s + 5]); p.w = pk2(x[8 * s + 6], x[8 * s + 7]);
    return __builtin_bit_cast(bf16x8, p);
}
DI bf16x8 cat4(u32x2 a, u32x2 b) { u32x4 p; p.x = a.x; p.y = a.y; p.z = b.x; p.w = b.y; return __builtin_bit_cast(bf16x8, p); }

typedef __attribute__((address_space(3))) s16x4 lds_s16x4;
DI bf16x8 tr8(const LAS bf16_t* p0, const LAS bf16_t* p1) {
    const s16x4 a = __builtin_amdgcn_ds_read_tr16_b64_v4i16((lds_s16x4*)p0), b = __builtin_amdgcn_ds_read_tr16_b64_v4i16((lds_s16x4*)p1);
    return (bf16x8){a[0], a[1], a[2], a[3], b[0], b[1], b[2], b[3]};
}
constexpr int NA_VS = 72;
constexpr int NA_TAB = 8 * NA_VS * 64 * 2;
constexpr float NA_L2E = 1.4426950408889634f;
DI void na_wave_unit(const Frame& F, const bf16_t* Z, bf16_t* O, const LAS float* tab, LAS bf16_t* vt,
                     int qrow0, int head, int nwin, int winrow0  , int ctxrow0, int qgrid_row, int krow_first, int qcol0) {
    const int lane = F.lane, r = lane & 31, h = lane >> 5;
    const int trq = (lane & 15) >> 2, trc = 16 * ((lane >> 4) & 1) + 4 * (lane & 3);
    bf16x8 qf[4];
    { const bf16_t* qp = Z + (size_t)(qrow0 + r) * ZS + C_QNA + head * 64 + 8 * h;
#pragma unroll
      for (int ks = 0; ks < 4; ++ks) qf[ks] = *(const bf16x8*)(qp + 16 * ks); }
    unsigned ix0[4], ix1[4];
    { const int qc = qcol0 + r; int cs = qc - 8; cs = cs < 0 ? 0 : (cs > 48 ? 48 : cs);
#pragma unroll
      for (int g = 0; g < 4; ++g) { unsigned p0 = 0u, p1 = 0u;
#pragma unroll
          for (int e = 0; e < 4; ++e) { const int kc0 = crow(4 * g + e, h), kc1 = 32 + kc0;
              int d0 = kc0 - qc; d0 = d0 < -15 ? -15 : (d0 > 15 ? 15 : d0); int d1 = kc1 - qc; d1 = d1 < -15 ? -15 : (d1 > 15 ? 15 : d1);
              const unsigned c0 = (kc0 < cs || kc0 >= cs + 16) ? 31u : (unsigned)(d0 + 15), c1 = (kc1 < cs || kc1 >= cs + 16) ? 31u : (unsigned)(d1 + 15);
              p0 |= c0 << (8 * e); p1 |= c1 << (8 * e); }
          ix0[g] = p0; ix1[g] = p1; } }
    f32x16 o0, o1;
#pragma unroll
    for (int i = 0; i < 16; ++i) { o0[i] = 0.f; o1[i] = 0.f; }
    float mrun = -1e30f, lrun = 0.f;
    const int ntile = nwin + 4;
    bf16x8 kc[2][4]; u32x4 vr[8];
    const unsigned klane = (unsigned)(r * ZS + 8 * h) * 2u, vlane = (unsigned)((lane >> 3) * ZS + 8 * (lane & 7)) * 2u;
    { const int krow0 = nwin > 0 ? winrow0 : ctxrow0;
      const char* kb = (const char*)Z + ((size_t)krow0 * ZS + C_KNA + head * 64) * 2; const char* vb = (const char*)Z + ((size_t)krow0 * ZS + C_VNA + head * 64) * 2;
#pragma unroll
      for (int ks = 0; ks < 4; ++ks) { kc[0][ks] = *(const bf16x8*)(kb + 32 * ks + klane); kc[1][ks] = *(const bf16x8*)(kb + (size_t)32 * ZS * 2 + 32 * ks + klane); }
#pragma unroll
      for (int i = 0; i < 8; ++i) vr[i] = *(const u32x4*)(vb + (size_t)i * 8 * ZS * 2 + vlane); }
#pragma unroll 1
    for (int j = 0; j < ntile; ++j) {
        const bool isw = j < nwin;
#pragma unroll
        for (int i = 0; i < 8; ++i) { const int p = lane + 64 * i; *(LAS u32x4*)(vt + (p >> 3) * NA_VS + 8 * (p & 7)) = vr[i]; }
        const int jn = (j + 1 < ntile) ? j + 1 : j;
        const int krown = (jn < nwin) ? winrow0 + jn * 64 : ctxrow0 + (jn - nwin) * 64;
        { const char* vb = (const char*)Z + ((size_t)krown * ZS + C_VNA + head * 64) * 2;
#pragma unroll
          for (int i = 0; i < 8; ++i) vr[i] = *(const u32x4*)(vb + (size_t)i * 8 * ZS * 2 + vlane); }
        f32x16 s0, s1;
#pragma unroll
        for (int i = 0; i < 16; ++i) { s0[i] = 0.f; s1[i] = 0.f; }
#pragma unroll
        for (int ks = 0; ks < 4; ++ks) { s0 = MFMA32(kc[0][ks], qf[ks], s0); s1 = MFMA32(kc[1][ks], qf[ks], s1); }
        { const char* kb = (const char*)Z + ((size_t)krown * ZS + C_KNA + head * 64) * 2;
#pragma unroll
          for (int ks = 0; ks < 4; ++ks) { kc[0][ks] = *(const bf16x8*)(kb + 32 * ks + klane); kc[1][ks] = *(const bf16x8*)(kb + (size_t)32 * ZS * 2 + 32 * ks + klane); } }
        const int drow = isw ? (krow_first + j - qgrid_row + 7) : 15;
        const LAS float* trow = tab + (head * 16 + drow) * 32;
#pragma unroll
        for (int g = 0; g < 4; ++g) asm volatile("" : "+v"(ix0[g]), "+v"(ix1[g]));
        float tmax = -1e30f;
#pragma unroll
        for (int i = 0; i < 16; ++i) {
            const float a = s0[i] * (0.125f * NA_L2E) + trow[(ix0[i >> 2] >> (8 * (i & 3))) & 0xffu];
            const float b = s1[i] * (0.125f * NA_L2E) + trow[(ix1[i >> 2] >> (8 * (i & 3))) & 0xffu];
            s0[i] = a; s1[i] = b; tmax = fmaxf(tmax, fmaxf(a, b));
        }
        tmax = fmaxf(tmax, __shfl_xor(tmax, 32));
        const float mnew = fmaxf(mrun, tmax), alpha = __builtin_amdgcn_exp2f(mrun - mnew);
        float psum = 0.f;
#pragma unroll
        for (int i = 0; i < 16; ++i) { const float a = __builtin_amdgcn_exp2f(s0[i] - mnew), b = __builtin_amdgcn_exp2f(s1[i] - mnew); s0[i] = a; s1[i] = b; psum += a + b; }
        psum += __shfl_xor(psum, 32);
        lrun = lrun * alpha + psum; mrun = mnew;
#pragma unroll
        for (int i = 0; i < 16; ++i) { o0[i] *= alpha; o1[i] *= alpha; }
#pragma unroll
        for (int nb = 0; nb < 2; ++nb)
#pragma unroll
            for (int s = 0; s < 2; ++s) {
                const bf16x8 pf = pack_step(nb ? s1 : s0, s);
                const LAS bf16_t* vp = vt + (32 * nb + 16 * s + 4 * h + trq) * NA_VS + trc;
                o0 = MFMA32(tr8(vp, vp + 8 * NA_VS), pf, o0); o1 = MFMA32(tr8(vp + 32, vp + 32 + 8 * NA_VS), pf, o1);
            }
        asm volatile("s_waitcnt lgkmcnt(0)" ::: "memory");
    }
    const float inv = 1.0f / lrun;
    bf16_t* op = O + (size_t)(qrow0 + r) * OS + head * 64 + 4 * h;
#pragma unroll
    for (int g = 0; g < 4; ++g) {
        u32x2 w0, w1; w0.x = pk2(o0[4 * g] * inv, o0[4 * g + 1] * inv); w0.y = pk2(o0[4 * g + 2] * inv, o0[4 * g + 3] * inv);
        w1.x = pk2(o1[4 * g] * inv, o1[4 * g + 1] * inv); w1.y = pk2(o1[4 * g + 2] * inv, o1[4 * g + 3] * inv);
        *(u32x2*)(op + 8 * g) = w0; *(u32x2*)(op + 32 + 8 * g) = w1;
    }
}
DI void phase_na(const Frame& F, int l, bool ctx_out) {
    const bf16_t* Z = (const bf16_t*)(F.ws + WS_R1); bf16_t* O = (bf16_t*)(F.ws + WS_R1 + R1_O);
    LAS float* tab = (LAS float*)(F.lds + NA_TAB);
    for (int i = F.tid; i < 8 * 16 * 32; i += 512) { const int hh = i >> 9, dr = (i >> 5) & 15, dc = i & 31;
        tab[i] = (dr == 15) ? 0.f : ((dc == 31) ? -1e30f : F.in[I_RPB][(size_t)l * 8 * 15 * 31 + (hh * 15 + dr) * 31 + dc] * NA_L2E); }
    __syncthreads();
    LAS bf16_t* vt = (LAS bf16_t*)(F.lds + F.wave * NA_VS * 64 * 2);
    const int nlat = NB * 32 * 2, ntot = nlat + (ctx_out ? NB * 8 : 0);
#pragma unroll 1
    for (int u = F.bid; u < ntot; u += F.G) {
        int qrow0, nwin, winrow0, ctxrow0, qgr, kfirst, qcol0;
        if (u < nlat) { const int b = u >> 6, rr = (u >> 1) & 31, half = u & 1;
            int rs = rr - 4; rs = rs < 0 ? 0 : (rs > 24 ? 24 : rs);
            qrow0 = b * SEQ + rr * 64 + half * 32; nwin = 8; winrow0 = b * SEQ + rs * 64; ctxrow0 = TL + b * CTXL; qgr = rr; kfirst = rs; qcol0 = half * 32;
        } else { const int v = u - nlat, b = v >> 3, qb = v & 7;
            qrow0 = TL + b * CTXL + qb * 32; nwin = 0; winrow0 = 0; ctxrow0 = TL + b * CTXL; qgr = 0; kfirst = 0; qcol0 = 0;
        }
        na_wave_unit(F, Z, O, tab, vt, qrow0, F.wave, nwin, winrow0, ctxrow0, qgr, kfirst, qcol0);
    }
    __syncthreads();
}

constexpr int GL_CUM = 0, GL_CUMS = 132, GL_QS = 33792, GL_KS = 51200, GL_KD = 68608, GL_RS = 136, GL_V = 86016, GL_VS = 72, GL_ST0 = 95232, GL_ST1 = 113664,
              GL_W2T = 132096, GL_B2 = 138240, GL_SEG = 138752, GL_DEC = 139776;
DI void gla_chain(const Frame& F, int l, int chain, bool ctx_out) {
    const int vs = chain & 3, dir = (chain >> 2) & 1, hd = (chain >> 3) & 3, b = chain >> 5;
    const bf16_t* Z = (const bf16_t*)(F.ws + WS_R1);
    bf16_t* OD = (bf16_t*)(F.ws + WS_R2 + (dir ? R2_OB : 0));
    LAS float* CUM = (LAS float*)(F.lds + GL_CUM); LAS bf16_t* QS = (LAS bf16_t*)(F.lds + GL_QS); LAS bf16_t* KS = (LAS bf16_t*)(F.lds + GL_KS);
    LAS bf16_t* VV = (LAS bf16_t*)(F.lds + GL_V);
    LAS bf16_t* W2T = (LAS bf16_t*)(F.lds + GL_W2T); LAS float* B2 = (LAS float*)(F.lds + GL_B2); LAS float* SEG = (LAS float*)(F.lds + GL_SEG); LAS float* DEC = (LAS float*)(F.lds + GL_DEC);
    const int tid = F.tid, lane = F.lane, wave = F.wave, r = lane & 31, h = lane >> 5;
    const int trq = (lane & 15) >> 2, trc = 16 * ((lane >> 4) & 1) + 4 * (lane & 3);
    __syncthreads();
    for (int i = tid; i < 16 * 128; i += 512) { const int ii = i >> 7, d = i & 127; W2T[d * 24 + ii] = f2bf(F.in[I_GGW][((size_t)(l * 2 + dir) * 16 + ii) * 512 + hd * 128 + d]); }
    if (tid < 128) B2[tid] = F.in[I_GGB][(size_t)(l * 2 + dir) * 512 + hd * 128 + tid];
    for (int i = tid; i < 128 * GL_VS / 2; i += 512) ((LAS unsigned*)(F.lds + GL_ST0))[i] = 0u;
    f32x16 S0, S1;
#pragma unroll
    for (int i = 0; i < 16; ++i) { S0[i] = 0.f; S1[i] = 0.f; }
    const int tau = tid >> 3, seg = tid & 7, d0 = seg * 16;
    const int atb = wave & 1, adb = wave >> 1;
    __syncthreads();
    const bf16x8 w2f = *(const LAS bf16x8*)(W2T + (32 * adb + r) * 24 + 8 * h);
    const float b2v = B2[32 * adb + r];
#define GL_ROW(s_, t_) ( ((s_) < 4 ? TL + b * CTXL + (dir ? 3 - (s_) : (s_)) * 64 : b * SEQ + (dir ? 31 - ((s_) - 4) : ((s_) - 4)) * 64) + (dir ? 63 - (t_) : (t_)) )
    u32x4 nq0, nq1, nk0, nk1, nvv; bf16x8 nlr;
    { const bf16_t* zr = Z + (size_t)GL_ROW(0, tau) * ZS;
      nq0 = *(const u32x4*)(zr + C_QGLA + hd * 128 + d0); nq1 = *(const u32x4*)(zr + C_QGLA + hd * 128 + d0 + 8);
      nk0 = *(const u32x4*)(zr + C_KGLA + hd * 128 + d0); nk1 = *(const u32x4*)(zr + C_KGLA + hd * 128 + d0 + 8);
      nvv = *(const u32x4*)(zr + C_VGLA + hd * 256 + vs * 64 + seg * 8);
      nlr = *(const bf16x8*)(Z + (size_t)GL_ROW(0, 32 * atb + r) * ZS + C_GATE + dir * 16 + 8 * h); }
#pragma unroll 1
    for (int s = 0; s < 36; ++s) {
        const bool isctx = s < 4;
        const bool emit = !isctx || ctx_out;
        LAS bf16_t* STo = (LAS bf16_t*)(F.lds + ((s & 1) ? GL_ST1 : GL_ST0)); LAS bf16_t* STn = (LAS bf16_t*)(F.lds + ((s & 1) ? GL_ST0 : GL_ST1));
        const u32x4 q0 = nq0, q1 = nq1, k0 = nk0, k1 = nk1, vv = nvv; const bf16x8 lrf = nlr;
        { const int sn = s < 35 ? s + 1 : 35;
          const bf16_t* zr = Z + (size_t)GL_ROW(sn, tau) * ZS;
          nq0 = *(const u32x4*)(zr + C_QGLA + hd * 128 + d0); nq1 = *(const u32x4*)(zr + C_QGLA + hd * 128 + d0 + 8);
          nk0 = *(const u32x4*)(zr + C_KGLA + hd * 128 + d0); nk1 = *(const u32x4*)(zr + C_KGLA + hd * 128 + d0 + 8);
          nvv = *(const u32x4*)(zr + C_VGLA + hd * 256 + vs * 64 + seg * 8);
          nlr = *(const bf16x8*)(Z + (size_t)GL_ROW(sn, 32 * atb + r) * ZS + C_GATE + dir * 16 + 8 * h); }
        {
            f32x16 ga;
#pragma unroll
            for (int i = 0; i < 16; ++i) ga[i] = 0.f;
            ga = MFMA32(lrf, w2f, ga);
            float sg[4];
#pragma unroll
            for (int g = 0; g < 4; ++g) {
                float run = 0.f;
#pragma unroll
                for (int e = 0; e < 4; ++e) { const float x = ga[4 * g + e] + b2v; run += (fminf(x, 0.f) - __logf(1.0f + __expf(-fabsf(x)))) * (1.0f / 16.0f); ga[4 * g + e] = run; }
                sg[g] = run;
            }
            float off = 0.f;
#pragma unroll
            for (int g = 0; g < 4; ++g) { const float ps = __shfl_xor(sg[g], 32); const float o = off + (h ? ps : 0.f);
#pragma unroll
                for (int e = 0; e < 4; ++e) CUM[(32 * atb + 8 * g + 4 * h + e) * GL_CUMS + 32 * adb + r] = ga[4 * g + e] + o;
                off += sg[g] + ps; }
            if (h == 0) SEG[atb * 128 + 32 * adb + r] = off;
        }
        __syncthreads();
        {
            float qv[16], kv[16];
            qv[0] = bf_lo(q0.x); qv[1] = bf_hi(q0.x); qv[2] = bf_lo(q0.y); qv[3] = bf_hi(q0.y); qv[4] = bf_lo(q0.z); qv[5] = bf_hi(q0.z); qv[6] = bf_lo(q0.w); qv[7] = bf_hi(q0.w);
            qv[8] = bf_lo(q1.x); qv[9] = bf_hi(q1.x); qv[10] = bf_lo(q1.y); qv[11] = bf_hi(q1.y); qv[12] = bf_lo(q1.z); qv[13] = bf_hi(q1.z); qv[14] = bf_lo(q1.w); qv[15] = bf_hi(q1.w);
            kv[0] = bf_lo(k0.x); kv[1] = bf_hi(k0.x); kv[2] = bf_lo(k0.y); kv[3] = bf_hi(k0.y); kv[4] = bf_lo(k0.z); kv[5] = bf_hi(k0.z); kv[6] = bf_lo(k0.w); kv[7] = bf_hi(k0.w);
            kv[8] = bf_lo(k1.x); kv[9] = bf_hi(k1.x); kv[10] = bf_lo(k1.y); kv[11] = bf_hi(k1.y); kv[12] = bf_lo(k1.z); kv[13] = bf_hi(k1.z); kv[14] = bf_lo(k1.w); kv[15] = bf_hi(k1.w);
            float qs[16], ks[16];
#pragma unroll
            for (int j = 0; j < 4; ++j) {
                const f32x4 e0 = *(const LAS f32x4*)(SEG + d0 + 4 * j), e1 = *(const LAS f32x4*)(SEG + 128 + d0 + 4 * j);
                const f32x4 cl = *(const LAS f32x4*)(CUM + tau * GL_CUMS + d0 + 4 * j);
#pragma unroll
                for (int e = 0; e < 4; ++e) {
                    const float cum = cl[e] + (tau >= 32 ? e0[e] : 0.f), last = e0[e] + e1[e];
                    const int jj = 4 * j + e;
                    const float ex = __expf(cum), inv = __builtin_amdgcn_rcpf(ex);
                    qs[jj] = qv[jj] * 0.08838834764831845f * ex;
                    ks[jj] = kv[jj] * inv;
                    if (tau == 0) DEC[d0 + jj] = __expf(last);
                }
            }
            u32x4 w;
            w.x = pk2(qs[0], qs[1]); w.y = pk2(qs[2], qs[3]); w.z = pk2(qs[4], qs[5]); w.w = pk2(qs[6], qs[7]); *(LAS u32x4*)(QS + tau * GL_RS + d0) = w;
            w.x = pk2(qs[8], qs[9]); w.y = pk2(qs[10], qs[11]); w.z = pk2(qs[12], qs[13]); w.w = pk2(qs[14], qs[15]); *(LAS u32x4*)(QS + tau * GL_RS + d0 + 8) = w;
            w.x = pk2(ks[0], ks[1]); w.y = pk2(ks[2], ks[3]); w.z = pk2(ks[4], ks[5]); w.w = pk2(ks[6], ks[7]); *(LAS u32x4*)(KS + tau * GL_RS + d0) = w;
            w.x = pk2(ks[8], ks[9]); w.y = pk2(ks[10], ks[11]); w.z = pk2(ks[12], ks[13]); w.w = pk2(ks[14], ks[15]); *(LAS u32x4*)(KS + tau * GL_RS + d0 + 8) = w;
            *(LAS u32x4*)(VV + tau * GL_VS + seg * 8) = vv;
        }
        __syncthreads();
        if (wave < 4) {
            if (emit) {
                const int vb = wave & 1, tb = wave >> 1;
                f32x16 a0, a1, oo;
#pragma unroll
                for (int i = 0; i < 16; ++i) { a0[i] = 0.f; a1[i] = 0.f; oo[i] = 0.f; }
#pragma unroll
                for (int kk = 0; kk < 8; ++kk) {
                    const bf16x8 qf = *(const LAS bf16x8*)(QS + (32 * tb + r) * GL_RS + 16 * kk + 8 * h);
                    const bf16x8 kf0 = *(const LAS bf16x8*)(KS + r * GL_RS + 16 * kk + 8 * h);
                    a0 = MFMA32(kf0, qf, a0);
                    if (tb == 1) { const bf16x8 kf1 = *(const LAS bf16x8*)(KS + (32 + r) * GL_RS + 16 * kk + 8 * h); a1 = MFMA32(kf1, qf, a1); }
                }
                const int tt = 32 * tb + r;
#pragma unroll
                for (int i = 0; i < 16; ++i) { const int sg0 = crow(i, h); if (sg0 > tt) a0[i] = 0.f; if (32 + sg0 > tt) a1[i] = 0.f; }
#pragma unroll
                for (int sb = 0; sb < 2; ++sb)
#pragma unroll
                    for (int st = 0; st < 2; ++st) {
                        if (sb == 1 && tb == 0) continue;
                        const bf16x8 pf = pack_step(sb ? a1 : a0, st);
                        const LAS bf16_t* vp = VV + (32 * sb + 16 * st + 4 * h + trq) * GL_VS + 32 * vb + trc;
                        oo = MFMA32(tr8(vp, vp + 8 * GL_VS), pf, oo);
                    }
#pragma unroll
                for (int kk = 0; kk < 8; ++kk) {
                    const LAS bf16_t* sp = STo + (16 * kk + 8 * h + trq) * GL_VS + 32 * vb + trc;
                    const bf16x8 qf = *(const LAS bf16x8*)(QS + (32 * tb + r) * GL_RS + 16 * kk + 8 * h);
                    oo = MFMA32(tr8(sp, sp + 4 * GL_VS), qf, oo);
                }
                const int orow = GL_ROW(s, tt);
                bf16_t* op = OD + (size_t)orow * D + hd * 256 + vs * 64 + 32 * vb + 4 * h;
#pragma unroll
                for (int g = 0; g < 4; ++g) { u32x2 w; w.x = pk2(oo[4 * g], oo[4 * g + 1]); w.y = pk2(oo[4 * g + 2], oo[4 * g + 3]); *(u32x2*)(op + 8 * g) = w; }
            }
        } else {
            const int db = wave - 4, dd = 32 * db + r;
            const float dec = DEC[dd];
#pragma unroll
            for (int kk = 0; kk < 4; ++kk) {
                const LAS bf16_t* kp = KS + (16 * kk + 8 * h + trq) * GL_RS + 32 * db + trc;
                const LAS bf16_t* v0p = VV + (16 * kk + 8 * h + trq) * GL_VS + trc;
                const bf16x8 kf = tr8(kp, kp + 4 * GL_RS);
                S0 = MFMA32(tr8(v0p, v0p + 4 * GL_VS), kf, S0); S1 = MFMA32(tr8(v0p + 32, v0p + 32 + 4 * GL_VS), kf, S1);
            }
#pragma unroll
            for (int i = 0; i < 16; ++i) { S0[i] *= dec; S1[i] *= dec; }
#pragma unroll
            for (int g = 0; g < 4; ++g) {
                u32x2 w0, w1; w0.x = pk2(S0[4 * g], S0[4 * g + 1]); w0.y = pk2(S0[4 * g + 2], S0[4 * g + 3]); w1.x = pk2(S1[4 * g], S1[4 * g + 1]); w1.y = pk2(S1[4 * g + 2], S1[4 * g + 3]);
                *(LAS u32x2*)(STn + dd * GL_VS + 8 * g + 4 * h) = w0; *(LAS u32x2*)(STn + dd * GL_VS + 32 + 8 * g + 4 * h) = w1;
            }
        }
    }
#undef GL_ROW
    __syncthreads();
}
DI void phase_gla_fin(const Frame& F, int l, int M) {
    const int NGW = F.G * 8, gw = F.bid * 8 + F.wave, lane = F.lane;
    const bf16_t* Z = (const bf16_t*)(F.ws + WS_R1); bf16_t* O = (bf16_t*)(F.ws + WS_R1 + R1_O);
    const bf16_t* OFp = (const bf16_t*)(F.ws + WS_R2); const bf16_t* OBp = (const bf16_t*)(F.ws + WS_R2 + R2_OB);
    const float* gn = F.in[I_GNG] + (size_t)l * 256;
    for (int t = gw; t < M; t += NGW) {
        const u32x4 a0 = *(const u32x4*)(OFp + (size_t)t * D + 16 * lane), a1 = *(const u32x4*)(OFp + (size_t)t * D + 16 * lane + 8);
        const u32x4 b0 = *(const u32x4*)(OBp + (size_t)t * D + 16 * lane), b1 = *(const u32x4*)(OBp + (size_t)t * D + 16 * lane + 8);
        const u32x4 r0 = *(const u32x4*)(Z + (size_t)t * ZS + C_RGLA + 16 * lane), r1 = *(const u32x4*)(Z + (size_t)t * ZS + C_RGLA + 16 * lane + 8);
        float o[16], rr[16];
        o[0] = bf_lo(a0.x) + bf_lo(b0.x); o[1] = bf_hi(a0.x) + bf_hi(b0.x); o[2] = bf_lo(a0.y) + bf_lo(b0.y); o[3] = bf_hi(a0.y) + bf_hi(b0.y);
        o[4] = bf_lo(a0.z) + bf_lo(b0.z); o[5] = bf_hi(a0.z) + bf_hi(b0.z); o[6] = bf_lo(a0.w) + bf_lo(b0.w); o[7] = bf_hi(a0.w) + bf_hi(b0.w);
        o[8] = bf_lo(a1.x) + bf_lo(b1.x); o[9] = bf_hi(a1.x) + bf_hi(b1.x); o[10] = bf_lo(a1.y) + bf_lo(b1.y); o[11] = bf_hi(a1.y) + bf_hi(b1.y);
        o[12] = bf_lo(a1.z) + bf_lo(b1.z); o[13] = bf_hi(a1.z) + bf_hi(b1.z); o[14] = bf_lo(a1.w) + bf_lo(b1.w); o[15] = bf_hi(a1.w) + bf_hi(b1.w);
        rr[0] = bf_lo(r0.x); rr[1] = bf_hi(r0.x); rr[2] = bf_lo(r0.y); rr[3] = bf_hi(r0.y); rr[4] = bf_lo(r0.z); rr[5] = bf_hi(r0.z); rr[6] = bf_lo(r0.w); rr[7] = bf_hi(r0.w);
        rr[8] = bf_lo(r1.x); rr[9] = bf_hi(r1.x); rr[10] = bf_lo(r1.y); rr[11] = bf_hi(r1.y); rr[12] = bf_lo(r1.z); rr[13] = bf_hi(r1.z); rr[14] = bf_lo(r1.w); rr[15] = bf_hi(r1.w);
        float ss = 0.f;
#pragma unroll
        for (int i = 0; i < 16; ++i) ss += o[i] * o[i];
        ss += __shfl_xor(ss, 1); ss += __shfl_xor(ss, 2); ss += __shfl_xor(ss, 4); ss += __shfl_xor(ss, 8);
        const float rstd = rsqrtf(ss * (1.0f / 256.0f) + RMS_EPS);
        const int v0 = (lane & 15) * 16;
        float y[16];
#pragma unroll
        for (int i = 0; i < 16; ++i) y[i] = o[i] * rstd * gn[v0 + i] * siluf_(rr[i]);
        u32x4 w0, w1; w0.x = pk2(y[0], y[1]); w0.y = pk2(y[2], y[3]); w0.z = pk2(y[4], y[5]); w0.w = pk2(y[6], y[7]);
        w1.x = pk2(y[8], y[9]); w1.y = pk2(y[10], y[11]); w1.z = pk2(y[12], y[13]); w1.w = pk2(y[14], y[15]);
        *(u32x4*)(O + (size_t)t * OS + 1024 + 16 * lane) = w0; *(u32x4*)(O + (size_t)t * OS + 1024 + 16 * lane + 8) = w1;
    }
}

constexpr int RT_HS = 1032;
template <bool DRY = false> DI void phase_router(const Frame& F, int l, int M) {
    LAS bf16_t* HH = (LAS bf16_t*)F.lds;
    LAS bf16_t* HL = HH + 32 * RT_HS;
    LAS float* H2F = (LAS float*)F.lds;
    bf16_t* H2 = (bf16_t*)(F.ws + WS_R1 + R1_H2);
    const float* xres = F.out; const float* cres = (const float*)(F.ws + WS_CTXS);
    const bf16_t* WRH = (const bf16_t*)(F.ws + WS_WRT) + (size_t)(l * 2) * NE * D; const bf16_t* WRL = WRH + (size_t)NE * D;
    int* toke = (int*)(F.ws + WS_TOKE); int* tokp = (int*)(F.ws + (DRY ? WS_TOKR : WS_TOKP)); float* tokw = (float*)(F.ws + WS_TOKW);
    unsigned* cnt = (unsigned*)(F.ws + WS_CTL) + CW_CNT + 4096 * l + (DRY ? 32 : 0);
    const int lane = F.lane, wave = F.wave, r = lane & 31, hh = lane >> 5;
    const float brt = F.in[I_BR][l * NE + lane];
    const int npass = (M + 31) / 32;
    float xr[4][16];
#pragma unroll
    for (int rr = 0; rr < 4; ++rr) { const int t = F.bid * 32 + 4 * wave + rr;
        if (F.bid < npass && t < M) load_row_f32(t >= TL ? cres + (size_t)(t - TL) * D : xres + (size_t)t * D, lane, xr[rr]);
        else {
#pragma unroll
            for (int i = 0; i < 16; ++i) xr[rr][i] = 0.f; } }
    float gg[16]; load_row_f32(F.in[I_G2] + (size_t)l * D, lane, gg);
#pragma unroll 1
    for (int ps = F.bid; ps < npass; ps += F.G) {
        __syncthreads();
        { const int t0 = ps * 32; const int mr = t0 >= TL ? 8 : t0 / SEQ;
          float sh[16], sc[16]; load_row_f32(modp(F, l, mr, 3), lane, sh); load_row_f32(modp(F, l, mr, 4), lane, sc);
#pragma unroll
          for (int rr = 0; rr < 4; ++rr) {
            const int row = 4 * wave + rr, t = ps * 32 + row;
            float h[16]; float ss = 0.f;
#pragma unroll
            for (int i = 0; i < 16; ++i) ss += xr[rr][i] * xr[rr][i];
            const float rstd = rsqrtf(wave_sum(ss) * (1.0f / D) + RMS_EPS);
#pragma unroll
            for (int i = 0; i < 16; ++i) h[i] = (t < M) ? xr[rr][i] * rstd * gg[i] * (1.0f + sc[i]) + sh[i] : 0.f;
            if (t < M) store_row_bf16(H2 + (size_t)t * D, lane, h);
#pragma unroll
            for (int i = 0; i < 2; ++i) {
                u32x4 whi; whi.x = pk2(h[8 * i], h[8 * i + 1]); whi.y = pk2(h[8 * i + 2], h[8 * i + 3]); whi.z = pk2(h[8 * i + 4], h[8 * i + 5]); whi.w = pk2(h[8 * i + 6], h[8 * i + 7]);
                u32x4 wlo; wlo.x = pk2(h[8 * i] - bf_lo(whi.x), h[8 * i + 1] - bf_hi(whi.x)); wlo.y = pk2(h[8 * i + 2] - bf_lo(whi.y), h[8 * i + 3] - bf_hi(whi.y));
                wlo.z = pk2(h[8 * i + 4] - bf_lo(whi.z), h[8 * i + 5] - bf_hi(whi.z)); wlo.w = pk2(h[8 * i + 6] - bf_lo(whi.w), h[8 * i + 7] - bf_hi(whi.w));
                *(LAS u32x4*)(HH + row * RT_HS + 8 * lane + 512 * i) = whi; *(LAS u32x4*)(HL + row * RT_HS + 8 * lane + 512 * i) = wlo; }
          }
          const int pn = ps + F.G;
#pragma unroll
          for (int rr = 0; rr < 4; ++rr) { const int t = pn * 32 + 4 * wave + rr;
              if (pn < npass && t < M) load_row_f32(t >= TL ? cres + (size_t)(t - TL) * D : xres + (size_t)t * D, lane, xr[rr]); }
        }
        __syncthreads();
        f32x16 a0, a1;
#pragma unroll
        for (int i = 0; i < 16; ++i) { a0[i] = 0.f; a1[i] = 0.f; }
        {
            const LAS bf16_t* hp = HH + r * RT_HS + 128 * wave + 8 * hh; const LAS bf16_t* lp = HL + r * RT_HS + 128 * wave + 8 * hh;
            const bf16_t* w0h = WRH + (size_t)r * D + 128 * wave + 8 * hh; const bf16_t* w1h = w0h + (size_t)32 * D;
            const bf16_t* w0l = WRL + (size_t)r * D + 128 * wave + 8 * hh; const bf16_t* w1l = w0l + (size_t)32 * D;
#pragma unroll
            for (int ks = 0; ks < 8; ++ks) {
                const bf16x8 ah = *(const LAS bf16x8*)(hp + 16 * ks), al = *(const LAS bf16x8*)(lp + 16 * ks);
                const bf16x8 b0h = *(const bf16x8*)(w0h + 16 * ks), b1h = *(const bf16x8*)(w1h + 16 * ks), b0l = *(const bf16x8*)(w0l + 16 * ks), b1l = *(const bf16x8*)(w1l + 16 * ks);
                a0 = MFMA32(ah, b0h, a0); a1 = MFMA32(ah, b1h, a1);
                a0 = MFMA32(al, b0h, a0); a1 = MFMA32(al, b1h, a1);
                a0 = MFMA32(ah, b0l, a0); a1 = MFMA32(ah, b1l, a1);
            }
        }
        __syncthreads();
#pragma unroll
        for (int i = 0; i < 16; ++i) { const int tk = crow(i, hh); H2F[(wave * 32 + tk) * 64 + r] = a0[i]; H2F[(wave * 32 + tk) * 64 + 32 + r] = a1[i]; }
        __syncthreads();
        LAS unsigned* lcnt = (LAS unsigned*)(F.lds + MISC_OFF + 2048);
        if (F.tid < 64) lcnt[F.tid] = 0u;
        __syncthreads();
        int myj[4]; unsigned mylp[4]; float myw[4];
#pragma unroll
        for (int rr = 0; rr < 4; ++rr) {
            const int row = 4 * wave + rr, t = ps * 32 + row;
            myj[rr] = -1; mylp[rr] = 0u; myw[rr] = 0.f;
            if (t >= M) continue;
            float logit = 0.f;
#pragma unroll
            for (int w = 0; w < 8; ++w) logit += H2F[(w * 32 + row) * 64 + lane];
            const float score = sigmoidf_(logit), sel = score + brt;
            float g1 = sel; g1 = fmaxf(g1, __shfl_xor(g1, 1)); g1 = fmaxf(g1, __shfl_xor(g1, 2)); g1 = fmaxf(g1, __shfl_xor(g1, 4));
            const unsigned long long bm = __ballot(sel == g1);
            const unsigned gm = (unsigned)((bm >> (lane & ~7)) & 0xffull);
            const int first = __builtin_ctz(gm);
            float g2 = ((lane & 7) == first) ? -INFINITY : sel; g2 = fmaxf(g2, __shfl_xor(g2, 1)); g2 = fmaxf(g2, __shfl_xor(g2, 2)); g2 = fmaxf(g2, __shfl_xor(g2, 4));
            const float gs = g1 + g2; const int g = lane >> 3;
            int grank = 0;
#pragma unroll
            for (int j = 0; j < 8; ++j) { const float o = __shfl(gs, 8 * j); grank += (o > gs || (o == gs && j < g)) ? 1 : 0; }
            const bool gsel = grank < 4;
            const float ms = gsel ? sel : -INFINITY;
            int rank = 0;
#pragma unroll 4
            for (int j = 0; j < 64; ++j) { const float o = __int_as_float(__builtin_amdgcn_readlane(__float_as_int(ms), j)); rank += (o > ms || (o == ms && j < lane)) ? 1 : 0; }
            const bool chosen = gsel && rank < 8;
            const unsigned long long cb = __ballot(chosen);
            const float ssum = wave_sum(chosen ? score : 0.f);
            if (chosen) {
                const int j = __builtin_popcountll(cb & ((1ull << lane) - 1ull));
                if (j < 8) { myj[rr] = j; mylp[rr] = __hip_atomic_fetch_add(&lcnt[lane], 1u, __ATOMIC_RELAXED, __HIP_MEMORY_SCOPE_WORKGROUP); myw[rr] = score * __builtin_amdgcn_rcpf(ssum) * 2.5f; }
            }
        }
        __syncthreads();
        if (F.tid < 64) { const unsigned c = lcnt[F.tid]; lcnt[64 + F.tid] = c ? atomicAdd(cnt + F.tid * 64, c) : 0u; }
        __syncthreads();
#pragma unroll
        for (int rr = 0; rr < 4; ++rr) {
            const int t = ps * 32 + 4 * wave + rr;
            if (myj[rr] >= 0) { const size_t o = (size_t)t * 8 + myj[rr]; toke[o] = lane; tokp[o] = (int)(lcnt[64 + lane] + mylp[rr]); tokw[o] = myw[rr]; }
        }
    }
    __syncthreads();
}
DI void moe_tables(const Frame& F, int l, int M) {
    LAS int* tb = (LAS int*)(F.lds + MISC_OFF + 64); LAS int* rb = tb + 72; LAS int* cn = rb + 72;
    const unsigned* cnt = (const unsigned*)(F.ws + WS_CTL) + CW_CNT + 4096 * l;
    __syncthreads();
    if (F.tid < NE) cn[F.tid] = (int)__hip_atomic_load(cnt + F.tid * 64, __ATOMIC_RELAXED, __HIP_MEMORY_SCOPE_AGENT);
    if (F.tid == NE) cn[NE] = M;
    __syncthreads();
    if (F.tid == 0) { int t = 0, r = 0; for (int e = 0; e < NEX; ++e) { tb[e] = t; rb[e] = r; t += (cn[e] + 255) >> 8; r += cn[e]; } tb[NEX] = t; }
    __syncthreads();
    LAS unsigned char* te = (LAS unsigned char*)(cn + 72);
    if (F.tid < NEX) { const int t0 = tb[F.tid], t1 = tb[F.tid + 1]; for (int t = t0; t < t1; ++t) te[t] = (unsigned char)F.tid; }
    __syncthreads();
}
DI void phase_route_tables(const Frame& F, int l, int M) {
    moe_tables(F, l, M);
    const LAS int* rb = (const LAS int*)(F.lds + MISC_OFF + 64) + 72;
    const int* toke = (const int*)(F.ws + WS_TOKE); const int* tokp = (const int*)(F.ws + WS_TOKP);
    int* tokr = (int*)(F.ws + WS_TOKR); int* rowl = (int*)(F.ws + WS_ROWL);
    for (int i = F.bid * 512 + F.tid; i < M * 8; i += F.G * 512) { const int row = rb[toke[i]] + tokp[i]; tokr[i] = row; rowl[row] = i >> 3; }
    const int shb = rb[NE];
    for (int i = F.bid * 512 + F.tid; i < M + 256; i += F.G * 512) rowl[shb + i] = (i < M) ? i : 0;
}
template <bool DRY = false> DI void phase_combine(const Frame& F, int l, int M) {
    moe_tables(F, l, M);
    const LAS int* rb = (const LAS int*)(F.lds + MISC_OFF + 64) + 72;
    const int shb = rb[NE];
    const int gw = F.bid * 8 + F.wave, lane = F.lane;
    const bf16_t* OS_ = (const bf16_t*)(F.ws + WS_R1);
    const int* tokr = (const int*)(F.ws + WS_TOKR); const float* tokw = (const float*)(F.ws + WS_TOKW);
    float* xres = F.out; float* cres = (float*)(F.ws + WS_CTXS);
    bf16_t* H = (bf16_t*)(F.ws + WS_R2 + (DRY ? (size_t)40 * 1024 * 1024 : 0));
    const int per = M / (GRID * 8);
    const int tbeg = gw * per;
    int mr_cur = -1;
    float g2v[16], shv[16], scv[16], gnv[16];
    if (l == 0) load_row_f32(F.in[I_G1] + D, lane, gnv); else load_row_f32(F.in[I_GF], lane, gnv);
    int4 nr0, nr1; f32x4 nw0, nw1; float xn[16];
    { const int t = tbeg; nr0 = *(const int4*)(tokr + (size_t)t * 8); nr1 = *(const int4*)(tokr + (size_t)t * 8 + 4); nw0 = *(const f32x4*)(tokw + (size_t)t * 8); nw1 = *(const f32x4*)(tokw + (size_t)t * 8 + 4);
      load_row_f32(t >= TL ? cres + (size_t)(t - TL) * D : xres + (size_t)t * D, lane, xn); }
#pragma unroll 1
    for (int k = 0; k < per; ++k) {
        const int t = tbeg + k;
        const bool isctx = t >= TL; const int mr = isctx ? 8 : t / SEQ;
        if (mr != mr_cur) { mr_cur = mr; load_row_f32(modp(F, l, mr, 5), lane, g2v); if (l == 0) { load_row_f32(modp(F, 1, mr, 0), lane, shv); load_row_f32(modp(F, 1, mr, 1), lane, scv); } }
        const int rows[8] = {nr0.x, nr0.y, nr0.z, nr0.w, nr1.x, nr1.y, nr1.z, nr1.w};
        const float wts[8] = {nw0[0], nw0[1], nw0[2], nw0[3], nw1[0], nw1[1], nw1[2], nw1[3]};
        float x[16];
#pragma unroll
        for (int i = 0; i < 16; ++i) x[i] = xn[i];
        u32x4 v[9][2];
#pragma unroll
        for (int i = 0; i < 2; ++i) v[8][i] = *(const u32x4*)(OS_ + (size_t)(shb + t) * D + 8 * lane + 512 * i);
#pragma unroll
        for (int j = 0; j < 8; ++j)
#pragma unroll
            for (int i = 0; i < 2; ++i) v[j][i] = *(const u32x4*)(OS_ + (size_t)rows[j] * D + 8 * lane + 512 * i);
        if (k + 1 < per) { const int tn = t + 1; nr0 = *(const int4*)(tokr + (size_t)tn * 8); nr1 = *(const int4*)(tokr + (size_t)tn * 8 + 4); nw0 = *(const f32x4*)(tokw + (size_t)tn * 8); nw1 = *(const f32x4*)(tokw + (size_t)tn * 8 + 4);
            load_row_f32(tn >= TL ? cres + (size_t)(tn - TL) * D : xres + (size_t)tn * D, lane, xn); }
        float y[16];
#pragma unroll
        for (int i = 0; i < 2; ++i) { const u32x4 a = v[8][i];
            y[8 * i + 0] = bf_lo(a.x); y[8 * i + 1] = bf_hi(a.x); y[8 * i + 2] = bf_lo(a.y); y[8 * i + 3] = bf_hi(a.y); y[8 * i + 4] = bf_lo(a.z); y[8 * i + 5] = bf_hi(a.z); y[8 * i + 6] = bf_lo(a.w); y[8 * i + 7] = bf_hi(a.w); }
#pragma unroll
        for (int j = 0; j < DBG_NROUTED; ++j) { const float w = wts[j];
#pragma unroll
            for (int i = 0; i < 2; ++i) { const u32x4 a = v[j][i];
                y[8 * i + 0] += w * bf_lo(a.x); y[8 * i + 1] += w * bf_hi(a.x); y[8 * i + 2] += w * bf_lo(a.y); y[8 * i + 3] += w * bf_hi(a.y);
                y[8 * i + 4] += w * bf_lo(a.z); y[8 * i + 5] += w * bf_hi(a.z); y[8 * i + 6] += w * bf_lo(a.w); y[8 * i + 7] += w * bf_hi(a.w); } }
        float* xr = isctx ? cres + (size_t)(t - TL) * D : xres + (size_t)t * D;
#pragma unroll
        for (int i = 0; i < 16; ++i) x[i] += g2v[i] * y[i];
        float ss = 0.f;
#pragma unroll
        for (int i = 0; i < 16; ++i) ss += x[i] * x[i];
        const float rstd = rsqrtf(wave_sum(ss) * (1.0f / D) + RMS_EPS);
        if (l == 0) {
            if (!DRY) store_row_f32(xr, lane, x);
            float h[16];
#pragma unroll
            for (int i = 0; i < 16; ++i) h[i] = x[i] * rstd * gnv[i] * (1.0f + scv[i]) + shv[i];
            store_row_bf16(H + (size_t)t * D, lane, h);
        } else {
#pragma unroll
            for (int i = 0; i < 16; ++i) x[i] = x[i] * rstd * gnv[i];
            if (!DRY) store_row_f32(xr, lane, x); else store_row_bf16(H + (size_t)t * D, lane, x);
        }
    }
}

constexpr int PH_PER_LAYER = 10, N_PHASES = 2 + 2 * PH_PER_LAYER;
template <class T> DI T* opaque_ptr(T* p) {
    unsigned long long v = (unsigned long long)p; unsigned lo = (unsigned)v, hi = (unsigned)(v >> 32);
    asm volatile("" : "+s"(lo), "+s"(hi)); return (T*)(__attribute__((address_space(1))) T*)(((unsigned long long)hi << 32) | lo);
}
template <int KIND> DI void run_phase(const Frame& F0, const int l0) {
    Frame F = F0; int l = l0; asm volatile("" : "+s"(l));
    F.ws = opaque_ptr(F0.ws); F.out = opaque_ptr(F0.out);
    { int t = F0.tid; asm volatile("" : "+v"(t)); F.tid = t; F.lane = t & 63; F.wave = __builtin_amdgcn_readfirstlane(t >> 6); }
    unsigned char* const ws = F.ws;
    const bool ctx_out = (l == 0);
    const int M = ctx_out ? TA : TL;
    if constexpr (KIND == 0) { mod_vectors(F); conv_router(F); conv_small(F, 0); conv_down(F, 0, (bf16_t*)(ws + WS_WBS + WB_WD)); }
    if constexpr (KIND == 1) { phase_norm1_first(F); }
    if constexpr (KIND == 2) {
        pg8::RectSched<37> S{(const char*)(ws + WS_R2), (const char*)(ws + wbs_base(l) + WB_WIN), D, D, ctx_out ? 72 : 64, ctx_out ? 0 : 8, ctx_out ? 0 : 11, 64, F.G, F.bid};
        pg8::EpiStoreBf16 E{(bf16_t*)(ws + WS_R1), ZS};
        pg8::gemm_phase<false>(F.lds, F.tid, D, D, D, S, E);
    }
    if constexpr (KIND == 3) {
        for (int ch = F.bid; ch < 256; ch += F.G) gla_chain(F, l, ch, ctx_out);
#if REPEAT_KIND == 31
        for (int ch = F.bid; ch < 256; ch += F.G) gla_chain(F, l, ch, ctx_out);
#endif
#if REPEAT_KIND == 32
        phase_na(F, l, ctx_out);
#endif
        phase_na(F, l, ctx_out);
        phase_conv(F, l, M);
    }
    if constexpr (KIND == 4) { phase_gla_fin(F, l, M); }
    if constexpr (KIND == 5) {
        const char* Ob = (const char*)(ws + WS_R1 + R1_O); bf16_t* Y = (bf16_t*)(ws + WS_R2); const bf16_t* Zb = (const bf16_t*)(ws + WS_R1);
        { pg8::RectSched<4> S{Ob, (const char*)(ws + wbs_base(l) + WB_WNA), OS, 512, M / 256, 0, 0, 0, F.G, F.bid}; pg8::EpiGate<0> E{Y, Zb, C_MERGE}; pg8::gemm_phase<false>(F.lds, F.tid, 512, OS, 512, S, E); }
        { pg8::RectSched<4> S{Ob + 512 * 2, (const char*)(ws + wbs_base(l) + WB_WSC), OS, 512, M / 256, 0, 0, 0, F.G, F.bid}; pg8::EpiGate<1> E{Y, Zb, C_MERGE + 1024}; pg8::gemm_phase<false>(F.lds, F.tid, 512, OS, 512, S, E); }
        { pg8::RectSched<4> S{Ob + 1024 * 2, (const char*)(ws + wbs_base(l) + WB_WGLA), OS, D, M / 256, 0, 0, 0, F.G, F.bid}; pg8::EpiGate<1> E{Y, Zb, C_MERGE + 2048}; pg8::gemm_phase<false>(F.lds, F.tid, D, OS, D, S, E); }
        if (l == 0) conv_small(F, 1, 32);
    }
    if constexpr (KIND == 6) {
        pg8::RectSched<4> S{(const char*)(ws + WS_R2), (const char*)(ws + wbs_base(l) + WB_WOUT), D, D, M / 256, 0, 0, 0, F.G, F.bid};
        pg8::EpiResid E{l == 0 ? F.in[I_X] : F.out, F.out, l == 0 ? F.in[I_CTX] : (const float*)(ws + WS_CTXS), (float*)(ws + WS_CTXS), modp(F, l, 0, 2)};
        pg8::gemm_phase<false>(F.lds, F.tid, D, D, D, S, E);
    }
    if constexpr (KIND == 7) {
#if REPEAT_KIND == 71
        phase_router<true>(F, l, M);
#endif
        phase_router(F, l, M); conv_gu(F, l, (bf16_t*)(ws + WS_R1));
#if REPEAT_KIND == 72
        conv_gu(F, l, (bf16_t*)(ws + WS_R1));
#endif
    }
    if constexpr (KIND == 8) { phase_route_tables(F, l, M); }
    if constexpr (KIND == 9) {
        moe_tables(F, l, M);
        const LAS int* tb = (const LAS int*)(F.lds + MISC_OFF + 64);
        pg8::MoeSched<true, 2> S{tb, tb + 72, tb + 144, (const char*)(ws + WS_R1 + R1_H2), (const int*)(ws + WS_ROWL), (const char*)(ws + WS_R1), (size_t)512 * D * 2, D, D, F.G, F.bid};
        pg8::EpiSwiGLU E{(bf16_t*)(ws + WS_R2)};
        pg8::gemm_phase<true>(F.lds, F.tid, D, D, D, S, E);
    }
    if constexpr (KIND == 10) {
        moe_tables(F, l, M);
        const LAS int* tb = (const LAS int*)(F.lds + MISC_OFF + 64);
        pg8::MoeSched<false, 4> S{tb, tb + 72, tb + 144, (const char*)(ws + WS_R2), nullptr, (const char*)(ws + WS_WBS + WB_WD), (size_t)D * FF * 2, FF, FF, F.G, F.bid};
        pg8::EpiDown E{(bf16_t*)(ws + WS_R1)};
        pg8::gemm_phase<false>(F.lds, F.tid, FF, FF, FF, S, E);
    }
    if constexpr (KIND == 11) {
#if REPEAT_KIND == 111
        phase_combine<true>(F, l, M);
#endif
        phase_combine(F, l, M); if (l == 0) conv_down(F, 1, (bf16_t*)(ws + WS_WBS + WB_WD));
    }
}
DI void make_frame(Frame& F, const Args& args, unsigned char* lds_raw) {
    F.lds = (LAS unsigned char*)lds_raw; F.ws = args.ws; F.in = args.in; F.out = args.out;
    F.tid = threadIdx.x; F.lane = F.tid & 63; F.wave = __builtin_amdgcn_readfirstlane(F.tid >> 6); F.G = GRID; F.bid = blockIdx.x;
}
template <int KIND> __global__ void __launch_bounds__(512, 2) fwd_k(Args args) {
    extern __shared__ __attribute__((aligned(16))) unsigned char lds_raw[];
    Frame F; make_frame(F, args, lds_raw);
    run_phase<KIND>(F, args.ph_lo);
}
#if MK_ONE_LAUNCH
__global__ void __launch_bounds__(512, 2) fwd(Args args) {
    extern __shared__ __attribute__((aligned(16))) unsigned char lds_raw[];
    Frame F; make_frame(F, args, lds_raw);
    volatile LAS unsigned* MISC = (volatile LAS unsigned*)(F.lds + MISC_OFF);
    if (F.tid < 4) MISC[F.tid] = 0u;
    __syncthreads();
    XcdBarrier bar = xcd_barrier_post((unsigned*)(F.ws + WS_CTL) + CW_BAR, MISC);
    run_phase<0>(F, 0); xcd_barrier(bar); if (REPEAT_KIND == 99) xcd_barrier(bar); if (REPEAT_KIND == 0) { run_phase<0>(F, 0); xcd_barrier(bar); }
    run_phase<1>(F, 0); xcd_barrier(bar); if (REPEAT_KIND == 99) xcd_barrier(bar); if (REPEAT_KIND == 1) { run_phase<1>(F, 0); xcd_barrier(bar); }
#pragma unroll 1
    for (int l = 0; l < 2; ++l) {
        run_phase<2>(F, l); xcd_barrier(bar); if (REPEAT_KIND == 99) xcd_barrier(bar); if (REPEAT_KIND == 2) { run_phase<2>(F, l); xcd_barrier(bar); }
        run_phase<3>(F, l); xcd_barrier(bar); if (REPEAT_KIND == 99) xcd_barrier(bar); if (REPEAT_KIND == 3) { run_phase<3>(F, l); xcd_barrier(bar); }
        run_phase<4>(F, l); xcd_barrier(bar); if (REPEAT_KIND == 99) xcd_barrier(bar); if (REPEAT_KIND == 4) { run_phase<4>(F, l); xcd_barrier(bar); }
        run_phase<5>(F, l); xcd_barrier(bar); if (REPEAT_KIND == 99) xcd_barrier(bar); if (REPEAT_KIND == 5) { run_phase<5>(F, l); xcd_barrier(bar); }
        run_phase<6>(F, l); xcd_barrier(bar); if (REPEAT_KIND == 99) xcd_barrier(bar); if (REPEAT_KIND == 6) { run_phase<6>(F, l); xcd_barrier(bar); }
        run_phase<7>(F, l); xcd_barrier(bar); if (REPEAT_KIND == 99) xcd_barrier(bar); if (REPEAT_KIND == 7) { run_phase<7>(F, l); xcd_barrier(bar); }
        run_phase<8>(F, l); xcd_barrier(bar); if (REPEAT_KIND == 99) xcd_barrier(bar); if (REPEAT_KIND == 8) { run_phase<8>(F, l); xcd_barrier(bar); }
        run_phase<9>(F, l); xcd_barrier(bar); if (REPEAT_KIND == 99) xcd_barrier(bar); if (REPEAT_KIND == 9) { run_phase<9>(F, l); xcd_barrier(bar); }
        run_phase<10>(F, l); xcd_barrier(bar); if (REPEAT_KIND == 99) xcd_barrier(bar); if (REPEAT_KIND == 10) { run_phase<10>(F, l); xcd_barrier(bar); }
        run_phase<11>(F, l); xcd_barrier(bar); if (REPEAT_KIND == 99) xcd_barrier(bar); if (REPEAT_KIND == 11) { run_phase<11>(F, l); xcd_barrier(bar); }
    }
}
#endif

template <int KIND> static bool prep_kernel() { return hipFuncSetAttribute((const void*)fwd_k<KIND>, hipFuncAttributeMaxDynamicSharedMemorySize, LDS_BYTES) == hipSuccess; }
template <int KIND> static void launch_k(int grid, hipStream_t stream, Args a, int l) { a.ph_lo = l; a.ph_hi = KIND; hipLaunchKernelGGL(fwd_k<KIND>, dim3(grid), dim3(512), LDS_BYTES, stream, a); }
extern "C" void kernel_launch(void* const* d_in, const int* in_sizes, int n_in, void* d_out, int out_size, void* d_ws, size_t ws_size, hipStream_t stream) {
    static int grid = 0;
    if (grid == 0) {
        if (n_in != N_INPUTS || ws_size < WS_END) { fprintf(stderr, "kernel_launch: need %d inputs and %zu bytes of workspace; got %d, %zu\n", N_INPUTS, (size_t)WS_END, n_in, ws_size); grid = -1; return; }
        int dev = 0, cus = 0;
        if (hipGetDevice(&dev) != hipSuccess || hipDeviceGetAttribute(&cus, hipDeviceAttributeMultiprocessorCount, dev) != hipSuccess) { grid = -1; return; }
#if MK_ONE_LAUNCH
        if (hipFuncSetAttribute((const void*)fwd, hipFuncAttributeMaxDynamicSharedMemorySize, LDS_BYTES) != hipSuccess) { grid = -1; return; }
#else
        bool ok = prep_kernel<0>() && prep_kernel<1>() && prep_kernel<2>() && prep_kernel<3>() && prep_kernel<4>() && prep_kernel<5>() && prep_kernel<6>() && prep_kernel<7>() && prep_kernel<8>() && prep_kernel<9>() && prep_kernel<10>() && prep_kernel<11>();
        if (!ok) { fprintf(stderr, "kernel_launch: hipFuncSetAttribute failed\n"); grid = -1; return; }
#endif
        (void)hipGetLastError();
        if (cus < GRID) { fprintf(stderr, "kernel_launch: built for a %d-CU device, found %d CUs\n", GRID, cus); grid = -1; return; }
        grid = GRID;
    }
    if (grid < 0) return;
    if (hipMemsetAsync((char*)d_ws + WS_CTL, 0, ZERO_BYTES, stream) != hipSuccess) return;
    Args a{};
    for (int i = 0; i < N_INPUTS; ++i) a.in[i] = (const float*)d_in[i];
    a.out = (float*)d_out; a.ws = (unsigned char*)d_ws;
#if MK_ONE_LAUNCH
    a.ph_lo = 0; a.ph_hi = N_PHASES;
    hipLaunchKernelGGL(fwd, dim3(grid), dim3(512), LDS_BYTES, stream, a);
#else
    launch_k<0>(grid, stream, a, 0); launch_k<1>(grid, stream, a, 0);
    for (int l = 0; l < 2; ++l) {
        launch_k<2>(grid, stream, a, l); launch_k<3>(grid, stream, a, l); launch_k<4>(grid, stream, a, l); launch_k<5>(grid, stream, a, l); launch_k<6>(grid, stream, a, l);
#ifdef DBG_STOP6
        break;
#endif
        launch_k<7>(grid, stream, a, l); launch_k<8>(grid, stream, a, l); launch_k<9>(grid, stream, a, l); launch_k<10>(grid, stream, a, l); launch_k<11>(grid, stream, a, l);
#ifdef DBG_STOP11
        break;
#endif
    }
#endif
}
```

```cpp
#include <hip/hip_runtime.h>
#include <cstdio>
#include <cstdint>

#define DBG_NROUTED 8
#ifndef REPEAT_KIND
#define REPEAT_KIND -1
#endif
#ifndef MK_ONE_LAUNCH
#define MK_ONE_LAUNCH 1
#endif

#define LAS __attribute__((address_space(3)))
#define DI __device__ __forceinline__
typedef unsigned short bf16_t;
typedef short bf16x8 __attribute__((ext_vector_type(8)));
typedef short s16x4 __attribute__((ext_vector_type(4)));
typedef float f32x4 __attribute__((ext_vector_type(4)));
typedef float f32x16 __attribute__((ext_vector_type(16)));
typedef unsigned u32x4 __attribute__((ext_vector_type(4)));
typedef unsigned u32x2 __attribute__((ext_vector_type(2)));
typedef __bf16 bf16x2_t __attribute__((ext_vector_type(2)));
typedef float f32x2_t __attribute__((ext_vector_type(2)));

DI unsigned pk2(float lo, float hi) { f32x2_t v = {lo, hi}; bf16x2_t b = __builtin_convertvector(v, bf16x2_t); return __builtin_bit_cast(unsigned, b); }
DI float bf_lo(unsigned u) { return __uint_as_float(u << 16); }
DI float bf_hi(unsigned u) { return __uint_as_float(u & 0xffff0000u); }
DI float bf2f(bf16_t b) { return __uint_as_float(((unsigned)b) << 16); }
DI bf16_t f2bf(float f) { return (bf16_t)(pk2(f, 0.f) & 0xffffu); }
DI float wave_sum(float v) {
#pragma unroll
    for (int o = 1; o < 64; o <<= 1) v += __shfl_xor(v, o);
    return v;
}
DI float sigmoidf_(float x) { return __builtin_amdgcn_rcpf(1.0f + __builtin_amdgcn_exp2f(-1.4426950408889634f * x)); }
DI float siluf_(float x) { return x * __builtin_amdgcn_rcpf(1.0f + __builtin_amdgcn_exp2f(-1.4426950408889634f * x)); }

constexpr int D = 1024, NB = 8, SEQ = 2048, CTXL = 256, TL = NB * SEQ, TC = NB * CTXL, TA = TL + TC;
constexpr int NIN = 9248, ZS = 9472  , NKV = 2592;
constexpr int C_KNA = 0, C_VNA = 512, C_KGLA = 1024, C_VGLA = 1536, C_GATE = 2560, C_QNA = 2592, C_BSC = 3104, C_CSC = 3616, C_XSC = 4128, C_QGLA = 4640, C_RGLA = 5152, C_MERGE = 6176;
constexpr int OS = 2048;
constexpr int NE = 64, NEX = 65  , FF = 256, TOPK = 8;
constexpr float RMS_EPS = 1e-6f;

enum { I_X = 0, I_C, I_CTX, I_CCTX, I_WMOD, I_BMOD, I_G1, I_G2, I_WIN, I_RPB, I_WNA, I_CONVW, I_WSC, I_GGW, I_GGB, I_GNG, I_WGLA, I_WOUT, I_WR, I_BR, I_WEG, I_WEU, I_WED, I_WSG, I_WSU, I_WSD, I_GF, N_INPUTS };

constexpr size_t WS_CTL = 0;
constexpr size_t CTL_BYTES = 65536;
constexpr int CW_BAR = 0, CW_CNT = 8192;
constexpr size_t WS_MOD = WS_CTL + CTL_BYTES;
constexpr size_t MOD_BYTES = 2 * 9 * 6 * 1024 * 4;
constexpr size_t ZERO_BYTES = CTL_BYTES + 458752;
constexpr size_t WS_CTXS = WS_CTL + ZERO_BYTES;
constexpr size_t WS_TOKE = WS_CTXS + (size_t)TC * D * 4;
constexpr size_t WS_TOKP = WS_TOKE + (size_t)TA * 8 * 4;
constexpr size_t WS_TOKW = WS_TOKP + (size_t)TA * 8 * 4;
constexpr size_t WS_TOKR = WS_TOKW + (size_t)TA * 8 * 4;
constexpr size_t WS_ROWL = WS_TOKR + (size_t)TA * 8 * 4;
constexpr size_t ROWL_BYTES = ((size_t)TA * 9 + 256) * 4;
constexpr size_t WS_WRT = (WS_ROWL + ROWL_BYTES + 255) & ~(size_t)255;
constexpr size_t WRT_BYTES = (size_t)2 * 2 * NE * D * 2;
constexpr size_t WS_WBS = WS_WRT + WRT_BYTES;
constexpr size_t WB_WIN = 0, WB_WNA = WB_WIN + (size_t)ZS * D * 2, WB_WSC = WB_WNA + (size_t)D * 512 * 2, WB_WGLA = WB_WSC + (size_t)D * 512 * 2,
                 WB_WOUT = WB_WGLA + (size_t)D * D * 2, WB_WD = WB_WOUT + (size_t)D * D * 2, WBS_BYTES = WB_WD + (size_t)NEX * D * FF * 2;
constexpr size_t WS_R2 = WS_WBS + WBS_BYTES;
constexpr size_t HID_ROWS = (size_t)TA * 9 + 256;
constexpr size_t R2_BYTES = HID_ROWS * FF * 2;
constexpr size_t R2_OB = (size_t)TA * D * 2;
constexpr size_t WS_R1 = WS_R2 + R2_BYTES;
constexpr size_t R1_O = (size_t)TA * ZS * 2;
constexpr size_t R1_BYTES = R1_O + (size_t)TA * OS * 2;
constexpr size_t R1_H2 = R1_O;
constexpr size_t WS_WBS1 = WS_R1 + R1_BYTES;
constexpr size_t WS_DECB = WS_WBS1 + WB_WD;
constexpr size_t WS_W2TG = WS_DECB + (size_t)NB * 4 * 2 * 36 * 128 * 4;
constexpr size_t WS_END = WS_W2TG + (size_t)2 * 2 * 512 * 16 * 2;
static_assert(HID_ROWS * D * 2 <= R1_O + 0, "out_slot must fit below H2");
static_assert((size_t)NEX * 512 * D * 2 <= R1_O, "WguT fits");

constexpr int LDS_BYTES = 147456, MISC_OFF = 143360;
constexpr int GRID = 256;

#define XB_TMO      128
#define XB_XCNT(j)  (256  + 64 * (j))
#define XB_XSUB(j)  (1280 + 64 * (j))
#define XB_XGEN(j)  (2304 + 64 * (j))
#define XB_TOP      3328
#define XB_TOPGEN   3392
#define XCD_BAR_WORDS 3456
#define XB_SPIN_CAP (1u << 22)
DI unsigned xb_ld(unsigned* p)              { return __hip_atomic_load(p, __ATOMIC_RELAXED, __HIP_MEMORY_SCOPE_AGENT); }
DI unsigned xb_add(unsigned* p, unsigned v) { return __hip_atomic_fetch_add(p, v, __ATOMIC_RELAXED, __HIP_MEMORY_SCOPE_AGENT); }
DI unsigned xb_xcc_id() { return (unsigned)__builtin_amdgcn_s_getreg((3 << 11) | 20) & 0xFu; }
#define XB_SPIN(cond, bar) do { unsigned _sp = 0; while (cond) { __builtin_amdgcn_s_sleep(1); \
    if ((++_sp & 255u) == 0u) { if (xb_ld(&(bar)[XB_TMO])) break; if (_sp > XB_SPIN_CAP) { atomicAdd(&(bar)[XB_TMO], 1u); break; } } } } while (0)
struct XcdBarrier { unsigned* bar; unsigned x; volatile LAS unsigned* st; };
DI XcdBarrier xcd_barrier_post(unsigned* bar, volatile LAS unsigned* st) {
    XcdBarrier b; b.bar = bar; b.x = xb_xcc_id(); b.st = st;
    if (threadIdx.x == 0) (void)xb_add(&bar[XB_XCNT(b.x)], 1u);
    return b;
}
DI void xcd_barrier_complete(unsigned* bar, unsigned x, unsigned& nloc, unsigned& nx) {
    const unsigned G = gridDim.x * gridDim.y * gridDim.z;
    unsigned sum, cnt, mine, sp = 0u;
    for (;;) {
        sum = 0u; cnt = 0u; mine = 0u;
#pragma unroll
        for (unsigned j = 0; j < 16; ++j) { const unsigned c = xb_ld(&bar[XB_XCNT(j)]); sum += c; cnt += (c > 0u) ? 1u : 0u; mine = (j == x) ? c : mine; }
        if (sum == G) break;
        __builtin_amdgcn_s_sleep(1);
        if ((++sp & 255u) == 0u) { if (xb_ld(&bar[XB_TMO])) break; if (sp > XB_SPIN_CAP) { atomicAdd(&bar[XB_TMO], 1u); break; } }
    }
    nloc = mine > 0u ? mine : 1u; nx = cnt > 0u ? cnt : 1u;
}
DI void xcd_barrier(const XcdBarrier& b) {
    asm volatile("s_waitcnt vmcnt(0)" ::: "memory");
    __syncthreads();
    if (threadIdx.x == 0) {
        unsigned* bar = b.bar;
        __builtin_amdgcn_s_waitcnt(0);
        const unsigned bx = xb_xcc_id();
        unsigned nloc = b.st[0], nx = b.st[1];
        if (nloc == 0u) { xcd_barrier_complete(bar, bx, nloc, nx); b.st[0] = nloc; b.st[1] = nx; }
        const unsigned old = xb_add(&bar[XB_XSUB(bx)], 1u);
        const unsigned gen = old / nloc;
        if (old + 1u == (gen + 1u) * nloc) {
            __builtin_amdgcn_fence(__ATOMIC_RELEASE, "agent");
            asm volatile("s_waitcnt vmcnt(0)" ::: "memory");
            const unsigned og = xb_add(&bar[XB_TOP], 1u);
            const unsigned tg = og / nx;
            if (og + 1u == (tg + 1u) * nx) xb_add(&bar[XB_TOPGEN], 1u);
            else XB_SPIN(xb_ld(&bar[XB_TOPGEN]) == tg, bar);
            __builtin_amdgcn_fence(__ATOMIC_ACQUIRE, "agent");
            xb_add(&bar[XB_XGEN(bx)], 1u);
            asm volatile("s_waitcnt vmcnt(0)" ::: "memory");
        } else {
            XB_SPIN(xb_ld(&bar[XB_XGEN(bx)]) == gen, bar);
            __builtin_amdgcn_fence(__ATOMIC_ACQUIRE, "agent");
            asm volatile("s_waitcnt vmcnt(0)" ::: "memory");
        }
    }
    __syncthreads();
}

namespace pg8 {
constexpr int BM = 256, BK = 64, HALF = 128, HTB = HALF * BK * 2, STAGE_BYTES = 8 * HTB;
DI int lds_byte(int r, int c) { const int st = (r >> 4) * 2 + (c >> 5), rr = r & 15, cc = c & 31, ob = rr * 64 + cc * 2; return st * 1024 + (ob ^ (((ob >> 9) & 1) << 5)); }
DI void stage_rc(int b, int& R, int& C) { const int st = b / 1024, sb = b % 1024, swz = sb ^ (((sb >> 9) & 1) << 5); R = (st >> 1) * 16 + swz / 64; C = (st & 1) * 32 + (swz % 64) / 2; }
DI int perm32(int rho) { const int n = rho >> 4, i = rho & 15; return 8 * (i >> 2) + 4 * n + (i & 3); }

struct GUnit {
    const char* A;
    const char* B;
    const int* rows;
    int pm, pn;
    int valid;
    int aux;
};

template <bool GATHER, class Epi, class Sched>
DI void gemm_phase(LAS unsigned char* lds, const int tid_, const int K_, const int lda, const int ldb, const Sched& S, const Epi& E) {
    int K = K_; asm volatile("" : "+s"(K));
    int tid = tid_; asm volatile("" : "+v"(tid));
    const int wid = __builtin_amdgcn_readfirstlane(tid >> 6), lane = tid & 63, wr = wid >> 2, wc = wid & 3, fr = lane & 15, fq = lane >> 4;
    const int nt = K / BK;
    unsigned voffA, voffB, cc2, ro;
    { int R, C; stage_rc(tid * 16, R, C); ro = (unsigned)R * 4u; cc2 = (unsigned)C * 2u; const int Rb = Epi::PERM ? ((R & ~31) + perm32(R & 31)) : R;
      voffA = (unsigned)(R * lda + C) * 2u; voffB = (unsigned)(Rb * ldb + C) * 2u; }
    const size_t hstepA = (size_t)HALF * lda * 2, qstepA = (size_t)64 * lda * 2, qstepB = (size_t)64 * ldb * 2;
    const unsigned rowb = (unsigned)lda * 2u;
    const size_t kstep = (size_t)(BK * 2);
    const size_t hstepB = (size_t)HALF * ldb * 2;
    const unsigned ldsw = (unsigned)wid * 1024u;
    const int aoff = lds_byte(wr * 64 + fr, fq * 8), boff = lds_byte(wc * 32 + fr, fq * 8);
#define PG8_SA(b, h) (((b) * 2 + (h)) * HTB)
#define PG8_SB(b, h) ((4 + (b) * 2 + (h)) * HTB)
#define PG8_STAGE2(bufoff, gbase, o0, o1) do { \
        __builtin_amdgcn_global_load_lds((const unsigned*)((const char*)(gbase) + (o0)), (LAS unsigned*)(lds + (bufoff) + ldsw), 16, 0, 0); \
        __builtin_amdgcn_global_load_lds((const unsigned*)((const char*)(gbase) + (o1)), (LAS unsigned*)(lds + (bufoff) + ldsw + 8192), 16, 0, 0); } while (0)
#define PG8_STAGEB(bufoff, gbase) do { \
        __builtin_amdgcn_global_load_lds((const unsigned*)((const char*)(gbase) + voffB), (LAS unsigned*)(lds + (bufoff) + ldsw), 16, 0, 0); \
        __builtin_amdgcn_global_load_lds((const unsigned*)((const char*)(gbase) + qstepB + voffB), (LAS unsigned*)(lds + (bufoff) + ldsw + 8192), 16, 0, 0); } while (0)
#define PG8_LDA(dst, b, h) do { _Pragma("unroll") for (int m = 0; m < 4; ++m) _Pragma("unroll") for (int k = 0; k < 2; ++k) dst[m][k] = *(const LAS bf16x8*)(lds + PG8_SA(b, h) + aoff + m * 2048 + k * 1024); } while (0)
#define PG8_LDB(dst, b, h) do { _Pragma("unroll") for (int n = 0; n < 2; ++n) _Pragma("unroll") for (int k = 0; k < 2; ++k) dst[n][k] = *(const LAS bf16x8*)(lds + PG8_SB(b, h) + boff + n * 2048 + k * 1024); } while (0)
#define PG8_MMA(ai, bj, At, Bt) do { __builtin_amdgcn_s_setprio(1); _Pragma("unroll") for (int m = 0; m < 4; ++m) _Pragma("unroll") for (int n = 0; n < 2; ++n) _Pragma("unroll") for (int k = 0; k < 2; ++k) \
        acc[ai][bj][m][n] = __builtin_amdgcn_mfma_f32_16x16x32_bf16(Bt[n][k], At[m][k], acc[ai][bj][m][n], 0, 0, 0); __builtin_amdgcn_s_setprio(0); } while (0)
#define PG8_WAIT_V(n) asm volatile("s_waitcnt vmcnt(" #n ")" ::: "memory")
#define PG8_WAIT_L(n) asm volatile("s_waitcnt lgkmcnt(" #n ")" ::: "memory")
#define PG8_BAR __builtin_amdgcn_s_barrier()
#define PG8_SCHED __builtin_amdgcn_sched_barrier(0)
#define PG8_RIDX(u, p0, p1) do { if (GATHER) { const char* _rb = (const char*)(u).rows; \
        p0 = (unsigned)*(const int*)(_rb + ro) | ((unsigned)*(const int*)(_rb + ro + HALF * 4) << 16); p1 = (unsigned)*(const int*)(_rb + ro + 64 * 4) | ((unsigned)*(const int*)(_rb + ro + (64 + HALF) * 4) << 16); } } while (0)
#define PG8_STAGEA(bufoff, gbase, h, p0, p1) do { if (GATHER) { const unsigned _o0 = (((p0) >> (16 * (h))) & 0xffffu) * rowb + cc2, _o1 = (((p1) >> (16 * (h))) & 0xffffu) * rowb + cc2; PG8_STAGE2(bufoff, gbase, _o0, _o1); } \
        else { __builtin_amdgcn_global_load_lds((const unsigned*)((const char*)(gbase) + (h) * hstepA + voffA), (LAS unsigned*)(lds + (bufoff) + ldsw), 16, 0, 0); \
               __builtin_amdgcn_global_load_lds((const unsigned*)((const char*)(gbase) + (h) * hstepA + qstepA + voffA), (LAS unsigned*)(lds + (bufoff) + ldsw + 8192), 16, 0, 0); } } while (0)
    GUnit cur, nxt; int ui = 0;
    if (!S.next(0, cur)) return;
    f32x4 acc[2][2][4][2];
#pragma unroll
    for (int a = 0; a < 2; ++a)
#pragma unroll
        for (int b = 0; b < 2; ++b)
#pragma unroll
            for (int m = 0; m < 4; ++m)
#pragma unroll
                for (int n = 0; n < 2; ++n) acc[a][b][m][n] = (f32x4){0.f, 0.f, 0.f, 0.f};
    bf16x8 At[4][2], B0[2][2], B1[2][2];
    const char* cA = cur.A; const char* cB = cur.B;
    unsigned cp0 = 0u, cp1 = 0u; PG8_RIDX(cur, cp0, cp1);
    PG8_STAGEB(PG8_SB(0, 0), cB); PG8_STAGEA(PG8_SA(0, 0), cA, 0, cp0, cp1); PG8_STAGEB(PG8_SB(0, 1), cB + hstepB); PG8_STAGEA(PG8_SA(0, 1), cA, 1, cp0, cp1);
    if (wr == 1) PG8_BAR;
    PG8_WAIT_V(4); PG8_BAR;
    PG8_STAGEB(PG8_SB(1, 0), cB + kstep); PG8_STAGEA(PG8_SA(1, 0), cA + kstep, 0, cp0, cp1); PG8_STAGEB(PG8_SB(1, 1), cB + hstepB + kstep);
    PG8_WAIT_V(6); PG8_BAR;
    for (;;) {
        const bool has_next = S.next(ui + 1, nxt);
        const char* nA = has_next ? nxt.A : cA; const char* nB = has_next ? nxt.B : cB;
        unsigned np0 = cp0, np1 = cp1;
        if (has_next) PG8_RIDX(nxt, np0, np1);
        for (int t = 0; t < nt; t += 2) {
            const bool last = (t == nt - 2);
            const char* a1 = cA + (size_t)(t + 1) * kstep;
            const char* a2 = last ? nA : cA + (size_t)(t + 2) * kstep; const char* b2 = last ? nB : cB + (size_t)(t + 2) * kstep;
            const char* a3 = a2 + kstep; const char* b3 = b2 + kstep;
            unsigned xp0 = cp0, xp1 = cp1;
            if (GATHER && last) { asm volatile("" : "+v"(np0), "+v"(np1)); xp0 = np0; xp1 = np1; }
            PG8_LDB(B0, 0, 0); PG8_SCHED; PG8_LDA(At, 0, 0); PG8_STAGEA(PG8_SA(1, 1), a1, 1, cp0, cp1);
            PG8_WAIT_L(8); PG8_BAR; PG8_WAIT_L(0); PG8_MMA(0, 0, At, B0); PG8_BAR; PG8_SCHED;
            PG8_LDB(B1, 0, 1); PG8_STAGEB(PG8_SB(0, 0), b2);
            PG8_BAR; PG8_WAIT_L(0); PG8_MMA(0, 1, At, B1); PG8_BAR;
            PG8_LDA(At, 0, 1); PG8_STAGEA(PG8_SA(0, 0), a2, 0, xp0, xp1);
            PG8_BAR; PG8_WAIT_L(0); PG8_MMA(1, 0, At, B0); PG8_BAR; PG8_SCHED;
            PG8_STAGEB(PG8_SB(0, 1), b2 + hstepB);
            PG8_WAIT_V(6); PG8_BAR; PG8_MMA(1, 1, At, B1); PG8_BAR;
            PG8_LDB(B0, 1, 0); PG8_SCHED; PG8_LDA(At, 1, 0); PG8_STAGEA(PG8_SA(0, 1), a2, 1, xp0, xp1);
            PG8_WAIT_L(8); PG8_BAR; PG8_WAIT_L(0); PG8_MMA(0, 0, At, B0); PG8_BAR; PG8_SCHED;
            PG8_LDB(B1, 1, 1); PG8_STAGEB(PG8_SB(1, 0), b3);
            PG8_BAR; PG8_WAIT_L(0); PG8_MMA(0, 1, At, B1); PG8_BAR;
            PG8_LDA(At, 1, 1); PG8_STAGEA(PG8_SA(1, 0), a3, 0, xp0, xp1);
            PG8_BAR; PG8_WAIT_L(0); PG8_MMA(1, 0, At, B0); PG8_BAR; PG8_SCHED;
            PG8_STAGEB(PG8_SB(1, 1), b3 + hstepB);
            PG8_WAIT_V(6); PG8_BAR; PG8_MMA(1, 1, At, B1); PG8_BAR;
        }
        E(acc, cur, wr, wc, fr, fq);
        if (!has_next) break;
#pragma unroll
        for (int a = 0; a < 2; ++a)
#pragma unroll
            for (int b = 0; b < 2; ++b)
#pragma unroll
                for (int m = 0; m < 4; ++m)
#pragma unroll
                    for (int n = 0; n < 2; ++n) acc[a][b][m][n] = (f32x4){0.f, 0.f, 0.f, 0.f};
        cur = nxt; cA = nA; cB = nB; cp0 = np0; cp1 = np1; ++ui;
    }
    PG8_WAIT_V(0);
    if (wr == 0) PG8_BAR;
    PG8_BAR;
#undef PG8_SA
#undef PG8_SB
#undef PG8_STAGE2
#undef PG8_STAGEB
#undef PG8_LDA
#undef PG8_LDB
#undef PG8_MMA
#undef PG8_WAIT_V
#undef PG8_WAIT_L
#undef PG8_BAR
#undef PG8_SCHED
#undef PG8_RIDX
#undef PG8_STAGEA
}

struct EpiStoreBf16 {
    static constexpr bool PERM = true;
    bf16_t* O; int ldc;
    DI void operator()(const f32x4 (&acc)[2][2][4][2], const GUnit& u, int wr, int wc, int fr, int fq) const {
        const int row0 = u.pm * BM + wr * 64 + fr, col0 = u.pn * BM + wc * 32 + 8 * fq;
#pragma unroll
        for (int ai = 0; ai < 2; ++ai)
#pragma unroll
            for (int m = 0; m < 4; ++m) { bf16_t* rowp = O + (size_t)(row0 + ai * HALF + m * 16) * ldc + col0;
#pragma unroll
                for (int bj = 0; bj < 2; ++bj) { const f32x4 v0 = acc[ai][bj][m][0], v1 = acc[ai][bj][m][1];
                    u32x4 w; w.x = pk2(v0[0], v0[1]); w.y = pk2(v0[2], v0[3]); w.z = pk2(v1[0], v1[1]); w.w = pk2(v1[2], v1[3]);
                    *(u32x4*)(rowp + bj * HALF) = w; } }
    }
};
template <int MODE> struct EpiGate {
    static constexpr bool PERM = true;
    bf16_t* Y; const bf16_t* Zg; int gcol0;
    DI void operator()(const f32x4 (&acc)[2][2][4][2], const GUnit& u, int wr, int wc, int fr, int fq) const {
        const int row0 = u.pm * BM + wr * 64 + fr, col0 = u.pn * BM + wc * 32 + 8 * fq;
#pragma unroll
        for (int ai = 0; ai < 2; ++ai) {
            u32x4 g[4][2], o[4][2];
#pragma unroll
            for (int m = 0; m < 4; ++m) { const size_t row = (size_t)(row0 + ai * HALF + m * 16);
#pragma unroll
                for (int bj = 0; bj < 2; ++bj) { g[m][bj] = *(const u32x4*)(Zg + row * ZS + gcol0 + col0 + bj * HALF); if (MODE == 1) o[m][bj] = *(const u32x4*)(Y + row * D + col0 + bj * HALF); } }
#pragma unroll
            for (int m = 0; m < 4; ++m) { const size_t row = (size_t)(row0 + ai * HALF + m * 16); bf16_t* rowp = Y + row * D + col0;
#pragma unroll
                for (int bj = 0; bj < 2; ++bj) { const f32x4 v0 = acc[ai][bj][m][0], v1 = acc[ai][bj][m][1]; const u32x4 gg = g[m][bj];
                    float r[8];
                    r[0] = v0[0] * sigmoidf_(bf_lo(gg.x)); r[1] = v0[1] * sigmoidf_(bf_hi(gg.x)); r[2] = v0[2] * sigmoidf_(bf_lo(gg.y)); r[3] = v0[3] * sigmoidf_(bf_hi(gg.y));
                    r[4] = v1[0] * sigmoidf_(bf_lo(gg.z)); r[5] = v1[1] * sigmoidf_(bf_hi(gg.z)); r[6] = v1[2] * sigmoidf_(bf_lo(gg.w)); r[7] = v1[3] * sigmoidf_(bf_hi(gg.w));
                    if (MODE == 1) { const u32x4 oo = o[m][bj];
                        r[0] += bf_lo(oo.x); r[1] += bf_hi(oo.x); r[2] += bf_lo(oo.y); r[3] += bf_hi(oo.y); r[4] += bf_lo(oo.z); r[5] += bf_hi(oo.z); r[6] += bf_lo(oo.w); r[7] += bf_hi(oo.w); }
                    u32x4 w; w.x = pk2(r[0], r[1]); w.y = pk2(r[2], r[3]); w.z = pk2(r[4], r[5]); w.w = pk2(r[6], r[7]);
                    *(u32x4*)(rowp + bj * HALF) = w; } }
        }
    }
};
struct EpiResid {
    static constexpr bool PERM = false;
    const float* xsrc; float* xdst; const float* csrc; float* cdst; const float* gate;
    DI void operator()(const f32x4 (&acc)[2][2][4][2], const GUnit& u, int wr, int wc, int fr, int fq) const {
        const int row0 = u.pm * BM + wr * 64 + fr, col0 = u.pn * BM + wc * 32 + 4 * fq;
        const bool isctx = (u.pm * BM) >= TL;
        const int mrow = isctx ? 8 : (u.pm * BM) / SEQ;
        const float* gp = gate + (size_t)mrow * 6144 + col0;
        f32x4 gv[2][2];
#pragma unroll
        for (int bj = 0; bj < 2; ++bj)
#pragma unroll
            for (int n = 0; n < 2; ++n) gv[bj][n] = *(const f32x4*)(gp + bj * HALF + n * 16);
        const float* sb = isctx ? csrc - (size_t)TL * D : xsrc; float* db = isctx ? cdst - (size_t)TL * D : xdst;
#pragma unroll
        for (int ai = 0; ai < 2; ++ai) {
            f32x4 s[4][2][2];
#pragma unroll
            for (int m = 0; m < 4; ++m) { const size_t off = (size_t)(row0 + ai * HALF + m * 16) * D + col0;
#pragma unroll
                for (int bj = 0; bj < 2; ++bj)
#pragma unroll
                    for (int n = 0; n < 2; ++n) s[m][bj][n] = *(const f32x4*)(sb + off + bj * HALF + n * 16); }
#pragma unroll
            for (int m = 0; m < 4; ++m) { const size_t off = (size_t)(row0 + ai * HALF + m * 16) * D + col0;
#pragma unroll
                for (int bj = 0; bj < 2; ++bj)
#pragma unroll
                    for (int n = 0; n < 2; ++n) *(f32x4*)(db + off + bj * HALF + n * 16) = s[m][bj][n] + gv[bj][n] * acc[ai][bj][m][n]; }
        }
    }
};
struct EpiSwiGLU {
    static constexpr bool PERM = true;
    bf16_t* Hd;
    DI void operator()(const f32x4 (&acc)[2][2][4][2], const GUnit& u, int wr, int wc, int fr, int fq) const {
        const int r0 = wr * 64 + fr, col0 = u.pn * HALF + wc * 32 + 8 * fq;
#pragma unroll
        for (int ai = 0; ai < 2; ++ai)
#pragma unroll
            for (int m = 0; m < 4; ++m) { const int r = r0 + ai * HALF + m * 16;
                const f32x4 g0 = acc[ai][0][m][0], g1 = acc[ai][0][m][1], u0 = acc[ai][1][m][0], u1 = acc[ai][1][m][1];
                u32x4 w; w.x = pk2(siluf_(g0[0]) * u0[0], siluf_(g0[1]) * u0[1]); w.y = pk2(siluf_(g0[2]) * u0[2], siluf_(g0[3]) * u0[3]);
                w.z = pk2(siluf_(g1[0]) * u1[0], siluf_(g1[1]) * u1[1]); w.w = pk2(siluf_(g1[2]) * u1[2], siluf_(g1[3]) * u1[3]);
                if (r < u.valid) *(u32x4*)(Hd + (size_t)(u.aux + r) * FF + col0) = w; }
    }
};
struct EpiDown {
    static constexpr bool PERM = true;
    bf16_t* Os;
    DI void operator()(const f32x4 (&acc)[2][2][4][2], const GUnit& u, int wr, int wc, int fr, int fq) const {
        const int r0 = wr * 64 + fr, col0 = u.pn * BM + wc * 32 + 8 * fq;
#pragma unroll
        for (int ai = 0; ai < 2; ++ai)
#pragma unroll
            for (int m = 0; m < 4; ++m) { const int r = r0 + ai * HALF + m * 16; bf16_t* rowp = Os + (size_t)(u.aux + r) * D + col0;
#pragma unroll
                for (int bj = 0; bj < 2; ++bj) { const f32x4 v0 = acc[ai][bj][m][0], v1 = acc[ai][bj][m][1];
                    u32x4 w; w.x = pk2(v0[0], v0[1]); w.y = pk2(v0[2], v0[3]); w.z = pk2(v1[0], v1[1]); w.w = pk2(v1[2], v1[3]);
                    if (r < u.valid) *(u32x4*)(rowp + bj * HALF) = w; } }
    }
};

template <int nN> struct RectSched {
    const char* A; const char* B; int lda, ldb; int nM, exM, exN, exPm0, G, c;
    DI bool next(int i, GUnit& u) const {
        const int L = i * G + c; const int nmain = nM * nN;
        int pm, pn;
        if (L < nmain) { const int W = (L & 7) * (nmain >> 3) + (L >> 3);
            const int grp = W / (8 * nN), rem = W % (8 * nN); pm = grp * 8 + (rem & 7); pn = rem >> 3; }
        else { const int L2 = L - nmain; if (L2 >= exM * exN) return false; pm = exPm0 + (L2 & 7); pn = L2 >> 3; }
        u.A = A + (size_t)pm * BM * lda * 2; u.B = B + (size_t)pn * BM * ldb * 2; u.rows = nullptr; u.pm = pm; u.pn = pn; u.valid = BM; u.aux = 0; return true;
    }
};
template <bool GATHER, int npn> struct MoeSched {
    const LAS int* tb; const LAS int* rb; const LAS int* cn;
    const char* A; const int* rowl; const char* B; size_t bstride; int lda, ldb, G, c;
    DI bool next(int i, GUnit& u) const {
        const int L0 = i * G + c; const int ntile = __builtin_amdgcn_readfirstlane(tb[NEX]); const int nwg = ntile * npn;
        if (L0 >= nwg) return false;
        const int q = nwg >> 3, rr = nwg & 7, xcd = L0 & 7, off = L0 >> 3;
        const int L = (xcd < rr ? xcd * (q + 1) : rr * (q + 1) + (xcd - rr) * q) + off;
        const int T = L / npn, pn = L % npn;
        const int e = __builtin_amdgcn_readfirstlane((int)((const LAS unsigned char*)(tb + 216))[T]);
        const int ti = T - __builtin_amdgcn_readfirstlane(tb[e]), row0 = __builtin_amdgcn_readfirstlane(rb[e]) + ti * BM;
        u.B = B + (size_t)e * bstride + (size_t)pn * BM * ldb * 2;
        if (GATHER) { u.A = A; u.rows = rowl + row0; } else { u.A = A + (size_t)row0 * lda * 2; u.rows = nullptr; }
        u.pm = T; u.pn = pn; const int rem = __builtin_amdgcn_readfirstlane(cn[e]) - ti * BM; u.valid = rem < BM ? rem : BM; u.aux = row0; return true;
    }
};
}

struct Args { const float* in[N_INPUTS]; float* out; unsigned char* ws; int ph_lo, ph_hi; };
struct Frame {
    LAS unsigned char* lds; unsigned char* ws; const float* const* in; float* out;
    int tid, lane, wave, G, bid;
};
DI const float* modp(const Frame& F, int l, int r, int which) { return (const float*)(F.ws + WS_MOD) + ((size_t)(l * 9 + r) * 6 + which) * 1024; }

DI void tr_item(const float* W, int ldw, bf16_t* WT, int ldt, int k0, int n0, int drow0, LAS float* scr, int lane) {
    float tmp[32];
#pragma unroll
    for (int i = 0; i < 32; ++i) { const int kk = 2 * i + (lane >> 5); tmp[i] = W[(size_t)(k0 + kk) * ldw + n0 + (lane & 31)]; }
#pragma unroll
    for (int i = 0; i < 32; ++i) { const int kk = 2 * i + (lane >> 5); scr[kk * 33 + (lane & 31)] = tmp[i]; }
    asm volatile("s_waitcnt lgkmcnt(0)" ::: "memory");
    const int c = lane & 7;
#pragma unroll
    for (int j = 0; j < 4; ++j) { const int n = (lane >> 3) + 8 * j; const LAS float* s = scr + (8 * c) * 33 + n;
        u32x4 o; o.x = pk2(s[0 * 33], s[1 * 33]); o.y = pk2(s[2 * 33], s[3 * 33]); o.z = pk2(s[4 * 33], s[5 * 33]); o.w = pk2(s[6 * 33], s[7 * 33]);
        *(u32x4*)(WT + (size_t)(drow0 + n) * ldt + k0 + 8 * c) = o; }
    asm volatile("s_waitcnt lgkmcnt(0)" ::: "memory");
}
template <int K, int N> DI void conv_plain(const Frame& F, const float* W, bf16_t* WT, int rot, int blk0 = 0) {
    LAS float* scr = (LAS float*)(F.lds + F.wave * 16384);
    const int NGW = (F.G - blk0) * 8, gw = ((F.bid - blk0) * 8 + F.wave + rot) % NGW;
    constexpr int nblk = N / 32, nit = (K / 64) * nblk;
    for (int it = gw; it < nit; it += NGW) { const int kb = it / nblk, nb = it % nblk; tr_item(W, N, WT, K, kb * 64, nb * 32, nb * 32, scr, F.lane); }
}
DI void conv_gu(const Frame& F, int l, bf16_t* WT) {
    LAS float* scr = (LAS float*)(F.lds + F.wave * 16384);
    const int NGW = F.G * 8, gw = F.bid * 8 + F.wave;
    const int nit = NEX * 2 * 128;
    for (int it = gw; it < nit; it += NGW) {
        const int e = it / 256, r = it % 256, isup = r / 128, r2 = r % 128, kb = r2 / 8, nb = r2 % 8, n0 = nb * 32;
        const float* W = (e < NE) ? F.in[isup ? I_WEU : I_WEG] + ((size_t)l * NE + e) * D * FF : F.in[isup ? I_WSU : I_WSG] + (size_t)l * D * FF;
        const int drow0 = ((n0 >> 7) << 8) + (n0 & 127) + (isup ? 128 : 0);
        tr_item(W, FF, WT + (size_t)e * 512 * D, D, kb * 64, n0, drow0, scr, F.lane);
    }
}
DI void conv_down(const Frame& F, int l, bf16_t* WT) {
    LAS float* scr = (LAS float*)(F.lds + F.wave * 16384);
    const int NGW = F.G * 8, gw = F.bid * 8 + F.wave;
    const int nit = NEX * 128;
    for (int it = gw; it < nit; it += NGW) {
        const int e = it / 128, r = it % 128, kb = r / 32, nb = r % 32;
        const float* W = (e < NE) ? F.in[I_WED] + ((size_t)l * NE + e) * FF * D : F.in[I_WSD] + (size_t)l * FF * D;
        tr_item(W, D, WT + (size_t)e * D * FF, FF, kb * 64, nb * 32, nb * 32, scr, F.lane);
    }
}
DI size_t wbs_base(int l) { return l == 0 ? WS_WBS : WS_WBS1; }
DI void conv_small(const Frame& F, int l, int blk0 = 0) {
    if (F.bid < blk0) return;
    bf16_t* wb = (bf16_t*)(F.ws + wbs_base(l));
    conv_plain<D, NIN>(F, F.in[I_WIN] + (size_t)l * D * NIN, (bf16_t*)((char*)wb + WB_WIN), 0, blk0);
    conv_plain<512, D>(F, F.in[I_WNA] + (size_t)l * 512 * D, (bf16_t*)((char*)wb + WB_WNA), 600, blk0);
    conv_plain<512, D>(F, F.in[I_WSC] + (size_t)l * 512 * D, (bf16_t*)((char*)wb + WB_WSC), 900, blk0);
    conv_plain<D, D>(F, F.in[I_WGLA] + (size_t)l * D * D, (bf16_t*)((char*)wb + WB_WGLA), 1200, blk0);
    conv_plain<D, D>(F, F.in[I_WOUT] + (size_t)l * D * D, (bf16_t*)((char*)wb + WB_WOUT), 1700, blk0);
    u32x4* z = (u32x4*)((char*)wb + WB_WIN + (size_t)NIN * D * 2);
    const int nz = (ZS - NIN) * D * 2 / 16;
    unsigned zz = 0u; asm volatile("" : "+v"(zz));
    for (int i = (F.bid - blk0) * 512 + F.tid; i < nz; i += (F.G - blk0) * 512) z[i] = (u32x4){zz, zz, zz, zz};
}
DI void conv_gate_w(const Frame& F) {
    bf16_t* wt = (bf16_t*)(F.ws + WS_W2TG);
    for (int i = F.bid * 512 + F.tid; i < 2 * 2 * 512 * 16; i += F.G * 512) { const int ld = i >> 13, rr = i & 8191, d = rr >> 4, ii = rr & 15; wt[i] = f2bf(F.in[I_GGW][((size_t)ld * 16 + ii) * 512 + d]); }
}
DI void conv_router(const Frame& F) {
    bf16_t* wrt = (bf16_t*)(F.ws + WS_WRT);
    for (int i = F.bid * 512 + F.tid; i < 2 * NE * D; i += F.G * 512) {
        const int l = i / (NE * D), r = i % (NE * D), e = r / D, k = r % D;
        const float w = F.in[I_WR][(size_t)l * D * NE + (size_t)k * NE + e];
        const bf16_t hi = f2bf(w); const bf16_t lo = f2bf(w - bf2f(hi));
        wrt[((size_t)(l * 2 + 0) * NE + e) * D + k] = hi; wrt[((size_t)(l * 2 + 1) * NE + e) * D + k] = lo;
    }
}
DI void mod_vectors(const Frame& F) {
    float* mod = (float*)(F.ws + WS_MOD);
    LAS float* SL = (LAS float*)F.lds;
    LAS float* PART = SL + 9 * 1024;
    __syncthreads();
    for (int i = F.tid; i < 9 * 1024; i += 512) { const float c = (i < 8 * 1024) ? F.in[I_C][i] : F.in[I_CCTX][i - 8 * 1024]; SL[i] = siluf_(c); }
    __syncthreads();
    for (int it = F.bid; it < 2 * 96; it += F.G) {
        const int l = it / 96, cb = it % 96, j = cb * 64 + F.lane;
        const float* W = F.in[I_WMOD] + (size_t)l * D * 6144 + j;
        float acc[9];
#pragma unroll
        for (int q = 0; q < 9; ++q) acc[q] = 0.f;
#pragma unroll 8
        for (int k = F.wave * 128; k < F.wave * 128 + 128; ++k) {
            const float w = W[(size_t)k * 6144];
#pragma unroll
            for (int q = 0; q < 9; ++q) acc[q] += SL[q * 1024 + k] * w;
        }
#pragma unroll
        for (int q = 0; q < 9; ++q) PART[(F.wave * 9 + q) * 64 + F.lane] = acc[q];
        __syncthreads();
        for (int q = F.wave; q < 9; q += 8) {
            float s = F.in[I_BMOD][l * 6144 + j];
#pragma unroll
            for (int w = 0; w < 8; ++w) s += PART[(w * 9 + q) * 64 + F.lane];
            mod[((size_t)(l * 9 + q)) * 6144 + j] = s;
        }
        __syncthreads();
    }
}

DI void load_row_f32(const float* p, int lane, float (&v)[16]) {
#pragma unroll
    for (int i = 0; i < 2; ++i) { const f32x4 a = *(const f32x4*)(p + 8 * lane + 512 * i), b = *(const f32x4*)(p + 8 * lane + 512 * i + 4);
        v[8 * i + 0] = a[0]; v[8 * i + 1] = a[1]; v[8 * i + 2] = a[2]; v[8 * i + 3] = a[3]; v[8 * i + 4] = b[0]; v[8 * i + 5] = b[1]; v[8 * i + 6] = b[2]; v[8 * i + 7] = b[3]; }
}
DI void store_row_f32(float* p, int lane, const float (&v)[16]) {
#pragma unroll
    for (int i = 0; i < 2; ++i) { *(f32x4*)(p + 8 * lane + 512 * i) = (f32x4){v[8 * i], v[8 * i + 1], v[8 * i + 2], v[8 * i + 3]}; *(f32x4*)(p + 8 * lane + 512 * i + 4) = (f32x4){v[8 * i + 4], v[8 * i + 5], v[8 * i + 6], v[8 * i + 7]}; }
}
DI void load_row_bf16(const bf16_t* p, int lane, float (&v)[16]) {
#pragma unroll
    for (int i = 0; i < 2; ++i) { const u32x4 a = *(const u32x4*)(p + 8 * lane + 512 * i);
        v[8 * i + 0] = bf_lo(a.x); v[8 * i + 1] = bf_hi(a.x); v[8 * i + 2] = bf_lo(a.y); v[8 * i + 3] = bf_hi(a.y); v[8 * i + 4] = bf_lo(a.z); v[8 * i + 5] = bf_hi(a.z); v[8 * i + 6] = bf_lo(a.w); v[8 * i + 7] = bf_hi(a.w); }
}
DI void store_row_bf16(bf16_t* p, int lane, const float (&v)[16]) {
#pragma unroll
    for (int i = 0; i < 2; ++i) { u32x4 w; w.x = pk2(v[8 * i], v[8 * i + 1]); w.y = pk2(v[8 * i + 2], v[8 * i + 3]); w.z = pk2(v[8 * i + 4], v[8 * i + 5]); w.w = pk2(v[8 * i + 6], v[8 * i + 7]);
        *(u32x4*)(p + 8 * lane + 512 * i) = w; }
}
DI void norm_mod(const float (&x)[16], const float* g, const float* shift, const float* scale, int lane, float (&h)[16]) {
    float ss = 0.f;
#pragma unroll
    for (int i = 0; i < 16; ++i) ss += x[i] * x[i];
    const float rstd = rsqrtf(wave_sum(ss) * (1.0f / D) + RMS_EPS);
    float gg[16], sh[16], sc[16]; load_row_f32(g, lane, gg); load_row_f32(shift, lane, sh); load_row_f32(scale, lane, sc);
#pragma unroll
    for (int i = 0; i < 16; ++i) h[i] = x[i] * rstd * gg[i] * (1.0f + sc[i]) + sh[i];
}

DI void phase_norm1_first(const Frame& F) {
    const int NGW = F.G * 8, gw = F.bid * 8 + F.wave;
    bf16_t* H = (bf16_t*)(F.ws + WS_R2);
    for (int t = gw; t < TA; t += NGW) {
        const bool isctx = t >= TL; const int r = isctx ? 8 : t / SEQ;
        const float* xr = isctx ? F.in[I_CTX] + (size_t)(t - TL) * D : F.in[I_X] + (size_t)t * D;
        float x[16], h[16]; load_row_f32(xr, F.lane, x);
        norm_mod(x, F.in[I_G1], modp(F, 0, r, 0), modp(F, 0, r, 1), F.lane, h);
        store_row_bf16(H + (size_t)t * D, F.lane, h);
    }
}

DI void phase_conv(const Frame& F, int l, int M) {
    const bf16_t* Z = (const bf16_t*)(F.ws + WS_R1); bf16_t* O = (bf16_t*)(F.ws + WS_R1 + R1_O);
    const float* cw = F.in[I_CONVW] + (size_t)l * 3 * 512;
    for (int it = F.bid * 512 + F.tid; it < M * 64; it += F.G * 512) {
        const int t = it >> 6, c0 = (it & 63) * 8;
        const int L = (t >= TL) ? CTXL : SEQ, pos = (t >= TL) ? (t - TL) % CTXL : t % SEQ;
        const bf16_t* zr = Z + (size_t)t * ZS;
        float u0[8], u1[8], u2[8], bb[8];
        { const u32x4 c = *(const u32x4*)(zr + C_CSC + c0), x = *(const u32x4*)(zr + C_XSC + c0), b = *(const u32x4*)(zr + C_BSC + c0);
          u1[0] = bf_lo(c.x) * bf_lo(x.x); u1[1] = bf_hi(c.x) * bf_hi(x.x); u1[2] = bf_lo(c.y) * bf_lo(x.y); u1[3] = bf_hi(c.y) * bf_hi(x.y);
          u1[4] = bf_lo(c.z) * bf_lo(x.z); u1[5] = bf_hi(c.z) * bf_hi(x.z); u1[6] = bf_lo(c.w) * bf_lo(x.w); u1[7] = bf_hi(c.w) * bf_hi(x.w);
          bb[0] = bf_lo(b.x); bb[1] = bf_hi(b.x); bb[2] = bf_lo(b.y); bb[3] = bf_hi(b.y); bb[4] = bf_lo(b.z); bb[5] = bf_hi(b.z); bb[6] = bf_lo(b.w); bb[7] = bf_hi(b.w); }
        if (pos > 0) { const u32x4 c = *(const u32x4*)(zr - ZS + C_CSC + c0), x = *(const u32x4*)(zr - ZS + C_XSC + c0);
          u0[0] = bf_lo(c.x) * bf_lo(x.x); u0[1] = bf_hi(c.x) * bf_hi(x.x); u0[2] = bf_lo(c.y) * bf_lo(x.y); u0[3] = bf_hi(c.y) * bf_hi(x.y);
          u0[4] = bf_lo(c.z) * bf_lo(x.z); u0[5] = bf_hi(c.z) * bf_hi(x.z); u0[6] = bf_lo(c.w) * bf_lo(x.w); u0[7] = bf_hi(c.w) * bf_hi(x.w); }
        else {
#pragma unroll
            for (int j = 0; j < 8; ++j) u0[j] = 0.f; }
        if (pos < L - 1) { const u32x4 c = *(const u32x4*)(zr + ZS + C_CSC + c0), x = *(const u32x4*)(zr + ZS + C_XSC + c0);
          u2[0] = bf_lo(c.x) * bf_lo(x.x); u2[1] = bf_hi(c.x) * bf_hi(x.x); u2[2] = bf_lo(c.y) * bf_lo(x.y); u2[3] = bf_hi(c.y) * bf_hi(x.y);
          u2[4] = bf_lo(c.z) * bf_lo(x.z); u2[5] = bf_hi(c.z) * bf_hi(x.z); u2[6] = bf_lo(c.w) * bf_lo(x.w); u2[7] = bf_hi(c.w) * bf_hi(x.w); }
        else {
#pragma unroll
            for (int j = 0; j < 8; ++j) u2[j] = 0.f; }
        float o[8];
#pragma unroll
        for (int j = 0; j < 8; ++j) o[j] = bb[j] * (u0[j] * cw[c0 + j] + u1[j] * cw[512 + c0 + j] + u2[j] * cw[1024 + c0 + j]);
        u32x4 w; w.x = pk2(o[0], o[1]); w.y = pk2(o[2], o[3]); w.z = pk2(o[4], o[5]); w.w = pk2(o[6], o[7]);
        *(u32x4*)(O + (size_t)t * OS + 512 + c0) = w;
    }
}

#define MFMA32(a, b, c) __builtin_amdgcn_mfma_f32_32x32x16_bf16((a), (b), (c), 0, 0, 0)
DI int crow(int reg, int h) { return (reg & 3) + 8 * (reg >> 2) + 4 * h; }
DI bf16x8 pack_step(const f32x16& x, int s) {
    u32x4 p; p.x = pk2(x[8 * s], x[8 * s + 1]); p.y = pk2(x[8 * s + 2], x[8 * s + 3]); p.z = pk2(x[8 * s + 4], x[8 * s + 5]); p.w = pk2(x[8 * s + 6], x[8 * s + 7]);
    return __builtin_bit_cast(bf16x8, p);
}
DI bf16x8 cat4(u32x2 a, u32x2 b) { u32x4 p; p.x = a.x; p.y = a.y; p.z = b.x; p.w = b.y; return __builtin_bit_cast(bf16x8, p); }

typedef __attribute__((address_space(3))) s16x4 lds_s16x4;
DI bf16x8 tr8(const LAS bf16_t* p0, const LAS bf16_t* p1) {
    const s16x4 a = __builtin_amdgcn_ds_read_tr16_b64_v4i16((lds_s16x4*)p0), b = __builtin_amdgcn_ds_read_tr16_b64_v4i16((lds_s16x4*)p1);
    return (bf16x8){a[0], a[1], a[2], a[3], b[0], b[1], b[2], b[3]};
}
constexpr int NA_VS = 72;
constexpr int NA_TAB = 8 * NA_VS * 64 * 2;
constexpr float NA_L2E = 1.4426950408889634f;
constexpr int NA_KOFF = 0, NA_VOFF = 2 * 64 * NA_VS * 2;
constexpr int NA_TAB2 = 4 * 64 * NA_VS * 2;
DI void na_block_unit(const Frame& F, const bf16_t* Z, bf16_t* O, const LAS float* tab, int head, bool isctxu, int b, int rg) {
    const int tid = F.tid, lane = F.lane, wave = F.wave, r = lane & 31, h = lane >> 5;
    const int trq = (lane & 15) >> 2, trc = 16 * ((lane >> 4) & 1) + 4 * (lane & 3);
    LAS bf16_t* KR = (LAS bf16_t*)(F.lds + NA_KOFF); LAS bf16_t* VR = (LAS bf16_t*)(F.lds + NA_VOFF);
    const int qrow_g = isctxu ? 0 : 4 * rg + (wave >> 1), qcol0 = isctxu ? 0 : 32 * (wave & 1);
    const int qrow0 = isctxu ? TL + b * CTXL + 32 * wave : b * SEQ + qrow_g * 64 + qcol0;
    int rs = qrow_g - 4; rs = rs < 0 ? 0 : (rs > 24 ? 24 : rs);
    int rs_lo = 4 * rg - 4; rs_lo = rs_lo < 0 ? 0 : (rs_lo > 24 ? 24 : rs_lo); int rs_hi = 4 * rg + 3 - 4; rs_hi = rs_hi < 0 ? 0 : (rs_hi > 24 ? 24 : rs_hi);
    const int nwin = isctxu ? 0 : rs_hi + 8 - rs_lo, ntile = nwin + 4;
    const int winrow0 = b * SEQ + rs_lo * 64, ctxrow0 = TL + b * CTXL;
    bf16x8 qf[4];
    { const bf16_t* qp = Z + (size_t)(qrow0 + r) * ZS + C_QNA + head * 64 + 8 * h;
#pragma unroll
      for (int ks = 0; ks < 4; ++ks) qf[ks] = *(const bf16x8*)(qp + 16 * ks); }
    unsigned ix0[4], ix1[4];
    { const int qc = qcol0 + r; int cs = qc - 8; cs = cs < 0 ? 0 : (cs > 48 ? 48 : cs);
#pragma unroll
      for (int g = 0; g < 4; ++g) { unsigned p0 = 0u, p1 = 0u;
#pragma unroll
          for (int e = 0; e < 4; ++e) { const int kc0 = crow(4 * g + e, h), kc1 = 32 + kc0;
              int d0 = kc0 - qc; d0 = d0 < -15 ? -15 : (d0 > 15 ? 15 : d0); int d1 = kc1 - qc; d1 = d1 < -15 ? -15 : (d1 > 15 ? 15 : d1);
              const unsigned c0 = (kc0 < cs || kc0 >= cs + 16) ? 31u : (unsigned)(d0 + 15), c1 = (kc1 < cs || kc1 >= cs + 16) ? 31u : (unsigned)(d1 + 15);
              p0 |= c0 << (8 * e); p1 |= c1 << (8 * e); }
          ix0[g] = p0; ix1[g] = p1; } }
    f32x16 o0, o1;
#pragma unroll
    for (int i = 0; i < 16; ++i) { o0[i] = 0.f; o1[i] = 0.f; }
    float mrun = -1e30f, lrun = 0.f;
    const int lkey = tid >> 3, lseg = tid & 7;
#define NA_TROW(j_) ((j_) < nwin ? winrow0 + (j_) * 64 : ctxrow0 + ((j_) - nwin) * 64)
#define NA_LD(j_, kk_, vv_) do { const bf16_t* zp = Z + (size_t)(NA_TROW(j_) + lkey) * ZS + head * 64 + 8 * lseg; kk_ = *(const u32x4*)(zp + C_KNA); vv_ = *(const u32x4*)(zp + C_VNA); } while (0)
#define NA_ST(slot_, kk_, vv_) do { *(LAS u32x4*)(KR + ((slot_) * 64 + lkey) * NA_VS + 8 * lseg) = kk_; *(LAS u32x4*)(VR + ((slot_) * 64 + lkey) * NA_VS + 8 * lseg) = vv_; } while (0)
    u32x4 sk, sv;
    __syncthreads();
    NA_LD(0, sk, sv); NA_ST(0, sk, sv); NA_LD(1, sk, sv);
#pragma unroll 1
    for (int j = 0; j < ntile; ++j) {
        __syncthreads();
        if (j + 1 < ntile) { NA_ST((j + 1) & 1, sk, sv); const int j2 = j + 2 < ntile ? j + 2 : ntile - 1; NA_LD(j2, sk, sv); }
        const bool isw = j < nwin;
        const int krow_g = rs_lo + j;
        if (isw && (krow_g < rs || krow_g >= rs + 8)) continue;
        const LAS bf16_t* kt = KR + (j & 1) * 64 * NA_VS; const LAS bf16_t* vt = VR + (j & 1) * 64 * NA_VS;
        f32x16 s0, s1;
#pragma unroll
        for (int i = 0; i < 16; ++i) { s0[i] = 0.f; s1[i] = 0.f; }
#pragma unroll
        for (int ks = 0; ks < 4; ++ks) { const bf16x8 k0 = *(const LAS bf16x8*)(kt + r * NA_VS + 16 * ks + 8 * h), k1 = *(const LAS bf16x8*)(kt + (32 + r) * NA_VS + 16 * ks + 8 * h);
            s0 = MFMA32(k0, qf[ks], s0); s1 = MFMA32(k1, qf[ks], s1); }
        const int drow = isw ? (krow_g - qrow_g + 7) : 15;
        const LAS float* trow = tab + (head * 16 + drow) * 32;
#pragma unroll
        for (int g = 0; g < 4; ++g) asm volatile("" : "+v"(ix0[g]), "+v"(ix1[g]));
        float tmax = -1e30f;
#pragma unroll
        for (int i = 0; i < 16; ++i) {
            const float a = s0[i] * (0.125f * NA_L2E) + trow[(ix0[i >> 2] >> (8 * (i & 3))) & 0xffu];
            const float bq = s1[i] * (0.125f * NA_L2E) + trow[(ix1[i >> 2] >> (8 * (i & 3))) & 0xffu];
            s0[i] = a; s1[i] = bq; tmax = fmaxf(tmax, fmaxf(a, bq));
        }
        tmax = fmaxf(tmax, __shfl_xor(tmax, 32));
        const float mnew = fmaxf(mrun, tmax), alpha = __builtin_amdgcn_exp2f(mrun - mnew);
        float psum = 0.f;
#pragma unroll
        for (int i = 0; i < 16; ++i) { const float a = __builtin_amdgcn_exp2f(s0[i] - mnew), bq = __builtin_amdgcn_exp2f(s1[i] - mnew); s0[i] = a; s1[i] = bq; psum += a + bq; }
        psum += __shfl_xor(psum, 32);
        lrun = lrun * alpha + psum; mrun = mnew;
#pragma unroll
        for (int i = 0; i < 16; ++i) { o0[i] *= alpha; o1[i] *= alpha; }
#pragma unroll
        for (int nb = 0; nb < 2; ++nb)
#pragma unroll
            for (int s = 0; s < 2; ++s) {
                const bf16x8 pf = pack_step(nb ? s1 : s0, s);
                const LAS bf16_t* vp = vt + (32 * nb + 16 * s + 4 * h + trq) * NA_VS + trc;
                o0 = MFMA32(tr8(vp, vp + 8 * NA_VS), pf, o0); o1 = MFMA32(tr8(vp + 32, vp + 32 + 8 * NA_VS), pf, o1);
            }
    }
#undef NA_TROW
#undef NA_LD
#undef NA_ST
    const float inv = 1.0f / lrun;
    bf16_t* op = O + (size_t)(qrow0 + r) * OS + head * 64 + 4 * h;
#pragma unroll
    for (int g = 0; g < 4; ++g) {
        u32x2 w0, w1; w0.x = pk2(o0[4 * g] * inv, o0[4 * g + 1] * inv); w0.y = pk2(o0[4 * g + 2] * inv, o0[4 * g + 3] * inv);
        w1.x = pk2(o1[4 * g] * inv, o1[4 * g + 1] * inv); w1.y = pk2(o1[4 * g + 2] * inv, o1[4 * g + 3] * inv);
        *(u32x2*)(op + 8 * g) = w0; *(u32x2*)(op + 32 + 8 * g) = w1;
    }
}
DI void phase_na(const Frame& F, int l, bool ctx_out) {
    const bf16_t* Z = (const bf16_t*)(F.ws + WS_R1); bf16_t* O = (bf16_t*)(F.ws + WS_R1 + R1_O);
    LAS float* tab = (LAS float*)(F.lds + NA_TAB2);
    __syncthreads();
    for (int i = F.tid; i < 8 * 16 * 32; i += 512) { const int hh = i >> 9, dr = (i >> 5) & 15, dc = i & 31;
        tab[i] = (dr == 15) ? 0.f : ((dc == 31) ? -1e30f : F.in[I_RPB][(size_t)l * 8 * 15 * 31 + (hh * 15 + dr) * 31 + dc] * NA_L2E); }
    __syncthreads();
    const int nlat = NB * 8 * 8, ntot = nlat + (ctx_out ? NB * 8 : 0);
#pragma unroll 1
    for (int u = F.bid; u < ntot; u += F.G) {
        if (u < nlat) na_block_unit(F, Z, O, tab, u & 7, false, u >> 6, (u >> 3) & 7);
        else { const int v = u - nlat; na_block_unit(F, Z, O, tab, v & 7, true, v >> 3, 0); }
    }
    __syncthreads();
}

constexpr int GP_CUM = 0, GL_CUMS = 132, GP_W2T = 33792  , GP_B2 = GP_W2T + 2 * 128 * 24 * 2  , GP_SEG = GP_B2 + 1024  ;
DI size_t gl_chunk_row(int b, int cn) { return cn < 4 ? (size_t)(TL + b * CTXL + cn * 64) : (size_t)(b * SEQ + (cn - 4) * 64); }
DI void gla_prep(const Frame& F, int l, int task) {
    const int cn = task % 36, hd = (task / 36) & 3, b = task / 144;
    bf16_t* Z = (bf16_t*)(F.ws + WS_R1); bf16_t* O = (bf16_t*)(F.ws + WS_R1 + R1_O); float* DECB = (float*)(F.ws + WS_DECB);
    LAS float* CUM = (LAS float*)(F.lds + GP_CUM); LAS float* SEG = (LAS float*)(F.lds + GP_SEG);
    const int tid = F.tid, lane = F.lane, wave = F.wave, r = lane & 31, h = lane >> 5;
    const size_t row0 = gl_chunk_row(b, cn);
    const bf16_t* W2G = (const bf16_t*)(F.ws + WS_W2TG);
    __syncthreads();
    const int tt = tid >> 3, seg = tid & 7, d0 = seg * 16;
    const int atb = wave & 1, adb = wave >> 1;
    const bf16_t* zr = Z + (row0 + tt) * ZS;
    const u32x4 q0 = *(const u32x4*)(zr + C_QGLA + hd * 128 + d0), q1 = *(const u32x4*)(zr + C_QGLA + hd * 128 + d0 + 8);
    const u32x4 k0 = *(const u32x4*)(zr + C_KGLA + hd * 128 + d0), k1 = *(const u32x4*)(zr + C_KGLA + hd * 128 + d0 + 8);
    float qv[16], kv[16];
    qv[0] = bf_lo(q0.x); qv[1] = bf_hi(q0.x); qv[2] = bf_lo(q0.y); qv[3] = bf_hi(q0.y); qv[4] = bf_lo(q0.z); qv[5] = bf_hi(q0.z); qv[6] = bf_lo(q0.w); qv[7] = bf_hi(q0.w);
    qv[8] = bf_lo(q1.x); qv[9] = bf_hi(q1.x); qv[10] = bf_lo(q1.y); qv[11] = bf_hi(q1.y); qv[12] = bf_lo(q1.z); qv[13] = bf_hi(q1.z); qv[14] = bf_lo(q1.w); qv[15] = bf_hi(q1.w);
    kv[0] = bf_lo(k0.x); kv[1] = bf_hi(k0.x); kv[2] = bf_lo(k0.y); kv[3] = bf_hi(k0.y); kv[4] = bf_lo(k0.z); kv[5] = bf_hi(k0.z); kv[6] = bf_lo(k0.w); kv[7] = bf_hi(k0.w);
    kv[8] = bf_lo(k1.x); kv[9] = bf_hi(k1.x); kv[10] = bf_lo(k1.y); kv[11] = bf_hi(k1.y); kv[12] = bf_lo(k1.z); kv[13] = bf_hi(k1.z); kv[14] = bf_lo(k1.w); kv[15] = bf_hi(k1.w);
    __syncthreads();
#pragma unroll 1
    for (int dir = 0; dir < 2; ++dir) {
        {
            const int tl = 32 * atb + r, tn = dir ? 63 - tl : tl;
            const bf16x8 lrf = *(const bf16x8*)(Z + (row0 + tn) * ZS + C_GATE + dir * 16 + 8 * h);
            const bf16x8 w2f = *(const bf16x8*)(W2G + ((size_t)(l * 2 + dir) * 512 + hd * 128 + 32 * adb + r) * 16 + 8 * h);
            const float b2v = F.in[I_GGB][(size_t)(l * 2 + dir) * 512 + hd * 128 + 32 * adb + r];
            f32x16 ga;
#pragma unroll
            for (int i = 0; i < 16; ++i) ga[i] = 0.f;
            ga = MFMA32(lrf, w2f, ga);
            float sg[4];
#pragma unroll
            for (int g = 0; g < 4; ++g) {
                float run = 0.f;
#pragma unroll
                for (int e = 0; e < 4; ++e) { const float x = ga[4 * g + e] + b2v; run += (fminf(x, 0.f) - __logf(1.0f + __expf(-fabsf(x)))) * (1.0f / 16.0f); ga[4 * g + e] = run; }
                sg[g] = run;
            }
            float off = 0.f;
#pragma unroll
            for (int g = 0; g < 4; ++g) { const float ps = __shfl_xor(sg[g], 32); const float o = off + (h ? ps : 0.f);
#pragma unroll
                for (int e = 0; e < 4; ++e) CUM[(32 * atb + 8 * g + 4 * h + e) * GL_CUMS + 32 * adb + r] = ga[4 * g + e] + o;
                off += sg[g] + ps; }
            if (h == 0) SEG[atb * 128 + 32 * adb + r] = off;
        }
        __syncthreads();
        {
            const int tau = dir ? 63 - tt : tt;
            float qs[16], ks[16];
#pragma unroll
            for (int j = 0; j < 4; ++j) {
                const f32x4 e0 = *(const LAS f32x4*)(SEG + d0 + 4 * j), e1 = *(const LAS f32x4*)(SEG + 128 + d0 + 4 * j);
                const f32x4 cl = *(const LAS f32x4*)(CUM + tau * GL_CUMS + d0 + 4 * j);
#pragma unroll
                for (int e = 0; e < 4; ++e) {
                    const float cum = cl[e] + (tau >= 32 ? e0[e] : 0.f);
                    const int jj = 4 * j + e;
                    const float ex = __expf(cum), inv = __builtin_amdgcn_rcpf(ex);
                    qs[jj] = qv[jj] * 0.08838834764831845f * ex;
                    ks[jj] = kv[jj] * inv;
                }
                if (tt == 0) { f32x4 dv;
#pragma unroll
                    for (int e = 0; e < 4; ++e) dv[e] = __expf(e0[e] + e1[e]);
                    *(f32x4*)(DECB + ((size_t)((b * 4 + hd) * 2 + dir) * 36 + cn) * 128 + d0 + 4 * j) = dv; }
            }
            bf16_t* qd = dir ? O + (row0 + tt) * OS + 1024 + hd * 128 + d0 : Z + (row0 + tt) * ZS + C_QGLA + hd * 128 + d0;
            bf16_t* kd = dir ? O + (row0 + tt) * OS + 1536 + hd * 128 + d0 : Z + (row0 + tt) * ZS + C_KGLA + hd * 128 + d0;
            u32x4 w;
            w.x = pk2(qs[0], qs[1]); w.y = pk2(qs[2], qs[3]); w.z = pk2(qs[4], qs[5]); w.w = pk2(qs[6], qs[7]); *(u32x4*)qd = w;
            w.x = pk2(qs[8], qs[9]); w.y = pk2(qs[10], qs[11]); w.z = pk2(qs[12], qs[13]); w.w = pk2(qs[14], qs[15]); *(u32x4*)(qd + 8) = w;
            w.x = pk2(ks[0], ks[1]); w.y = pk2(ks[2], ks[3]); w.z = pk2(ks[4], ks[5]); w.w = pk2(ks[6], ks[7]); *(u32x4*)kd = w;
            w.x = pk2(ks[8], ks[9]); w.y = pk2(ks[10], ks[11]); w.z = pk2(ks[12], ks[13]); w.w = pk2(ks[14], ks[15]); *(u32x4*)(kd + 8) = w;
        }
        __syncthreads();
    }
}
constexpr int GL_RS = 136, GL_VS = 72, GC_QS = 0, GC_KS = GC_QS + 2 * 64 * GL_RS * 2, GC_V = GC_KS + 2 * 64 * GL_RS * 2, GC_ST = GC_V + 2 * 64 * GL_VS * 2, GC_DEC = GC_ST + 2 * 128 * GL_VS * 2;
static_assert(GC_DEC + 2 * 128 * 4 <= MISC_OFF, "GLA chain LDS");
DI void gla_chain(const Frame& F, int l, int chain, bool ctx_out) {
    const int vs = chain & 3, dir = (chain >> 2) & 1, hd = (chain >> 3) & 3, b = chain >> 5;
    const bf16_t* Z = (const bf16_t*)(F.ws + WS_R1); const bf16_t* O = (const bf16_t*)(F.ws + WS_R1 + R1_O); const float* DECB = (const float*)(F.ws + WS_DECB);
    bf16_t* OD = (bf16_t*)(F.ws + WS_R2 + (dir ? R2_OB : 0));
    const int tid = F.tid, lane = F.lane, wave = F.wave, r = lane & 31, h = lane >> 5;
    const int trq = (lane & 15) >> 2, trc = 16 * ((lane >> 4) & 1) + 4 * (lane & 3);
    const int tau = tid >> 3, seg = tid & 7, d0 = seg * 16;
#define GL_CN(s_) ((s_) < 4 ? (dir ? 3 - (s_) : (s_)) : 4 + (dir ? 31 - ((s_) - 4) : ((s_) - 4)))
#define GL_ROW(s_, t_) (gl_chunk_row(b, GL_CN(s_)) + (dir ? 63 - (t_) : (t_)))
    const bf16_t* qbase = dir ? O + 1024 + hd * 128 + d0 : Z + C_QGLA + hd * 128 + d0; const bf16_t* kbase = dir ? O + 1536 + hd * 128 + d0 : Z + C_KGLA + hd * 128 + d0;
    const size_t qstr = dir ? OS : ZS;
    const bf16_t* vbase = Z + C_VGLA + hd * 256 + vs * 64 + seg * 8;
    const float* dbase = DECB + (size_t)((b * 4 + hd) * 2 + dir) * 36 * 128;
    __syncthreads();
    for (int i = tid; i < 128 * GL_VS / 2; i += 512) ((LAS unsigned*)(F.lds + GC_ST))[i] = 0u;
    f32x16 S0, S1;
#pragma unroll
    for (int i = 0; i < 16; ++i) { S0[i] = 0.f; S1[i] = 0.f; }
    u32x4 nq0, nq1, nk0, nk1, nvv; float ndec = 0.f;
#define GL_LOAD(s_) do { const size_t rw = GL_ROW(s_, tau); nq0 = *(const u32x4*)(qbase + rw * qstr); nq1 = *(const u32x4*)(qbase + rw * qstr + 8); nk0 = *(const u32x4*)(kbase + rw * qstr); nk1 = *(const u32x4*)(kbase + rw * qstr + 8); \
        nvv = *(const u32x4*)(vbase + rw * ZS); if (tid < 128) ndec = dbase[GL_CN(s_) * 128 + tid]; } while (0)
#define GL_PUT(p_) do { LAS bf16_t* qd = (LAS bf16_t*)(F.lds + GC_QS) + ((p_) * 64 + tau) * GL_RS + d0; LAS bf16_t* kd = (LAS bf16_t*)(F.lds + GC_KS) + ((p_) * 64 + tau) * GL_RS + d0; \
        *(LAS u32x4*)qd = nq0; *(LAS u32x4*)(qd + 8) = nq1; *(LAS u32x4*)kd = nk0; *(LAS u32x4*)(kd + 8) = nk1; *(LAS u32x4*)((LAS bf16_t*)(F.lds + GC_V) + ((p_) * 64 + tau) * GL_VS + seg * 8) = nvv; \
        if (tid < 128) ((LAS float*)(F.lds + GC_DEC))[(p_) * 128 + tid] = ndec; } while (0)
    GL_LOAD(0); GL_PUT(0); GL_LOAD(1);
    __syncthreads();
#pragma unroll 1
    for (int s = 0; s < 36; ++s) {
        const int p = s & 1;
        const bool emit = (s >= 4) || ctx_out;
        const LAS bf16_t* QS = (const LAS bf16_t*)(F.lds + GC_QS) + p * 64 * GL_RS; const LAS bf16_t* KS = (const LAS bf16_t*)(F.lds + GC_KS) + p * 64 * GL_RS;
        const LAS bf16_t* VV = (const LAS bf16_t*)(F.lds + GC_V) + p * 64 * GL_VS;
        const LAS bf16_t* STo = (const LAS bf16_t*)(F.lds + GC_ST) + p * 128 * GL_VS; LAS bf16_t* STn = (LAS bf16_t*)(F.lds + GC_ST) + (p ^ 1) * 128 * GL_VS;
        if (wave < 4) {
            if (emit) {
                const int vb = wave & 1, tb = wave >> 1;
                f32x16 a0, a1, oo, oi;
#pragma unroll
                for (int i = 0; i < 16; ++i) { a0[i] = 0.f; a1[i] = 0.f; oo[i] = 0.f; oi[i] = 0.f; }
#pragma unroll
                for (int kk = 0; kk < 8; ++kk) {
                    const bf16x8 qf = *(const LAS bf16x8*)(QS + (32 * tb + r) * GL_RS + 16 * kk + 8 * h);
                    const bf16x8 kf0 = *(const LAS bf16x8*)(KS + r * GL_RS + 16 * kk + 8 * h);
                    const LAS bf16_t* sp = STo + (16 * kk + 8 * h + trq) * GL_VS + 32 * vb + trc;
                    a0 = MFMA32(kf0, qf, a0);
                    oi = MFMA32(tr8(sp, sp + 4 * GL_VS), qf, oi);
                    if (tb == 1) { const bf16x8 kf1 = *(const LAS bf16x8*)(KS + (32 + r) * GL_RS + 16 * kk + 8 * h); a1 = MFMA32(kf1, qf, a1); }
                }
                const int tt = 32 * tb + r;
#pragma unroll
                for (int i = 0; i < 16; ++i) { const int sg0 = crow(i, h); if (sg0 > tt) a0[i] = 0.f; if (32 + sg0 > tt) a1[i] = 0.f; }
#pragma unroll
                for (int sb = 0; sb < 2; ++sb)
#pragma unroll
                    for (int st = 0; st < 2; ++st) {
                        if (sb == 1 && tb == 0) continue;
                        const bf16x8 pf = pack_step(sb ? a1 : a0, st);
                        const LAS bf16_t* vp = VV + (32 * sb + 16 * st + 4 * h + trq) * GL_VS + 32 * vb + trc;
                        oo = MFMA32(tr8(vp, vp + 8 * GL_VS), pf, oo);
                    }
#pragma unroll
                for (int i = 0; i < 16; ++i) oo[i] += oi[i];
                const size_t orow = GL_ROW(s, tt);
                bf16_t* op = OD + orow * D + hd * 256 + vs * 64 + 32 * vb + 4 * h;
#pragma unroll
                for (int g = 0; g < 4; ++g) { u32x2 w; w.x = pk2(oo[4 * g], oo[4 * g + 1]); w.y = pk2(oo[4 * g + 2], oo[4 * g + 3]); *(u32x2*)(op + 8 * g) = w; }
            }
        } else {
            const int db = wave - 4, dd = 32 * db + r;
            const float dec = ((const LAS float*)(F.lds + GC_DEC))[p * 128 + dd];
#pragma unroll
            for (int kk = 0; kk < 4; ++kk) {
                const LAS bf16_t* kp = KS + (16 * kk + 8 * h + trq) * GL_RS + 32 * db + trc;
                const LAS bf16_t* v0p = VV + (16 * kk + 8 * h + trq) * GL_VS + trc;
                const bf16x8 kf = tr8(kp, kp + 4 * GL_RS);
                S0 = MFMA32(tr8(v0p, v0p + 4 * GL_VS), kf, S0); S1 = MFMA32(tr8(v0p + 32, v0p + 32 + 4 * GL_VS), kf, S1);
            }
#pragma unroll
            for (int i = 0; i < 16; ++i) { S0[i] *= dec; S1[i] *= dec; }
#pragma unroll
            for (int g = 0; g < 4; ++g) {
                u32x2 w0, w1; w0.x = pk2(S0[4 * g], S0[4 * g + 1]); w0.y = pk2(S0[4 * g + 2], S0[4 * g + 3]); w1.x = pk2(S1[4 * g], S1[4 * g + 1]); w1.y = pk2(S1[4 * g + 2], S1[4 * g + 3]);
                *(LAS u32x2*)(STn + dd * GL_VS + 8 * g + 4 * h) = w0; *(LAS u32x2*)(STn + dd * GL_VS + 32 + 8 * g + 4 * h) = w1;
            }
        }
        if (s + 1 < 36) { GL_PUT(p ^ 1); const int s2 = s + 2 < 36 ? s + 2 : 35; GL_LOAD(s2); }
        __syncthreads();
    }
#undef GL_ROW
#undef GL_CN
#undef GL_LOAD
#undef GL_PUT
}
DI void phase_gla_fin(const Frame& F, int l, int M) {
    const int NGW = F.G * 8, gw = F.bid * 8 + F.wave, lane = F.lane;
    const bf16_t* Z = (const bf16_t*)(F.ws + WS_R1); bf16_t* O = (bf16_t*)(F.ws + WS_R1 + R1_O);
    const bf16_t* OFp = (const bf16_t*)(F.ws + WS_R2); const bf16_t* OBp = (const bf16_t*)(F.ws + WS_R2 + R2_OB);
    const float* gn = F.in[I_GNG] + (size_t)l * 256;
    for (int t = gw; t < M; t += NGW) {
        const u32x4 a0 = *(const u32x4*)(OFp + (size_t)t * D + 16 * lane), a1 = *(const u32x4*)(OFp + (size_t)t * D + 16 * lane + 8);
        const u32x4 b0 = *(const u32x4*)(OBp + (size_t)t * D + 16 * lane), b1 = *(const u32x4*)(OBp + (size_t)t * D + 16 * lane + 8);
        const u32x4 r0 = *(const u32x4*)(Z + (size_t)t * ZS + C_RGLA + 16 * lane), r1 = *(const u32x4*)(Z + (size_t)t * ZS + C_RGLA + 16 * lane + 8);
        float o[16], rr[16];
        o[0] = bf_lo(a0.x) + bf_lo(b0.x); o[1] = bf_hi(a0.x) + bf_hi(b0.x); o[2] = bf_lo(a0.y) + bf_lo(b0.y); o[3] = bf_hi(a0.y) + bf_hi(b0.y);
        o[4] = bf_lo(a0.z) + bf_lo(b0.z); o[5] = bf_hi(a0.z) + bf_hi(b0.z); o[6] = bf_lo(a0.w) + bf_lo(b0.w); o[7] = bf_hi(a0.w) + bf_hi(b0.w);
        o[8] = bf_lo(a1.x) + bf_lo(b1.x); o[9] = bf_hi(a1.x) + bf_hi(b1.x); o[10] = bf_lo(a1.y) + bf_lo(b1.y); o[11] = bf_hi(a1.y) + bf_hi(b1.y);
        o[12] = bf_lo(a1.z) + bf_lo(b1.z); o[13] = bf_hi(a1.z) + bf_hi(b1.z); o[14] = bf_lo(a1.w) + bf_lo(b1.w); o[15] = bf_hi(a1.w) + bf_hi(b1.w);
        rr[0] = bf_lo(r0.x); rr[1] = bf_hi(r0.x); rr[2] = bf_lo(r0.y); rr[3] = bf_hi(r0.y); rr[4] = bf_lo(r0.z); rr[5] = bf_hi(r0.z); rr[6] = bf_lo(r0.w); rr[7] = bf_hi(r0.w);
        rr[8] = bf_lo(r1.x); rr[9] = bf_hi(r1.x); rr[10] = bf_lo(r1.y); rr[11] = bf_hi(r1.y); rr[12] = bf_lo(r1.z); rr[13] = bf_hi(r1.z); rr[14] = bf_lo(r1.w); rr[15] = bf_hi(r1.w);
        float ss = 0.f;
#pragma unroll
        for (int i = 0; i < 16; ++i) ss += o[i] * o[i];
        ss += __shfl_xor(ss, 1); ss += __shfl_xor(ss, 2); ss += __shfl_xor(ss, 4); ss += __shfl_xor(ss, 8);
        const float rstd = rsqrtf(ss * (1.0f / 256.0f) + RMS_EPS);
        const int v0 = (lane & 15) * 16;
        float y[16];
#pragma unroll
        for (int i = 0; i < 16; ++i) y[i] = o[i] * rstd * gn[v0 + i] * siluf_(rr[i]);
        u32x4 w0, w1; w0.x = pk2(y[0], y[1]); w0.y = pk2(y[2], y[3]); w0.z = pk2(y[4], y[5]); w0.w = pk2(y[6], y[7]);
        w1.x = pk2(y[8], y[9]); w1.y = pk2(y[10], y[11]); w1.z = pk2(y[12], y[13]); w1.w = pk2(y[14], y[15]);
        *(u32x4*)(O + (size_t)t * OS + 1024 + 16 * lane) = w0; *(u32x4*)(O + (size_t)t * OS + 1024 + 16 * lane + 8) = w1;
    }
}

constexpr int RT_HS = 1032;
template <bool DRY = false> DI void phase_router(const Frame& F, int l, int M) {
    LAS bf16_t* HH = (LAS bf16_t*)F.lds;
    LAS bf16_t* HL = HH + 32 * RT_HS;
    LAS float* H2F = (LAS float*)F.lds;
    bf16_t* H2 = (bf16_t*)(F.ws + WS_R1 + R1_H2);
    const float* xres = F.out; const float* cres = (const float*)(F.ws + WS_CTXS);
    const bf16_t* WRH = (const bf16_t*)(F.ws + WS_WRT) + (size_t)(l * 2) * NE * D; const bf16_t* WRL = WRH + (size_t)NE * D;
    int* toke = (int*)(F.ws + WS_TOKE); int* tokp = (int*)(F.ws + (DRY ? WS_TOKR : WS_TOKP)); float* tokw = (float*)(F.ws + WS_TOKW);
    unsigned* cnt = (unsigned*)(F.ws + WS_CTL) + CW_CNT + 4096 * l + (DRY ? 32 : 0);
    const int lane = F.lane, wave = F.wave, r = lane & 31, hh = lane >> 5;
    const float brt = F.in[I_BR][l * NE + lane];
    const int npass = (M + 31) / 32;
    float xr[4][16];
#pragma unroll
    for (int rr = 0; rr < 4; ++rr) { const int t = F.bid * 32 + 4 * wave + rr;
        if (F.bid < npass && t < M) load_row_f32(t >= TL ? cres + (size_t)(t - TL) * D : xres + (size_t)t * D, lane, xr[rr]);
        else {
#pragma unroll
            for (int i = 0; i < 16; ++i) xr[rr][i] = 0.f; } }
    float gg[16]; load_row_f32(F.in[I_G2] + (size_t)l * D, lane, gg);
#pragma unroll 1
    for (int ps = F.bid; ps < npass; ps += F.G) {
        __syncthreads();
        { const int t0 = ps * 32; const int mr = t0 >= TL ? 8 : t0 / SEQ;
          float sh[16], sc[16]; load_row_f32(modp(F, l, mr, 3), lane, sh); load_row_f32(modp(F, l, mr, 4), lane, sc);
#pragma unroll
          for (int rr = 0; rr < 4; ++rr) {
            const int row = 4 * wave + rr, t = ps * 32 + row;
            float h[16]; float ss = 0.f;
#pragma unroll
            for (int i = 0; i < 16; ++i) ss += xr[rr][i] * xr[rr][i];
            const float rstd = rsqrtf(wave_sum(ss) * (1.0f / D) + RMS_EPS);
#pragma unroll
            for (int i = 0; i < 16; ++i) h[i] = (t < M) ? xr[rr][i] * rstd * gg[i] * (1.0f + sc[i]) + sh[i] : 0.f;
            if (t < M) store_row_bf16(H2 + (size_t)t * D, lane, h);
#pragma unroll
            for (int i = 0; i < 2; ++i) {
                u32x4 whi; whi.x = pk2(h[8 * i], h[8 * i + 1]); whi.y = pk2(h[8 * i + 2], h[8 * i + 3]); whi.z = pk2(h[8 * i + 4], h[8 * i + 5]); whi.w = pk2(h[8 * i + 6], h[8 * i + 7]);
                u32x4 wlo; wlo.x = pk2(h[8 * i] - bf_lo(whi.x), h[8 * i + 1] - bf_hi(whi.x)); wlo.y = pk2(h[8 * i + 2] - bf_lo(whi.y), h[8 * i + 3] - bf_hi(whi.y));
                wlo.z = pk2(h[8 * i + 4] - bf_lo(whi.z), h[8 * i + 5] - bf_hi(whi.z)); wlo.w = pk2(h[8 * i + 6] - bf_lo(whi.w), h[8 * i + 7] - bf_hi(whi.w));
                *(LAS u32x4*)(HH + row * RT_HS + 8 * lane + 512 * i) = whi; *(LAS u32x4*)(HL + row * RT_HS + 8 * lane + 512 * i) = wlo; }
          }
          const int pn = ps + F.G;
#pragma unroll
          for (int rr = 0; rr < 4; ++rr) { const int t = pn * 32 + 4 * wave + rr;
              if (pn < npass && t < M) load_row_f32(t >= TL ? cres + (size_t)(t - TL) * D : xres + (size_t)t * D, lane, xr[rr]); }
        }
        __syncthreads();
        f32x16 a0, a1;
#pragma unroll
        for (int i = 0; i < 16; ++i) { a0[i] = 0.f; a1[i] = 0.f; }
        {
            const LAS bf16_t* hp = HH + r * RT_HS + 128 * wave + 8 * hh; const LAS bf16_t* lp = HL + r * RT_HS + 128 * wave + 8 * hh;
            const bf16_t* w0h = WRH + (size_t)r * D + 128 * wave + 8 * hh; const bf16_t* w1h = w0h + (size_t)32 * D;
            const bf16_t* w0l = WRL + (size_t)r * D + 128 * wave + 8 * hh; const bf16_t* w1l = w0l + (size_t)32 * D;
#pragma unroll
            for (int ks = 0; ks < 8; ++ks) {
                const bf16x8 ah = *(const LAS bf16x8*)(hp + 16 * ks), al = *(const LAS bf16x8*)(lp + 16 * ks);
                const bf16x8 b0h = *(const bf16x8*)(w0h + 16 * ks), b1h = *(const bf16x8*)(w1h + 16 * ks), b0l = *(const bf16x8*)(w0l + 16 * ks), b1l = *(const bf16x8*)(w1l + 16 * ks);
                a0 = MFMA32(ah, b0h, a0); a1 = MFMA32(ah, b1h, a1);
                a0 = MFMA32(al, b0h, a0); a1 = MFMA32(al, b1h, a1);
                a0 = MFMA32(ah, b0l, a0); a1 = MFMA32(ah, b1l, a1);
            }
        }
        __syncthreads();
#pragma unroll
        for (int i = 0; i < 16; ++i) { const int tk = crow(i, hh); H2F[(wave * 32 + tk) * 64 + r] = a0[i]; H2F[(wave * 32 + tk) * 64 + 32 + r] = a1[i]; }
        __syncthreads();
        LAS unsigned* lcnt = (LAS unsigned*)(F.lds + MISC_OFF + 2048);
        if (F.tid < 64) lcnt[F.tid] = 0u;
        __syncthreads();
        int myj[4]; unsigned mylp[4]; float myw[4];
#pragma unroll
        for (int rr = 0; rr < 4; ++rr) {
            const int row = 4 * wave + rr, t = ps * 32 + row;
            myj[rr] = -1; mylp[rr] = 0u; myw[rr] = 0.f;
            if (t >= M) continue;
            float logit = 0.f;
#pragma unroll
            for (int w = 0; w < 8; ++w) logit += H2F[(w * 32 + row) * 64 + lane];
            const float score = sigmoidf_(logit), sel = score + brt;
            float g1 = sel; g1 = fmaxf(g1, __shfl_xor(g1, 1)); g1 = fmaxf(g1, __shfl_xor(g1, 2)); g1 = fmaxf(g1, __shfl_xor(g1, 4));
            const unsigned long long bm = __ballot(sel == g1);
            const unsigned gm = (unsigned)((bm >> (lane & ~7)) & 0xffull);
            const int first = __builtin_ctz(gm);
            float g2 = ((lane & 7) == first) ? -INFINITY : sel; g2 = fmaxf(g2, __shfl_xor(g2, 1)); g2 = fmaxf(g2, __shfl_xor(g2, 2)); g2 = fmaxf(g2, __shfl_xor(g2, 4));
            const float gs = g1 + g2; const int g = lane >> 3;
            int grank = 0;
#pragma unroll
            for (int j = 0; j < 8; ++j) { const float o = __shfl(gs, 8 * j); grank += (o > gs || (o == gs && j < g)) ? 1 : 0; }
            const bool gsel = grank < 4;
            const float ms = gsel ? sel : -INFINITY;
            int rank = 0;
#pragma unroll 4
            for (int j = 0; j < 64; ++j) { const float o = __int_as_float(__builtin_amdgcn_readlane(__float_as_int(ms), j)); rank += (o > ms || (o == ms && j < lane)) ? 1 : 0; }
            const bool chosen = gsel && rank < 8;
            const unsigned long long cb = __ballot(chosen);
            const float ssum = wave_sum(chosen ? score : 0.f);
            if (chosen) {
                const int j = __builtin_popcountll(cb & ((1ull << lane) - 1ull));
                if (j < 8) { myj[rr] = j; mylp[rr] = __hip_atomic_fetch_add(&lcnt[lane], 1u, __ATOMIC_RELAXED, __HIP_MEMORY_SCOPE_WORKGROUP); myw[rr] = score * __builtin_amdgcn_rcpf(ssum) * 2.5f; }
            }
        }
        __syncthreads();
        if (F.tid < 64) { const unsigned c = lcnt[F.tid]; lcnt[64 + F.tid] = c ? atomicAdd(cnt + F.tid * 64, c) : 0u; }
        __syncthreads();
#pragma unroll
        for (int rr = 0; rr < 4; ++rr) {
            const int t = ps * 32 + 4 * wave + rr;
            if (myj[rr] >= 0) { const size_t o = (size_t)t * 8 + myj[rr]; toke[o] = lane; tokp[o] = (int)(lcnt[64 + lane] + mylp[rr]); tokw[o] = myw[rr]; }
        }
    }
    __syncthreads();
}
DI void moe_tables(const Frame& F, int l, int M) {
    LAS int* tb = (LAS int*)(F.lds + MISC_OFF + 64); LAS int* rb = tb + 72; LAS int* cn = rb + 72;
    const unsigned* cnt = (const unsigned*)(F.ws + WS_CTL) + CW_CNT + 4096 * l;
    __syncthreads();
    if (F.tid < NE) cn[F.tid] = (int)__hip_atomic_load(cnt + F.tid * 64, __ATOMIC_RELAXED, __HIP_MEMORY_SCOPE_AGENT);
    if (F.tid == NE) cn[NE] = M;
    __syncthreads();
    if (F.tid == 0) { int t = 0, r = 0; for (int e = 0; e < NEX; ++e) { tb[e] = t; rb[e] = r; t += (cn[e] + 255) >> 8; r += cn[e]; } tb[NEX] = t; }
    __syncthreads();
    LAS unsigned char* te = (LAS unsigned char*)(cn + 72);
    if (F.tid < NEX) { const int t0 = tb[F.tid], t1 = tb[F.tid + 1]; for (int t = t0; t < t1; ++t) te[t] = (unsigned char)F.tid; }
    __syncthreads();
}
DI void phase_route_tables(const Frame& F, int l, int M) {
    moe_tables(F, l, M);
    const LAS int* rb = (const LAS int*)(F.lds + MISC_OFF + 64) + 72;
    const int* toke = (const int*)(F.ws + WS_TOKE); const int* tokp = (const int*)(F.ws + WS_TOKP);
    int* tokr = (int*)(F.ws + WS_TOKR); int* rowl = (int*)(F.ws + WS_ROWL);
    for (int i = F.bid * 512 + F.tid; i < M * 8; i += F.G * 512) { const int row = rb[toke[i]] + tokp[i]; tokr[i] = row; rowl[row] = i >> 3; }
    const int shb = rb[NE];
    for (int i = F.bid * 512 + F.tid; i < M + 256; i += F.G * 512) rowl[shb + i] = (i < M) ? i : 0;
}
template <bool DRY = false> DI void phase_combine(const Frame& F, int l, int M) {
    moe_tables(F, l, M);
    const LAS int* rb = (const LAS int*)(F.lds + MISC_OFF + 64) + 72;
    const int shb = rb[NE];
    const int gw = F.bid * 8 + F.wave, lane = F.lane;
    const bf16_t* OS_ = (const bf16_t*)(F.ws + WS_R1);
    const int* tokr = (const int*)(F.ws + WS_TOKR); const float* tokw = (const float*)(F.ws + WS_TOKW);
    float* xres = F.out; float* cres = (float*)(F.ws + WS_CTXS);
    bf16_t* H = (bf16_t*)(F.ws + WS_R2 + (DRY ? (size_t)40 * 1024 * 1024 : 0));
    const int per = M / (GRID * 8);
    const int tbeg = gw * per;
    int mr_cur = -1;
    float g2v[16], shv[16], scv[16], gnv[16];
    if (l == 0) load_row_f32(F.in[I_G1] + D, lane, gnv); else load_row_f32(F.in[I_GF], lane, gnv);
    int4 nr0, nr1; f32x4 nw0, nw1; float xn[16];
    { const int t = tbeg; nr0 = *(const int4*)(tokr + (size_t)t * 8); nr1 = *(const int4*)(tokr + (size_t)t * 8 + 4); nw0 = *(const f32x4*)(tokw + (size_t)t * 8); nw1 = *(const f32x4*)(tokw + (size_t)t * 8 + 4);
      load_row_f32(t >= TL ? cres + (size_t)(t - TL) * D : xres + (size_t)t * D, lane, xn); }
#pragma unroll 1
    for (int k = 0; k < per; ++k) {
        const int t = tbeg + k;
        const bool isctx = t >= TL; const int mr = isctx ? 8 : t / SEQ;
        if (mr != mr_cur) { mr_cur = mr; load_row_f32(modp(F, l, mr, 5), lane, g2v); if (l == 0) { load_row_f32(modp(F, 1, mr, 0), lane, shv); load_row_f32(modp(F, 1, mr, 1), lane, scv); } }
        const int rows[8] = {nr0.x, nr0.y, nr0.z, nr0.w, nr1.x, nr1.y, nr1.z, nr1.w};
        const float wts[8] = {nw0[0], nw0[1], nw0[2], nw0[3], nw1[0], nw1[1], nw1[2], nw1[3]};
        float x[16];
#pragma unroll
        for (int i = 0; i < 16; ++i) x[i] = xn[i];
        u32x4 v[9][2];
#pragma unroll
        for (int i = 0; i < 2; ++i) v[8][i] = *(const u32x4*)(OS_ + (size_t)(shb + t) * D + 8 * lane + 512 * i);
#pragma unroll
        for (int j = 0; j < 8; ++j)
#pragma unroll
            for (int i = 0; i < 2; ++i) v[j][i] = *(const u32x4*)(OS_ + (size_t)rows[j] * D + 8 * lane + 512 * i);
        if (k + 1 < per) { const int tn = t + 1; nr0 = *(const int4*)(tokr + (size_t)tn * 8); nr1 = *(const int4*)(tokr + (size_t)tn * 8 + 4); nw0 = *(const f32x4*)(tokw + (size_t)tn * 8); nw1 = *(const f32x4*)(tokw + (size_t)tn * 8 + 4);
            load_row_f32(tn >= TL ? cres + (size_t)(tn - TL) * D : xres + (size_t)tn * D, lane, xn); }
        float y[16];
#pragma unroll
        for (int i = 0; i < 2; ++i) { const u32x4 a = v[8][i];
            y[8 * i + 0] = bf_lo(a.x); y[8 * i + 1] = bf_hi(a.x); y[8 * i + 2] = bf_lo(a.y); y[8 * i + 3] = bf_hi(a.y); y[8 * i + 4] = bf_lo(a.z); y[8 * i + 5] = bf_hi(a.z); y[8 * i + 6] = bf_lo(a.w); y[8 * i + 7] = bf_hi(a.w); }
#pragma unroll
        for (int j = 0; j < DBG_NROUTED; ++j) { const float w = wts[j];
#pragma unroll
            for (int i = 0; i < 2; ++i) { const u32x4 a = v[j][i];
                y[8 * i + 0] += w * bf_lo(a.x); y[8 * i + 1] += w * bf_hi(a.x); y[8 * i + 2] += w * bf_lo(a.y); y[8 * i + 3] += w * bf_hi(a.y);
                y[8 * i + 4] += w * bf_lo(a.z); y[8 * i + 5] += w * bf_hi(a.z); y[8 * i + 6] += w * bf_lo(a.w); y[8 * i + 7] += w * bf_hi(a.w); } }
        float* xr = isctx ? cres + (size_t)(t - TL) * D : xres + (size_t)t * D;
#pragma unroll
        for (int i = 0; i < 16; ++i) x[i] += g2v[i] * y[i];
        float ss = 0.f;
#pragma unroll
        for (int i = 0; i < 16; ++i) ss += x[i] * x[i];
        const float rstd = rsqrtf(wave_sum(ss) * (1.0f / D) + RMS_EPS);
        if (l == 0) {
            if (!DRY) store_row_f32(xr, lane, x);
            float h[16];
#pragma unroll
            for (int i = 0; i < 16; ++i) h[i] = x[i] * rstd * gnv[i] * (1.0f + scv[i]) + shv[i];
            store_row_bf16(H + (size_t)t * D, lane, h);
        } else {
#pragma unroll
            for (int i = 0; i < 16; ++i) x[i] = x[i] * rstd * gnv[i];
            if (!DRY) store_row_f32(xr, lane, x); else store_row_bf16(H + (size_t)t * D, lane, x);
        }
    }
}

constexpr int PH_PER_LAYER = 10, N_PHASES = 2 + 2 * PH_PER_LAYER;
template <class T> DI T* opaque_ptr(T* p) {
    unsigned long long v = (unsigned long long)p; unsigned lo = (unsigned)v, hi = (unsigned)(v >> 32);
    asm volatile("" : "+s"(lo), "+s"(hi)); return (T*)(__attribute__((address_space(1))) T*)(((unsigned long long)hi << 32) | lo);
}
template <int KIND> DI void run_phase(const Frame& F0, const int l0) {
    Frame F = F0; int l = l0; asm volatile("" : "+s"(l));
    F.ws = opaque_ptr(F0.ws); F.out = opaque_ptr(F0.out);
    { int t = F0.tid; asm volatile("" : "+v"(t)); F.tid = t; F.lane = t & 63; F.wave = __builtin_amdgcn_readfirstlane(t >> 6); }
    unsigned char* const ws = F.ws;
    const bool ctx_out = (l == 0);
    const int M = ctx_out ? TA : TL;
    if constexpr (KIND == 0) { mod_vectors(F); conv_router(F); conv_gate_w(F); conv_small(F, 0); conv_down(F, 0, (bf16_t*)(ws + WS_WBS + WB_WD)); }
    if constexpr (KIND == 1) { phase_norm1_first(F); }
    if constexpr (KIND == 2) {
        pg8::RectSched<37> S{(const char*)(ws + WS_R2), (const char*)(ws + wbs_base(l) + WB_WIN), D, D, ctx_out ? 72 : 64, ctx_out ? 0 : 8, ctx_out ? 0 : 11, 64, F.G, F.bid};
        pg8::EpiStoreBf16 E{(bf16_t*)(ws + WS_R1), ZS};
        pg8::gemm_phase<false>(F.lds, F.tid, D, D, D, S, E);
    }
    if constexpr (KIND == 3) {
#pragma unroll 1
        for (int t = F.bid; t < NB * 4 * 36; t += F.G) gla_prep(F, l, t);
        phase_na(F, l, ctx_out);
        phase_conv(F, l, M);
    }
    if constexpr (KIND == 12) {
#pragma unroll 1
        for (int ch = F.bid; ch < 256; ch += F.G) gla_chain(F, l, ch, ctx_out);
    }
    if constexpr (KIND == 4) { phase_gla_fin(F, l, M); }
    if constexpr (KIND == 5) {
        const char* Ob = (const char*)(ws + WS_R1 + R1_O); bf16_t* Y = (bf16_t*)(ws + WS_R2); const bf16_t* Zb = (const bf16_t*)(ws + WS_R1);
        { pg8::RectSched<4> S{Ob, (const char*)(ws + wbs_base(l) + WB_WNA), OS, 512, M / 256, 0, 0, 0, F.G, F.bid}; pg8::EpiGate<0> E{Y, Zb, C_MERGE}; pg8::gemm_phase<false>(F.lds, F.tid, 512, OS, 512, S, E); }
        { pg8::RectSched<4> S{Ob + 512 * 2, (const char*)(ws + wbs_base(l) + WB_WSC), OS, 512, M / 256, 0, 0, 0, F.G, F.bid}; pg8::EpiGate<1> E{Y, Zb, C_MERGE + 1024}; pg8::gemm_phase<false>(F.lds, F.tid, 512, OS, 512, S, E); }
        { pg8::RectSched<4> S{Ob + 1024 * 2, (const char*)(ws + wbs_base(l) + WB_WGLA), OS, D, M / 256, 0, 0, 0, F.G, F.bid}; pg8::EpiGate<1> E{Y, Zb, C_MERGE + 2048}; pg8::gemm_phase<false>(F.lds, F.tid, D, OS, D, S, E); }
        if (l == 0) conv_small(F, 1, 32);
    }
    if constexpr (KIND == 6) {
        pg8::RectSched<4> S{(const char*)(ws + WS_R2), (const char*)(ws + wbs_base(l) + WB_WOUT), D, D, M / 256, 0, 0, 0, F.G, F.bid};
        pg8::EpiResid E{l == 0 ? F.in[I_X] : F.out, F.out, l == 0 ? F.in[I_CTX] : (const float*)(ws + WS_CTXS), (float*)(ws + WS_CTXS), modp(F, l, 0, 2)};
        pg8::gemm_phase<false>(F.lds, F.tid, D, D, D, S, E);
    }
    if constexpr (KIND == 7) {
#if REPEAT_KIND == 71
        phase_router<true>(F, l, M);
#endif
        phase_router(F, l, M); conv_gu(F, l, (bf16_t*)(ws + WS_R1));
#if REPEAT_KIND == 72
        conv_gu(F, l, (bf16_t*)(ws + WS_R1));
#endif
    }
    if constexpr (KIND == 8) { phase_route_tables(F, l, M); }
    if constexpr (KIND == 9) {
        moe_tables(F, l, M);
        const LAS int* tb = (const LAS int*)(F.lds + MISC_OFF + 64);
        pg8::MoeSched<true, 2> S{tb, tb + 72, tb + 144, (const char*)(ws + WS_R1 + R1_H2), (const int*)(ws + WS_ROWL), (const char*)(ws + WS_R1), (size_t)512 * D * 2, D, D, F.G, F.bid};
        pg8::EpiSwiGLU E{(bf16_t*)(ws + WS_R2)};
        pg8::gemm_phase<true>(F.lds, F.tid, D, D, D, S, E);
    }
    if constexpr (KIND == 10) {
        moe_tables(F, l, M);
        const LAS int* tb = (const LAS int*)(F.lds + MISC_OFF + 64);
        pg8::MoeSched<false, 4> S{tb, tb + 72, tb + 144, (const char*)(ws + WS_R2), nullptr, (const char*)(ws + WS_WBS + WB_WD), (size_t)D * FF * 2, FF, FF, F.G, F.bid};
        pg8::EpiDown E{(bf16_t*)(ws + WS_R1)};
        pg8::gemm_phase<false>(F.lds, F.tid, FF, FF, FF, S, E);
    }
    if constexpr (KIND == 11) {
#if REPEAT_KIND == 111
        phase_combine<true>(F, l, M);
#endif
        phase_combine(F, l, M); if (l == 0) conv_down(F, 1, (bf16_t*)(ws + WS_WBS + WB_WD));
    }
}
DI void make_frame(Frame& F, const Args& args, unsigned char* lds_raw) {
    F.lds = (LAS unsigned char*)lds_raw; F.ws = args.ws; F.in = args.in; F.out = args.out;
    F.tid = threadIdx.x; F.lane = F.tid & 63; F.wave = __builtin_amdgcn_readfirstlane(F.tid >> 6); F.G = GRID; F.bid = blockIdx.x;
}
template <int KIND> __global__ void __launch_bounds__(512, 2) fwd_k(Args args) {
    extern __shared__ __attribute__((aligned(16))) unsigned char lds_raw[];
    Frame F; make_frame(F, args, lds_raw);
    run_phase<KIND>(F, args.ph_lo);
}
#if MK_ONE_LAUNCH
__global__ void __launch_bounds__(512, 2) fwd(Args args) {
    extern __shared__ __attribute__((aligned(16))) unsigned char lds_raw[];
    Frame F; make_frame(F, args, lds_raw);
    volatile LAS unsigned* MISC = (volatile LAS unsigned*)(F.lds + MISC_OFF);
    if (F.tid < 4) MISC[F.tid] = 0u;
    __syncthreads();
    XcdBarrier bar = xcd_barrier_post((unsigned*)(F.ws + WS_CTL) + CW_BAR, MISC);
    run_phase<0>(F, 0); xcd_barrier(bar); if (REPEAT_KIND == 99) xcd_barrier(bar); if (REPEAT_KIND == 0) { run_phase<0>(F, 0); xcd_barrier(bar); }
    run_phase<1>(F, 0); xcd_barrier(bar); if (REPEAT_KIND == 99) xcd_barrier(bar); if (REPEAT_KIND == 1) { run_phase<1>(F, 0); xcd_barrier(bar); }
#pragma unroll 1
    for (int l = 0; l < 2; ++l) {
        run_phase<2>(F, l); xcd_barrier(bar); if (REPEAT_KIND == 99) xcd_barrier(bar); if (REPEAT_KIND == 2) { run_phase<2>(F, l); xcd_barrier(bar); }
        run_phase<3>(F, l); xcd_barrier(bar); if (REPEAT_KIND == 99) xcd_barrier(bar);
        run_phase<12>(F, l); xcd_barrier(bar); if (REPEAT_KIND == 99) xcd_barrier(bar); if (REPEAT_KIND == 12) { run_phase<12>(F, l); xcd_barrier(bar); }
        run_phase<4>(F, l); xcd_barrier(bar); if (REPEAT_KIND == 99) xcd_barrier(bar); if (REPEAT_KIND == 4) { run_phase<4>(F, l); xcd_barrier(bar); }
        run_phase<5>(F, l); xcd_barrier(bar); if (REPEAT_KIND == 99) xcd_barrier(bar); if (REPEAT_KIND == 5) { run_phase<5>(F, l); xcd_barrier(bar); }
        run_phase<6>(F, l); xcd_barrier(bar); if (REPEAT_KIND == 99) xcd_barrier(bar); if (REPEAT_KIND == 6) { run_phase<6>(F, l); xcd_barrier(bar); }
        run_phase<7>(F, l); xcd_barrier(bar); if (REPEAT_KIND == 99) xcd_barrier(bar); if (REPEAT_KIND == 7) { run_phase<7>(F, l); xcd_barrier(bar); }
        run_phase<8>(F, l); xcd_barrier(bar); if (REPEAT_KIND == 99) xcd_barrier(bar); if (REPEAT_KIND == 8) { run_phase<8>(F, l); xcd_barrier(bar); }
        run_phase<9>(F, l); xcd_barrier(bar); if (REPEAT_KIND == 99) xcd_barrier(bar); if (REPEAT_KIND == 9) { run_phase<9>(F, l); xcd_barrier(bar); }
        run_phase<10>(F, l); xcd_barrier(bar); if (REPEAT_KIND == 99) xcd_barrier(bar); if (REPEAT_KIND == 10) { run_phase<10>(F, l); xcd_barrier(bar); }
        run_phase<11>(F, l); xcd_barrier(bar); if (REPEAT_KIND == 99) xcd_barrier(bar); if (REPEAT_KIND == 11) { run_phase<11>(F, l); xcd_barrier(bar); }
    }
}
#endif

template <int KIND> static bool prep_kernel() { return hipFuncSetAttribute((const void*)fwd_k<KIND>, hipFuncAttributeMaxDynamicSharedMemorySize, LDS_BYTES) == hipSuccess; }
template <int KIND> static void launch_k(int grid, hipStream_t stream, Args a, int l) { a.ph_lo = l; a.ph_hi = KIND; hipLaunchKernelGGL(fwd_k<KIND>, dim3(grid), dim3(512), LDS_BYTES, stream, a); }
extern "C" void kernel_launch(void* const* d_in, const int* in_sizes, int n_in, void* d_out, int out_size, void* d_ws, size_t ws_size, hipStream_t stream) {
    static int grid = 0;
    if (grid == 0) {
        if (n_in != N_INPUTS || ws_size < WS_END) { fprintf(stderr, "kernel_launch: need %d inputs and %zu bytes of workspace; got %d, %zu\n", N_INPUTS, (size_t)WS_END, n_in, ws_size); grid = -1; return; }
        int dev = 0, cus = 0;
        if (hipGetDevice(&dev) != hipSuccess || hipDeviceGetAttribute(&cus, hipDeviceAttributeMultiprocessorCount, dev) != hipSuccess) { grid = -1; return; }
#if MK_ONE_LAUNCH
        if (hipFuncSetAttribute((const void*)fwd, hipFuncAttributeMaxDynamicSharedMemorySize, LDS_BYTES) != hipSuccess) { grid = -1; return; }
#else
        bool ok = prep_kernel<0>() && prep_kernel<1>() && prep_kernel<2>() && prep_kernel<3>() && prep_kernel<4>() && prep_kernel<5>() && prep_kernel<6>() && prep_kernel<7>() && prep_kernel<8>() && prep_kernel<9>() && prep_kernel<10>() && prep_kernel<11>() && prep_kernel<12>();
        if (!ok) { fprintf(stderr, "kernel_launch: hipFuncSetAttribute failed\n"); grid = -1; return; }
#endif
        (void)hipGetLastError();
        if (cus < GRID) { fprintf(stderr, "kernel_launch: built for a %d-CU device, found %d CUs\n", GRID, cus); grid = -1; return; }
        grid = GRID;
    }
    if (grid < 0) return;
    if (hipMemsetAsync((char*)d_ws + WS_CTL, 0, ZERO_BYTES, stream) != hipSuccess) return;
    Args a{};
    for (int i = 0; i < N_INPUTS; ++i) a.in[i] = (const float*)d_in[i];
    a.out = (float*)d_out; a.ws = (unsigned char*)d_ws;
#if MK_ONE_LAUNCH
    a.ph_lo = 0; a.ph_hi = N_PHASES;
    hipLaunchKernelGGL(fwd, dim3(grid), dim3(512), LDS_BYTES, stream, a);
#else
    launch_k<0>(grid, stream, a, 0); launch_k<1>(grid, stream, a, 0);
    for (int l = 0; l < 2; ++l) {
        launch_k<2>(grid, stream, a, l); launch_k<3>(grid, stream, a, l); launch_k<12>(grid, stream, a, l); launch_k<4>(grid, stream, a, l); launch_k<5>(grid, stream, a, l); launch_k<6>(grid, stream, a, l);
#ifdef DBG_STOP6
        break;
#endif
        launch_k<7>(grid, stream, a, l); launch_k<8>(grid, stream, a, l); launch_k<9>(grid, stream, a, l); launch_k<10>(grid, stream, a, l); launch_k<11>(grid, stream, a, l);
#ifdef DBG_STOP11
        break;
#endif
    }
#endif
}
```

```cpp
#include <hip/hip_runtime.h>
#include <cstdio>
#include <cstdint>

#define DBG_NROUTED 8
#ifndef REPEAT_KIND
#define REPEAT_KIND -1
#endif
#ifndef PG8_SP2
#define PG8_SP2 1
#endif
#ifndef PG8_ALIGN
#define PG8_ALIGN 1
#endif
#ifndef MK_ONE_LAUNCH
#define MK_ONE_LAUNCH 1
#endif

#define LAS __attribute__((address_space(3)))
#define DI __device__ __forceinline__
typedef unsigned short bf16_t;
typedef short bf16x8 __attribute__((ext_vector_type(8)));
typedef short s16x4 __attribute__((ext_vector_type(4)));
typedef float f32x4 __attribute__((ext_vector_type(4)));
typedef float f32x16 __attribute__((ext_vector_type(16)));
typedef unsigned u32x4 __attribute__((ext_vector_type(4)));
typedef unsigned u32x2 __attribute__((ext_vector_type(2)));
typedef __bf16 bf16x2_t __attribute__((ext_vector_type(2)));
typedef float f32x2_t __attribute__((ext_vector_type(2)));

DI unsigned pk2(float lo, float hi) { f32x2_t v = {lo, hi}; bf16x2_t b = __builtin_convertvector(v, bf16x2_t); return __builtin_bit_cast(unsigned, b); }
DI float bf_lo(unsigned u) { return __uint_as_float(u << 16); }
DI float bf_hi(unsigned u) { return __uint_as_float(u & 0xffff0000u); }
DI float bf2f(bf16_t b) { return __uint_as_float(((unsigned)b) << 16); }
DI bf16_t f2bf(float f) { return (bf16_t)(pk2(f, 0.f) & 0xffffu); }
DI float wave_sum(float v) {
#pragma unroll
    for (int o = 1; o < 64; o <<= 1) v += __shfl_xor(v, o);
    return v;
}
DI float sigmoidf_(float x) { return __builtin_amdgcn_rcpf(1.0f + __builtin_amdgcn_exp2f(-1.4426950408889634f * x)); }
DI float siluf_(float x) { return x * __builtin_amdgcn_rcpf(1.0f + __builtin_amdgcn_exp2f(-1.4426950408889634f * x)); }

constexpr int D = 1024, NB = 8, SEQ = 2048, CTXL = 256, TL = NB * SEQ, TC = NB * CTXL, TA = TL + TC;
constexpr int NIN = 9248, ZS = 9472  , NKV = 2592;
constexpr int C_KNA = 0, C_VNA = 512, C_KGLA = 1024, C_VGLA = 1536, C_GATE = 2560, C_QNA = 2592, C_BSC = 3104, C_CSC = 3616, C_XSC = 4128, C_QGLA = 4640, C_RGLA = 5152, C_MERGE = 6176;
constexpr int OS = 2048;
constexpr int NE = 64, NEX = 65  , FF = 256, TOPK = 8;
constexpr float RMS_EPS = 1e-6f;

enum { I_X = 0, I_C, I_CTX, I_CCTX, I_WMOD, I_BMOD, I_G1, I_G2, I_WIN, I_RPB, I_WNA, I_CONVW, I_WSC, I_GGW, I_GGB, I_GNG, I_WGLA, I_WOUT, I_WR, I_BR, I_WEG, I_WEU, I_WED, I_WSG, I_WSU, I_WSD, I_GF, N_INPUTS };

constexpr size_t WS_CTL = 0;
constexpr size_t CTL_BYTES = 65536;
constexpr int CW_BAR = 0, CW_CNT = 8192;
constexpr size_t WS_MOD = WS_CTL + CTL_BYTES;
constexpr size_t MOD_BYTES = 2 * 9 * 6 * 1024 * 4;
constexpr size_t ZERO_BYTES = CTL_BYTES + 458752;
constexpr size_t WS_CTXS = WS_CTL + ZERO_BYTES;
constexpr size_t WS_TOKE = WS_CTXS + (size_t)TC * D * 4;
constexpr size_t WS_TOKP = WS_TOKE + (size_t)TA * 8 * 4;
constexpr size_t WS_TOKW = WS_TOKP + (size_t)TA * 8 * 4;
constexpr size_t WS_TOKR = WS_TOKW + (size_t)TA * 8 * 4;
constexpr size_t WS_ROWL = WS_TOKR + (size_t)TA * 8 * 4;
constexpr size_t ROWL_BYTES = ((size_t)TA * 9 + 256) * 4;
constexpr size_t WS_WRT = (WS_ROWL + ROWL_BYTES + 255) & ~(size_t)255;
constexpr size_t WRT_BYTES = (size_t)2 * 2 * NE * D * 2;
constexpr size_t WS_WBS = WS_WRT + WRT_BYTES;
constexpr size_t WB_WIN = 0, WB_WNA = WB_WIN + (size_t)ZS * D * 2, WB_WSC = WB_WNA + (size_t)D * 512 * 2, WB_WGLA = WB_WSC + (size_t)D * 512 * 2,
                 WB_WOUT = WB_WGLA + (size_t)D * D * 2, WB_WD = WB_WOUT + (size_t)D * D * 2, WBS_BYTES = WB_WD + (size_t)NEX * D * FF * 2;
constexpr size_t WS_R2 = WS_WBS + WBS_BYTES;
constexpr size_t HID_ROWS = (size_t)TA * 9 + 256;
constexpr size_t R2_BYTES = HID_ROWS * FF * 2;
constexpr size_t R2_OB = (size_t)TA * D * 2;
constexpr size_t WS_R1 = WS_R2 + R2_BYTES;
constexpr size_t R1_O = (size_t)TA * ZS * 2;
constexpr size_t R1_BYTES = R1_O + (size_t)TA * OS * 2;
constexpr size_t R1_H2 = R1_O;
constexpr size_t WS_WBS1 = WS_R1 + R1_BYTES;
constexpr size_t WS_DECB = WS_WBS1 + WB_WD;
constexpr size_t WS_W2TG = WS_DECB + (size_t)NB * 4 * 2 * 36 * 128 * 4;
constexpr size_t WS_END = WS_W2TG + (size_t)2 * 2 * 512 * 16 * 2;
static_assert(HID_ROWS * D * 2 <= R1_O + 0, "out_slot must fit below H2");
static_assert((size_t)NEX * 512 * D * 2 <= R1_O, "WguT fits");

constexpr int LDS_BYTES = 147456, MISC_OFF = 143360;
constexpr int GRID = 256;

#define XB_TMO      128
#define XB_XCNT(j)  (256  + 64 * (j))
#define XB_XSUB(j)  (1280 + 64 * (j))
#define XB_XGEN(j)  (2304 + 64 * (j))
#define XB_TOP      3328
#define XB_TOPGEN   3392
#define XCD_BAR_WORDS 3456
#define XB_SPIN_CAP (1u << 22)
DI unsigned xb_ld(unsigned* p)              { return __hip_atomic_load(p, __ATOMIC_RELAXED, __HIP_MEMORY_SCOPE_AGENT); }
DI unsigned xb_add(unsigned* p, unsigned v) { return __hip_atomic_fetch_add(p, v, __ATOMIC_RELAXED, __HIP_MEMORY_SCOPE_AGENT); }
DI unsigned xb_xcc_id() { return (unsigned)__builtin_amdgcn_s_getreg((3 << 11) | 20) & 0xFu; }
#define XB_SPIN(cond, bar) do { unsigned _sp = 0; while (cond) { __builtin_amdgcn_s_sleep(1); \
    if ((++_sp & 255u) == 0u) { if (xb_ld(&(bar)[XB_TMO])) break; if (_sp > XB_SPIN_CAP) { atomicAdd(&(bar)[XB_TMO], 1u); break; } } } } while (0)
struct XcdBarrier { unsigned* bar; unsigned x; volatile LAS unsigned* st; };
DI XcdBarrier xcd_barrier_post(unsigned* bar, volatile LAS unsigned* st) {
    XcdBarrier b; b.bar = bar; b.x = xb_xcc_id(); b.st = st;
    if (threadIdx.x == 0) (void)xb_add(&bar[XB_XCNT(b.x)], 1u);
    return b;
}
DI void xcd_barrier_complete(unsigned* bar, unsigned x, unsigned& nloc, unsigned& nx) {
    const unsigned G = gridDim.x * gridDim.y * gridDim.z;
    unsigned sum, cnt, mine, sp = 0u;
    for (;;) {
        sum = 0u; cnt = 0u; mine = 0u;
#pragma unroll
        for (unsigned j = 0; j < 16; ++j) { const unsigned c = xb_ld(&bar[XB_XCNT(j)]); sum += c; cnt += (c > 0u) ? 1u : 0u; mine = (j == x) ? c : mine; }
        if (sum == G) break;
        __builtin_amdgcn_s_sleep(1);
        if ((++sp & 255u) == 0u) { if (xb_ld(&bar[XB_TMO])) break; if (sp > XB_SPIN_CAP) { atomicAdd(&bar[XB_TMO], 1u); break; } }
    }
    nloc = mine > 0u ? mine : 1u; nx = cnt > 0u ? cnt : 1u;
}
DI void xcd_barrier(const XcdBarrier& b) {
    asm volatile("s_waitcnt vmcnt(0)" ::: "memory");
    __syncthreads();
    if (threadIdx.x == 0) {
        unsigned* bar = b.bar;
        __builtin_amdgcn_s_waitcnt(0);
        const unsigned bx = xb_xcc_id();
        unsigned nloc = b.st[0], nx = b.st[1];
        if (nloc == 0u) { xcd_barrier_complete(bar, bx, nloc, nx); b.st[0] = nloc; b.st[1] = nx; }
        const unsigned old = xb_add(&bar[XB_XSUB(bx)], 1u);
        const unsigned gen = old / nloc;
        if (old + 1u == (gen + 1u) * nloc) {
            __builtin_amdgcn_fence(__ATOMIC_RELEASE, "agent");
            asm volatile("s_waitcnt vmcnt(0)" ::: "memory");
            const unsigned og = xb_add(&bar[XB_TOP], 1u);
            const unsigned tg = og / nx;
            if (og + 1u == (tg + 1u) * nx) xb_add(&bar[XB_TOPGEN], 1u);
            else XB_SPIN(xb_ld(&bar[XB_TOPGEN]) == tg, bar);
            __builtin_amdgcn_fence(__ATOMIC_ACQUIRE, "agent");
            xb_add(&bar[XB_XGEN(bx)], 1u);
            asm volatile("s_waitcnt vmcnt(0)" ::: "memory");
        } else {
            XB_SPIN(xb_ld(&bar[XB_XGEN(bx)]) == gen, bar);
            __builtin_amdgcn_fence(__ATOMIC_ACQUIRE, "agent");
            asm volatile("s_waitcnt vmcnt(0)" ::: "memory");
        }
    }
    __syncthreads();
}

namespace pg8 {
constexpr int BM = 256, BK = 64, HALF = 128, HTB = HALF * BK * 2, STAGE_BYTES = 8 * HTB;
DI int lds_byte(int r, int c) { const int st = (r >> 4) * 2 + (c >> 5), rr = r & 15, cc = c & 31, ob = rr * 64 + cc * 2; return st * 1024 + (ob ^ (((ob >> 9) & 1) << 5)); }
DI void stage_rc(int b, int& R, int& C) { const int st = b / 1024, sb = b % 1024, swz = sb ^ (((sb >> 9) & 1) << 5); R = (st >> 1) * 16 + swz / 64; C = (st & 1) * 32 + (swz % 64) / 2; }
DI int perm32(int rho) { const int n = rho >> 4, i = rho & 15; return 8 * (i >> 2) + 4 * n + (i & 3); }

struct GUnit {
    const char* A;
    const char* B;
    const int* rows;
    int pm, pn;
    int valid;
    int aux;
};

template <bool GATHER, class Epi, class Sched>
DI void gemm_phase(LAS unsigned char* lds, const int tid_, const int K_, const int lda, const int ldb, const Sched& S, const Epi& E) {
    int K = K_; asm volatile("" : "+s"(K));
    int tid = tid_; asm volatile("" : "+v"(tid));
    const int wid = __builtin_amdgcn_readfirstlane(tid >> 6), lane = tid & 63, wr = wid >> 2, wc = wid & 3, fr = lane & 15, fq = lane >> 4;
    const int nt = K / BK;
    unsigned voffA, voffB, cc2, ro;
    { int R, C; stage_rc(tid * 16, R, C); ro = (unsigned)R * 4u; cc2 = (unsigned)C * 2u; const int Rb = Epi::PERM ? ((R & ~31) + perm32(R & 31)) : R;
      voffA = (unsigned)(R * lda + C) * 2u; voffB = (unsigned)(Rb * ldb + C) * 2u; }
    const size_t hstepA = (size_t)HALF * lda * 2, qstepA = (size_t)64 * lda * 2, qstepB = (size_t)64 * ldb * 2;
    const unsigned rowb = (unsigned)lda * 2u;
    const size_t kstep = (size_t)(BK * 2);
    const size_t hstepB = (size_t)HALF * ldb * 2;
    const unsigned ldsw = (unsigned)wid * 1024u;
    const int aoff = lds_byte(wr * 64 + fr, fq * 8), boff = lds_byte(wc * 32 + fr, fq * 8);
#define PG8_SA(b, h) (((b) * 2 + (h)) * HTB)
#define PG8_SB(b, h) ((4 + (b) * 2 + (h)) * HTB)
#define PG8_STAGE2(bufoff, gbase, o0, o1) do { \
        __builtin_amdgcn_global_load_lds((const unsigned*)((const char*)(gbase) + (o0)), (LAS unsigned*)(lds + (bufoff) + ldsw), 16, 0, 0); \
        __builtin_amdgcn_global_load_lds((const unsigned*)((const char*)(gbase) + (o1)), (LAS unsigned*)(lds + (bufoff) + ldsw + 8192), 16, 0, 0); } while (0)
#define PG8_STAGEB(bufoff, gbase) do { \
        __builtin_amdgcn_global_load_lds((const unsigned*)((const char*)(gbase) + voffB), (LAS unsigned*)(lds + (bufoff) + ldsw), 16, 0, 0); \
        __builtin_amdgcn_global_load_lds((const unsigned*)((const char*)(gbase) + qstepB + voffB), (LAS unsigned*)(lds + (bufoff) + ldsw + 8192), 16, 0, 0); } while (0)
#define PG8_LDA(dst, b, h) do { _Pragma("unroll") for (int m = 0; m < 4; ++m) _Pragma("unroll") for (int k = 0; k < 2; ++k) dst[m][k] = *(const LAS bf16x8*)(lds + PG8_SA(b, h) + aoff + m * 2048 + k * 1024); } while (0)
#define PG8_LDB(dst, b, h) do { _Pragma("unroll") for (int n = 0; n < 2; ++n) _Pragma("unroll") for (int k = 0; k < 2; ++k) dst[n][k] = *(const LAS bf16x8*)(lds + PG8_SB(b, h) + boff + n * 2048 + k * 1024); } while (0)
#define PG8_MMA(ai, bj, At, Bt) do { __builtin_amdgcn_s_setprio(1); _Pragma("unroll") for (int m = 0; m < 4; ++m) _Pragma("unroll") for (int n = 0; n < 2; ++n) _Pragma("unroll") for (int k = 0; k < 2; ++k) \
        acc[ai][bj][m][n] = __builtin_amdgcn_mfma_f32_16x16x32_bf16(Bt[n][k], At[m][k], acc[ai][bj][m][n], 0, 0, 0); __builtin_amdgcn_s_setprio(0); } while (0)
#define PG8_WAIT_V(n) asm volatile("s_waitcnt vmcnt(" #n ")" ::: "memory")
#define PG8_WAIT_L(n) asm volatile("s_waitcnt lgkmcnt(" #n ")" ::: "memory")
#define PG8_BAR __builtin_amdgcn_s_barrier()
#define PG8_SCHED __builtin_amdgcn_sched_barrier(0)
#define PG8_RIDX(u, p0, p1) do { if (GATHER) { const char* _rb = (const char*)(u).rows; \
        p0 = (unsigned)*(const int*)(_rb + ro) | ((unsigned)*(const int*)(_rb + ro + HALF * 4) << 16); p1 = (unsigned)*(const int*)(_rb + ro + 64 * 4) | ((unsigned)*(const int*)(_rb + ro + (64 + HALF) * 4) << 16); } } while (0)
#define PG8_STAGEA(bufoff, gbase, h, p0, p1) do { if (GATHER) { const unsigned _o0 = (((p0) >> (16 * (h))) & 0xffffu) * rowb + cc2, _o1 = (((p1) >> (16 * (h))) & 0xffffu) * rowb + cc2; PG8_STAGE2(bufoff, gbase, _o0, _o1); } \
        else { __builtin_amdgcn_global_load_lds((const unsigned*)((const char*)(gbase) + (h) * hstepA + voffA), (LAS unsigned*)(lds + (bufoff) + ldsw), 16, 0, 0); \
               __builtin_amdgcn_global_load_lds((const unsigned*)((const char*)(gbase) + (h) * hstepA + qstepA + voffA), (LAS unsigned*)(lds + (bufoff) + ldsw + 8192), 16, 0, 0); } } while (0)
    GUnit cur, nxt; int ui = 0;
    if (!S.next(0, cur)) return;
    f32x4 acc[2][2][4][2];
#pragma unroll
    for (int a = 0; a < 2; ++a)
#pragma unroll
        for (int b = 0; b < 2; ++b)
#pragma unroll
            for (int m = 0; m < 4; ++m)
#pragma unroll
                for (int n = 0; n < 2; ++n) acc[a][b][m][n] = (f32x4){0.f, 0.f, 0.f, 0.f};
    bf16x8 At[4][2], B0[2][2], B1[2][2];
    const char* cA = cur.A; const char* cB = cur.B;
    unsigned cp0 = 0u, cp1 = 0u; PG8_RIDX(cur, cp0, cp1);
#if PG8_SP2
    PG8_STAGEB(PG8_SB(0, 0), cB); PG8_STAGEB(PG8_SB(0, 1), cB + hstepB); PG8_STAGEA(PG8_SA(0, 0), cA, 0, cp0, cp1); PG8_STAGEA(PG8_SA(0, 1), cA, 1, cp0, cp1);
    if (wr == 1) PG8_BAR;
    PG8_WAIT_V(2); PG8_BAR;
    PG8_STAGEB(PG8_SB(1, 0), cB + kstep); PG8_STAGEA(PG8_SA(1, 0), cA + kstep, 0, cp0, cp1); PG8_STAGEB(PG8_SB(1, 1), cB + hstepB + kstep);
    PG8_WAIT_V(6); PG8_BAR;
#else
    PG8_STAGEB(PG8_SB(0, 0), cB); PG8_STAGEA(PG8_SA(0, 0), cA, 0, cp0, cp1); PG8_STAGEB(PG8_SB(0, 1), cB + hstepB); PG8_STAGEA(PG8_SA(0, 1), cA, 1, cp0, cp1);
    if (wr == 1) PG8_BAR;
    PG8_WAIT_V(4); PG8_BAR;
    PG8_STAGEB(PG8_SB(1, 0), cB + kstep); PG8_STAGEA(PG8_SA(1, 0), cA + kstep, 0, cp0, cp1); PG8_STAGEB(PG8_SB(1, 1), cB + hstepB + kstep);
    PG8_WAIT_V(6); PG8_BAR;
#endif
    for (;;) {
        const bool has_next = S.next(ui + 1, nxt);
        const char* nA = has_next ? nxt.A : cA; const char* nB = has_next ? nxt.B : cB;
        unsigned np0 = cp0, np1 = cp1;
        if (has_next) PG8_RIDX(nxt, np0, np1);
        for (int t = 0; t < nt; t += 2) {
            const bool last = (t == nt - 2);
            const char* a1 = cA + (size_t)(t + 1) * kstep;
            const char* a2 = last ? nA : cA + (size_t)(t + 2) * kstep; const char* b2 = last ? nB : cB + (size_t)(t + 2) * kstep;
            const char* a3 = a2 + kstep; const char* b3 = b2 + kstep;
            unsigned xp0 = cp0, xp1 = cp1;
            if (GATHER && last) { asm volatile("" : "+v"(np0), "+v"(np1)); xp0 = np0; xp1 = np1; }
#if PG8_SP2
            PG8_LDB(B0, 0, 0); PG8_LDB(B1, 0, 1); PG8_SCHED; PG8_LDA(At, 0, 0); PG8_STAGEA(PG8_SA(1, 1), a1, 1, cp0, cp1);
            PG8_WAIT_V(8); PG8_WAIT_L(0); PG8_BAR; PG8_MMA(0, 0, At, B0); PG8_MMA(0, 1, At, B1); PG8_BAR; PG8_SCHED;
            PG8_LDA(At, 0, 1); PG8_STAGEB(PG8_SB(0, 0), b2); PG8_STAGEB(PG8_SB(0, 1), b2 + hstepB); PG8_STAGEA(PG8_SA(0, 0), a2, 0, xp0, xp1);
            PG8_WAIT_V(8); PG8_WAIT_L(0); PG8_BAR; PG8_MMA(1, 0, At, B0); PG8_MMA(1, 1, At, B1); PG8_BAR; PG8_SCHED;
            PG8_LDB(B0, 1, 0); PG8_LDB(B1, 1, 1); PG8_SCHED; PG8_LDA(At, 1, 0); PG8_STAGEA(PG8_SA(0, 1), a2, 1, xp0, xp1);
            PG8_WAIT_V(8); PG8_WAIT_L(0); PG8_BAR; PG8_MMA(0, 0, At, B0); PG8_MMA(0, 1, At, B1); PG8_BAR; PG8_SCHED;
            PG8_LDA(At, 1, 1); PG8_STAGEB(PG8_SB(1, 0), b3); PG8_STAGEB(PG8_SB(1, 1), b3 + hstepB); PG8_STAGEA(PG8_SA(1, 0), a3, 0, xp0, xp1);
            PG8_WAIT_V(8); PG8_WAIT_L(0); PG8_BAR; PG8_MMA(1, 0, At, B0); PG8_MMA(1, 1, At, B1); PG8_BAR; PG8_SCHED;
#else
            PG8_LDB(B0, 0, 0); PG8_SCHED; PG8_LDA(At, 0, 0); PG8_STAGEA(PG8_SA(1, 1), a1, 1, cp0, cp1);
            PG8_WAIT_L(8); PG8_BAR; PG8_WAIT_L(0); PG8_MMA(0, 0, At, B0); PG8_BAR; PG8_SCHED;
            PG8_LDB(B1, 0, 1); PG8_STAGEB(PG8_SB(0, 0), b2);
            PG8_BAR; PG8_WAIT_L(0); PG8_MMA(0, 1, At, B1); PG8_BAR;
            PG8_LDA(At, 0, 1); PG8_STAGEA(PG8_SA(0, 0), a2, 0, xp0, xp1);
            PG8_BAR; PG8_WAIT_L(0); PG8_MMA(1, 0, At, B0); PG8_BAR; PG8_SCHED;
            PG8_STAGEB(PG8_SB(0, 1), b2 + hstepB);
            PG8_WAIT_V(6); PG8_BAR; PG8_MMA(1, 1, At, B1); PG8_BAR;
            PG8_LDB(B0, 1, 0); PG8_SCHED; PG8_LDA(At, 1, 0); PG8_STAGEA(PG8_SA(0, 1), a2, 1, xp0, xp1);
            PG8_WAIT_L(8); PG8_BAR; PG8_WAIT_L(0); PG8_MMA(0, 0, At, B0); PG8_BAR; PG8_SCHED;
            PG8_LDB(B1, 1, 1); PG8_STAGEB(PG8_SB(1, 0), b3);
            PG8_BAR; PG8_WAIT_L(0); PG8_MMA(0, 1, At, B1); PG8_BAR;
            PG8_LDA(At, 1, 1); PG8_STAGEA(PG8_SA(1, 0), a3, 0, xp0, xp1);
            PG8_BAR; PG8_WAIT_L(0); PG8_MMA(1, 0, At, B0); PG8_BAR; PG8_SCHED;
            PG8_STAGEB(PG8_SB(1, 1), b3 + hstepB);
            PG8_WAIT_V(6); PG8_BAR; PG8_MMA(1, 1, At, B1); PG8_BAR;
        #endif
        }
#if PG8_ALIGN
        if (wr == 0) PG8_BAR;
#endif
        E(acc, cur, wr, wc, fr, fq);
        if (!has_next) break;
#pragma unroll
        for (int a = 0; a < 2; ++a)
#pragma unroll
            for (int b = 0; b < 2; ++b)
#pragma unroll
                for (int m = 0; m < 4; ++m)
#pragma unroll
                    for (int n = 0; n < 2; ++n) acc[a][b][m][n] = (f32x4){0.f, 0.f, 0.f, 0.f};
        cur = nxt; cA = nA; cB = nB; cp0 = np0; cp1 = np1; ++ui;
#if PG8_ALIGN
        if (wr == 1) PG8_BAR;
#endif
    }
    PG8_WAIT_V(0);
#if !PG8_ALIGN
    if (wr == 0) PG8_BAR;
#endif
    PG8_BAR;
#undef PG8_SA
#undef PG8_SB
#undef PG8_STAGE2
#undef PG8_STAGEB
#undef PG8_LDA
#undef PG8_LDB
#undef PG8_MMA
#undef PG8_WAIT_V
#undef PG8_WAIT_L
#undef PG8_BAR
#undef PG8_SCHED
#undef PG8_RIDX
#undef PG8_STAGEA
}

struct EpiStoreBf16 {
    static constexpr bool PERM = true;
    bf16_t* O; int ldc;
    DI void operator()(const f32x4 (&acc)[2][2][4][2], const GUnit& u, int wr, int wc, int fr, int fq) const {
        const int row0 = u.pm * BM + wr * 64 + fr, col0 = u.pn * BM + wc * 32 + 8 * fq;
#pragma unroll
        for (int ai = 0; ai < 2; ++ai)
#pragma unroll
            for (int m = 0; m < 4; ++m) { bf16_t* rowp = O + (size_t)(row0 + ai * HALF + m * 16) * ldc + col0;
#pragma unroll
                for (int bj = 0; bj < 2; ++bj) { const f32x4 v0 = acc[ai][bj][m][0], v1 = acc[ai][bj][m][1];
                    u32x4 w; w.x = pk2(v0[0], v0[1]); w.y = pk2(v0[2], v0[3]); w.z = pk2(v1[0], v1[1]); w.w = pk2(v1[2], v1[3]);
                    *(u32x4*)(rowp + bj * HALF) = w; } }
    }
};
template <int MODE> struct EpiGate {
    static constexpr bool PERM = true;
    bf16_t* Y; const bf16_t* Zg; int gcol0;
    DI void operator()(const f32x4 (&acc)[2][2][4][2], const GUnit& u, int wr, int wc, int fr, int fq) const {
        const int row0 = u.pm * BM + wr * 64 + fr, col0 = u.pn * BM + wc * 32 + 8 * fq;
#pragma unroll
        for (int ai = 0; ai < 2; ++ai) {
            u32x4 g[4][2], o[4][2];
#pragma unroll
            for (int m = 0; m < 4; ++m) { const size_t row = (size_t)(row0 + ai * HALF + m * 16);
#pragma unroll
                for (int bj = 0; bj < 2; ++bj) { g[m][bj] = *(const u32x4*)(Zg + row * ZS + gcol0 + col0 + bj * HALF); if (MODE == 1) o[m][bj] = *(const u32x4*)(Y + row * D + col0 + bj * HALF); } }
#pragma unroll
            for (int m = 0; m < 4; ++m) { const size_t row = (size_t)(row0 + ai * HALF + m * 16); bf16_t* rowp = Y + row * D + col0;
#pragma unroll
                for (int bj = 0; bj < 2; ++bj) { const f32x4 v0 = acc[ai][bj][m][0], v1 = acc[ai][bj][m][1]; const u32x4 gg = g[m][bj];
                    float r[8];
                    r[0] = v0[0] * sigmoidf_(bf_lo(gg.x)); r[1] = v0[1] * sigmoidf_(bf_hi(gg.x)); r[2] = v0[2] * sigmoidf_(bf_lo(gg.y)); r[3] = v0[3] * sigmoidf_(bf_hi(gg.y));
                    r[4] = v1[0] * sigmoidf_(bf_lo(gg.z)); r[5] = v1[1] * sigmoidf_(bf_hi(gg.z)); r[6] = v1[2] * sigmoidf_(bf_lo(gg.w)); r[7] = v1[3] * sigmoidf_(bf_hi(gg.w));
                    if (MODE == 1) { const u32x4 oo = o[m][bj];
                        r[0] += bf_lo(oo.x); r[1] += bf_hi(oo.x); r[2] += bf_lo(oo.y); r[3] += bf_hi(oo.y); r[4] += bf_lo(oo.z); r[5] += bf_hi(oo.z); r[6] += bf_lo(oo.w); r[7] += bf_hi(oo.w); }
                    u32x4 w; w.x = pk2(r[0], r[1]); w.y = pk2(r[2], r[3]); w.z = pk2(r[4], r[5]); w.w = pk2(r[6], r[7]);
                    *(u32x4*)(rowp + bj * HALF) = w; } }
        }
    }
};
struct EpiResid {
    static constexpr bool PERM = false;
    const float* xsrc; float* xdst; const float* csrc; float* cdst; const float* gate;
    DI void operator()(const f32x4 (&acc)[2][2][4][2], const GUnit& u, int wr, int wc, int fr, int fq) const {
        const int row0 = u.pm * BM + wr * 64 + fr, col0 = u.pn * BM + wc * 32 + 4 * fq;
        const bool isctx = (u.pm * BM) >= TL;
        const int mrow = isctx ? 8 : (u.pm * BM) / SEQ;
        const float* gp = gate + (size_t)mrow * 6144 + col0;
        f32x4 gv[2][2];
#pragma unroll
        for (int bj = 0; bj < 2; ++bj)
#pragma unroll
            for (int n = 0; n < 2; ++n) gv[bj][n] = *(const f32x4*)(gp + bj * HALF + n * 16);
        const float* sb = isctx ? csrc - (size_t)TL * D : xsrc; float* db = isctx ? cdst - (size_t)TL * D : xdst;
#pragma unroll
        for (int ai = 0; ai < 2; ++ai) {
            f32x4 s[4][2][2];
#pragma unroll
            for (int m = 0; m < 4; ++m) { const size_t off = (size_t)(row0 + ai * HALF + m * 16) * D + col0;
#pragma unroll
                for (int bj = 0; bj < 2; ++bj)
#pragma unroll
                    for (int n = 0; n < 2; ++n) s[m][bj][n] = *(const f32x4*)(sb + off + bj * HALF + n * 16); }
#pragma unroll
            for (int m = 0; m < 4; ++m) { const size_t off = (size_t)(row0 + ai * HALF + m * 16) * D + col0;
#pragma unroll
                for (int bj = 0; bj < 2; ++bj)
#pragma unroll
                    for (int n = 0; n < 2; ++n) *(f32x4*)(db + off + bj * HALF + n * 16) = s[m][bj][n] + gv[bj][n] * acc[ai][bj][m][n]; }
        }
    }
};
struct EpiSwiGLU {
    static constexpr bool PERM = true;
    bf16_t* Hd;
    DI void operator()(const f32x4 (&acc)[2][2][4][2], const GUnit& u, int wr, int wc, int fr, int fq) const {
        const int r0 = wr * 64 + fr, col0 = u.pn * HALF + wc * 32 + 8 * fq;
#pragma unroll
        for (int ai = 0; ai < 2; ++ai)
#pragma unroll
            for (int m = 0; m < 4; ++m) { const int r = r0 + ai * HALF + m * 16;
                const f32x4 g0 = acc[ai][0][m][0], g1 = acc[ai][0][m][1], u0 = acc[ai][1][m][0], u1 = acc[ai][1][m][1];
                u32x4 w; w.x = pk2(siluf_(g0[0]) * u0[0], siluf_(g0[1]) * u0[1]); w.y = pk2(siluf_(g0[2]) * u0[2], siluf_(g0[3]) * u0[3]);
                w.z = pk2(siluf_(g1[0]) * u1[0], siluf_(g1[1]) * u1[1]); w.w = pk2(siluf_(g1[2]) * u1[2], siluf_(g1[3]) * u1[3]);
                if (r < u.valid) *(u32x4*)(Hd + (size_t)(u.aux + r) * FF + col0) = w; }
    }
};
struct EpiDown {
    static constexpr bool PERM = true;
    bf16_t* Os;
    DI void operator()(const f32x4 (&acc)[2][2][4][2], const GUnit& u, int wr, int wc, int fr, int fq) const {
        const int r0 = wr * 64 + fr, col0 = u.pn * BM + wc * 32 + 8 * fq;
#pragma unroll
        for (int ai = 0; ai < 2; ++ai)
#pragma unroll
            for (int m = 0; m < 4; ++m) { const int r = r0 + ai * HALF + m * 16; bf16_t* rowp = Os + (size_t)(u.aux + r) * D + col0;
#pragma unroll
                for (int bj = 0; bj < 2; ++bj) { const f32x4 v0 = acc[ai][bj][m][0], v1 = acc[ai][bj][m][1];
                    u32x4 w; w.x = pk2(v0[0], v0[1]); w.y = pk2(v0[2], v0[3]); w.z = pk2(v1[0], v1[1]); w.w = pk2(v1[2], v1[3]);
                    if (r < u.valid) *(u32x4*)(rowp + bj * HALF) = w; } }
    }
};

template <int nN> struct RectSched {
    const char* A; const char* B; int lda, ldb; int nM, exM, exN, exPm0, G, c;
    DI bool next(int i, GUnit& u) const {
        const int L = i * G + c; const int nmain = nM * nN;
        int pm, pn;
        if (L < nmain) { const int W = (L & 7) * (nmain >> 3) + (L >> 3);
            const int grp = W / (8 * nN), rem = W % (8 * nN); pm = grp * 8 + (rem & 7); pn = rem >> 3; }
        else { const int L2 = L - nmain; if (L2 >= exM * exN) return false; pm = exPm0 + (L2 & 7); pn = L2 >> 3; }
        u.A = A + (size_t)pm * BM * lda * 2; u.B = B + (size_t)pn * BM * ldb * 2; u.rows = nullptr; u.pm = pm; u.pn = pn; u.valid = BM; u.aux = 0; return true;
    }
};
template <bool GATHER, int npn> struct MoeSched {
    const LAS int* tb; const LAS int* rb; const LAS int* cn;
    const char* A; const int* rowl; const char* B; size_t bstride; int lda, ldb, G, c;
    DI bool next(int i, GUnit& u) const {
        const int L0 = i * G + c; const int ntile = __builtin_amdgcn_readfirstlane(tb[NEX]); const int nwg = ntile * npn;
        if (L0 >= nwg) return false;
        const int q = nwg >> 3, rr = nwg & 7, xcd = L0 & 7, off = L0 >> 3;
        const int L = (xcd < rr ? xcd * (q + 1) : rr * (q + 1) + (xcd - rr) * q) + off;
        const int T = L / npn, pn = L % npn;
        const int e = __builtin_amdgcn_readfirstlane((int)((const LAS unsigned char*)(tb + 216))[T]);
        const int ti = T - __builtin_amdgcn_readfirstlane(tb[e]), row0 = __builtin_amdgcn_readfirstlane(rb[e]) + ti * BM;
        u.B = B + (size_t)e * bstride + (size_t)pn * BM * ldb * 2;
        if (GATHER) { u.A = A; u.rows = rowl + row0; } else { u.A = A + (size_t)row0 * lda * 2; u.rows = nullptr; }
        u.pm = T; u.pn = pn; const int rem = __builtin_amdgcn_readfirstlane(cn[e]) - ti * BM; u.valid = rem < BM ? rem : BM; u.aux = row0; return true;
    }
};
}

struct Args { const float* in[N_INPUTS]; float* out; unsigned char* ws; int ph_lo, ph_hi; };
struct Frame {
    LAS unsigned char* lds; unsigned char* ws; const float* const* in; float* out;
    int tid, lane, wave, G, bid;
};
DI const float* modp(const Frame& F, int l, int r, int which) { return (const float*)(F.ws + WS_MOD) + ((size_t)(l * 9 + r) * 6 + which) * 1024; }

DI void tr_item(const float* W, int ldw, bf16_t* WT, int ldt, int k0, int n0, int drow0, LAS float* scr, int lane) {
    float tmp[32];
#pragma unroll
    for (int i = 0; i < 32; ++i) { const int kk = 2 * i + (lane >> 5); tmp[i] = W[(size_t)(k0 + kk) * ldw + n0 + (lane & 31)]; }
#pragma unroll
    for (int i = 0; i < 32; ++i) { const int kk = 2 * i + (lane >> 5); scr[kk * 33 + (lane & 31)] = tmp[i]; }
    asm volatile("s_waitcnt lgkmcnt(0)" ::: "memory");
    const int c = lane & 7;
#pragma unroll
    for (int j = 0; j < 4; ++j) { const int n = (lane >> 3) + 8 * j; const LAS float* s = scr + (8 * c) * 33 + n;
        u32x4 o; o.x = pk2(s[0 * 33], s[1 * 33]); o.y = pk2(s[2 * 33], s[3 * 33]); o.z = pk2(s[4 * 33], s[5 * 33]); o.w = pk2(s[6 * 33], s[7 * 33]);
        *(u32x4*)(WT + (size_t)(drow0 + n) * ldt + k0 + 8 * c) = o; }
    asm volatile("s_waitcnt lgkmcnt(0)" ::: "memory");
}
template <int K, int N> DI void conv_plain(const Frame& F, const float* W, bf16_t* WT, int rot, int blk0 = 0) {
    LAS float* scr = (LAS float*)(F.lds + F.wave * 16384);
    const int NGW = (F.G - blk0) * 8, gw = ((F.bid - blk0) * 8 + F.wave + rot) % NGW;
    constexpr int nblk = N / 32, nit = (K / 64) * nblk;
    for (int it = gw; it < nit; it += NGW) { const int kb = it / nblk, nb = it % nblk; tr_item(W, N, WT, K, kb * 64, nb * 32, nb * 32, scr, F.lane); }
}
DI void conv_gu(const Frame& F, int l, bf16_t* WT) {
    LAS float* scr = (LAS float*)(F.lds + F.wave * 16384);
    const int NGW = F.G * 8, gw = F.bid * 8 + F.wave;
    const int nit = NEX * 2 * 128;
    for (int it = gw; it < nit; it += NGW) {
        const int e = it / 256, r = it % 256, isup = r / 128, r2 = r % 128, kb = r2 / 8, nb = r2 % 8, n0 = nb * 32;
        const float* W = (e < NE) ? F.in[isup ? I_WEU : I_WEG] + ((size_t)l * NE + e) * D * FF : F.in[isup ? I_WSU : I_WSG] + (size_t)l * D * FF;
        const int drow0 = ((n0 >> 7) << 8) + (n0 & 127) + (isup ? 128 : 0);
        tr_item(W, FF, WT + (size_t)e * 512 * D, D, kb * 64, n0, drow0, scr, F.lane);
    }
}
DI void conv_down(const Frame& F, int l, bf16_t* WT) {
    LAS float* scr = (LAS float*)(F.lds + F.wave * 16384);
    const int NGW = F.G * 8, gw = F.bid * 8 + F.wave;
    const int nit = NEX * 128;
    for (int it = gw; it < nit; it += NGW) {
        const int e = it / 128, r = it % 128, kb = r / 32, nb = r % 32;
        const float* W = (e < NE) ? F.in[I_WED] + ((size_t)l * NE + e) * FF * D : F.in[I_WSD] + (size_t)l * FF * D;
        tr_item(W, D, WT + (size_t)e * D * FF, FF, kb * 64, nb * 32, nb * 32, scr, F.lane);
    }
}
DI size_t wbs_base(int l) { return l == 0 ? WS_WBS : WS_WBS1; }
DI void conv_small(const Frame& F, int l, int blk0 = 0) {
    if (F.bid < blk0) return;
    bf16_t* wb = (bf16_t*)(F.ws + wbs_base(l));
    conv_plain<D, NIN>(F, F.in[I_WIN] + (size_t)l * D * NIN, (bf16_t*)((char*)wb + WB_WIN), 0, blk0);
    conv_plain<512, D>(F, F.in[I_WNA] + (size_t)l * 512 * D, (bf16_t*)((char*)wb + WB_WNA), 600, blk0);
    conv_plain<512, D>(F, F.in[I_WSC] + (size_t)l * 512 * D, (bf16_t*)((char*)wb + WB_WSC), 900, blk0);
    conv_plain<D, D>(F, F.in[I_WGLA] + (size_t)l * D * D, (bf16_t*)((char*)wb + WB_WGLA), 1200, blk0);
    conv_plain<D, D>(F, F.in[I_WOUT] + (size_t)l * D * D, (bf16_t*)((char*)wb + WB_WOUT), 1700, blk0);
    u32x4* z = (u32x4*)((char*)wb + WB_WIN + (size_t)NIN * D * 2);
    const int nz = (ZS - NIN) * D * 2 / 16;
    unsigned zz = 0u; asm volatile("" : "+v"(zz));
    for (int i = (F.bid - blk0) * 512 + F.tid; i < nz; i += (F.G - blk0) * 512) z[i] = (u32x4){zz, zz, zz, zz};
}
DI void conv_gate_w(const Frame& F) {
    bf16_t* wt = (bf16_t*)(F.ws + WS_W2TG);
    for (int i = F.bid * 512 + F.tid; i < 2 * 2 * 512 * 16; i += F.G * 512) { const int ld = i >> 13, rr = i & 8191, d = rr >> 4, ii = rr & 15; wt[i] = f2bf(F.in[I_GGW][((size_t)ld * 16 + ii) * 512 + d]); }
}
DI void conv_router(const Frame& F) {
    bf16_t* wrt = (bf16_t*)(F.ws + WS_WRT);
    for (int i = F.bid * 512 + F.tid; i < 2 * NE * D; i += F.G * 512) {
        const int l = i / (NE * D), r = i % (NE * D), e = r / D, k = r % D;
        const float w = F.in[I_WR][(size_t)l * D * NE + (size_t)k * NE + e];
        const bf16_t hi = f2bf(w); const bf16_t lo = f2bf(w - bf2f(hi));
        wrt[((size_t)(l * 2 + 0) * NE + e) * D + k] = hi; wrt[((size_t)(l * 2 + 1) * NE + e) * D + k] = lo;
    }
}
DI void mod_vectors(const Frame& F) {
    float* mod = (float*)(F.ws + WS_MOD);
    LAS float* SL = (LAS float*)F.lds;
    LAS float* PART = SL + 9 * 1024;
    __syncthreads();
    for (int i = F.tid; i < 9 * 1024; i += 512) { const float c = (i < 8 * 1024) ? F.in[I_C][i] : F.in[I_CCTX][i - 8 * 1024]; SL[i] = siluf_(c); }
    __syncthreads();
    for (int it = F.bid; it < 2 * 96; it += F.G) {
        const int l = it / 96, cb = it % 96, j = cb * 64 + F.lane;
        const float* W = F.in[I_WMOD] + (size_t)l * D * 6144 + j;
        float acc[9];
#pragma unroll
        for (int q = 0; q < 9; ++q) acc[q] = 0.f;
#pragma unroll 8
        for (int k = F.wave * 128; k < F.wave * 128 + 128; ++k) {
            const float w = W[(size_t)k * 6144];
#pragma unroll
            for (int q = 0; q < 9; ++q) acc[q] += SL[q * 1024 + k] * w;
        }
#pragma unroll
        for (int q = 0; q < 9; ++q) PART[(F.wave * 9 + q) * 64 + F.lane] = acc[q];
        __syncthreads();
        for (int q = F.wave; q < 9; q += 8) {
            float s = F.in[I_BMOD][l * 6144 + j];
#pragma unroll
            for (int w = 0; w < 8; ++w) s += PART[(w * 9 + q) * 64 + F.lane];
            mod[((size_t)(l * 9 + q)) * 6144 + j] = s;
        }
        __syncthreads();
    }
}

DI void load_row_f32(const float* p, int lane, float (&v)[16]) {
#pragma unroll
    for (int i = 0; i < 2; ++i) { const f32x4 a = *(const f32x4*)(p + 8 * lane + 512 * i), b = *(const f32x4*)(p + 8 * lane + 512 * i + 4);
        v[8 * i + 0] = a[0]; v[8 * i + 1] = a[1]; v[8 * i + 2] = a[2]; v[8 * i + 3] = a[3]; v[8 * i + 4] = b[0]; v[8 * i + 5] = b[1]; v[8 * i + 6] = b[2]; v[8 * i + 7] = b[3]; }
}
DI void store_row_f32(float* p, int lane, const float (&v)[16]) {
#pragma unroll
    for (int i = 0; i < 2; ++i) { *(f32x4*)(p + 8 * lane + 512 * i) = (f32x4){v[8 * i], v[8 * i + 1], v[8 * i + 2], v[8 * i + 3]}; *(f32x4*)(p + 8 * lane + 512 * i + 4) = (f32x4){v[8 * i + 4], v[8 * i + 5], v[8 * i + 6], v[8 * i + 7]}; }
}
DI void load_row_bf16(const bf16_t* p, int lane, float (&v)[16]) {
#pragma unroll
    for (int i = 0; i < 2; ++i) { const u32x4 a = *(const u32x4*)(p + 8 * lane + 512 * i);
        v[8 * i + 0] = bf_lo(a.x); v[8 * i + 1] = bf_hi(a.x); v[8 * i + 2] = bf_lo(a.y); v[8 * i + 3] = bf_hi(a.y); v[8 * i + 4] = bf_lo(a.z); v[8 * i + 5] = bf_hi(a.z); v[8 * i + 6] = bf_lo(a.w); v[8 * i + 7] = bf_hi(a.w); }
}
DI void store_row_bf16(bf16_t* p, int lane, const float (&v)[16]) {
#pragma unroll
    for (int i = 0; i < 2; ++i) { u32x4 w; w.x = pk2(v[8 * i], v[8 * i + 1]); w.y = pk2(v[8 * i + 2], v[8 * i + 3]); w.z = pk2(v[8 * i + 4], v[8 * i + 5]); w.w = pk2(v[8 * i + 6], v[8 * i + 7]);
        *(u32x4*)(p + 8 * lane + 512 * i) = w; }
}
DI void norm_mod(const float (&x)[16], const float* g, const float* shift, const float* scale, int lane, float (&h)[16]) {
    float ss = 0.f;
#pragma unroll
    for (int i = 0; i < 16; ++i) ss += x[i] * x[i];
    const float rstd = rsqrtf(wave_sum(ss) * (1.0f / D) + RMS_EPS);
    float gg[16], sh[16], sc[16]; load_row_f32(g, lane, gg); load_row_f32(shift, lane, sh); load_row_f32(scale, lane, sc);
#pragma unroll
    for (int i = 0; i < 16; ++i) h[i] = x[i] * rstd * gg[i] * (1.0f + sc[i]) + sh[i];
}

DI void phase_norm1_first(const Frame& F) {
    const int NGW = F.G * 8, gw = F.bid * 8 + F.wave;
    bf16_t* H = (bf16_t*)(F.ws + WS_R2);
    for (int t = gw; t < TA; t += NGW) {
        const bool isctx = t >= TL; const int r = isctx ? 8 : t / SEQ;
        const float* xr = isctx ? F.in[I_CTX] + (size_t)(t - TL) * D : F.in[I_X] + (size_t)t * D;
        float x[16], h[16]; load_row_f32(xr, F.lane, x);
        norm_mod(x, F.in[I_G1], modp(F, 0, r, 0), modp(F, 0, r, 1), F.lane, h);
        store_row_bf16(H + (size_t)t * D, F.lane, h);
    }
}

DI void phase_conv(const Frame& F, int l, int M) {
    const bf16_t* Z = (const bf16_t*)(F.ws + WS_R1); bf16_t* O = (bf16_t*)(F.ws + WS_R1 + R1_O);
    const float* cw = F.in[I_CONVW] + (size_t)l * 3 * 512;
    for (int it = F.bid * 512 + F.tid; it < M * 64; it += F.G * 512) {
        const int t = it >> 6, c0 = (it & 63) * 8;
        const int L = (t >= TL) ? CTXL : SEQ, pos = (t >= TL) ? (t - TL) % CTXL : t % SEQ;
        const bf16_t* zr = Z + (size_t)t * ZS;
        float u0[8], u1[8], u2[8], bb[8];
        { const u32x4 c = *(const u32x4*)(zr + C_CSC + c0), x = *(const u32x4*)(zr + C_XSC + c0), b = *(const u32x4*)(zr + C_BSC + c0);
          u1[0] = bf_lo(c.x) * bf_lo(x.x); u1[1] = bf_hi(c.x) * bf_hi(x.x); u1[2] = bf_lo(c.y) * bf_lo(x.y); u1[3] = bf_hi(c.y) * bf_hi(x.y);
          u1[4] = bf_lo(c.z) * bf_lo(x.z); u1[5] = bf_hi(c.z) * bf_hi(x.z); u1[6] = bf_lo(c.w) * bf_lo(x.w); u1[7] = bf_hi(c.w) * bf_hi(x.w);
          bb[0] = bf_lo(b.x); bb[1] = bf_hi(b.x); bb[2] = bf_lo(b.y); bb[3] = bf_hi(b.y); bb[4] = bf_lo(b.z); bb[5] = bf_hi(b.z); bb[6] = bf_lo(b.w); bb[7] = bf_hi(b.w); }
        if (pos > 0) { const u32x4 c = *(const u32x4*)(zr - ZS + C_CSC + c0), x = *(const u32x4*)(zr - ZS + C_XSC + c0);
          u0[0] = bf_lo(c.x) * bf_lo(x.x); u0[1] = bf_hi(c.x) * bf_hi(x.x); u0[2] = bf_lo(c.y) * bf_lo(x.y); u0[3] = bf_hi(c.y) * bf_hi(x.y);
          u0[4] = bf_lo(c.z) * bf_lo(x.z); u0[5] = bf_hi(c.z) * bf_hi(x.z); u0[6] = bf_lo(c.w) * bf_lo(x.w); u0[7] = bf_hi(c.w) * bf_hi(x.w); }
        else {
#pragma unroll
            for (int j = 0; j < 8; ++j) u0[j] = 0.f; }
        if (pos < L - 1) { const u32x4 c = *(const u32x4*)(zr + ZS + C_CSC + c0), x = *(const u32x4*)(zr + ZS + C_XSC + c0);
          u2[0] = bf_lo(c.x) * bf_lo(x.x); u2[1] = bf_hi(c.x) * bf_hi(x.x); u2[2] = bf_lo(c.y) * bf_lo(x.y); u2[3] = bf_hi(c.y) * bf_hi(x.y);
          u2[4] = bf_lo(c.z) * bf_lo(x.z); u2[5] = bf_hi(c.z) * bf_hi(x.z); u2[6] = bf_lo(c.w) * bf_lo(x.w); u2[7] = bf_hi(c.w) * bf_hi(x.w); }
        else {
#pragma unroll
            for (int j = 0; j < 8; ++j) u2[j] = 0.f; }
        float o[8];
#pragma unroll
        for (int j = 0; j < 8; ++j) o[j] = bb[j] * (u0[j] * cw[c0 + j] + u1[j] * cw[512 + c0 + j] + u2[j] * cw[1024 + c0 + j]);
        u32x4 w; w.x = pk2(o[0], o[1]); w.y = pk2(o[2], o[3]); w.z = pk2(o[4], o[5]); w.w = pk2(o[6], o[7]);
        *(u32x4*)(O + (size_t)t * OS + 512 + c0) = w;
    }
}

#define MFMA32(a, b, c) __builtin_amdgcn_mfma_f32_32x32x16_bf16((a), (b), (c), 0, 0, 0)
DI int crow(int reg, int h) { return (reg & 3) + 8 * (reg >> 2) + 4 * h; }
DI bf16x8 pack_step(const f32x16& x, int s) {
    u32x4 p; p.x = pk2(x[8 * s], x[8 * s + 1]); p.y = pk2(x[8 * s + 2], x[8 * s + 3]); p.z = pk2(x[8 * s + 4], x[8 * s + 5]); p.w = pk2(x[8 * s + 6], x[8 * s + 7]);
    return __builtin_bit_cast(bf16x8, p);
}
DI bf16x8 cat4(u32x2 a, u32x2 b) { u32x4 p; p.x = a.x; p.y = a.y; p.z = b.x; p.w = b.y; return __builtin_bit_cast(bf16x8, p); }

typedef __attribute__((address_space(3))) s16x4 lds_s16x4;
DI bf16x8 tr8(const LAS bf16_t* p0, const LAS bf16_t* p1) {
    const s16x4 a = __builtin_amdgcn_ds_read_tr16_b64_v4i16((lds_s16x4*)p0), b = __builtin_amdgcn_ds_read_tr16_b64_v4i16((lds_s16x4*)p1);
    return (bf16x8){a[0], a[1], a[2], a[3], b[0], b[1], b[2], b[3]};
}
constexpr int NA_VS = 72;
constexpr int NA_TAB = 8 * NA_VS * 64 * 2;
constexpr float NA_L2E = 1.4426950408889634f;
constexpr int NA_KOFF = 0, NA_VOFF = 2 * 64 * NA_VS * 2;
constexpr int NA_TAB2 = 4 * 64 * NA_VS * 2;
DI void na_block_unit(const Frame& F, const bf16_t* Z, bf16_t* O, const LAS float* tab, int head, bool isctxu, int b, int rg) {
    const int tid = F.tid, lane = F.lane, wave = F.wave, r = lane & 31, h = lane >> 5;
    const int trq = (lane & 15) >> 2, trc = 16 * ((lane >> 4) & 1) + 4 * (lane & 3);
    LAS bf16_t* KR = (LAS bf16_t*)(F.lds + NA_KOFF); LAS bf16_t* VR = (LAS bf16_t*)(F.lds + NA_VOFF);
    const int qrow_g = isctxu ? 0 : 4 * rg + (wave >> 1), qcol0 = isctxu ? 0 : 32 * (wave & 1);
    const int qrow0 = isctxu ? TL + b * CTXL + 32 * wave : b * SEQ + qrow_g * 64 + qcol0;
    int rs = qrow_g - 4; rs = rs < 0 ? 0 : (rs > 24 ? 24 : rs);
    int rs_lo = 4 * rg - 4; rs_lo = rs_lo < 0 ? 0 : (rs_lo > 24 ? 24 : rs_lo); int rs_hi = 4 * rg + 3 - 4; rs_hi = rs_hi < 0 ? 0 : (rs_hi > 24 ? 24 : rs_hi);
    const int nwin = isctxu ? 0 : rs_hi + 8 - rs_lo, ntile = nwin + 4;
    const int winrow0 = b * SEQ + rs_lo * 64, ctxrow0 = TL + b * CTXL;
    bf16x8 qf[4];
    { const bf16_t* qp = Z + (size_t)(qrow0 + r) * ZS + C_QNA + head * 64 + 8 * h;
#pragma unroll
      for (int ks = 0; ks < 4; ++ks) qf[ks] = *(const bf16x8*)(qp + 16 * ks); }
    unsigned ix0[4], ix1[4];
    { const int qc = qcol0 + r; int cs = qc - 8; cs = cs < 0 ? 0 : (cs > 48 ? 48 : cs);
#pragma unroll
      for (int g = 0; g < 4; ++g) { unsigned p0 = 0u, p1 = 0u;
#pragma unroll
          for (int e = 0; e < 4; ++e) { const int kc0 = crow(4 * g + e, h), kc1 = 32 + kc0;
              int d0 = kc0 - qc; d0 = d0 < -15 ? -15 : (d0 > 15 ? 15 : d0); int d1 = kc1 - qc; d1 = d1 < -15 ? -15 : (d1 > 15 ? 15 : d1);
              const unsigned c0 = (kc0 < cs || kc0 >= cs + 16) ? 31u : (unsigned)(d0 + 15), c1 = (kc1 < cs || kc1 >= cs + 16) ? 31u : (unsigned)(d1 + 15);
              p0 |= c0 << (8 * e); p1 |= c1 << (8 * e); }
          ix0[g] = p0; ix1[g] = p1; } }
    f32x16 o0, o1;
#pragma unroll
    for (int i = 0; i < 16; ++i) { o0[i] = 0.f; o1[i] = 0.f; }
    float mrun = -1e30f, lrun = 0.f;
    const int lkey = tid >> 3, lseg = tid & 7;
#define NA_TROW(j_) ((j_) < nwin ? winrow0 + (j_) * 64 : ctxrow0 + ((j_) - nwin) * 64)
#define NA_LD(j_, kk_, vv_) do { const bf16_t* zp = Z + (size_t)(NA_TROW(j_) + lkey) * ZS + head * 64 + 8 * lseg; kk_ = *(const u32x4*)(zp + C_KNA); vv_ = *(const u32x4*)(zp + C_VNA); } while (0)
#define NA_ST(slot_, kk_, vv_) do { *(LAS u32x4*)(KR + ((slot_) * 64 + lkey) * NA_VS + 8 * lseg) = kk_; *(LAS u32x4*)(VR + ((slot_) * 64 + lkey) * NA_VS + 8 * lseg) = vv_; } while (0)
    u32x4 sk, sv;
    __syncthreads();
    NA_LD(0, sk, sv); NA_ST(0, sk, sv); NA_LD(1, sk, sv);
#pragma unroll 1
    for (int j = 0; j < ntile; ++j) {
        __syncthreads();
        if (j + 1 < ntile) { NA_ST((j + 1) & 1, sk, sv); const int j2 = j + 2 < ntile ? j + 2 : ntile - 1; NA_LD(j2, sk, sv); }
        const bool isw = j < nwin;
        const int krow_g = rs_lo + j;
        if (isw && (krow_g < rs || krow_g >= rs + 8)) continue;
        const LAS bf16_t* kt = KR + (j & 1) * 64 * NA_VS; const LAS bf16_t* vt = VR + (j & 1) * 64 * NA_VS;
        f32x16 s0, s1;
#pragma unroll
        for (int i = 0; i < 16; ++i) { s0[i] = 0.f; s1[i] = 0.f; }
#pragma unroll
        for (int ks = 0; ks < 4; ++ks) { const bf16x8 k0 = *(const LAS bf16x8*)(kt + r * NA_VS + 16 * ks + 8 * h), k1 = *(const LAS bf16x8*)(kt + (32 + r) * NA_VS + 16 * ks + 8 * h);
            s0 = MFMA32(k0, qf[ks], s0); s1 = MFMA32(k1, qf[ks], s1); }
        const int drow = isw ? (krow_g - qrow_g + 7) : 15;
        const LAS float* trow = tab + (head * 16 + drow) * 32;
#pragma unroll
        for (int g = 0; g < 4; ++g) asm volatile("" : "+v"(ix0[g]), "+v"(ix1[g]));
        float tmax = -1e30f;
#pragma unroll
        for (int i = 0; i < 16; ++i) {
            const float a = s0[i] * (0.125f * NA_L2E) + trow[(ix0[i >> 2] >> (8 * (i & 3))) & 0xffu];
            const float bq = s1[i] * (0.125f * NA_L2E) + trow[(ix1[i >> 2] >> (8 * (i & 3))) & 0xffu];
            s0[i] = a; s1[i] = bq; tmax = fmaxf(tmax, fmaxf(a, bq));
        }
        tmax = fmaxf(tmax, __shfl_xor(tmax, 32));
        const float mnew = fmaxf(mrun, tmax), alpha = __builtin_amdgcn_exp2f(mrun - mnew);
        float psum = 0.f;
#pragma unroll
        for (int i = 0; i < 16; ++i) { const float a = __builtin_amdgcn_exp2f(s0[i] - mnew), bq = __builtin_amdgcn_exp2f(s1[i] - mnew); s0[i] = a; s1[i] = bq; psum += a + bq; }
        psum += __shfl_xor(psum, 32);
        lrun = lrun * alpha + psum; mrun = mnew;
#pragma unroll
        for (int i = 0; i < 16; ++i) { o0[i] *= alpha; o1[i] *= alpha; }
#pragma unroll
        for (int nb = 0; nb < 2; ++nb)
#pragma unroll
            for (int s = 0; s < 2; ++s) {
                const bf16x8 pf = pack_step(nb ? s1 : s0, s);
                const LAS bf16_t* vp = vt + (32 * nb + 16 * s + 4 * h + trq) * NA_VS + trc;
                o0 = MFMA32(tr8(vp, vp + 8 * NA_VS), pf, o0); o1 = MFMA32(tr8(vp + 32, vp + 32 + 8 * NA_VS), pf, o1);
            }
    }
#undef NA_TROW
#undef NA_LD
#undef NA_ST
    const float inv = 1.0f / lrun;
    bf16_t* op = O + (size_t)(qrow0 + r) * OS + head * 64 + 4 * h;
#pragma unroll
    for (int g = 0; g < 4; ++g) {
        u32x2 w0, w1; w0.x = pk2(o0[4 * g] * inv, o0[4 * g + 1] * inv); w0.y = pk2(o0[4 * g + 2] * inv, o0[4 * g + 3] * inv);
        w1.x = pk2(o1[4 * g] * inv, o1[4 * g + 1] * inv); w1.y = pk2(o1[4 * g + 2] * inv, o1[4 * g + 3] * inv);
        *(u32x2*)(op + 8 * g) = w0; *(u32x2*)(op + 32 + 8 * g) = w1;
    }
}
DI void phase_na(const Frame& F, int l, bool ctx_out) {
    const bf16_t* Z = (const bf16_t*)(F.ws + WS_R1); bf16_t* O = (bf16_t*)(F.ws + WS_R1 + R1_O);
    LAS float* tab = (LAS float*)(F.lds + NA_TAB2);
    __syncthreads();
    for (int i = F.tid; i < 8 * 16 * 32; i += 512) { const int hh = i >> 9, dr = (i >> 5) & 15, dc = i & 31;
        tab[i] = (dr == 15) ? 0.f : ((dc == 31) ? -1e30f : F.in[I_RPB][(size_t)l * 8 * 15 * 31 + (hh * 15 + dr) * 31 + dc] * NA_L2E); }
    __syncthreads();
    const int nlat = NB * 8 * 8, ntot = nlat + (ctx_out ? NB * 8 : 0);
#pragma unroll 1
    for (int u = F.bid; u < ntot; u += F.G) {
        if (u < nlat) na_block_unit(F, Z, O, tab, u & 7, false, u >> 6, (u >> 3) & 7);
        else { const int v = u - nlat; na_block_unit(F, Z, O, tab, v & 7, true, v >> 3, 0); }
    }
    __syncthreads();
}

constexpr int GP_CUM = 0, GL_CUMS = 132, GP_W2T = 33792  , GP_B2 = GP_W2T + 2 * 128 * 24 * 2  , GP_SEG = GP_B2 + 1024  ;
DI size_t gl_chunk_row(int b, int cn) { return cn < 4 ? (size_t)(TL + b * CTXL + cn * 64) : (size_t)(b * SEQ + (cn - 4) * 64); }
DI void gla_prep(const Frame& F, int l, int task) {
    const int cn = task % 36, hd = (task / 36) & 3, b = task / 144;
    bf16_t* Z = (bf16_t*)(F.ws + WS_R1); bf16_t* O = (bf16_t*)(F.ws + WS_R1 + R1_O); float* DECB = (float*)(F.ws + WS_DECB);
    LAS float* CUM = (LAS float*)(F.lds + GP_CUM); LAS float* SEG = (LAS float*)(F.lds + GP_SEG);
    const int tid = F.tid, lane = F.lane, wave = F.wave, r = lane & 31, h = lane >> 5;
    const size_t row0 = gl_chunk_row(b, cn);
    const bf16_t* W2G = (const bf16_t*)(F.ws + WS_W2TG);
    __syncthreads();
    const int tt = tid >> 3, seg = tid & 7, d0 = seg * 16;
    const int atb = wave & 1, adb = wave >> 1;
    const bf16_t* zr = Z + (row0 + tt) * ZS;
    const u32x4 q0 = *(const u32x4*)(zr + C_QGLA + hd * 128 + d0), q1 = *(const u32x4*)(zr + C_QGLA + hd * 128 + d0 + 8);
    const u32x4 k0 = *(const u32x4*)(zr + C_KGLA + hd * 128 + d0), k1 = *(const u32x4*)(zr + C_KGLA + hd * 128 + d0 + 8);
    float qv[16], kv[16];
    qv[0] = bf_lo(q0.x); qv[1] = bf_hi(q0.x); qv[2] = bf_lo(q0.y); qv[3] = bf_hi(q0.y); qv[4] = bf_lo(q0.z); qv[5] = bf_hi(q0.z); qv[6] = bf_lo(q0.w); qv[7] = bf_hi(q0.w);
    qv[8] = bf_lo(q1.x); qv[9] = bf_hi(q1.x); qv[10] = bf_lo(q1.y); qv[11] = bf_hi(q1.y); qv[12] = bf_lo(q1.z); qv[13] = bf_hi(q1.z); qv[14] = bf_lo(q1.w); qv[15] = bf_hi(q1.w);
    kv[0] = bf_lo(k0.x); kv[1] = bf_hi(k0.x); kv[2] = bf_lo(k0.y); kv[3] = bf_hi(k0.y); kv[4] = bf_lo(k0.z); kv[5] = bf_hi(k0.z); kv[6] = bf_lo(k0.w); kv[7] = bf_hi(k0.w);
    kv[8] = bf_lo(k1.x); kv[9] = bf_hi(k1.x); kv[10] = bf_lo(k1.y); kv[11] = bf_hi(k1.y); kv[12] = bf_lo(k1.z); kv[13] = bf_hi(k1.z); kv[14] = bf_lo(k1.w); kv[15] = bf_hi(k1.w);
    __syncthreads();
#pragma unroll 1
    for (int dir = 0; dir < 2; ++dir) {
        {
            const int tl = 32 * atb + r, tn = dir ? 63 - tl : tl;
            const bf16x8 lrf = *(const bf16x8*)(Z + (row0 + tn) * ZS + C_GATE + dir * 16 + 8 * h);
            const bf16x8 w2f = *(const bf16x8*)(W2G + ((size_t)(l * 2 + dir) * 512 + hd * 128 + 32 * adb + r) * 16 + 8 * h);
            const float b2v = F.in[I_GGB][(size_t)(l * 2 + dir) * 512 + hd * 128 + 32 * adb + r];
            f32x16 ga;
#pragma unroll
            for (int i = 0; i < 16; ++i) ga[i] = 0.f;
            ga = MFMA32(lrf, w2f, ga);
            float sg[4];
#pragma unroll
            for (int g = 0; g < 4; ++g) {
                float run = 0.f;
#pragma unroll
                for (int e = 0; e < 4; ++e) { const float x = ga[4 * g + e] + b2v; run += (fminf(x, 0.f) - __logf(1.0f + __expf(-fabsf(x)))) * (1.0f / 16.0f); ga[4 * g + e] = run; }
                sg[g] = run;
            }
            float off = 0.f;
#pragma unroll
            for (int g = 0; g < 4; ++g) { const float ps = __shfl_xor(sg[g], 32); const float o = off + (h ? ps : 0.f);
#pragma unroll
                for (int e = 0; e < 4; ++e) CUM[(32 * atb + 8 * g + 4 * h + e) * GL_CUMS + 32 * adb + r] = ga[4 * g + e] + o;
                off += sg[g] + ps; }
            if (h == 0) SEG[atb * 128 + 32 * adb + r] = off;
        }
        __syncthreads();
        {
            const int tau = dir ? 63 - tt : tt;
            float qs[16], ks[16];
#pragma unroll
            for (int j = 0; j < 4; ++j) {
                const f32x4 e0 = *(const LAS f32x4*)(SEG + d0 + 4 * j), e1 = *(const LAS f32x4*)(SEG + 128 + d0 + 4 * j);
                const f32x4 cl = *(const LAS f32x4*)(CUM + tau * GL_CUMS + d0 + 4 * j);
#pragma unroll
                for (int e = 0; e < 4; ++e) {
                    const float cum = cl[e] + (tau >= 32 ? e0[e] : 0.f);
                    const int jj = 4 * j + e;
                    const float ex = __expf(cum), inv = __builtin_amdgcn_rcpf(ex);
                    qs[jj] = qv[jj] * 0.08838834764831845f * ex;
                    ks[jj] = kv[jj] * inv;
                }
                if (tt == 0) { f32x4 dv;
#pragma unroll
                    for (int e = 0; e < 4; ++e) dv[e] = __expf(e0[e] + e1[e]);
                    *(f32x4*)(DECB + ((size_t)((b * 4 + hd) * 2 + dir) * 36 + cn) * 128 + d0 + 4 * j) = dv; }
            }
            bf16_t* qd = dir ? O + (row0 + tt) * OS + 1024 + hd * 128 + d0 : Z + (row0 + tt) * ZS + C_QGLA + hd * 128 + d0;
            bf16_t* kd = dir ? O + (row0 + tt) * OS + 1536 + hd * 128 + d0 : Z + (row0 + tt) * ZS + C_KGLA + hd * 128 + d0;
            u32x4 w;
            w.x = pk2(qs[0], qs[1]); w.y = pk2(qs[2], qs[3]); w.z = pk2(qs[4], qs[5]); w.w = pk2(qs[6], qs[7]); *(u32x4*)qd = w;
            w.x = pk2(qs[8], qs[9]); w.y = pk2(qs[10], qs[11]); w.z = pk2(qs[12], qs[13]); w.w = pk2(qs[14], qs[15]); *(u32x4*)(qd + 8) = w;
            w.x = pk2(ks[0], ks[1]); w.y = pk2(ks[2], ks[3]); w.z = pk2(ks[4], ks[5]); w.w = pk2(ks[6], ks[7]); *(u32x4*)kd = w;
            w.x = pk2(ks[8], ks[9]); w.y = pk2(ks[10], ks[11]); w.z = pk2(ks[12], ks[13]); w.w = pk2(ks[14], ks[15]); *(u32x4*)(kd + 8) = w;
        }
        __syncthreads();
    }
}
constexpr int GL_RS = 136, GL_VS = 72, GC_QS = 0, GC_KS = GC_QS + 2 * 64 * GL_RS * 2, GC_V = GC_KS + 2 * 64 * GL_RS * 2, GC_ST = GC_V + 2 * 64 * GL_VS * 2, GC_DEC = GC_ST + 2 * 128 * GL_VS * 2;
static_assert(GC_DEC + 2 * 128 * 4 <= MISC_OFF, "GLA chain LDS");
DI void gla_chain(const Frame& F, int l, int chain, bool ctx_out) {
    const int vs = chain & 3, dir = (chain >> 2) & 1, hd = (chain >> 3) & 3, b = chain >> 5;
    const bf16_t* Z = (const bf16_t*)(F.ws + WS_R1); const bf16_t* O = (const bf16_t*)(F.ws + WS_R1 + R1_O); const float* DECB = (const float*)(F.ws + WS_DECB);
    bf16_t* OD = (bf16_t*)(F.ws + WS_R2 + (dir ? R2_OB : 0));
    const int tid = F.tid, lane = F.lane, wave = F.wave, r = lane & 31, h = lane >> 5;
    const int trq = (lane & 15) >> 2, trc = 16 * ((lane >> 4) & 1) + 4 * (lane & 3);
    const int tau = tid >> 3, seg = tid & 7, d0 = seg * 16;
#define GL_CN(s_) ((s_) < 4 ? (dir ? 3 - (s_) : (s_)) : 4 + (dir ? 31 - ((s_) - 4) : ((s_) - 4)))
#define GL_ROW(s_, t_) (gl_chunk_row(b, GL_CN(s_)) + (dir ? 63 - (t_) : (t_)))
    const bf16_t* qbase = dir ? O + 1024 + hd * 128 + d0 : Z + C_QGLA + hd * 128 + d0; const bf16_t* kbase = dir ? O + 1536 + hd * 128 + d0 : Z + C_KGLA + hd * 128 + d0;
    const size_t qstr = dir ? OS : ZS;
    const bf16_t* vbase = Z + C_VGLA + hd * 256 + vs * 64 + seg * 8;
    const float* dbase = DECB + (size_t)((b * 4 + hd) * 2 + dir) * 36 * 128;
    __syncthreads();
    for (int i = tid; i < 128 * GL_VS / 2; i += 512) ((LAS unsigned*)(F.lds + GC_ST))[i] = 0u;
    f32x16 S0, S1;
#pragma unroll
    for (int i = 0; i < 16; ++i) { S0[i] = 0.f; S1[i] = 0.f; }
    u32x4 nq0, nq1, nk0, nk1, nvv; float ndec = 0.f;
#define GL_LOAD(s_) do { const size_t rw = GL_ROW(s_, tau); nq0 = *(const u32x4*)(qbase + rw * qstr); nq1 = *(const u32x4*)(qbase + rw * qstr + 8); nk0 = *(const u32x4*)(kbase + rw * qstr); nk1 = *(const u32x4*)(kbase + rw * qstr + 8); \
        nvv = *(const u32x4*)(vbase + rw * ZS); if (tid < 128) ndec = dbase[GL_CN(s_) * 128 + tid]; } while (0)
#define GL_PUT(p_) do { LAS bf16_t* qd = (LAS bf16_t*)(F.lds + GC_QS) + ((p_) * 64 + tau) * GL_RS + d0; LAS bf16_t* kd = (LAS bf16_t*)(F.lds + GC_KS) + ((p_) * 64 + tau) * GL_RS + d0; \
        *(LAS u32x4*)qd = nq0; *(LAS u32x4*)(qd + 8) = nq1; *(LAS u32x4*)kd = nk0; *(LAS u32x4*)(kd + 8) = nk1; *(LAS u32x4*)((LAS bf16_t*)(F.lds + GC_V) + ((p_) * 64 + tau) * GL_VS + seg * 8) = nvv; \
        if (tid < 128) ((LAS float*)(F.lds + GC_DEC))[(p_) * 128 + tid] = ndec; } while (0)
    GL_LOAD(0); GL_PUT(0); GL_LOAD(1);
    __syncthreads();
#pragma unroll 1
    for (int s = 0; s < 36; ++s) {
        const int p = s & 1;
        const bool emit = (s >= 4) || ctx_out;
        const LAS bf16_t* QS = (const LAS bf16_t*)(F.lds + GC_QS) + p * 64 * GL_RS; const LAS bf16_t* KS = (const LAS bf16_t*)(F.lds + GC_KS) + p * 64 * GL_RS;
        const LAS bf16_t* VV = (const LAS bf16_t*)(F.lds + GC_V) + p * 64 * GL_VS;
        const LAS bf16_t* STo = (const LAS bf16_t*)(F.lds + GC_ST) + p * 128 * GL_VS; LAS bf16_t* STn = (LAS bf16_t*)(F.lds + GC_ST) + (p ^ 1) * 128 * GL_VS;
        if (wave < 4) {
            if (emit) {
                const int vb = wave & 1, tb = wave >> 1;
                f32x16 a0, a1, oo, oi;
#pragma unroll
                for (int i = 0; i < 16; ++i) { a0[i] = 0.f; a1[i] = 0.f; oo[i] = 0.f; oi[i] = 0.f; }
#pragma unroll
                for (int kk = 0; kk < 8; ++kk) {
                    const bf16x8 qf = *(const LAS bf16x8*)(QS + (32 * tb + r) * GL_RS + 16 * kk + 8 * h);
                    const bf16x8 kf0 = *(const LAS bf16x8*)(KS + r * GL_RS + 16 * kk + 8 * h);
                    const LAS bf16_t* sp = STo + (16 * kk + 8 * h + trq) * GL_VS + 32 * vb + trc;
                    a0 = MFMA32(kf0, qf, a0);
                    oi = MFMA32(tr8(sp, sp + 4 * GL_VS), qf, oi);
                    if (tb == 1) { const bf16x8 kf1 = *(const LAS bf16x8*)(KS + (32 + r) * GL_RS + 16 * kk + 8 * h); a1 = MFMA32(kf1, qf, a1); }
                }
                const int tt = 32 * tb + r;
#pragma unroll
                for (int i = 0; i < 16; ++i) { const int sg0 = crow(i, h); if (sg0 > tt) a0[i] = 0.f; if (32 + sg0 > tt) a1[i] = 0.f; }
#pragma unroll
                for (int sb = 0; sb < 2; ++sb)
#pragma unroll
                    for (int st = 0; st < 2; ++st) {
                        if (sb == 1 && tb == 0) continue;
                        const bf16x8 pf = pack_step(sb ? a1 : a0, st);
                        const LAS bf16_t* vp = VV + (32 * sb + 16 * st + 4 * h + trq) * GL_VS + 32 * vb + trc;
                        oo = MFMA32(tr8(vp, vp + 8 * GL_VS), pf, oo);
                    }
#pragma unroll
                for (int i = 0; i < 16; ++i) oo[i] += oi[i];
                const size_t orow = GL_ROW(s, tt);
                bf16_t* op = OD + orow * D + hd * 256 + vs * 64 + 32 * vb + 4 * h;
#pragma unroll
                for (int g = 0; g < 4; ++g) { u32x2 w; w.x = pk2(oo[4 * g], oo[4 * g + 1]); w.y = pk2(oo[4 * g + 2], oo[4 * g + 3]); *(u32x2*)(op + 8 * g) = w; }
            }
        } else {
            const int db = wave - 4, dd = 32 * db + r;
            const float dec = ((const LAS float*)(F.lds + GC_DEC))[p * 128 + dd];
#pragma unroll
            for (int kk = 0; kk < 4; ++kk) {
                const LAS bf16_t* kp = KS + (16 * kk + 8 * h + trq) * GL_RS + 32 * db + trc;
                const LAS bf16_t* v0p = VV + (16 * kk + 8 * h + trq) * GL_VS + trc;
                const bf16x8 kf = tr8(kp, kp + 4 * GL_RS);
                S0 = MFMA32(tr8(v0p, v0p + 4 * GL_VS), kf, S0); S1 = MFMA32(tr8(v0p + 32, v0p + 32 + 4 * GL_VS), kf, S1);
            }
#pragma unroll
            for (int i = 0; i < 16; ++i) { S0[i] *= dec; S1[i] *= dec; }
#pragma unroll
            for (int g = 0; g < 4; ++g) {
                u32x2 w0, w1; w0.x = pk2(S0[4 * g], S0[4 * g + 1]); w0.y = pk2(S0[4 * g + 2], S0[4 * g + 3]); w1.x = pk2(S1[4 * g], S1[4 * g + 1]); w1.y = pk2(S1[4 * g + 2], S1[4 * g + 3]);
                *(LAS u32x2*)(STn + dd * GL_VS + 8 * g + 4 * h) = w0; *(LAS u32x2*)(STn + dd * GL_VS + 32 + 8 * g + 4 * h) = w1;
            }
        }
        if (s + 1 < 36) { GL_PUT(p ^ 1); const int s2 = s + 2 < 36 ? s + 2 : 35; GL_LOAD(s2); }
        __syncthreads();
    }
#undef GL_ROW
#undef GL_CN
#undef GL_LOAD
#undef GL_PUT
}
DI void phase_gla_fin(const Frame& F, int l, int M) {
    const int NGW = F.G * 8, gw = F.bid * 8 + F.wave, lane = F.lane;
    const bf16_t* Z = (const bf16_t*)(F.ws + WS_R1); bf16_t* O = (bf16_t*)(F.ws + WS_R1 + R1_O);
    const bf16_t* OFp = (const bf16_t*)(F.ws + WS_R2); const bf16_t* OBp = (const bf16_t*)(F.ws + WS_R2 + R2_OB);
    const float* gn = F.in[I_GNG] + (size_t)l * 256;
    for (int t = gw; t < M; t += NGW) {
        const u32x4 a0 = *(const u32x4*)(OFp + (size_t)t * D + 16 * lane), a1 = *(const u32x4*)(OFp + (size_t)t * D + 16 * lane + 8);
        const u32x4 b0 = *(const u32x4*)(OBp + (size_t)t * D + 16 * lane), b1 = *(const u32x4*)(OBp + (size_t)t * D + 16 * lane + 8);
        const u32x4 r0 = *(const u32x4*)(Z + (size_t)t * ZS + C_RGLA + 16 * lane), r1 = *(const u32x4*)(Z + (size_t)t * ZS + C_RGLA + 16 * lane + 8);
        float o[16], rr[16];
        o[0] = bf_lo(a0.x) + bf_lo(b0.x); o[1] = bf_hi(a0.x) + bf_hi(b0.x); o[2] = bf_lo(a0.y) + bf_lo(b0.y); o[3] = bf_hi(a0.y) + bf_hi(b0.y);
        o[4] = bf_lo(a0.z) + bf_lo(b0.z); o[5] = bf_hi(a0.z) + bf_hi(b0.z); o[6] = bf_lo(a0.w) + bf_lo(b0.w); o[7] = bf_hi(a0.w) + bf_hi(b0.w);
        o[8] = bf_lo(a1.x) + bf_lo(b1.x); o[9] = bf_hi(a1.x) + bf_hi(b1.x); o[10] = bf_lo(a1.y) + bf_lo(b1.y); o[11] = bf_hi(a1.y) + bf_hi(b1.y);
        o[12] = bf_lo(a1.z) + bf_lo(b1.z); o[13] = bf_hi(a1.z) + bf_hi(b1.z); o[14] = bf_lo(a1.w) + bf_lo(b1.w); o[15] = bf_hi(a1.w) + bf_hi(b1.w);
        rr[0] = bf_lo(r0.x); rr[1] = bf_hi(r0.x); rr[2] = bf_lo(r0.y); rr[3] = bf_hi(r0.y); rr[4] = bf_lo(r0.z); rr[5] = bf_hi(r0.z); rr[6] = bf_lo(r0.w); rr[7] = bf_hi(r0.w);
        rr[8] = bf_lo(r1.x); rr[9] = bf_hi(r1.x); rr[10] = bf_lo(r1.y); rr[11] = bf_hi(r1.y); rr[12] = bf_lo(r1.z); rr[13] = bf_hi(r1.z); rr[14] = bf_lo(r1.w); rr[15] = bf_hi(r1.w);
        float ss = 0.f;
#pragma unroll
        for (int i = 0; i < 16; ++i) ss += o[i] * o[i];
        ss += __shfl_xor(ss, 1); ss += __shfl_xor(ss, 2); ss += __shfl_xor(ss, 4); ss += __shfl_xor(ss, 8);
        const float rstd = rsqrtf(ss * (1.0f / 256.0f) + RMS_EPS);
        const int v0 = (lane & 15) * 16;
        float y[16];
#pragma unroll
        for (int i = 0; i < 16; ++i) y[i] = o[i] * rstd * gn[v0 + i] * siluf_(rr[i]);
        u32x4 w0, w1; w0.x = pk2(y[0], y[1]); w0.y = pk2(y[2], y[3]); w0.z = pk2(y[4], y[5]); w0.w = pk2(y[6], y[7]);
        w1.x = pk2(y[8], y[9]); w1.y = pk2(y[10], y[11]); w1.z = pk2(y[12], y[13]); w1.w = pk2(y[14], y[15]);
        *(u32x4*)(O + (size_t)t * OS + 1024 + 16 * lane) = w0; *(u32x4*)(O + (size_t)t * OS + 1024 + 16 * lane + 8) = w1;
    }
}

constexpr int RT_HS = 1032;
template <bool DRY = false> DI void phase_router(const Frame& F, int l, int M) {
    LAS bf16_t* HH = (LAS bf16_t*)F.lds;
    LAS bf16_t* HL = HH + 32 * RT_HS;
    LAS float* H2F = (LAS float*)F.lds;
    bf16_t* H2 = (bf16_t*)(F.ws + WS_R1 + R1_H2);
    const float* xres = F.out; const float* cres = (const float*)(F.ws + WS_CTXS);
    const bf16_t* WRH = (const bf16_t*)(F.ws + WS_WRT) + (size_t)(l * 2) * NE * D; const bf16_t* WRL = WRH + (size_t)NE * D;
    int* toke = (int*)(F.ws + WS_TOKE); int* tokp = (int*)(F.ws + (DRY ? WS_TOKR : WS_TOKP)); float* tokw = (float*)(F.ws + WS_TOKW);
    unsigned* cnt = (unsigned*)(F.ws + WS_CTL) + CW_CNT + 4096 * l + (DRY ? 32 : 0);
    const int lane = F.lane, wave = F.wave, r = lane & 31, hh = lane >> 5;
    const float brt = F.in[I_BR][l * NE + lane];
    const int npass = (M + 31) / 32;
    float xr[4][16];
#pragma unroll
    for (int rr = 0; rr < 4; ++rr) { const int t = F.bid * 32 + 4 * wave + rr;
        if (F.bid < npass && t < M) load_row_f32(t >= TL ? cres + (size_t)(t - TL) * D : xres + (size_t)t * D, lane, xr[rr]);
        else {
#pragma unroll
            for (int i = 0; i < 16; ++i) xr[rr][i] = 0.f; } }
    float gg[16]; load_row_f32(F.in[I_G2] + (size_t)l * D, lane, gg);
#pragma unroll 1
    for (int ps = F.bid; ps < npass; ps += F.G) {
        __syncthreads();
        { const int t0 = ps * 32; const int mr = t0 >= TL ? 8 : t0 / SEQ;
          float sh[16], sc[16]; load_row_f32(modp(F, l, mr, 3), lane, sh); load_row_f32(modp(F, l, mr, 4), lane, sc);
#pragma unroll
          for (int rr = 0; rr < 4; ++rr) {
            const int row = 4 * wave + rr, t = ps * 32 + row;
            float h[16]; float ss = 0.f;
#pragma unroll
            for (int i = 0; i < 16; ++i) ss += xr[rr][i] * xr[rr][i];
            const float rstd = rsqrtf(wave_sum(ss) * (1.0f / D) + RMS_EPS);
#pragma unroll
            for (int i = 0; i < 16; ++i) h[i] = (t < M) ? xr[rr][i] * rstd * gg[i] * (1.0f + sc[i]) + sh[i] : 0.f;
            if (t < M) store_row_bf16(H2 + (size_t)t * D, lane, h);
#pragma unroll
            for (int i = 0; i < 2; ++i) {
                u32x4 whi; whi.x = pk2(h[8 * i], h[8 * i + 1]); whi.y = pk2(h[8 * i + 2], h[8 * i + 3]); whi.z = pk2(h[8 * i + 4], h[8 * i + 5]); whi.w = pk2(h[8 * i + 6], h[8 * i + 7]);
                u32x4 wlo; wlo.x = pk2(h[8 * i] - bf_lo(whi.x), h[8 * i + 1] - bf_hi(whi.x)); wlo.y = pk2(h[8 * i + 2] - bf_lo(whi.y), h[8 * i + 3] - bf_hi(whi.y));
                wlo.z = pk2(h[8 * i + 4] - bf_lo(whi.z), h[8 * i + 5] - bf_hi(whi.z)); wlo.w = pk2(h[8 * i + 6] - bf_lo(whi.w), h[8 * i + 7] - bf_hi(whi.w));
                *(LAS u32x4*)(HH + row * RT_HS + 8 * lane + 512 * i) = whi; *(LAS u32x4*)(HL + row * RT_HS + 8 * lane + 512 * i) = wlo; }
          }
          const int pn = ps + F.G;
#pragma unroll
          for (int rr = 0; rr < 4; ++rr) { const int t = pn * 32 + 4 * wave + rr;
              if (pn < npass && t < M) load_row_f32(t >= TL ? cres + (size_t)(t - TL) * D : xres + (size_t)t * D, lane, xr[rr]); }
        }
        __syncthreads();
        f32x16 a0, a1;
#pragma unroll
        for (int i = 0; i < 16; ++i) { a0[i] = 0.f; a1[i] = 0.f; }
        {
            const LAS bf16_t* hp = HH + r * RT_HS + 128 * wave + 8 * hh; const LAS bf16_t* lp = HL + r * RT_HS + 128 * wave + 8 * hh;
            const bf16_t* w0h = WRH + (size_t)r * D + 128 * wave + 8 * hh; const bf16_t* w1h = w0h + (size_t)32 * D;
            const bf16_t* w0l = WRL + (size_t)r * D + 128 * wave + 8 * hh; const bf16_t* w1l = w0l + (size_t)32 * D;
#pragma unroll
            for (int ks = 0; ks < 8; ++ks) {
                const bf16x8 ah = *(const LAS bf16x8*)(hp + 16 * ks), al = *(const LAS bf16x8*)(lp + 16 * ks);
                const bf16x8 b0h = *(const bf16x8*)(w0h + 16 * ks), b1h = *(const bf16x8*)(w1h + 16 * ks), b0l = *(const bf16x8*)(w0l + 16 * ks), b1l = *(const bf16x8*)(w1l + 16 * ks);
                a0 = MFMA32(ah, b0h, a0); a1 = MFMA32(ah, b1h, a1);
                a0 = MFMA32(al, b0h, a0); a1 = MFMA32(al, b1h, a1);
                a0 = MFMA32(ah, b0l, a0); a1 = MFMA32(ah, b1l, a1);
            }
        }
        __syncthreads();
#pragma unroll
        for (int i = 0; i < 16; ++i) { const int tk = crow(i, hh); H2F[(wave * 32 + tk) * 64 + r] = a0[i]; H2F[(wave * 32 + tk) * 64 + 32 + r] = a1[i]; }
        __syncthreads();
        LAS unsigned* lcnt = (LAS unsigned*)(F.lds + MISC_OFF + 2048);
        if (F.tid < 64) lcnt[F.tid] = 0u;
        __syncthreads();
        int myj[4]; unsigned mylp[4]; float myw[4];
#pragma unroll
        for (int rr = 0; rr < 4; ++rr) {
            const int row = 4 * wave + rr, t = ps * 32 + row;
            myj[rr] = -1; mylp[rr] = 0u; myw[rr] = 0.f;
            if (t >= M) continue;
            float logit = 0.f;
#pragma unroll
            for (int w = 0; w < 8; ++w) logit += H2F[(w * 32 + row) * 64 + lane];
            const float score = sigmoidf_(logit), sel = score + brt;
            float g1 = sel; g1 = fmaxf(g1, __shfl_xor(g1, 1)); g1 = fmaxf(g1, __shfl_xor(g1, 2)); g1 = fmaxf(g1, __shfl_xor(g1, 4));
            const unsigned long long bm = __ballot(sel == g1);
            const unsigned gm = (unsigned)((bm >> (lane & ~7)) & 0xffull);
            const int first = __builtin_ctz(gm);
            float g2 = ((lane & 7) == first) ? -INFINITY : sel; g2 = fmaxf(g2, __shfl_xor(g2, 1)); g2 = fmaxf(g2, __shfl_xor(g2, 2)); g2 = fmaxf(g2, __shfl_xor(g2, 4));
            const float gs = g1 + g2; const int g = lane >> 3;
            int grank = 0;
#pragma unroll
            for (int j = 0; j < 8; ++j) { const float o = __shfl(gs, 8 * j); grank += (o > gs || (o == gs && j < g)) ? 1 : 0; }
            const bool gsel = grank < 4;
            const float ms = gsel ? sel : -INFINITY;
            int rank = 0;
#pragma unroll 4
            for (int j = 0; j < 64; ++j) { const float o = __int_as_float(__builtin_amdgcn_readlane(__float_as_int(ms), j)); rank += (o > ms || (o == ms && j < lane)) ? 1 : 0; }
            const bool chosen = gsel && rank < 8;
            const unsigned long long cb = __ballot(chosen);
            const float ssum = wave_sum(chosen ? score : 0.f);
            if (chosen) {
                const int j = __builtin_popcountll(cb & ((1ull << lane) - 1ull));
                if (j < 8) { myj[rr] = j; mylp[rr] = __hip_atomic_fetch_add(&lcnt[lane], 1u, __ATOMIC_RELAXED, __HIP_MEMORY_SCOPE_WORKGROUP); myw[rr] = score * __builtin_amdgcn_rcpf(ssum) * 2.5f; }
            }
        }
        __syncthreads();
        if (F.tid < 64) { const unsigned c = lcnt[F.tid]; lcnt[64 + F.tid] = c ? atomicAdd(cnt + F.tid * 64, c) : 0u; }
        __syncthreads();
#pragma unroll
        for (int rr = 0; rr < 4; ++rr) {
            const int t = ps * 32 + 4 * wave + rr;
            if (myj[rr] >= 0) { const size_t o = (size_t)t * 8 + myj[rr]; toke[o] = lane; tokp[o] = (int)(lcnt[64 + lane] + mylp[rr]); tokw[o] = myw[rr]; }
        }
    }
    __syncthreads();
}
DI void moe_tables(const Frame& F, int l, int M) {
    LAS int* tb = (LAS int*)(F.lds + MISC_OFF + 64); LAS int* rb = tb + 72; LAS int* cn = rb + 72;
    const unsigned* cnt = (const unsigned*)(F.ws + WS_CTL) + CW_CNT + 4096 * l;
    __syncthreads();
    if (F.tid < NE) cn[F.tid] = (int)__hip_atomic_load(cnt + F.tid * 64, __ATOMIC_RELAXED, __HIP_MEMORY_SCOPE_AGENT);
    if (F.tid == NE) cn[NE] = M;
    __syncthreads();
    if (F.tid == 0) { int t = 0, r = 0; for (int e = 0; e < NEX; ++e) { tb[e] = t; rb[e] = r; t += (cn[e] + 255) >> 8; r += cn[e]; } tb[NEX] = t; }
    __syncthreads();
    LAS unsigned char* te = (LAS unsigned char*)(cn + 72);
    if (F.tid < NEX) { const int t0 = tb[F.tid], t1 = tb[F.tid + 1]; for (int t = t0; t < t1; ++t) te[t] = (unsigned char)F.tid; }
    __syncthreads();
}
DI void phase_route_tables(const Frame& F, int l, int M) {
    moe_tables(F, l, M);
    const LAS int* rb = (const LAS int*)(F.lds + MISC_OFF + 64) + 72;
    const int* toke = (const int*)(F.ws + WS_TOKE); const int* tokp = (const int*)(F.ws + WS_TOKP);
    int* tokr = (int*)(F.ws + WS_TOKR); int* rowl = (int*)(F.ws + WS_ROWL);
    for (int i = F.bid * 512 + F.tid; i < M * 8; i += F.G * 512) { const int row = rb[toke[i]] + tokp[i]; tokr[i] = row; rowl[row] = i >> 3; }
    const int shb = rb[NE];
    for (int i = F.bid * 512 + F.tid; i < M + 256; i += F.G * 512) rowl[shb + i] = (i < M) ? i : 0;
}
template <bool DRY = false> DI void phase_combine(const Frame& F, int l, int M) {
    moe_tables(F, l, M);
    const LAS int* rb = (const LAS int*)(F.lds + MISC_OFF + 64) + 72;
    const int shb = rb[NE];
    const int gw = F.bid * 8 + F.wave, lane = F.lane;
    const bf16_t* OS_ = (const bf16_t*)(F.ws + WS_R1);
    const int* tokr = (const int*)(F.ws + WS_TOKR); const float* tokw = (const float*)(F.ws + WS_TOKW);
    float* xres = F.out; float* cres = (float*)(F.ws + WS_CTXS);
    bf16_t* H = (bf16_t*)(F.ws + WS_R2 + (DRY ? (size_t)40 * 1024 * 1024 : 0));
    const int per = M / (GRID * 8);
    const int tbeg = gw * per;
    int mr_cur = -1;
    float g2v[16], shv[16], scv[16], gnv[16];
    if (l == 0) load_row_f32(F.in[I_G1] + D, lane, gnv); else load_row_f32(F.in[I_GF], lane, gnv);
    int4 nr0, nr1; f32x4 nw0, nw1; float xn[16];
    { const int t = tbeg; nr0 = *(const int4*)(tokr + (size_t)t * 8); nr1 = *(const int4*)(tokr + (size_t)t * 8 + 4); nw0 = *(const f32x4*)(tokw + (size_t)t * 8); nw1 = *(const f32x4*)(tokw + (size_t)t * 8 + 4);
      load_row_f32(t >= TL ? cres + (size_t)(t - TL) * D : xres + (size_t)t * D, lane, xn); }
#pragma unroll 1
    for (int k = 0; k < per; ++k) {
        const int t = tbeg + k;
        const bool isctx = t >= TL; const int mr = isctx ? 8 : t / SEQ;
        if (mr != mr_cur) { mr_cur = mr; load_row_f32(modp(F, l, mr, 5), lane, g2v); if (l == 0) { load_row_f32(modp(F, 1, mr, 0), lane, shv); load_row_f32(modp(F, 1, mr, 1), lane, scv); } }
        const int rows[8] = {nr0.x, nr0.y, nr0.z, nr0.w, nr1.x, nr1.y, nr1.z, nr1.w};
        const float wts[8] = {nw0[0], nw0[1], nw0[2], nw0[3], nw1[0], nw1[1], nw1[2], nw1[3]};
        float x[16];
#pragma unroll
        for (int i = 0; i < 16; ++i) x[i] = xn[i];
        u32x4 v[9][2];
#pragma unroll
        for (int i = 0; i < 2; ++i) v[8][i] = *(const u32x4*)(OS_ + (size_t)(shb + t) * D + 8 * lane + 512 * i);
#pragma unroll
        for (int j = 0; j < 8; ++j)
#pragma unroll
            for (int i = 0; i < 2; ++i) v[j][i] = *(const u32x4*)(OS_ + (size_t)rows[j] * D + 8 * lane + 512 * i);
        if (k + 1 < per) { const int tn = t + 1; nr0 = *(const int4*)(tokr + (size_t)tn * 8); nr1 = *(const int4*)(tokr + (size_t)tn * 8 + 4); nw0 = *(const f32x4*)(tokw + (size_t)tn * 8); nw1 = *(const f32x4*)(tokw + (size_t)tn * 8 + 4);
            load_row_f32(tn >= TL ? cres + (size_t)(tn - TL) * D : xres + (size_t)tn * D, lane, xn); }
        float y[16];
#pragma unroll
        for (int i = 0; i < 2; ++i) { const u32x4 a = v[8][i];
            y[8 * i + 0] = bf_lo(a.x); y[8 * i + 1] = bf_hi(a.x); y[8 * i + 2] = bf_lo(a.y); y[8 * i + 3] = bf_hi(a.y); y[8 * i + 4] = bf_lo(a.z); y[8 * i + 5] = bf_hi(a.z); y[8 * i + 6] = bf_lo(a.w); y[8 * i + 7] = bf_hi(a.w); }
#pragma unroll
        for (int j = 0; j < DBG_NROUTED; ++j) { const float w = wts[j];
#pragma unroll
            for (int i = 0; i < 2; ++i) { const u32x4 a = v[j][i];
                y[8 * i + 0] += w * bf_lo(a.x); y[8 * i + 1] += w * bf_hi(a.x); y[8 * i + 2] += w * bf_lo(a.y); y[8 * i + 3] += w * bf_hi(a.y);
                y[8 * i + 4] += w * bf_lo(a.z); y[8 * i + 5] += w * bf_hi(a.z); y[8 * i + 6] += w * bf_lo(a.w); y[8 * i + 7] += w * bf_hi(a.w); } }
        float* xr = isctx ? cres + (size_t)(t - TL) * D : xres + (size_t)t * D;
#pragma unroll
        for (int i = 0; i < 16; ++i) x[i] += g2v[i] * y[i];
        float ss = 0.f;
#pragma unroll
        for (int i = 0; i < 16; ++i) ss += x[i] * x[i];
        const float rstd = rsqrtf(wave_sum(ss) * (1.0f / D) + RMS_EPS);
        if (l == 0) {
            if (!DRY) store_row_f32(xr, lane, x);
            float h[16];
#pragma unroll
            for (int i = 0; i < 16; ++i) h[i] = x[i] * rstd * gnv[i] * (1.0f + scv[i]) + shv[i];
            store_row_bf16(H + (size_t)t * D, lane, h);
        } else {
#pragma unroll
            for (int i = 0; i < 16; ++i) x[i] = x[i] * rstd * gnv[i];
            if (!DRY) store_row_f32(xr, lane, x); else store_row_bf16(H + (size_t)t * D, lane, x);
        }
    }
}

constexpr int PH_PER_LAYER = 10, N_PHASES = 2 + 2 * PH_PER_LAYER;
template <class T> DI T* opaque_ptr(T* p) {
    unsigned long long v = (unsigned long long)p; unsigned lo = (unsigned)v, hi = (unsigned)(v >> 32);
    asm volatile("" : "+s"(lo), "+s"(hi)); return (T*)(__attribute__((address_space(1))) T*)(((unsigned long long)hi << 32) | lo);
}
template <int KIND> DI void run_phase(const Frame& F0, const int l0) {
    Frame F = F0; int l = l0; asm volatile("" : "+s"(l));
    F.ws = opaque_ptr(F0.ws); F.out = opaque_ptr(F0.out);
    { int t = F0.tid; asm volatile("" : "+v"(t)); F.tid = t; F.lane = t & 63; F.wave = __builtin_amdgcn_readfirstlane(t >> 6); }
    unsigned char* const ws = F.ws;
    const bool ctx_out = (l == 0);
    const int M = ctx_out ? TA : TL;
    if constexpr (KIND == 0) { mod_vectors(F); conv_router(F); conv_gate_w(F); conv_small(F, 0); conv_down(F, 0, (bf16_t*)(ws + WS_WBS + WB_WD)); }
    if constexpr (KIND == 1) { phase_norm1_first(F); }
    if constexpr (KIND == 2) {
        pg8::RectSched<37> S{(const char*)(ws + WS_R2), (const char*)(ws + wbs_base(l) + WB_WIN), D, D, ctx_out ? 72 : 64, ctx_out ? 0 : 8, ctx_out ? 0 : 11, 64, F.G, F.bid};
        pg8::EpiStoreBf16 E{(bf16_t*)(ws + WS_R1), ZS};
        pg8::gemm_phase<false>(F.lds, F.tid, D, D, D, S, E);
    }
    if constexpr (KIND == 3) {
#pragma unroll 1
        for (int t = F.bid; t < NB * 4 * 36; t += F.G) gla_prep(F, l, t);
        phase_na(F, l, ctx_out);
        phase_conv(F, l, M);
    }
    if constexpr (KIND == 12) {
#pragma unroll 1
        for (int ch = F.bid; ch < 256; ch += F.G) gla_chain(F, l, ch, ctx_out);
    }
    if constexpr (KIND == 4) { phase_gla_fin(F, l, M); }
    if constexpr (KIND == 5) {
        const char* Ob = (const char*)(ws + WS_R1 + R1_O); bf16_t* Y = (bf16_t*)(ws + WS_R2); const bf16_t* Zb = (const bf16_t*)(ws + WS_R1);
        { pg8::RectSched<4> S{Ob, (const char*)(ws + wbs_base(l) + WB_WNA), OS, 512, M / 256, 0, 0, 0, F.G, F.bid}; pg8::EpiGate<0> E{Y, Zb, C_MERGE}; pg8::gemm_phase<false>(F.lds, F.tid, 512, OS, 512, S, E); }
        { pg8::RectSched<4> S{Ob + 512 * 2, (const char*)(ws + wbs_base(l) + WB_WSC), OS, 512, M / 256, 0, 0, 0, F.G, F.bid}; pg8::EpiGate<1> E{Y, Zb, C_MERGE + 1024}; pg8::gemm_phase<false>(F.lds, F.tid, 512, OS, 512, S, E); }
        { pg8::RectSched<4> S{Ob + 1024 * 2, (const char*)(ws + wbs_base(l) + WB_WGLA), OS, D, M / 256, 0, 0, 0, F.G, F.bid}; pg8::EpiGate<1> E{Y, Zb, C_MERGE + 2048}; pg8::gemm_phase<false>(F.lds, F.tid, D, OS, D, S, E); }
        if (l == 0) conv_small(F, 1, 32);
    }
    if constexpr (KIND == 6) {
        pg8::RectSched<4> S{(const char*)(ws + WS_R2), (const char*)(ws + wbs_base(l) + WB_WOUT), D, D, M / 256, 0, 0, 0, F.G, F.bid};
        pg8::EpiResid E{l == 0 ? F.in[I_X] : F.out, F.out, l == 0 ? F.in[I_CTX] : (const float*)(ws + WS_CTXS), (float*)(ws + WS_CTXS), modp(F, l, 0, 2)};
        pg8::gemm_phase<false>(F.lds, F.tid, D, D, D, S, E);
    }
    if constexpr (KIND == 7) {
#if REPEAT_KIND == 71
        phase_router<true>(F, l, M);
#endif
        phase_router(F, l, M); conv_gu(F, l, (bf16_t*)(ws + WS_R1));
#if REPEAT_KIND == 72
        conv_gu(F, l, (bf16_t*)(ws + WS_R1));
#endif
    }
    if constexpr (KIND == 8) { phase_route_tables(F, l, M); }
    if constexpr (KIND == 9) {
        moe_tables(F, l, M);
        const LAS int* tb = (const LAS int*)(F.lds + MISC_OFF + 64);
        pg8::MoeSched<true, 2> S{tb, tb + 72, tb + 144, (const char*)(ws + WS_R1 + R1_H2), (const int*)(ws + WS_ROWL), (const char*)(ws + WS_R1), (size_t)512 * D * 2, D, D, F.G, F.bid};
        pg8::EpiSwiGLU E{(bf16_t*)(ws + WS_R2)};
        pg8::gemm_phase<true>(F.lds, F.tid, D, D, D, S, E);
    }
    if constexpr (KIND == 10) {
        moe_tables(F, l, M);
        const LAS int* tb = (const LAS int*)(F.lds + MISC_OFF + 64);
        pg8::MoeSched<false, 4> S{tb, tb + 72, tb + 144, (const char*)(ws + WS_R2), nullptr, (const char*)(ws + WS_WBS + WB_WD), (size_t)D * FF * 2, FF, FF, F.G, F.bid};
        pg8::EpiDown E{(bf16_t*)(ws + WS_R1)};
        pg8::gemm_phase<false>(F.lds, F.tid, FF, FF, FF, S, E);
    }
    if constexpr (KIND == 11) {
#if REPEAT_KIND == 111
        phase_combine<true>(F, l, M);
#endif
        phase_combine(F, l, M); if (l == 0) conv_down(F, 1, (bf16_t*)(ws + WS_WBS + WB_WD));
    }
}
DI void make_frame(Frame& F, const Args& args, unsigned char* lds_raw) {
    F.lds = (LAS unsigned char*)lds_raw; F.ws = args.ws; F.in = args.in; F.out = args.out;
    F.tid = threadIdx.x; F.lane = F.tid & 63; F.wave = __builtin_amdgcn_readfirstlane(F.tid >> 6); F.G = GRID; F.bid = blockIdx.x;
}
template <int KIND> __global__ void __launch_bounds__(512, 2) fwd_k(Args args) {
    extern __shared__ __attribute__((aligned(16))) unsigned char lds_raw[];
    Frame F; make_frame(F, args, lds_raw);
    run_phase<KIND>(F, args.ph_lo);
}
#if MK_ONE_LAUNCH
__global__ void __launch_bounds__(512, 2) fwd(Args args) {
    extern __shared__ __attribute__((aligned(16))) unsigned char lds_raw[];
    Frame F; make_frame(F, args, lds_raw);
    volatile LAS unsigned* MISC = (volatile LAS unsigned*)(F.lds + MISC_OFF);
    if (F.tid < 4) MISC[F.tid] = 0u;
    __syncthreads();
    XcdBarrier bar = xcd_barrier_post((unsigned*)(F.ws + WS_CTL) + CW_BAR, MISC);
    run_phase<0>(F, 0); xcd_barrier(bar); if (REPEAT_KIND == 99) xcd_barrier(bar); if (REPEAT_KIND == 0) { run_phase<0>(F, 0); xcd_barrier(bar); }
    run_phase<1>(F, 0); xcd_barrier(bar); if (REPEAT_KIND == 99) xcd_barrier(bar); if (REPEAT_KIND == 1) { run_phase<1>(F, 0); xcd_barrier(bar); }
#pragma unroll 1
    for (int l = 0; l < 2; ++l) {
        run_phase<2>(F, l); xcd_barrier(bar); if (REPEAT_KIND == 99) xcd_barrier(bar); if (REPEAT_KIND == 2) { run_phase<2>(F, l); xcd_barrier(bar); }
        run_phase<3>(F, l); xcd_barrier(bar); if (REPEAT_KIND == 99) xcd_barrier(bar);
        run_phase<12>(F, l); xcd_barrier(bar); if (REPEAT_KIND == 99) xcd_barrier(bar); if (REPEAT_KIND == 12) { run_phase<12>(F, l); xcd_barrier(bar); }
        run_phase<4>(F, l); xcd_barrier(bar); if (REPEAT_KIND == 99) xcd_barrier(bar); if (REPEAT_KIND == 4) { run_phase<4>(F, l); xcd_barrier(bar); }
        run_phase<5>(F, l); xcd_barrier(bar); if (REPEAT_KIND == 99) xcd_barrier(bar); if (REPEAT_KIND == 5) { run_phase<5>(F, l); xcd_barrier(bar); }
        run_phase<6>(F, l); xcd_barrier(bar); if (REPEAT_KIND == 99) xcd_barrier(bar); if (REPEAT_KIND == 6) { run_phase<6>(F, l); xcd_barrier(bar); }
        run_phase<7>(F, l); xcd_barrier(bar); if (REPEAT_KIND == 99) xcd_barrier(bar); if (REPEAT_KIND == 7) { run_phase<7>(F, l); xcd_barrier(bar); }
        run_phase<8>(F, l); xcd_barrier(bar); if (REPEAT_KIND == 99) xcd_barrier(bar); if (REPEAT_KIND == 8) { run_phase<8>(F, l); xcd_barrier(bar); }
        run_phase<9>(F, l); xcd_barrier(bar); if (REPEAT_KIND == 99) xcd_barrier(bar); if (REPEAT_KIND == 9) { run_phase<9>(F, l); xcd_barrier(bar); }
        run_phase<10>(F, l); xcd_barrier(bar); if (REPEAT_KIND == 99) xcd_barrier(bar); if (REPEAT_KIND == 10) { run_phase<10>(F, l); xcd_barrier(bar); }
        run_phase<11>(F, l); xcd_barrier(bar); if (REPEAT_KIND == 99) xcd_barrier(bar); if (REPEAT_KIND == 11) { run_phase<11>(F, l); xcd_barrier(bar); }
    }
}
#endif

template <int KIND> static bool prep_kernel() { return hipFuncSetAttribute((const void*)fwd_k<KIND>, hipFuncAttributeMaxDynamicSharedMemorySize, LDS_BYTES) == hipSuccess; }
template <int KIND> static void launch_k(int grid, hipStream_t stream, Args a, int l) { a.ph_lo = l; a.ph_hi = KIND; hipLaunchKernelGGL(fwd_k<KIND>, dim3(grid), dim3(512), LDS_BYTES, stream, a); }
extern "C" void kernel_launch(void* const* d_in, const int* in_sizes, int n_in, void* d_out, int out_size, void* d_ws, size_t ws_size, hipStream_t stream) {
    static int grid = 0;
    if (grid == 0) {
        if (n_in != N_INPUTS || ws_size < WS_END) { fprintf(stderr, "kernel_launch: need %d inputs and %zu bytes of workspace; got %d, %zu\n", N_INPUTS, (size_t)WS_END, n_in, ws_size); grid = -1; return; }
        int dev = 0, cus = 0;
        if (hipGetDevice(&dev) != hipSuccess || hipDeviceGetAttribute(&cus, hipDeviceAttributeMultiprocessorCount, dev) != hipSuccess) { grid = -1; return; }
#if MK_ONE_LAUNCH
        if (hipFuncSetAttribute((const void*)fwd, hipFuncAttributeMaxDynamicSharedMemorySize, LDS_BYTES) != hipSuccess) { grid = -1; return; }
#else
        bool ok = prep_kernel<0>() && prep_kernel<1>() && prep_kernel<2>() && prep_kernel<3>() && prep_kernel<4>() && prep_kernel<5>() && prep_kernel<6>() && prep_kernel<7>() && prep_kernel<8>() && prep_kernel<9>() && prep_kernel<10>() && prep_kernel<11>() && prep_kernel<12>();
        if (!ok) { fprintf(stderr, "kernel_launch: hipFuncSetAttribute failed\n"); grid = -1; return; }
#endif
        (void)hipGetLastError();
        if (cus < GRID) { fprintf(stderr, "kernel_launch: built for a %d-CU device, found %d CUs\n", GRID, cus); grid = -1; return; }
        grid = GRID;
    }
    if (grid < 0) return;
    if (hipMemsetAsync((char*)d_ws + WS_CTL, 0, ZERO_BYTES, stream) != hipSuccess) return;
    Args a{};
    for (int i = 0; i < N_INPUTS; ++i) a.in[i] = (const float*)d_in[i];
    a.out = (float*)d_out; a.ws = (unsigned char*)d_ws;
#if MK_ONE_LAUNCH
    a.ph_lo = 0; a.ph_hi = N_PHASES;
    hipLaunchKernelGGL(fwd, dim3(grid), dim3(512), LDS_BYTES, stream, a);
#else
    launch_k<0>(grid, stream, a, 0); launch_k<1>(grid, stream, a, 0);
    for (int l = 0; l < 2; ++l) {
        launch_k<2>(grid, stream, a, l); launch_k<3>(grid, stream, a, l); launch_k<12>(grid, stream, a, l); launch_k<4>(grid, stream, a, l); launch_k<5>(grid, stream, a, l); launch_k<6>(grid, stream, a, l);
#ifdef DBG_STOP6
        break;
#endif
        launch_k<7>(grid, stream, a, l); launch_k<8>(grid, stream, a, l); launch_k<9>(grid, stream, a, l); launch_k<10>(grid, stream, a, l); launch_k<11>(grid, stream, a, l);
#ifdef DBG_STOP11
        break;
#endif
    }
#endif
}
```

```cpp
#include <hip/hip_runtime.h>
#include <cstdio>
#include <cstdint>

#define DBG_NROUTED 8
#ifndef REPEAT_KIND
#define REPEAT_KIND -1
#endif
#ifndef PG8_SP2
#define PG8_SP2 1
#endif
#ifndef PG8_ALIGN
#define PG8_ALIGN 1
#endif
#ifndef MK_ONE_LAUNCH
#define MK_ONE_LAUNCH 1
#endif

#define LAS __attribute__((address_space(3)))
#define DI __device__ __forceinline__
typedef unsigned short bf16_t;
typedef short bf16x8 __attribute__((ext_vector_type(8)));
typedef short s16x4 __attribute__((ext_vector_type(4)));
typedef float f32x4 __attribute__((ext_vector_type(4)));
typedef float f32x16 __attribute__((ext_vector_type(16)));
typedef unsigned u32x4 __attribute__((ext_vector_type(4)));
typedef unsigned u32x2 __attribute__((ext_vector_type(2)));
typedef __bf16 bf16x2_t __attribute__((ext_vector_type(2)));
typedef float f32x2_t __attribute__((ext_vector_type(2)));

DI unsigned pk2(float lo, float hi) { f32x2_t v = {lo, hi}; bf16x2_t b = __builtin_convertvector(v, bf16x2_t); return __builtin_bit_cast(unsigned, b); }
DI float bf_lo(unsigned u) { return __uint_as_float(u << 16); }
DI float bf_hi(unsigned u) { return __uint_as_float(u & 0xffff0000u); }
DI float bf2f(bf16_t b) { return __uint_as_float(((unsigned)b) << 16); }
DI bf16_t f2bf(float f) { return (bf16_t)(pk2(f, 0.f) & 0xffffu); }
DI float wave_sum(float v) {
#pragma unroll
    for (int o = 1; o < 64; o <<= 1) v += __shfl_xor(v, o);
    return v;
}
DI float sigmoidf_(float x) { return __builtin_amdgcn_rcpf(1.0f + __builtin_amdgcn_exp2f(-1.4426950408889634f * x)); }
DI float siluf_(float x) { return x * __builtin_amdgcn_rcpf(1.0f + __builtin_amdgcn_exp2f(-1.4426950408889634f * x)); }

constexpr int D = 1024, NB = 8, SEQ = 2048, CTXL = 256, TL = NB * SEQ, TC = NB * CTXL, TA = TL + TC;
constexpr int NIN = 9248, ZS = 9472  , NKV = 2592;
constexpr int C_KNA = 0, C_VNA = 512, C_KGLA = 1024, C_VGLA = 1536, C_GATE = 2560, C_QNA = 2592, C_BSC = 3104, C_CSC = 3616, C_XSC = 4128, C_QGLA = 4640, C_RGLA = 5152, C_MERGE = 6176;
constexpr int OS = 2048;
constexpr int NE = 64, NEX = 65  , FF = 256, TOPK = 8;
constexpr float RMS_EPS = 1e-6f;

enum { I_X = 0, I_C, I_CTX, I_CCTX, I_WMOD, I_BMOD, I_G1, I_G2, I_WIN, I_RPB, I_WNA, I_CONVW, I_WSC, I_GGW, I_GGB, I_GNG, I_WGLA, I_WOUT, I_WR, I_BR, I_WEG, I_WEU, I_WED, I_WSG, I_WSU, I_WSD, I_GF, N_INPUTS };

constexpr size_t WS_CTL = 0;
constexpr size_t CTL_BYTES = 65536;
constexpr int CW_BAR = 0, CW_CNT = 8192;
constexpr size_t WS_MOD = WS_CTL + CTL_BYTES;
constexpr size_t MOD_BYTES = 2 * 9 * 6 * 1024 * 4;
constexpr size_t ZERO_BYTES = CTL_BYTES + 458752;
constexpr size_t WS_CTXS = WS_CTL + ZERO_BYTES;
constexpr size_t WS_TOKE = WS_CTXS + (size_t)TC * D * 4;
constexpr size_t WS_TOKP = WS_TOKE + (size_t)TA * 8 * 4;
constexpr size_t WS_TOKW = WS_TOKP + (size_t)TA * 8 * 4;
constexpr size_t WS_TOKR = WS_TOKW + (size_t)TA * 8 * 4;
constexpr size_t WS_ROWL = WS_TOKR + (size_t)TA * 8 * 4;
constexpr size_t ROWL_BYTES = ((size_t)TA * 9 + 256) * 4;
constexpr size_t WS_WRT = (WS_ROWL + ROWL_BYTES + 255) & ~(size_t)255;
constexpr size_t WRT_BYTES = (size_t)2 * 2 * NE * D * 2;
constexpr size_t WS_WBS = WS_WRT + WRT_BYTES;
constexpr size_t WB_WIN = 0, WB_WNA = WB_WIN + (size_t)ZS * D * 2, WB_WSC = WB_WNA + (size_t)D * 512 * 2, WB_WGLA = WB_WSC + (size_t)D * 512 * 2,
                 WB_WOUT = WB_WGLA + (size_t)D * D * 2, WB_WD = WB_WOUT + (size_t)D * D * 2, WBS_BYTES = WB_WD + (size_t)NEX * D * FF * 2;
constexpr size_t WS_R2 = WS_WBS + WBS_BYTES;
constexpr size_t HID_ROWS = (size_t)TA * 9 + 256;
constexpr size_t R2_BYTES = HID_ROWS * FF * 2;
constexpr size_t R2_OB = (size_t)TA * D * 2;
constexpr size_t WS_R1 = WS_R2 + R2_BYTES;
constexpr size_t R1_O = (size_t)TA * ZS * 2;
constexpr size_t R1_BYTES = R1_O + (size_t)TA * OS * 2;
constexpr size_t R1_H2 = R1_O;
constexpr size_t WS_WBS1 = WS_R1 + R1_BYTES;
constexpr size_t WS_DECB = WS_WBS1 + WB_WD;
constexpr size_t WS_W2TG = WS_DECB + (size_t)NB * 4 * 2 * 36 * 128 * 4;
constexpr size_t WS_END = WS_W2TG + (size_t)2 * 2 * 512 * 16 * 2;
static_assert(HID_ROWS * D * 2 <= R1_O + 0, "out_slot must fit below H2");
static_assert((size_t)NEX * 512 * D * 2 <= R1_O, "WguT fits");

constexpr int LDS_BYTES = 147456, MISC_OFF = 143360;
constexpr int GRID = 256;

#define XB_TMO      128
#define XB_XCNT(j)  (256  + 64 * (j))
#define XB_XSUB(j)  (1280 + 64 * (j))
#define XB_XGEN(j)  (2304 + 64 * (j))
#define XB_TOP      3328
#define XB_TOPGEN   3392
#define XCD_BAR_WORDS 3456
#define XB_SPIN_CAP (1u << 22)
DI unsigned xb_ld(unsigned* p)              { return __hip_atomic_load(p, __ATOMIC_RELAXED, __HIP_MEMORY_SCOPE_AGENT); }
DI unsigned xb_add(unsigned* p, unsigned v) { return __hip_atomic_fetch_add(p, v, __ATOMIC_RELAXED, __HIP_MEMORY_SCOPE_AGENT); }
DI unsigned xb_xcc_id() { return (unsigned)__builtin_amdgcn_s_getreg((3 << 11) | 20) & 0xFu; }
#define XB_SPIN(cond, bar) do { unsigned _sp = 0; while (cond) { __builtin_amdgcn_s_sleep(1); \
    if ((++_sp & 255u) == 0u) { if (xb_ld(&(bar)[XB_TMO])) break; if (_sp > XB_SPIN_CAP) { atomicAdd(&(bar)[XB_TMO], 1u); break; } } } } while (0)
struct XcdBarrier { unsigned* bar; unsigned x; volatile LAS unsigned* st; };
DI XcdBarrier xcd_barrier_post(unsigned* bar, volatile LAS unsigned* st) {
    XcdBarrier b; b.bar = bar; b.x = xb_xcc_id(); b.st = st;
    if (threadIdx.x == 0) (void)xb_add(&bar[XB_XCNT(b.x)], 1u);
    return b;
}
DI void xcd_barrier_complete(unsigned* bar, unsigned x, unsigned& nloc, unsigned& nx) {
    const unsigned G = gridDim.x * gridDim.y * gridDim.z;
    unsigned sum, cnt, mine, sp = 0u;
    for (;;) {
        sum = 0u; cnt = 0u; mine = 0u;
#pragma unroll
        for (unsigned j = 0; j < 16; ++j) { const unsigned c = xb_ld(&bar[XB_XCNT(j)]); sum += c; cnt += (c > 0u) ? 1u : 0u; mine = (j == x) ? c : mine; }
        if (sum == G) break;
        __builtin_amdgcn_s_sleep(1);
        if ((++sp & 255u) == 0u) { if (xb_ld(&bar[XB_TMO])) break; if (sp > XB_SPIN_CAP) { atomicAdd(&bar[XB_TMO], 1u); break; } }
    }
    nloc = mine > 0u ? mine : 1u; nx = cnt > 0u ? cnt : 1u;
}
DI void xcd_barrier(const XcdBarrier& b) {
    asm volatile("s_waitcnt vmcnt(0)" ::: "memory");
    __syncthreads();
    if (threadIdx.x == 0) {
        unsigned* bar = b.bar;
        __builtin_amdgcn_s_waitcnt(0);
        const unsigned bx = xb_xcc_id();
        unsigned nloc = b.st[0], nx = b.st[1];
        if (nloc == 0u) { xcd_barrier_complete(bar, bx, nloc, nx); b.st[0] = nloc; b.st[1] = nx; }
        const unsigned old = xb_add(&bar[XB_XSUB(bx)], 1u);
        const unsigned gen = old / nloc;
        if (old + 1u == (gen + 1u) * nloc) {
            __builtin_amdgcn_fence(__ATOMIC_RELEASE, "agent");
            asm volatile("s_waitcnt vmcnt(0)" ::: "memory");
            const unsigned og = xb_add(&bar[XB_TOP], 1u);
            const unsigned tg = og / nx;
            if (og + 1u == (tg + 1u) * nx) xb_add(&bar[XB_TOPGEN], 1u);
            else XB_SPIN(xb_ld(&bar[XB_TOPGEN]) == tg, bar);
            __builtin_amdgcn_fence(__ATOMIC_ACQUIRE, "agent");
            xb_add(&bar[XB_XGEN(bx)], 1u);
            asm volatile("s_waitcnt vmcnt(0)" ::: "memory");
        } else {
            XB_SPIN(xb_ld(&bar[XB_XGEN(bx)]) == gen, bar);
            __builtin_amdgcn_fence(__ATOMIC_ACQUIRE, "agent");
            asm volatile("s_waitcnt vmcnt(0)" ::: "memory");
        }
    }
    __syncthreads();
}

namespace pg8 {
constexpr int BM = 256, BK = 64, HALF = 128, HTB = HALF * BK * 2, STAGE_BYTES = 8 * HTB;
DI int lds_byte(int r, int c) { const int st = (r >> 4) * 2 + (c >> 5), rr = r & 15, cc = c & 31, ob = rr * 64 + cc * 2; return st * 1024 + (ob ^ (((ob >> 9) & 1) << 5)); }
DI void stage_rc(int b, int& R, int& C) { const int st = b / 1024, sb = b % 1024, swz = sb ^ (((sb >> 9) & 1) << 5); R = (st >> 1) * 16 + swz / 64; C = (st & 1) * 32 + (swz % 64) / 2; }
DI int perm32(int rho) { const int n = rho >> 4, i = rho & 15; return 8 * (i >> 2) + 4 * n + (i & 3); }

struct GUnit {
    const char* A;
    const char* B;
    const int* rows;
    int pm, pn;
    int valid;
    int aux;
};

template <bool GATHER, class Epi, class Sched>
DI void gemm_phase(LAS unsigned char* lds, const int tid_, const int K_, const int lda, const int ldb, const Sched& S, const Epi& E) {
    int K = K_; asm volatile("" : "+s"(K));
    int tid = tid_; asm volatile("" : "+v"(tid));
    const int wid = __builtin_amdgcn_readfirstlane(tid >> 6), lane = tid & 63, wr = wid >> 2, wc = wid & 3, fr = lane & 15, fq = lane >> 4;
    const int nt = K / BK;
    unsigned voffA, voffB, cc2, ro;
    { int R, C; stage_rc(tid * 16, R, C); ro = (unsigned)R * 4u; cc2 = (unsigned)C * 2u; const int Rb = Epi::PERM ? ((R & ~31) + perm32(R & 31)) : R;
      voffA = (unsigned)(R * lda + C) * 2u; voffB = (unsigned)(Rb * ldb + C) * 2u; }
    const size_t hstepA = (size_t)HALF * lda * 2, qstepA = (size_t)64 * lda * 2, qstepB = (size_t)64 * ldb * 2;
    const unsigned rowb = (unsigned)lda * 2u;
    const size_t kstep = (size_t)(BK * 2);
    const size_t hstepB = (size_t)HALF * ldb * 2;
    const unsigned ldsw = (unsigned)wid * 1024u;
    const int aoff = lds_byte(wr * 64 + fr, fq * 8), boff = lds_byte(wc * 32 + fr, fq * 8);
#define PG8_SA(b, h) (((b) * 2 + (h)) * HTB)
#define PG8_SB(b, h) ((4 + (b) * 2 + (h)) * HTB)
#define PG8_STAGE2(bufoff, gbase, o0, o1) do { \
        __builtin_amdgcn_global_load_lds((const unsigned*)((const char*)(gbase) + (o0)), (LAS unsigned*)(lds + (bufoff) + ldsw), 16, 0, 0); \
        __builtin_amdgcn_global_load_lds((const unsigned*)((const char*)(gbase) + (o1)), (LAS unsigned*)(lds + (bufoff) + ldsw + 8192), 16, 0, 0); } while (0)
#define PG8_STAGEB(bufoff, gbase) do { unsigned _vo = voffB; asm volatile("" : "+v"(_vo));     \
        __builtin_amdgcn_global_load_lds((const unsigned*)((const char*)(gbase) + _vo), (LAS unsigned*)(lds + (bufoff) + ldsw), 16, 0, 0); \
        __builtin_amdgcn_global_load_lds((const unsigned*)((const char*)(gbase) + qstepB + _vo), (LAS unsigned*)(lds + (bufoff) + ldsw + 8192), 16, 0, 0); } while (0)
#define PG8_LDA(dst, b, h) do { _Pragma("unroll") for (int m = 0; m < 4; ++m) _Pragma("unroll") for (int k = 0; k < 2; ++k) dst[m][k] = *(const LAS bf16x8*)(lds + PG8_SA(b, h) + aoff + m * 2048 + k * 1024); } while (0)
#define PG8_LDB(dst, b, h) do { _Pragma("unroll") for (int n = 0; n < 2; ++n) _Pragma("unroll") for (int k = 0; k < 2; ++k) dst[n][k] = *(const LAS bf16x8*)(lds + PG8_SB(b, h) + boff + n * 2048 + k * 1024); } while (0)
#define PG8_MMA(ai, bj, At, Bt) do { __builtin_amdgcn_s_setprio(1); _Pragma("unroll") for (int m = 0; m < 4; ++m) _Pragma("unroll") for (int n = 0; n < 2; ++n) _Pragma("unroll") for (int k = 0; k < 2; ++k) \
        acc[ai][bj][m][n] = __builtin_amdgcn_mfma_f32_16x16x32_bf16(Bt[n][k], At[m][k], acc[ai][bj][m][n], 0, 0, 0); __builtin_amdgcn_s_setprio(0); } while (0)
#define PG8_WAIT_V(n) asm volatile("s_waitcnt vmcnt(" #n ")" ::: "memory")
#define PG8_WAIT_L(n) asm volatile("s_waitcnt lgkmcnt(" #n ")" ::: "memory")
#define PG8_BAR __builtin_amdgcn_s_barrier()
#define PG8_SCHED __builtin_amdgcn_sched_barrier(0)
#define PG8_RIDX(u, p0, p1) do { if (GATHER) { const char* _rb = (const char*)(u).rows; \
        p0 = (unsigned)*(const int*)(_rb + ro) | ((unsigned)*(const int*)(_rb + ro + HALF * 4) << 16); p1 = (unsigned)*(const int*)(_rb + ro + 64 * 4) | ((unsigned)*(const int*)(_rb + ro + (64 + HALF) * 4) << 16); } } while (0)
#define PG8_STAGEA(bufoff, gbase, h, p0, p1) do { if (GATHER) { const unsigned _o0 = (((p0) >> (16 * (h))) & 0xffffu) * rowb + cc2, _o1 = (((p1) >> (16 * (h))) & 0xffffu) * rowb + cc2; PG8_STAGE2(bufoff, gbase, _o0, _o1); } \
        else { unsigned _va = voffA; asm volatile("" : "+v"(_va)); \
               __builtin_amdgcn_global_load_lds((const unsigned*)((const char*)(gbase) + (h) * hstepA + _va), (LAS unsigned*)(lds + (bufoff) + ldsw), 16, 0, 0); \
               __builtin_amdgcn_global_load_lds((const unsigned*)((const char*)(gbase) + (h) * hstepA + qstepA + _va), (LAS unsigned*)(lds + (bufoff) + ldsw + 8192), 16, 0, 0); } } while (0)
    GUnit cur, nxt; int ui = 0;
    if (!S.next(0, cur)) return;
    f32x4 acc[2][2][4][2];
#pragma unroll
    for (int a = 0; a < 2; ++a)
#pragma unroll
        for (int b = 0; b < 2; ++b)
#pragma unroll
            for (int m = 0; m < 4; ++m)
#pragma unroll
                for (int n = 0; n < 2; ++n) acc[a][b][m][n] = (f32x4){0.f, 0.f, 0.f, 0.f};
    bf16x8 At[4][2], B0[2][2], B1[2][2];
    const char* cA = cur.A; const char* cB = cur.B;
    unsigned cp0 = 0u, cp1 = 0u; PG8_RIDX(cur, cp0, cp1);
#if PG8_SP2
    PG8_STAGEB(PG8_SB(0, 0), cB); PG8_STAGEB(PG8_SB(0, 1), cB + hstepB); PG8_STAGEA(PG8_SA(0, 0), cA, 0, cp0, cp1); PG8_STAGEA(PG8_SA(0, 1), cA, 1, cp0, cp1);
    if (wr == 1) PG8_BAR;
    PG8_WAIT_V(2); PG8_BAR;
    PG8_STAGEB(PG8_SB(1, 0), cB + kstep); PG8_STAGEA(PG8_SA(1, 0), cA + kstep, 0, cp0, cp1); PG8_STAGEB(PG8_SB(1, 1), cB + hstepB + kstep);
    PG8_WAIT_V(6); PG8_BAR;
#else
    PG8_STAGEB(PG8_SB(0, 0), cB); PG8_STAGEA(PG8_SA(0, 0), cA, 0, cp0, cp1); PG8_STAGEB(PG8_SB(0, 1), cB + hstepB); PG8_STAGEA(PG8_SA(0, 1), cA, 1, cp0, cp1);
    if (wr == 1) PG8_BAR;
    PG8_WAIT_V(4); PG8_BAR;
    PG8_STAGEB(PG8_SB(1, 0), cB + kstep); PG8_STAGEA(PG8_SA(1, 0), cA + kstep, 0, cp0, cp1); PG8_STAGEB(PG8_SB(1, 1), cB + hstepB + kstep);
    PG8_WAIT_V(6); PG8_BAR;
#endif
    for (;;) {
        const bool has_next = S.next(ui + 1, nxt);
        const char* nA = has_next ? nxt.A : cA; const char* nB = has_next ? nxt.B : cB;
        unsigned np0 = cp0, np1 = cp1;
        if (has_next) PG8_RIDX(nxt, np0, np1);
        for (int t = 0; t < nt; t += 2) {
            const bool last = (t == nt - 2);
            const char* a1 = cA + (size_t)(t + 1) * kstep;
            const char* a2 = last ? nA : cA + (size_t)(t + 2) * kstep; const char* b2 = last ? nB : cB + (size_t)(t + 2) * kstep;
            const char* a3 = a2 + kstep; const char* b3 = b2 + kstep;
            unsigned xp0 = cp0, xp1 = cp1;
            if (GATHER && last) { asm volatile("" : "+v"(np0), "+v"(np1)); xp0 = np0; xp1 = np1; }
#if PG8_SP2
            const bool after_epi = (Epi::NSTORE > 0) && (t == 0) && (ui > 0);
            PG8_LDB(B0, 0, 0); PG8_LDB(B1, 0, 1); PG8_SCHED; PG8_LDA(At, 0, 0); PG8_STAGEA(PG8_SA(1, 1), a1, 1, cp0, cp1);
            if (after_epi) { if constexpr (Epi::NSTORE == 16) PG8_WAIT_V(24); else if constexpr (Epi::NSTORE == 8) PG8_WAIT_V(16); else PG8_WAIT_V(8); } else PG8_WAIT_V(8);
            PG8_WAIT_L(0); PG8_BAR; PG8_MMA(0, 0, At, B0); PG8_MMA(0, 1, At, B1); PG8_BAR; PG8_SCHED;
            PG8_LDA(At, 0, 1); PG8_STAGEB(PG8_SB(0, 0), b2); PG8_STAGEB(PG8_SB(0, 1), b2 + hstepB); PG8_STAGEA(PG8_SA(0, 0), a2, 0, xp0, xp1);
            if (after_epi) { if constexpr (Epi::NSTORE == 16) PG8_WAIT_V(24); else if constexpr (Epi::NSTORE == 8) PG8_WAIT_V(16); else PG8_WAIT_V(8); } else PG8_WAIT_V(8);
            PG8_WAIT_L(0); PG8_BAR; PG8_MMA(1, 0, At, B0); PG8_MMA(1, 1, At, B1); PG8_BAR; PG8_SCHED;
            PG8_LDB(B0, 1, 0); PG8_LDB(B1, 1, 1); PG8_SCHED; PG8_LDA(At, 1, 0); PG8_STAGEA(PG8_SA(0, 1), a2, 1, xp0, xp1);
            PG8_WAIT_V(8); PG8_WAIT_L(0); PG8_BAR; PG8_MMA(0, 0, At, B0); PG8_MMA(0, 1, At, B1); PG8_BAR; PG8_SCHED;
            PG8_LDA(At, 1, 1); PG8_STAGEB(PG8_SB(1, 0), b3); PG8_STAGEB(PG8_SB(1, 1), b3 + hstepB); PG8_STAGEA(PG8_SA(1, 0), a3, 0, xp0, xp1);
            PG8_WAIT_V(8); PG8_WAIT_L(0); PG8_BAR; PG8_MMA(1, 0, At, B0); PG8_MMA(1, 1, At, B1); PG8_BAR; PG8_SCHED;
#else
            PG8_LDB(B0, 0, 0); PG8_SCHED; PG8_LDA(At, 0, 0); PG8_STAGEA(PG8_SA(1, 1), a1, 1, cp0, cp1);
            PG8_WAIT_L(8); PG8_BAR; PG8_WAIT_L(0); PG8_MMA(0, 0, At, B0); PG8_BAR; PG8_SCHED;
            PG8_LDB(B1, 0, 1); PG8_STAGEB(PG8_SB(0, 0), b2);
            PG8_BAR; PG8_WAIT_L(0); PG8_MMA(0, 1, At, B1); PG8_BAR;
            PG8_LDA(At, 0, 1); PG8_STAGEA(PG8_SA(0, 0), a2, 0, xp0, xp1);
            PG8_BAR; PG8_WAIT_L(0); PG8_MMA(1, 0, At, B0); PG8_BAR; PG8_SCHED;
            PG8_STAGEB(PG8_SB(0, 1), b2 + hstepB);
            PG8_WAIT_V(6); PG8_BAR; PG8_MMA(1, 1, At, B1); PG8_BAR;
            PG8_LDB(B0, 1, 0); PG8_SCHED; PG8_LDA(At, 1, 0); PG8_STAGEA(PG8_SA(0, 1), a2, 1, xp0, xp1);
            PG8_WAIT_L(8); PG8_BAR; PG8_WAIT_L(0); PG8_MMA(0, 0, At, B0); PG8_BAR; PG8_SCHED;
            PG8_LDB(B1, 1, 1); PG8_STAGEB(PG8_SB(1, 0), b3);
            PG8_BAR; PG8_WAIT_L(0); PG8_MMA(0, 1, At, B1); PG8_BAR;
            PG8_LDA(At, 1, 1); PG8_STAGEA(PG8_SA(1, 0), a3, 0, xp0, xp1);
            PG8_BAR; PG8_WAIT_L(0); PG8_MMA(1, 0, At, B0); PG8_BAR; PG8_SCHED;
            PG8_STAGEB(PG8_SB(1, 1), b3 + hstepB);
            PG8_WAIT_V(6); PG8_BAR; PG8_MMA(1, 1, At, B1); PG8_BAR;
        #endif
        }
#if PG8_ALIGN
        if (wr == 0) PG8_BAR;
#endif
        E(acc, cur, wr, wc, fr, fq);
        if (!has_next) break;
#pragma unroll
        for (int a = 0; a < 2; ++a)
#pragma unroll
            for (int b = 0; b < 2; ++b)
#pragma unroll
                for (int m = 0; m < 4; ++m)
#pragma unroll
                    for (int n = 0; n < 2; ++n) acc[a][b][m][n] = (f32x4){0.f, 0.f, 0.f, 0.f};
        cur = nxt; cA = nA; cB = nB; cp0 = np0; cp1 = np1; ++ui;
#if PG8_ALIGN
        if (wr == 1) PG8_BAR;
#endif
    }
    PG8_WAIT_V(0);
#if !PG8_ALIGN
    if (wr == 0) PG8_BAR;
#endif
    PG8_BAR;
#undef PG8_SA
#undef PG8_SB
#undef PG8_STAGE2
#undef PG8_STAGEB
#undef PG8_LDA
#undef PG8_LDB
#undef PG8_MMA
#undef PG8_WAIT_V
#undef PG8_WAIT_L
#undef PG8_BAR
#undef PG8_SCHED
#undef PG8_RIDX
#undef PG8_STAGEA
}

struct EpiStoreBf16 {
    static constexpr bool PERM = true; static constexpr int NSTORE = 16;
    bf16_t* O; int ldc;
    DI void operator()(const f32x4 (&acc)[2][2][4][2], const GUnit& u, int wr, int wc, int fr, int fq) const {
        const int row0 = u.pm * BM + wr * 64 + fr, col0 = u.pn * BM + wc * 32 + 8 * fq;
#pragma unroll
        for (int ai = 0; ai < 2; ++ai)
#pragma unroll
            for (int m = 0; m < 4; ++m) { bf16_t* rowp = O + (size_t)(row0 + ai * HALF + m * 16) * ldc + col0;
#pragma unroll
                for (int bj = 0; bj < 2; ++bj) { const f32x4 v0 = acc[ai][bj][m][0], v1 = acc[ai][bj][m][1];
                    u32x4 w; w.x = pk2(v0[0], v0[1]); w.y = pk2(v0[2], v0[3]); w.z = pk2(v1[0], v1[1]); w.w = pk2(v1[2], v1[3]);
                    *(u32x4*)(rowp + bj * HALF) = w; } }
    }
};
template <int MODE> struct EpiGate {
    static constexpr bool PERM = true; static constexpr int NSTORE = 0;
    bf16_t* Y; const bf16_t* Zg; int gcol0;
    DI void operator()(const f32x4 (&acc)[2][2][4][2], const GUnit& u, int wr, int wc, int fr, int fq) const {
        const int row0 = u.pm * BM + wr * 64 + fr, col0 = u.pn * BM + wc * 32 + 8 * fq;
#pragma unroll
        for (int ai = 0; ai < 2; ++ai) {
            u32x4 g[4][2], o[4][2];
#pragma unroll
            for (int m = 0; m < 4; ++m) { const size_t row = (size_t)(row0 + ai * HALF + m * 16);
#pragma unroll
                for (int bj = 0; bj < 2; ++bj) { g[m][bj] = *(const u32x4*)(Zg + row * ZS + gcol0 + col0 + bj * HALF); if (MODE == 1) o[m][bj] = *(const u32x4*)(Y + row * D + col0 + bj * HALF); } }
#pragma unroll
            for (int m = 0; m < 4; ++m) { const size_t row = (size_t)(row0 + ai * HALF + m * 16); bf16_t* rowp = Y + row * D + col0;
#pragma unroll
                for (int bj = 0; bj < 2; ++bj) { const f32x4 v0 = acc[ai][bj][m][0], v1 = acc[ai][bj][m][1]; const u32x4 gg = g[m][bj];
                    float r[8];
                    r[0] = v0[0] * sigmoidf_(bf_lo(gg.x)); r[1] = v0[1] * sigmoidf_(bf_hi(gg.x)); r[2] = v0[2] * sigmoidf_(bf_lo(gg.y)); r[3] = v0[3] * sigmoidf_(bf_hi(gg.y));
                    r[4] = v1[0] * sigmoidf_(bf_lo(gg.z)); r[5] = v1[1] * sigmoidf_(bf_hi(gg.z)); r[6] = v1[2] * sigmoidf_(bf_lo(gg.w)); r[7] = v1[3] * sigmoidf_(bf_hi(gg.w));
                    if (MODE == 1) { const u32x4 oo = o[m][bj];
                        r[0] += bf_lo(oo.x); r[1] += bf_hi(oo.x); r[2] += bf_lo(oo.y); r[3] += bf_hi(oo.y); r[4] += bf_lo(oo.z); r[5] += bf_hi(oo.z); r[6] += bf_lo(oo.w); r[7] += bf_hi(oo.w); }
                    u32x4 w; w.x = pk2(r[0], r[1]); w.y = pk2(r[2], r[3]); w.z = pk2(r[4], r[5]); w.w = pk2(r[6], r[7]);
                    *(u32x4*)(rowp + bj * HALF) = w; } }
        }
    }
};
struct EpiResid {
    static constexpr bool PERM = false; static constexpr int NSTORE = 0;
    const float* xsrc; float* xdst; const float* csrc; float* cdst; const float* gate;
    DI void operator()(const f32x4 (&acc)[2][2][4][2], const GUnit& u, int wr, int wc, int fr, int fq) const {
        const int row0 = u.pm * BM + wr * 64 + fr, col0 = u.pn * BM + wc * 32 + 4 * fq;
        const bool isctx = (u.pm * BM) >= TL;
        const int mrow = isctx ? 8 : (u.pm * BM) / SEQ;
        const float* gp = gate + (size_t)mrow * 6144 + col0;
        f32x4 gv[2][2];
#pragma unroll
        for (int bj = 0; bj < 2; ++bj)
#pragma unroll
            for (int n = 0; n < 2; ++n) gv[bj][n] = *(const f32x4*)(gp + bj * HALF + n * 16);
        const float* sb = isctx ? csrc - (size_t)TL * D : xsrc; float* db = isctx ? cdst - (size_t)TL * D : xdst;
#pragma unroll
        for (int ai = 0; ai < 2; ++ai) {
            f32x4 s[4][2][2];
#pragma unroll
            for (int m = 0; m < 4; ++m) { const size_t off = (size_t)(row0 + ai * HALF + m * 16) * D + col0;
#pragma unroll
                for (int bj = 0; bj < 2; ++bj)
#pragma unroll
                    for (int n = 0; n < 2; ++n) s[m][bj][n] = *(const f32x4*)(sb + off + bj * HALF + n * 16); }
#pragma unroll
            for (int m = 0; m < 4; ++m) { const size_t off = (size_t)(row0 + ai * HALF + m * 16) * D + col0;
#pragma unroll
                for (int bj = 0; bj < 2; ++bj)
#pragma unroll
                    for (int n = 0; n < 2; ++n) *(f32x4*)(db + off + bj * HALF + n * 16) = s[m][bj][n] + gv[bj][n] * acc[ai][bj][m][n]; }
        }
    }
};
struct EpiSwiGLU {
    static constexpr bool PERM = true; static constexpr int NSTORE = 0;
    bf16_t* Hd;
    DI void operator()(const f32x4 (&acc)[2][2][4][2], const GUnit& u, int wr, int wc, int fr, int fq) const {
        const int r0 = wr * 64 + fr, col0 = u.pn * HALF + wc * 32 + 8 * fq;
#pragma unroll
        for (int ai = 0; ai < 2; ++ai)
#pragma unroll
            for (int m = 0; m < 4; ++m) { const int r = r0 + ai * HALF + m * 16;
                const f32x4 g0 = acc[ai][0][m][0], g1 = acc[ai][0][m][1], u0 = acc[ai][1][m][0], u1 = acc[ai][1][m][1];
                u32x4 w; w.x = pk2(siluf_(g0[0]) * u0[0], siluf_(g0[1]) * u0[1]); w.y = pk2(siluf_(g0[2]) * u0[2], siluf_(g0[3]) * u0[3]);
                w.z = pk2(siluf_(g1[0]) * u1[0], siluf_(g1[1]) * u1[1]); w.w = pk2(siluf_(g1[2]) * u1[2], siluf_(g1[3]) * u1[3]);
                if (r < u.valid) *(u32x4*)(Hd + (size_t)(u.aux + r) * FF + col0) = w; }
    }
};
DI unsigned pk4_fp8(float a, float b, float c, float d) { int p = 0; p = __builtin_amdgcn_cvt_pk_fp8_f32(a, b, p, false); p = __builtin_amdgcn_cvt_pk_fp8_f32(c, d, p, true); return (unsigned)p; }
struct EpiDown {
    static constexpr bool PERM = true; static constexpr int NSTORE = 0;
    unsigned char* Os; int rmask;
    DI void operator()(const f32x4 (&acc)[2][2][4][2], const GUnit& u, int wr, int wc, int fr, int fq) const {
        const int r0 = wr * 64 + fr, col0 = u.pn * BM + wc * 32 + 8 * fq;
#pragma unroll
        for (int ai = 0; ai < 2; ++ai)
#pragma unroll
            for (int m = 0; m < 4; ++m) { const int r = r0 + ai * HALF + m * 16; unsigned char* rowp = Os + (size_t)((u.aux + r) & rmask) * D + col0;
#pragma unroll
                for (int bj = 0; bj < 2; ++bj) { const f32x4 v0 = acc[ai][bj][m][0], v1 = acc[ai][bj][m][1];
                    u32x2 w; w.x = pk4_fp8(v0[0], v0[1], v0[2], v0[3]); w.y = pk4_fp8(v1[0], v1[1], v1[2], v1[3]);
                    if (r < u.valid) *(u32x2*)(rowp + bj * HALF) = w; } }
    }
};

template <int nN> struct RectSched {
    const char* A; const char* B; int lda, ldb; int nM, exM, exN, exPm0, G, c;
    DI bool next(int i, GUnit& u) const {
        const int L = i * G + c; const int nmain = nM * nN;
        int pm, pn;
        if (L < nmain) { const int W = (L & 7) * (nmain >> 3) + (L >> 3);
            const int grp = W / (8 * nN), rem = W % (8 * nN); pm = grp * 8 + (rem & 7); pn = rem >> 3; }
        else { const int L2 = L - nmain; if (L2 >= exM * exN) return false; pm = exPm0 + (L2 & 7); pn = L2 >> 3; }
        u.A = A + (size_t)pm * BM * lda * 2; u.B = B + (size_t)pn * BM * ldb * 2; u.rows = nullptr; u.pm = pm; u.pn = pn; u.valid = BM; u.aux = 0; return true;
    }
};
template <bool GATHER, int npn> struct MoeSched {
    const LAS int* tb; const LAS int* rb; const LAS int* cn;
    const char* A; const int* rowl; const char* B; size_t bstride; int lda, ldb, G, c;
    DI bool next(int i, GUnit& u) const {
        const int L0 = i * G + c; const int ntile = __builtin_amdgcn_readfirstlane(tb[NEX]); const int nwg = ntile * npn;
        if (L0 >= nwg) return false;
        const int q = nwg >> 3, rr = nwg & 7, xcd = L0 & 7, off = L0 >> 3;
        const int L = (xcd < rr ? xcd * (q + 1) : rr * (q + 1) + (xcd - rr) * q) + off;
        const int T = L / npn, pn = L % npn;
        const int e = __builtin_amdgcn_readfirstlane((int)((const LAS unsigned char*)(tb + 216))[T]);
        const int ti = T - __builtin_amdgcn_readfirstlane(tb[e]), row0 = __builtin_amdgcn_readfirstlane(rb[e]) + ti * BM;
        u.B = B + (size_t)e * bstride + (size_t)pn * BM * ldb * 2;
        if (GATHER) { u.A = A; u.rows = rowl + row0; } else { u.A = A + (size_t)row0 * lda * 2; u.rows = nullptr; }
        u.pm = T; u.pn = pn; const int rem = __builtin_amdgcn_readfirstlane(cn[e]) - ti * BM; u.valid = rem < BM ? rem : BM; u.aux = row0; return true;
    }
};
}

struct Args { const float* in[N_INPUTS]; float* out; unsigned char* ws; int ph_lo, ph_hi; };
struct Frame {
    LAS unsigned char* lds; unsigned char* ws; const float* const* in; float* out;
    int tid, lane, wave, G, bid;
};
DI const float* modp(const Frame& F, int l, int r, int which) { return (const float*)(F.ws + WS_MOD) + ((size_t)(l * 9 + r) * 6 + which) * 1024; }

DI void tr_item(const float* W, int ldw, bf16_t* WT, int ldt, int k0, int n0, int drow0, LAS float* scr, int lane) {
    float tmp[32];
#pragma unroll
    for (int i = 0; i < 32; ++i) { const int kk = 2 * i + (lane >> 5); tmp[i] = W[(size_t)(k0 + kk) * ldw + n0 + (lane & 31)]; }
#pragma unroll
    for (int i = 0; i < 32; ++i) { const int kk = 2 * i + (lane >> 5); scr[kk * 33 + (lane & 31)] = tmp[i]; }
    asm volatile("s_waitcnt lgkmcnt(0)" ::: "memory");
    const int c = lane & 7;
#pragma unroll
    for (int j = 0; j < 4; ++j) { const int n = (lane >> 3) + 8 * j; const LAS float* s = scr + (8 * c) * 33 + n;
        u32x4 o; o.x = pk2(s[0 * 33], s[1 * 33]); o.y = pk2(s[2 * 33], s[3 * 33]); o.z = pk2(s[4 * 33], s[5 * 33]); o.w = pk2(s[6 * 33], s[7 * 33]);
        *(u32x4*)(WT + (size_t)(drow0 + n) * ldt + k0 + 8 * c) = o; }
    asm volatile("s_waitcnt lgkmcnt(0)" ::: "memory");
}
template <int K, int N> DI void conv_plain(const Frame& F, const float* W, bf16_t* WT, int rot, int blk0 = 0) {
    LAS float* scr = (LAS float*)(F.lds + F.wave * 16384);
    const int NGW = (F.G - blk0) * 8, gw = ((F.bid - blk0) * 8 + F.wave + rot) % NGW;
    constexpr int nblk = N / 32, nit = (K / 64) * nblk;
    for (int it = gw; it < nit; it += NGW) { const int kb = it / nblk, nb = it % nblk; tr_item(W, N, WT, K, kb * 64, nb * 32, nb * 32, scr, F.lane); }
}
DI void conv_gu(const Frame& F, int l, bf16_t* WT) {
    LAS float* scr = (LAS float*)(F.lds + F.wave * 16384);
    const int NGW = F.G * 8, gw = F.bid * 8 + F.wave;
    const int nit = NEX * 2 * 128;
    for (int it = gw; it < nit; it += NGW) {
        const int e = it / 256, r = it % 256, isup = r / 128, r2 = r % 128, kb = r2 / 8, nb = r2 % 8, n0 = nb * 32;
        const float* W = (e < NE) ? F.in[isup ? I_WEU : I_WEG] + ((size_t)l * NE + e) * D * FF : F.in[isup ? I_WSU : I_WSG] + (size_t)l * D * FF;
        const int drow0 = ((n0 >> 7) << 8) + (n0 & 127) + (isup ? 128 : 0);
        tr_item(W, FF, WT + (size_t)e * 512 * D, D, kb * 64, n0, drow0, scr, F.lane);
    }
}
DI void conv_down(const Frame& F, int l, bf16_t* WT) {
    LAS float* scr = (LAS float*)(F.lds + F.wave * 16384);
    const int NGW = F.G * 8, gw = F.bid * 8 + F.wave;
    const int nit = NEX * 128;
    for (int it = gw; it < nit; it += NGW) {
        const int e = it / 128, r = it % 128, kb = r / 32, nb = r % 32;
        const float* W = (e < NE) ? F.in[I_WED] + ((size_t)l * NE + e) * FF * D : F.in[I_WSD] + (size_t)l * FF * D;
        tr_item(W, D, WT + (size_t)e * D * FF, FF, kb * 64, nb * 32, nb * 32, scr, F.lane);
    }
}
DI size_t wbs_base(int l) { return l == 0 ? WS_WBS : WS_WBS1; }
DI void conv_small(const Frame& F, int l, int blk0 = 0) {
    if (F.bid < blk0) return;
    bf16_t* wb = (bf16_t*)(F.ws + wbs_base(l));
    conv_plain<D, NIN>(F, F.in[I_WIN] + (size_t)l * D * NIN, (bf16_t*)((char*)wb + WB_WIN), 0, blk0);
    conv_plain<512, D>(F, F.in[I_WNA] + (size_t)l * 512 * D, (bf16_t*)((char*)wb + WB_WNA), 600, blk0);
    conv_plain<512, D>(F, F.in[I_WSC] + (size_t)l * 512 * D, (bf16_t*)((char*)wb + WB_WSC), 900, blk0);
    conv_plain<D, D>(F, F.in[I_WGLA] + (size_t)l * D * D, (bf16_t*)((char*)wb + WB_WGLA), 1200, blk0);
    conv_plain<D, D>(F, F.in[I_WOUT] + (size_t)l * D * D, (bf16_t*)((char*)wb + WB_WOUT), 1700, blk0);
    u32x4* z = (u32x4*)((char*)wb + WB_WIN + (size_t)NIN * D * 2);
    const int nz = (ZS - NIN) * D * 2 / 16;
    unsigned zz = 0u; asm volatile("" : "+v"(zz));
    for (int i = (F.bid - blk0) * 512 + F.tid; i < nz; i += (F.G - blk0) * 512) z[i] = (u32x4){zz, zz, zz, zz};
}
DI void conv_gate_w(const Frame& F) {
    bf16_t* wt = (bf16_t*)(F.ws + WS_W2TG);
    for (int i = F.bid * 512 + F.tid; i < 2 * 2 * 512 * 16; i += F.G * 512) { const int ld = i >> 13, rr = i & 8191, d = rr >> 4, ii = rr & 15; wt[i] = f2bf(F.in[I_GGW][((size_t)ld * 16 + ii) * 512 + d]); }
}
DI void conv_router(const Frame& F) {
    bf16_t* wrt = (bf16_t*)(F.ws + WS_WRT);
    for (int i = F.bid * 512 + F.tid; i < 2 * NE * D; i += F.G * 512) {
        const int l = i / (NE * D), r = i % (NE * D), e = r / D, k = r % D;
        const float w = F.in[I_WR][(size_t)l * D * NE + (size_t)k * NE + e];
        const bf16_t hi = f2bf(w); const bf16_t lo = f2bf(w - bf2f(hi));
        wrt[((size_t)(l * 2 + 0) * NE + e) * D + k] = hi; wrt[((size_t)(l * 2 + 1) * NE + e) * D + k] = lo;
    }
}
DI void mod_vectors(const Frame& F) {
    float* mod = (float*)(F.ws + WS_MOD);
    LAS float* SL = (LAS float*)F.lds;
    LAS float* PART = SL + 9 * 1024;
    __syncthreads();
    for (int i = F.tid; i < 9 * 1024; i += 512) { const float c = (i < 8 * 1024) ? F.in[I_C][i] : F.in[I_CCTX][i - 8 * 1024]; SL[i] = siluf_(c); }
    __syncthreads();
    for (int it = F.bid; it < 2 * 96; it += F.G) {
        const int l = it / 96, cb = it % 96, j = cb * 64 + F.lane;
        const float* W = F.in[I_WMOD] + (size_t)l * D * 6144 + j;
        float acc[9];
#pragma unroll
        for (int q = 0; q < 9; ++q) acc[q] = 0.f;
#pragma unroll 8
        for (int k = F.wave * 128; k < F.wave * 128 + 128; ++k) {
            const float w = W[(size_t)k * 6144];
#pragma unroll
            for (int q = 0; q < 9; ++q) acc[q] += SL[q * 1024 + k] * w;
        }
#pragma unroll
        for (int q = 0; q < 9; ++q) PART[(F.wave * 9 + q) * 64 + F.lane] = acc[q];
        __syncthreads();
        for (int q = F.wave; q < 9; q += 8) {
            float s = F.in[I_BMOD][l * 6144 + j];
#pragma unroll
            for (int w = 0; w < 8; ++w) s += PART[(w * 9 + q) * 64 + F.lane];
            mod[((size_t)(l * 9 + q)) * 6144 + j] = s;
        }
        __syncthreads();
    }
}

DI void load_row_f32(const float* p, int lane, float (&v)[16]) {
#pragma unroll
    for (int i = 0; i < 2; ++i) { const f32x4 a = *(const f32x4*)(p + 8 * lane + 512 * i), b = *(const f32x4*)(p + 8 * lane + 512 * i + 4);
        v[8 * i + 0] = a[0]; v[8 * i + 1] = a[1]; v[8 * i + 2] = a[2]; v[8 * i + 3] = a[3]; v[8 * i + 4] = b[0]; v[8 * i + 5] = b[1]; v[8 * i + 6] = b[2]; v[8 * i + 7] = b[3]; }
}
DI void store_row_f32(float* p, int lane, const float (&v)[16]) {
#pragma unroll
    for (int i = 0; i < 2; ++i) { *(f32x4*)(p + 8 * lane + 512 * i) = (f32x4){v[8 * i], v[8 * i + 1], v[8 * i + 2], v[8 * i + 3]}; *(f32x4*)(p + 8 * lane + 512 * i + 4) = (f32x4){v[8 * i + 4], v[8 * i + 5], v[8 * i + 6], v[8 * i + 7]}; }
}
DI void load_row_bf16(const bf16_t* p, int lane, float (&v)[16]) {
#pragma unroll
    for (int i = 0; i < 2; ++i) { const u32x4 a = *(const u32x4*)(p + 8 * lane + 512 * i);
        v[8 * i + 0] = bf_lo(a.x); v[8 * i + 1] = bf_hi(a.x); v[8 * i + 2] = bf_lo(a.y); v[8 * i + 3] = bf_hi(a.y); v[8 * i + 4] = bf_lo(a.z); v[8 * i + 5] = bf_hi(a.z); v[8 * i + 6] = bf_lo(a.w); v[8 * i + 7] = bf_hi(a.w); }
}
DI void store_row_bf16(bf16_t* p, int lane, const float (&v)[16]) {
#pragma unroll
    for (int i = 0; i < 2; ++i) { u32x4 w; w.x = pk2(v[8 * i], v[8 * i + 1]); w.y = pk2(v[8 * i + 2], v[8 * i + 3]); w.z = pk2(v[8 * i + 4], v[8 * i + 5]); w.w = pk2(v[8 * i + 6], v[8 * i + 7]);
        *(u32x4*)(p + 8 * lane + 512 * i) = w; }
}
DI void norm_mod(const float (&x)[16], const float* g, const float* shift, const float* scale, int lane, float (&h)[16]) {
    float ss = 0.f;
#pragma unroll
    for (int i = 0; i < 16; ++i) ss += x[i] * x[i];
    const float rstd = rsqrtf(wave_sum(ss) * (1.0f / D) + RMS_EPS);
    float gg[16], sh[16], sc[16]; load_row_f32(g, lane, gg); load_row_f32(shift, lane, sh); load_row_f32(scale, lane, sc);
#pragma unroll
    for (int i = 0; i < 16; ++i) h[i] = x[i] * rstd * gg[i] * (1.0f + sc[i]) + sh[i];
}

DI void phase_norm1_first(const Frame& F) {
    const int NGW = F.G * 8, gw = F.bid * 8 + F.wave;
    bf16_t* H = (bf16_t*)(F.ws + WS_R2);
    for (int t = gw; t < TA; t += NGW) {
        const bool isctx = t >= TL; const int r = isctx ? 8 : t / SEQ;
        const float* xr = isctx ? F.in[I_CTX] + (size_t)(t - TL) * D : F.in[I_X] + (size_t)t * D;
        float x[16], h[16]; load_row_f32(xr, F.lane, x);
        norm_mod(x, F.in[I_G1], modp(F, 0, r, 0), modp(F, 0, r, 1), F.lane, h);
        store_row_bf16(H + (size_t)t * D, F.lane, h);
    }
}

DI void phase_conv(const Frame& F, int l, int M) {
    const bf16_t* Z = (const bf16_t*)(F.ws + WS_R1); bf16_t* O = (bf16_t*)(F.ws + WS_R1 + R1_O);
    const float* cw = F.in[I_CONVW] + (size_t)l * 3 * 512;
    for (int it = F.bid * 512 + F.tid; it < M * 64; it += F.G * 512) {
        const int t = it >> 6, c0 = (it & 63) * 8;
        const int L = (t >= TL) ? CTXL : SEQ, pos = (t >= TL) ? (t - TL) % CTXL : t % SEQ;
        const bf16_t* zr = Z + (size_t)t * ZS;
        float u0[8], u1[8], u2[8], bb[8];
        { const u32x4 c = *(const u32x4*)(zr + C_CSC + c0), x = *(const u32x4*)(zr + C_XSC + c0), b = *(const u32x4*)(zr + C_BSC + c0);
          u1[0] = bf_lo(c.x) * bf_lo(x.x); u1[1] = bf_hi(c.x) * bf_hi(x.x); u1[2] = bf_lo(c.y) * bf_lo(x.y); u1[3] = bf_hi(c.y) * bf_hi(x.y);
          u1[4] = bf_lo(c.z) * bf_lo(x.z); u1[5] = bf_hi(c.z) * bf_hi(x.z); u1[6] = bf_lo(c.w) * bf_lo(x.w); u1[7] = bf_hi(c.w) * bf_hi(x.w);
          bb[0] = bf_lo(b.x); bb[1] = bf_hi(b.x); bb[2] = bf_lo(b.y); bb[3] = bf_hi(b.y); bb[4] = bf_lo(b.z); bb[5] = bf_hi(b.z); bb[6] = bf_lo(b.w); bb[7] = bf_hi(b.w); }
        if (pos > 0) { const u32x4 c = *(const u32x4*)(zr - ZS + C_CSC + c0), x = *(const u32x4*)(zr - ZS + C_XSC + c0);
          u0[0] = bf_lo(c.x) * bf_lo(x.x); u0[1] = bf_hi(c.x) * bf_hi(x.x); u0[2] = bf_lo(c.y) * bf_lo(x.y); u0[3] = bf_hi(c.y) * bf_hi(x.y);
          u0[4] = bf_lo(c.z) * bf_lo(x.z); u0[5] = bf_hi(c.z) * bf_hi(x.z); u0[6] = bf_lo(c.w) * bf_lo(x.w); u0[7] = bf_hi(c.w) * bf_hi(x.w); }
        else {
#pragma unroll
            for (int j = 0; j < 8; ++j) u0[j] = 0.f; }
        if (pos < L - 1) { const u32x4 c = *(const u32x4*)(zr + ZS + C_CSC + c0), x = *(const u32x4*)(zr + ZS + C_XSC + c0);
          u2[0] = bf_lo(c.x) * bf_lo(x.x); u2[1] = bf_hi(c.x) * bf_hi(x.x); u2[2] = bf_lo(c.y) * bf_lo(x.y); u2[3] = bf_hi(c.y) * bf_hi(x.y);
          u2[4] = bf_lo(c.z) * bf_lo(x.z); u2[5] = bf_hi(c.z) * bf_hi(x.z); u2[6] = bf_lo(c.w) * bf_lo(x.w); u2[7] = bf_hi(c.w) * bf_hi(x.w); }
        else {
#pragma unroll
            for (int j = 0; j < 8; ++j) u2[j] = 0.f; }
        float o[8];
#pragma unroll
        for (int j = 0; j < 8; ++j) o[j] = bb[j] * (u0[j] * cw[c0 + j] + u1[j] * cw[512 + c0 + j] + u2[j] * cw[1024 + c0 + j]);
        u32x4 w; w.x = pk2(o[0], o[1]); w.y = pk2(o[2], o[3]); w.z = pk2(o[4], o[5]); w.w = pk2(o[6], o[7]);
        *(u32x4*)(O + (size_t)t * OS + 512 + c0) = w;
    }
}

#define MFMA32(a, b, c) __builtin_amdgcn_mfma_f32_32x32x16_bf16((a), (b), (c), 0, 0, 0)
DI int crow(int reg, int h) { return (reg & 3) + 8 * (reg >> 2) + 4 * h; }
DI bf16x8 pack_step(const f32x16& x, int s) {
    u32x4 p; p.x = pk2(x[8 * s], x[8 * s + 1]); p.y = pk2(x[8 * s + 2], x[8 * s + 3]); p.z = pk2(x[8 * s + 4], x[8 * s + 5]); p.w = pk2(x[8 * s + 6], x[8 * s + 7]);
    return __builtin_bit_cast(bf16x8, p);
}
DI bf16x8 cat4(u32x2 a, u32x2 b) { u32x4 p; p.x = a.x; p.y = a.y; p.z = b.x; p.w = b.y; return __builtin_bit_cast(bf16x8, p); }

typedef __attribute__((address_space(3))) s16x4 lds_s16x4;
DI bf16x8 tr8(const LAS bf16_t* p0, const LAS bf16_t* p1) {
    const s16x4 a = __builtin_amdgcn_ds_read_tr16_b64_v4i16((lds_s16x4*)p0), b = __builtin_amdgcn_ds_read_tr16_b64_v4i16((lds_s16x4*)p1);
    return (bf16x8){a[0], a[1], a[2], a[3], b[0], b[1], b[2], b[3]};
}
constexpr int NA_VS = 72;
constexpr int NA_TAB = 8 * NA_VS * 64 * 2;
constexpr float NA_L2E = 1.4426950408889634f;
constexpr int NA_KOFF = 0, NA_VOFF = 2 * 64 * NA_VS * 2;
constexpr int NA_TAB2 = 4 * 64 * NA_VS * 2;
DI void na_block_unit(const Frame& F, const bf16_t* Z, bf16_t* O, const LAS float* tab, int head, bool isctxu, int b, int rg) {
    const int tid = F.tid, lane = F.lane, wave = F.wave, r = lane & 31, h = lane >> 5;
    const int trq = (lane & 15) >> 2, trc = 16 * ((lane >> 4) & 1) + 4 * (lane & 3);
    LAS bf16_t* KR = (LAS bf16_t*)(F.lds + NA_KOFF); LAS bf16_t* VR = (LAS bf16_t*)(F.lds + NA_VOFF);
    const int qrow_g = isctxu ? 0 : 4 * rg + (wave >> 1), qcol0 = isctxu ? 0 : 32 * (wave & 1);
    const int qrow0 = isctxu ? TL + b * CTXL + 32 * wave : b * SEQ + qrow_g * 64 + qcol0;
    int rs = qrow_g - 4; rs = rs < 0 ? 0 : (rs > 24 ? 24 : rs);
    int rs_lo = 4 * rg - 4; rs_lo = rs_lo < 0 ? 0 : (rs_lo > 24 ? 24 : rs_lo); int rs_hi = 4 * rg + 3 - 4; rs_hi = rs_hi < 0 ? 0 : (rs_hi > 24 ? 24 : rs_hi);
    const int nwin = isctxu ? 0 : rs_hi + 8 - rs_lo, ntile = nwin + 4;
    const int winrow0 = b * SEQ + rs_lo * 64, ctxrow0 = TL + b * CTXL;
    bf16x8 qf[4];
    { const bf16_t* qp = Z + (size_t)(qrow0 + r) * ZS + C_QNA + head * 64 + 8 * h;
#pragma unroll
      for (int ks = 0; ks < 4; ++ks) qf[ks] = *(const bf16x8*)(qp + 16 * ks); }
    unsigned ix0[4], ix1[4];
    { const int qc = qcol0 + r; int cs = qc - 8; cs = cs < 0 ? 0 : (cs > 48 ? 48 : cs);
#pragma unroll
      for (int g = 0; g < 4; ++g) { unsigned p0 = 0u, p1 = 0u;
#pragma unroll
          for (int e = 0; e < 4; ++e) { const int kc0 = crow(4 * g + e, h), kc1 = 32 + kc0;
              int d0 = kc0 - qc; d0 = d0 < -15 ? -15 : (d0 > 15 ? 15 : d0); int d1 = kc1 - qc; d1 = d1 < -15 ? -15 : (d1 > 15 ? 15 : d1);
              const unsigned c0 = (kc0 < cs || kc0 >= cs + 16) ? 31u : (unsigned)(d0 + 15), c1 = (kc1 < cs || kc1 >= cs + 16) ? 31u : (unsigned)(d1 + 15);
              p0 |= c0 << (8 * e); p1 |= c1 << (8 * e); }
          ix0[g] = p0; ix1[g] = p1; } }
    f32x16 o0, o1;
#pragma unroll
    for (int i = 0; i < 16; ++i) { o0[i] = 0.f; o1[i] = 0.f; }
    float mrun = -1e30f, lrun = 0.f;
    const int lkey = tid >> 3, lseg = tid & 7;
#define NA_TROW(j_) ((j_) < nwin ? winrow0 + (j_) * 64 : ctxrow0 + ((j_) - nwin) * 64)
#define NA_LD(j_, kk_, vv_) do { const bf16_t* zp = Z + (size_t)(NA_TROW(j_) + lkey) * ZS + head * 64 + 8 * lseg; kk_ = *(const u32x4*)(zp + C_KNA); vv_ = *(const u32x4*)(zp + C_VNA); } while (0)
#define NA_ST(slot_, kk_, vv_) do { *(LAS u32x4*)(KR + ((slot_) * 64 + lkey) * NA_VS + 8 * lseg) = kk_; *(LAS u32x4*)(VR + ((slot_) * 64 + lkey) * NA_VS + 8 * lseg) = vv_; } while (0)
    u32x4 sk, sv;
    __syncthreads();
    NA_LD(0, sk, sv); NA_ST(0, sk, sv); NA_LD(1, sk, sv);
#pragma unroll 1
    for (int j = 0; j < ntile; ++j) {
        __syncthreads();
        if (j + 1 < ntile) { NA_ST((j + 1) & 1, sk, sv); const int j2 = j + 2 < ntile ? j + 2 : ntile - 1; NA_LD(j2, sk, sv); }
        const bool isw = j < nwin;
        const int krow_g = rs_lo + j;
        if (isw && (krow_g < rs || krow_g >= rs + 8)) continue;
        const LAS bf16_t* kt = KR + (j & 1) * 64 * NA_VS; const LAS bf16_t* vt = VR + (j & 1) * 64 * NA_VS;
        f32x16 s0, s1;
#pragma unroll
        for (int i = 0; i < 16; ++i) { s0[i] = 0.f; s1[i] = 0.f; }
#pragma unroll
        for (int ks = 0; ks < 4; ++ks) { const bf16x8 k0 = *(const LAS bf16x8*)(kt + r * NA_VS + 16 * ks + 8 * h), k1 = *(const LAS bf16x8*)(kt + (32 + r) * NA_VS + 16 * ks + 8 * h);
            s0 = MFMA32(k0, qf[ks], s0); s1 = MFMA32(k1, qf[ks], s1); }
        const int drow = isw ? (krow_g - qrow_g + 7) : 15;
        const LAS float* trow = tab + (head * 16 + drow) * 32;
#pragma unroll
        for (int g = 0; g < 4; ++g) asm volatile("" : "+v"(ix0[g]), "+v"(ix1[g]));
        float tmax = -1e30f;
#pragma unroll
        for (int i = 0; i < 16; ++i) {
            const float a = s0[i] * (0.125f * NA_L2E) + trow[(ix0[i >> 2] >> (8 * (i & 3))) & 0xffu];
            const float bq = s1[i] * (0.125f * NA_L2E) + trow[(ix1[i >> 2] >> (8 * (i & 3))) & 0xffu];
            s0[i] = a; s1[i] = bq; tmax = fmaxf(tmax, fmaxf(a, bq));
        }
        tmax = fmaxf(tmax, __shfl_xor(tmax, 32));
        const float mnew = fmaxf(mrun, tmax), alpha = __builtin_amdgcn_exp2f(mrun - mnew);
        float psum = 0.f;
#pragma unroll
        for (int i = 0; i < 16; ++i) { const float a = __builtin_amdgcn_exp2f(s0[i] - mnew), bq = __builtin_amdgcn_exp2f(s1[i] - mnew); s0[i] = a; s1[i] = bq; psum += a + bq; }
        psum += __shfl_xor(psum, 32);
        lrun = lrun * alpha + psum; mrun = mnew;
#pragma unroll
        for (int i = 0; i < 16; ++i) { o0[i] *= alpha; o1[i] *= alpha; }
#pragma unroll
        for (int nb = 0; nb < 2; ++nb)
#pragma unroll
            for (int s = 0; s < 2; ++s) {
                const bf16x8 pf = pack_step(nb ? s1 : s0, s);
                const LAS bf16_t* vp = vt + (32 * nb + 16 * s + 4 * h + trq) * NA_VS + trc;
                o0 = MFMA32(tr8(vp, vp + 8 * NA_VS), pf, o0); o1 = MFMA32(tr8(vp + 32, vp + 32 + 8 * NA_VS), pf, o1);
            }
    }
#undef NA_TROW
#undef NA_LD
#undef NA_ST
    const float inv = 1.0f / lrun;
    bf16_t* op = O + (size_t)(qrow0 + r) * OS + head * 64 + 4 * h;
#pragma unroll
    for (int g = 0; g < 4; ++g) {
        u32x2 w0, w1; w0.x = pk2(o0[4 * g] * inv, o0[4 * g + 1] * inv); w0.y = pk2(o0[4 * g + 2] * inv, o0[4 * g + 3] * inv);
        w1.x = pk2(o1[4 * g] * inv, o1[4 * g + 1] * inv); w1.y = pk2(o1[4 * g + 2] * inv, o1[4 * g + 3] * inv);
        *(u32x2*)(op + 8 * g) = w0; *(u32x2*)(op + 32 + 8 * g) = w1;
    }
}
DI void phase_na(const Frame& F, int l, bool ctx_out) {
    const bf16_t* Z = (const bf16_t*)(F.ws + WS_R1); bf16_t* O = (bf16_t*)(F.ws + WS_R1 + R1_O);
    LAS float* tab = (LAS float*)(F.lds + NA_TAB2);
    __syncthreads();
    for (int i = F.tid; i < 8 * 16 * 32; i += 512) { const int hh = i >> 9, dr = (i >> 5) & 15, dc = i & 31;
        tab[i] = (dr == 15) ? 0.f : ((dc == 31) ? -1e30f : F.in[I_RPB][(size_t)l * 8 * 15 * 31 + (hh * 15 + dr) * 31 + dc] * NA_L2E); }
    __syncthreads();
    const int nlat = NB * 8 * 8, ntot = nlat + (ctx_out ? NB * 8 : 0);
#pragma unroll 1
    for (int u = F.bid; u < ntot; u += F.G) {
        if (u < nlat) na_block_unit(F, Z, O, tab, u & 7, false, u >> 6, (u >> 3) & 7);
        else { const int v = u - nlat; na_block_unit(F, Z, O, tab, v & 7, true, v >> 3, 0); }
    }
    __syncthreads();
}

constexpr int GP_CUM = 0, GL_CUMS = 132, GP_W2T = 33792  , GP_B2 = GP_W2T + 2 * 128 * 24 * 2  , GP_SEG = GP_B2 + 1024  ;
DI size_t gl_chunk_row(int b, int cn) { return cn < 4 ? (size_t)(TL + b * CTXL + cn * 64) : (size_t)(b * SEQ + (cn - 4) * 64); }
DI void gla_prep(const Frame& F, int l, int task) {
    const int cn = task % 36, hd = (task / 36) & 3, b = task / 144;
    bf16_t* Z = (bf16_t*)(F.ws + WS_R1); bf16_t* O = (bf16_t*)(F.ws + WS_R1 + R1_O); float* DECB = (float*)(F.ws + WS_DECB);
    LAS float* CUM = (LAS float*)(F.lds + GP_CUM); LAS float* SEG = (LAS float*)(F.lds + GP_SEG);
    const int tid = F.tid, lane = F.lane, wave = F.wave, r = lane & 31, h = lane >> 5;
    const size_t row0 = gl_chunk_row(b, cn);
    const bf16_t* W2G = (const bf16_t*)(F.ws + WS_W2TG);
    __syncthreads();
    const int tt = tid >> 3, seg = tid & 7, d0 = seg * 16;
    const int atb = wave & 1, adb = wave >> 1;
    const bf16_t* zr = Z + (row0 + tt) * ZS;
    const u32x4 q0 = *(const u32x4*)(zr + C_QGLA + hd * 128 + d0), q1 = *(const u32x4*)(zr + C_QGLA + hd * 128 + d0 + 8);
    const u32x4 k0 = *(const u32x4*)(zr + C_KGLA + hd * 128 + d0), k1 = *(const u32x4*)(zr + C_KGLA + hd * 128 + d0 + 8);
    float qv[16], kv[16];
    qv[0] = bf_lo(q0.x); qv[1] = bf_hi(q0.x); qv[2] = bf_lo(q0.y); qv[3] = bf_hi(q0.y); qv[4] = bf_lo(q0.z); qv[5] = bf_hi(q0.z); qv[6] = bf_lo(q0.w); qv[7] = bf_hi(q0.w);
    qv[8] = bf_lo(q1.x); qv[9] = bf_hi(q1.x); qv[10] = bf_lo(q1.y); qv[11] = bf_hi(q1.y); qv[12] = bf_lo(q1.z); qv[13] = bf_hi(q1.z); qv[14] = bf_lo(q1.w); qv[15] = bf_hi(q1.w);
    kv[0] = bf_lo(k0.x); kv[1] = bf_hi(k0.x); kv[2] = bf_lo(k0.y); kv[3] = bf_hi(k0.y); kv[4] = bf_lo(k0.z); kv[5] = bf_hi(k0.z); kv[6] = bf_lo(k0.w); kv[7] = bf_hi(k0.w);
    kv[8] = bf_lo(k1.x); kv[9] = bf_hi(k1.x); kv[10] = bf_lo(k1.y); kv[11] = bf_hi(k1.y); kv[12] = bf_lo(k1.z); kv[13] = bf_hi(k1.z); kv[14] = bf_lo(k1.w); kv[15] = bf_hi(k1.w);
    __syncthreads();
#pragma unroll 1
    for (int dir = 0; dir < 2; ++dir) {
        {
            const int tl = 32 * atb + r, tn = dir ? 63 - tl : tl;
            const bf16x8 lrf = *(const bf16x8*)(Z + (row0 + tn) * ZS + C_GATE + dir * 16 + 8 * h);
            const bf16x8 w2f = *(const bf16x8*)(W2G + ((size_t)(l * 2 + dir) * 512 + hd * 128 + 32 * adb + r) * 16 + 8 * h);
            const float b2v = F.in[I_GGB][(size_t)(l * 2 + dir) * 512 + hd * 128 + 32 * adb + r];
            f32x16 ga;
#pragma unroll
            for (int i = 0; i < 16; ++i) ga[i] = 0.f;
            ga = MFMA32(lrf, w2f, ga);
            float sg[4];
#pragma unroll
            for (int g = 0; g < 4; ++g) {
                float run = 0.f;
#pragma unroll
                for (int e = 0; e < 4; ++e) { const float x = ga[4 * g + e] + b2v; run += (fminf(x, 0.f) - __logf(1.0f + __expf(-fabsf(x)))) * (1.0f / 16.0f); ga[4 * g + e] = run; }
                sg[g] = run;
            }
            float off = 0.f;
#pragma unroll
            for (int g = 0; g < 4; ++g) { const float ps = __shfl_xor(sg[g], 32); const float o = off + (h ? ps : 0.f);
#pragma unroll
                for (int e = 0; e < 4; ++e) CUM[(32 * atb + 8 * g + 4 * h + e) * GL_CUMS + 32 * adb + r] = ga[4 * g + e] + o;
                off += sg[g] + ps; }
            if (h == 0) SEG[atb * 128 + 32 * adb + r] = off;
        }
        __syncthreads();
        {
            const int tau = dir ? 63 - tt : tt;
            float qs[16], ks[16];
#pragma unroll
            for (int j = 0; j < 4; ++j) {
                const f32x4 e0 = *(const LAS f32x4*)(SEG + d0 + 4 * j), e1 = *(const LAS f32x4*)(SEG + 128 + d0 + 4 * j);
                const f32x4 cl = *(const LAS f32x4*)(CUM + tau * GL_CUMS + d0 + 4 * j);
#pragma unroll
                for (int e = 0; e < 4; ++e) {
                    const float cum = cl[e] + (tau >= 32 ? e0[e] : 0.f);
                    const int jj = 4 * j + e;
                    const float ex = __expf(cum), inv = __builtin_amdgcn_rcpf(ex);
                    qs[jj] = qv[jj] * 0.08838834764831845f * ex;
                    ks[jj] = kv[jj] * inv;
                }
                if (tt == 0) { f32x4 dv;
#pragma unroll
                    for (int e = 0; e < 4; ++e) dv[e] = __expf(e0[e] + e1[e]);
                    *(f32x4*)(DECB + ((size_t)((b * 4 + hd) * 2 + dir) * 36 + cn) * 128 + d0 + 4 * j) = dv; }
            }
            bf16_t* qd = dir ? O + (row0 + tt) * OS + 1024 + hd * 128 + d0 : Z + (row0 + tt) * ZS + C_QGLA + hd * 128 + d0;
            bf16_t* kd = dir ? O + (row0 + tt) * OS + 1536 + hd * 128 + d0 : Z + (row0 + tt) * ZS + C_KGLA + hd * 128 + d0;
            u32x4 w;
            w.x = pk2(qs[0], qs[1]); w.y = pk2(qs[2], qs[3]); w.z = pk2(qs[4], qs[5]); w.w = pk2(qs[6], qs[7]); *(u32x4*)qd = w;
            w.x = pk2(qs[8], qs[9]); w.y = pk2(qs[10], qs[11]); w.z = pk2(qs[12], qs[13]); w.w = pk2(qs[14], qs[15]); *(u32x4*)(qd + 8) = w;
            w.x = pk2(ks[0], ks[1]); w.y = pk2(ks[2], ks[3]); w.z = pk2(ks[4], ks[5]); w.w = pk2(ks[6], ks[7]); *(u32x4*)kd = w;
            w.x = pk2(ks[8], ks[9]); w.y = pk2(ks[10], ks[11]); w.z = pk2(ks[12], ks[13]); w.w = pk2(ks[14], ks[15]); *(u32x4*)(kd + 8) = w;
        }
        __syncthreads();
    }
}
constexpr int GL_RS = 136, GL_VS = 72, GC_QS = 0, GC_KS = GC_QS + 2 * 64 * GL_RS * 2, GC_V = GC_KS + 2 * 64 * GL_RS * 2, GC_ST = GC_V + 2 * 64 * GL_VS * 2, GC_DEC = GC_ST + 2 * 128 * GL_VS * 2;
static_assert(GC_DEC + 2 * 128 * 4 <= MISC_OFF, "GLA chain LDS");
DI void gla_chain(const Frame& F, int l, int chain, bool ctx_out) {
    const int vs = chain & 3, dir = (chain >> 2) & 1, hd = (chain >> 3) & 3, b = chain >> 5;
    const bf16_t* Z = (const bf16_t*)(F.ws + WS_R1); const bf16_t* O = (const bf16_t*)(F.ws + WS_R1 + R1_O); const float* DECB = (const float*)(F.ws + WS_DECB);
    bf16_t* OD = (bf16_t*)(F.ws + WS_R2 + (dir ? R2_OB : 0));
    const int tid = F.tid, lane = F.lane, wave = F.wave, r = lane & 31, h = lane >> 5;
    const int trq = (lane & 15) >> 2, trc = 16 * ((lane >> 4) & 1) + 4 * (lane & 3);
    const int tau = tid >> 3, seg = tid & 7, d0 = seg * 16;
#define GL_CN(s_) ((s_) < 4 ? (dir ? 3 - (s_) : (s_)) : 4 + (dir ? 31 - ((s_) - 4) : ((s_) - 4)))
#define GL_ROW(s_, t_) (gl_chunk_row(b, GL_CN(s_)) + (dir ? 63 - (t_) : (t_)))
    const bf16_t* qbase = dir ? O + 1024 + hd * 128 + d0 : Z + C_QGLA + hd * 128 + d0; const bf16_t* kbase = dir ? O + 1536 + hd * 128 + d0 : Z + C_KGLA + hd * 128 + d0;
    const size_t qstr = dir ? OS : ZS;
    const bf16_t* vbase = Z + C_VGLA + hd * 256 + vs * 64 + seg * 8;
    const float* dbase = DECB + (size_t)((b * 4 + hd) * 2 + dir) * 36 * 128;
    __syncthreads();
    for (int i = tid; i < 128 * GL_VS / 2; i += 512) ((LAS unsigned*)(F.lds + GC_ST))[i] = 0u;
    f32x16 S0, S1;
#pragma unroll
    for (int i = 0; i < 16; ++i) { S0[i] = 0.f; S1[i] = 0.f; }
    u32x4 nq0, nq1, nk0, nk1, nvv; float ndec = 0.f;
#define GL_LOAD(s_) do { const size_t rw = GL_ROW(s_, tau); nq0 = *(const u32x4*)(qbase + rw * qstr); nq1 = *(const u32x4*)(qbase + rw * qstr + 8); nk0 = *(const u32x4*)(kbase + rw * qstr); nk1 = *(const u32x4*)(kbase + rw * qstr + 8); \
        nvv = *(const u32x4*)(vbase + rw * ZS); if (tid < 128) ndec = dbase[GL_CN(s_) * 128 + tid]; } while (0)
#define GL_PUT(p_) do { LAS bf16_t* qd = (LAS bf16_t*)(F.lds + GC_QS) + ((p_) * 64 + tau) * GL_RS + d0; LAS bf16_t* kd = (LAS bf16_t*)(F.lds + GC_KS) + ((p_) * 64 + tau) * GL_RS + d0; \
        *(LAS u32x4*)qd = nq0; *(LAS u32x4*)(qd + 8) = nq1; *(LAS u32x4*)kd = nk0; *(LAS u32x4*)(kd + 8) = nk1; *(LAS u32x4*)((LAS bf16_t*)(F.lds + GC_V) + ((p_) * 64 + tau) * GL_VS + seg * 8) = nvv; \
        if (tid < 128) ((LAS float*)(F.lds + GC_DEC))[(p_) * 128 + tid] = ndec; } while (0)
    GL_LOAD(0); GL_PUT(0); GL_LOAD(1);
    __syncthreads();
#pragma unroll 1
    for (int s = 0; s < 36; ++s) {
        const int p = s & 1;
        const bool emit = (s >= 4) || ctx_out;
        const LAS bf16_t* QS = (const LAS bf16_t*)(F.lds + GC_QS) + p * 64 * GL_RS; const LAS bf16_t* KS = (const LAS bf16_t*)(F.lds + GC_KS) + p * 64 * GL_RS;
        const LAS bf16_t* VV = (const LAS bf16_t*)(F.lds + GC_V) + p * 64 * GL_VS;
        const LAS bf16_t* STo = (const LAS bf16_t*)(F.lds + GC_ST) + p * 128 * GL_VS; LAS bf16_t* STn = (LAS bf16_t*)(F.lds + GC_ST) + (p ^ 1) * 128 * GL_VS;
        if (wave < 4) {
            if (emit) {
                const int vb = wave & 1, tb = wave >> 1;
                f32x16 a0, a1, oo, oi;
#pragma unroll
                for (int i = 0; i < 16; ++i) { a0[i] = 0.f; a1[i] = 0.f; oo[i] = 0.f; oi[i] = 0.f; }
#pragma unroll
                for (int kk = 0; kk < 8; ++kk) {
                    const bf16x8 qf = *(const LAS bf16x8*)(QS + (32 * tb + r) * GL_RS + 16 * kk + 8 * h);
                    const bf16x8 kf0 = *(const LAS bf16x8*)(KS + r * GL_RS + 16 * kk + 8 * h);
                    const LAS bf16_t* sp = STo + (16 * kk + 8 * h + trq) * GL_VS + 32 * vb + trc;
                    a0 = MFMA32(kf0, qf, a0);
                    oi = MFMA32(tr8(sp, sp + 4 * GL_VS), qf, oi);
                    if (tb == 1) { const bf16x8 kf1 = *(const LAS bf16x8*)(KS + (32 + r) * GL_RS + 16 * kk + 8 * h); a1 = MFMA32(kf1, qf, a1); }
                }
                const int tt = 32 * tb + r;
#pragma unroll
                for (int i = 0; i < 16; ++i) { const int sg0 = crow(i, h); if (sg0 > tt) a0[i] = 0.f; if (32 + sg0 > tt) a1[i] = 0.f; }
#pragma unroll
                for (int sb = 0; sb < 2; ++sb)
#pragma unroll
                    for (int st = 0; st < 2; ++st) {
                        if (sb == 1 && tb == 0) continue;
                        const bf16x8 pf = pack_step(sb ? a1 : a0, st);
                        const LAS bf16_t* vp = VV + (32 * sb + 16 * st + 4 * h + trq) * GL_VS + 32 * vb + trc;
                        oo = MFMA32(tr8(vp, vp + 8 * GL_VS), pf, oo);
                    }
#pragma unroll
                for (int i = 0; i < 16; ++i) oo[i] += oi[i];
                const size_t orow = GL_ROW(s, tt);
                bf16_t* op = OD + orow * D + hd * 256 + vs * 64 + 32 * vb + 4 * h;
#pragma unroll
                for (int g = 0; g < 4; ++g) { u32x2 w; w.x = pk2(oo[4 * g], oo[4 * g + 1]); w.y = pk2(oo[4 * g + 2], oo[4 * g + 3]); *(u32x2*)(op + 8 * g) = w; }
            }
        } else {
            const int db = wave - 4, dd = 32 * db + r;
            const float dec = ((const LAS float*)(F.lds + GC_DEC))[p * 128 + dd];
#pragma unroll
            for (int kk = 0; kk < 4; ++kk) {
                const LAS bf16_t* kp = KS + (16 * kk + 8 * h + trq) * GL_RS + 32 * db + trc;
                const LAS bf16_t* v0p = VV + (16 * kk + 8 * h + trq) * GL_VS + trc;
                const bf16x8 kf = tr8(kp, kp + 4 * GL_RS);
                S0 = MFMA32(tr8(v0p, v0p + 4 * GL_VS), kf, S0); S1 = MFMA32(tr8(v0p + 32, v0p + 32 + 4 * GL_VS), kf, S1);
            }
#pragma unroll
            for (int i = 0; i < 16; ++i) { S0[i] *= dec; S1[i] *= dec; }
#pragma unroll
            for (int g = 0; g < 4; ++g) {
                u32x2 w0, w1; w0.x = pk2(S0[4 * g], S0[4 * g + 1]); w0.y = pk2(S0[4 * g + 2], S0[4 * g + 3]); w1.x = pk2(S1[4 * g], S1[4 * g + 1]); w1.y = pk2(S1[4 * g + 2], S1[4 * g + 3]);
                *(LAS u32x2*)(STn + dd * GL_VS + 8 * g + 4 * h) = w0; *(LAS u32x2*)(STn + dd * GL_VS + 32 + 8 * g + 4 * h) = w1;
            }
        }
        if (s + 1 < 36) { GL_PUT(p ^ 1); const int s2 = s + 2 < 36 ? s + 2 : 35; GL_LOAD(s2); }
        __syncthreads();
    }
#undef GL_ROW
#undef GL_CN
#undef GL_LOAD
#undef GL_PUT
}
DI void phase_gla_fin(const Frame& F, int l, int M) {
    const int NGW = F.G * 8, gw = F.bid * 8 + F.wave, lane = F.lane;
    const bf16_t* Z = (const bf16_t*)(F.ws + WS_R1); bf16_t* O = (bf16_t*)(F.ws + WS_R1 + R1_O);
    const bf16_t* OFp = (const bf16_t*)(F.ws + WS_R2); const bf16_t* OBp = (const bf16_t*)(F.ws + WS_R2 + R2_OB);
    const float* gn = F.in[I_GNG] + (size_t)l * 256;
    for (int t = gw; t < M; t += NGW) {
        const u32x4 a0 = *(const u32x4*)(OFp + (size_t)t * D + 16 * lane), a1 = *(const u32x4*)(OFp + (size_t)t * D + 16 * lane + 8);
        const u32x4 b0 = *(const u32x4*)(OBp + (size_t)t * D + 16 * lane), b1 = *(const u32x4*)(OBp + (size_t)t * D + 16 * lane + 8);
        const u32x4 r0 = *(const u32x4*)(Z + (size_t)t * ZS + C_RGLA + 16 * lane), r1 = *(const u32x4*)(Z + (size_t)t * ZS + C_RGLA + 16 * lane + 8);
        float o[16], rr[16];
        o[0] = bf_lo(a0.x) + bf_lo(b0.x); o[1] = bf_hi(a0.x) + bf_hi(b0.x); o[2] = bf_lo(a0.y) + bf_lo(b0.y); o[3] = bf_hi(a0.y) + bf_hi(b0.y);
        o[4] = bf_lo(a0.z) + bf_lo(b0.z); o[5] = bf_hi(a0.z) + bf_hi(b0.z); o[6] = bf_lo(a0.w) + bf_lo(b0.w); o[7] = bf_hi(a0.w) + bf_hi(b0.w);
        o[8] = bf_lo(a1.x) + bf_lo(b1.x); o[9] = bf_hi(a1.x) + bf_hi(b1.x); o[10] = bf_lo(a1.y) + bf_lo(b1.y); o[11] = bf_hi(a1.y) + bf_hi(b1.y);
        o[12] = bf_lo(a1.z) + bf_lo(b1.z); o[13] = bf_hi(a1.z) + bf_hi(b1.z); o[14] = bf_lo(a1.w) + bf_lo(b1.w); o[15] = bf_hi(a1.w) + bf_hi(b1.w);
        rr[0] = bf_lo(r0.x); rr[1] = bf_hi(r0.x); rr[2] = bf_lo(r0.y); rr[3] = bf_hi(r0.y); rr[4] = bf_lo(r0.z); rr[5] = bf_hi(r0.z); rr[6] = bf_lo(r0.w); rr[7] = bf_hi(r0.w);
        rr[8] = bf_lo(r1.x); rr[9] = bf_hi(r1.x); rr[10] = bf_lo(r1.y); rr[11] = bf_hi(r1.y); rr[12] = bf_lo(r1.z); rr[13] = bf_hi(r1.z); rr[14] = bf_lo(r1.w); rr[15] = bf_hi(r1.w);
        float ss = 0.f;
#pragma unroll
        for (int i = 0; i < 16; ++i) ss += o[i] * o[i];
        ss += __shfl_xor(ss, 1); ss += __shfl_xor(ss, 2); ss += __shfl_xor(ss, 4); ss += __shfl_xor(ss, 8);
        const float rstd = rsqrtf(ss * (1.0f / 256.0f) + RMS_EPS);
        const int v0 = (lane & 15) * 16;
        float y[16];
#pragma unroll
        for (int i = 0; i < 16; ++i) y[i] = o[i] * rstd * gn[v0 + i] * siluf_(rr[i]);
        u32x4 w0, w1; w0.x = pk2(y[0], y[1]); w0.y = pk2(y[2], y[3]); w0.z = pk2(y[4], y[5]); w0.w = pk2(y[6], y[7]);
        w1.x = pk2(y[8], y[9]); w1.y = pk2(y[10], y[11]); w1.z = pk2(y[12], y[13]); w1.w = pk2(y[14], y[15]);
        *(u32x4*)(O + (size_t)t * OS + 1024 + 16 * lane) = w0; *(u32x4*)(O + (size_t)t * OS + 1024 + 16 * lane + 8) = w1;
    }
}

constexpr int RT_HS = 1032;
template <bool DRY = false> DI void phase_router(const Frame& F, int l, int M) {
    LAS bf16_t* HH = (LAS bf16_t*)F.lds;
    LAS bf16_t* HL = HH + 32 * RT_HS;
    LAS float* H2F = (LAS float*)F.lds;
    bf16_t* H2 = (bf16_t*)(F.ws + WS_R1 + R1_H2);
    const float* xres = F.out; const float* cres = (const float*)(F.ws + WS_CTXS);
    const bf16_t* WRH = (const bf16_t*)(F.ws + WS_WRT) + (size_t)(l * 2) * NE * D; const bf16_t* WRL = WRH + (size_t)NE * D;
    int* toke = (int*)(F.ws + WS_TOKE); int* tokp = (int*)(F.ws + (DRY ? WS_TOKR : WS_TOKP)); float* tokw = (float*)(F.ws + WS_TOKW);
    unsigned* cnt = (unsigned*)(F.ws + WS_CTL) + CW_CNT + 4096 * l + (DRY ? 32 : 0);
    const int lane = F.lane, wave = F.wave, r = lane & 31, hh = lane >> 5;
    const float brt = F.in[I_BR][l * NE + lane];
    const int npass = (M + 31) / 32;
    float xr[4][16];
#pragma unroll
    for (int rr = 0; rr < 4; ++rr) { const int t = F.bid * 32 + 4 * wave + rr;
        if (F.bid < npass && t < M) load_row_f32(t >= TL ? cres + (size_t)(t - TL) * D : xres + (size_t)t * D, lane, xr[rr]);
        else {
#pragma unroll
            for (int i = 0; i < 16; ++i) xr[rr][i] = 0.f; } }
    float gg[16]; load_row_f32(F.in[I_G2] + (size_t)l * D, lane, gg);
#pragma unroll 1
    for (int ps = F.bid; ps < npass; ps += F.G) {
        __syncthreads();
        { const int t0 = ps * 32; const int mr = t0 >= TL ? 8 : t0 / SEQ;
          float sh[16], sc[16]; load_row_f32(modp(F, l, mr, 3), lane, sh); load_row_f32(modp(F, l, mr, 4), lane, sc);
#pragma unroll
          for (int rr = 0; rr < 4; ++rr) {
            const int row = 4 * wave + rr, t = ps * 32 + row;
            float h[16]; float ss = 0.f;
#pragma unroll
            for (int i = 0; i < 16; ++i) ss += xr[rr][i] * xr[rr][i];
            const float rstd = rsqrtf(wave_sum(ss) * (1.0f / D) + RMS_EPS);
#pragma unroll
            for (int i = 0; i < 16; ++i) h[i] = (t < M) ? xr[rr][i] * rstd * gg[i] * (1.0f + sc[i]) + sh[i] : 0.f;
            if (t < M) store_row_bf16(H2 + (size_t)t * D, lane, h);
#pragma unroll
            for (int i = 0; i < 2; ++i) {
                u32x4 whi; whi.x = pk2(h[8 * i], h[8 * i + 1]); whi.y = pk2(h[8 * i + 2], h[8 * i + 3]); whi.z = pk2(h[8 * i + 4], h[8 * i + 5]); whi.w = pk2(h[8 * i + 6], h[8 * i + 7]);
                u32x4 wlo; wlo.x = pk2(h[8 * i] - bf_lo(whi.x), h[8 * i + 1] - bf_hi(whi.x)); wlo.y = pk2(h[8 * i + 2] - bf_lo(whi.y), h[8 * i + 3] - bf_hi(whi.y));
                wlo.z = pk2(h[8 * i + 4] - bf_lo(whi.z), h[8 * i + 5] - bf_hi(whi.z)); wlo.w = pk2(h[8 * i + 6] - bf_lo(whi.w), h[8 * i + 7] - bf_hi(whi.w));
                *(LAS u32x4*)(HH + row * RT_HS + 8 * lane + 512 * i) = whi; *(LAS u32x4*)(HL + row * RT_HS + 8 * lane + 512 * i) = wlo; }
          }
          const int pn = ps + F.G;
#pragma unroll
          for (int rr = 0; rr < 4; ++rr) { const int t = pn * 32 + 4 * wave + rr;
              if (pn < npass && t < M) load_row_f32(t >= TL ? cres + (size_t)(t - TL) * D : xres + (size_t)t * D, lane, xr[rr]); }
        }
        __syncthreads();
        f32x16 a0, a1;
#pragma unroll
        for (int i = 0; i < 16; ++i) { a0[i] = 0.f; a1[i] = 0.f; }
        {
            const LAS bf16_t* hp = HH + r * RT_HS + 128 * wave + 8 * hh; const LAS bf16_t* lp = HL + r * RT_HS + 128 * wave + 8 * hh;
            const bf16_t* w0h = WRH + (size_t)r * D + 128 * wave + 8 * hh; const bf16_t* w1h = w0h + (size_t)32 * D;
            const bf16_t* w0l = WRL + (size_t)r * D + 128 * wave + 8 * hh; const bf16_t* w1l = w0l + (size_t)32 * D;
#pragma unroll
            for (int ks = 0; ks < 8; ++ks) {
                const bf16x8 ah = *(const LAS bf16x8*)(hp + 16 * ks), al = *(const LAS bf16x8*)(lp + 16 * ks);
                const bf16x8 b0h = *(const bf16x8*)(w0h + 16 * ks), b1h = *(const bf16x8*)(w1h + 16 * ks), b0l = *(const bf16x8*)(w0l + 16 * ks), b1l = *(const bf16x8*)(w1l + 16 * ks);
                a0 = MFMA32(ah, b0h, a0); a1 = MFMA32(ah, b1h, a1);
                a0 = MFMA32(al, b0h, a0); a1 = MFMA32(al, b1h, a1);
                a0 = MFMA32(ah, b0l, a0); a1 = MFMA32(ah, b1l, a1);
            }
        }
        __syncthreads();
#pragma unroll
        for (int i = 0; i < 16; ++i) { const int tk = crow(i, hh); H2F[(wave * 32 + tk) * 64 + r] = a0[i]; H2F[(wave * 32 + tk) * 64 + 32 + r] = a1[i]; }
        __syncthreads();
        LAS unsigned* lcnt = (LAS unsigned*)(F.lds + MISC_OFF + 2048);
        if (F.tid < 64) lcnt[F.tid] = 0u;
        __syncthreads();
        int myj[4]; unsigned mylp[4]; float myw[4];
#pragma unroll
        for (int rr = 0; rr < 4; ++rr) {
            const int row = 4 * wave + rr, t = ps * 32 + row;
            myj[rr] = -1; mylp[rr] = 0u; myw[rr] = 0.f;
            if (t >= M) continue;
            float logit = 0.f;
#pragma unroll
            for (int w = 0; w < 8; ++w) logit += H2F[(w * 32 + row) * 64 + lane];
            const float score = sigmoidf_(logit), sel = score + brt;
            float g1 = sel; g1 = fmaxf(g1, __shfl_xor(g1, 1)); g1 = fmaxf(g1, __shfl_xor(g1, 2)); g1 = fmaxf(g1, __shfl_xor(g1, 4));
            const unsigned long long bm = __ballot(sel == g1);
            const unsigned gm = (unsigned)((bm >> (lane & ~7)) & 0xffull);
            const int first = __builtin_ctz(gm);
            float g2 = ((lane & 7) == first) ? -INFINITY : sel; g2 = fmaxf(g2, __shfl_xor(g2, 1)); g2 = fmaxf(g2, __shfl_xor(g2, 2)); g2 = fmaxf(g2, __shfl_xor(g2, 4));
            const float gs = g1 + g2; const int g = lane >> 3;
            int grank = 0;
#pragma unroll
            for (int j = 0; j < 8; ++j) { const float o = __shfl(gs, 8 * j); grank += (o > gs || (o == gs && j < g)) ? 1 : 0; }
            const bool gsel = grank < 4;
            const float ms = gsel ? sel : -INFINITY;
            int rank = 0;
#pragma unroll 4
            for (int j = 0; j < 64; ++j) { const float o = __int_as_float(__builtin_amdgcn_readlane(__float_as_int(ms), j)); rank += (o > ms || (o == ms && j < lane)) ? 1 : 0; }
            const bool chosen = gsel && rank < 8;
            const unsigned long long cb = __ballot(chosen);
            const float ssum = wave_sum(chosen ? score : 0.f);
            if (chosen) {
                const int j = __builtin_popcountll(cb & ((1ull << lane) - 1ull));
                if (j < 8) { myj[rr] = j; mylp[rr] = __hip_atomic_fetch_add(&lcnt[lane], 1u, __ATOMIC_RELAXED, __HIP_MEMORY_SCOPE_WORKGROUP); myw[rr] = score * __builtin_amdgcn_rcpf(ssum) * 2.5f; }
            }
        }
        __syncthreads();
        if (F.tid < 64) { const unsigned c = lcnt[F.tid]; lcnt[64 + F.tid] = c ? atomicAdd(cnt + F.tid * 64, c) : 0u; }
        __syncthreads();
#pragma unroll
        for (int rr = 0; rr < 4; ++rr) {
            const int t = ps * 32 + 4 * wave + rr;
            if (myj[rr] >= 0) { const size_t o = (size_t)t * 8 + myj[rr]; toke[o] = lane; tokp[o] = (int)(lcnt[64 + lane] + mylp[rr]); tokw[o] = myw[rr]; }
        }
    }
    __syncthreads();
}
DI void moe_tables(const Frame& F, int l, int M) {
    LAS int* tb = (LAS int*)(F.lds + MISC_OFF + 64); LAS int* rb = tb + 72; LAS int* cn = rb + 72;
    const unsigned* cnt = (const unsigned*)(F.ws + WS_CTL) + CW_CNT + 4096 * l;
    __syncthreads();
    if (F.tid < NE) cn[F.tid] = (int)__hip_atomic_load(cnt + F.tid * 64, __ATOMIC_RELAXED, __HIP_MEMORY_SCOPE_AGENT);
    if (F.tid == NE) cn[NE] = M;
    __syncthreads();
    if (F.tid == 0) { int t = 0, r = 0; for (int e = 0; e < NEX; ++e) { tb[e] = t; rb[e] = r; t += (cn[e] + 255) >> 8; r += cn[e]; } tb[NEX] = t; }
    __syncthreads();
    LAS unsigned char* te = (LAS unsigned char*)(cn + 72);
    if (F.tid < NEX) { const int t0 = tb[F.tid], t1 = tb[F.tid + 1]; for (int t = t0; t < t1; ++t) te[t] = (unsigned char)F.tid; }
    __syncthreads();
}
DI void phase_route_tables(const Frame& F, int l, int M) {
    moe_tables(F, l, M);
    const LAS int* rb = (const LAS int*)(F.lds + MISC_OFF + 64) + 72;
    const int* toke = (const int*)(F.ws + WS_TOKE); const int* tokp = (const int*)(F.ws + WS_TOKP);
    int* tokr = (int*)(F.ws + WS_TOKR); int* rowl = (int*)(F.ws + WS_ROWL);
    for (int i = F.bid * 512 + F.tid; i < M * 8; i += F.G * 512) { const int row = rb[toke[i]] + tokp[i]; tokr[i] = row; rowl[row] = i >> 3; }
    const int shb = rb[NE];
    for (int i = F.bid * 512 + F.tid; i < M + 256; i += F.G * 512) rowl[shb + i] = (i < M) ? i : 0;
}
template <bool DRY = false> DI void phase_combine(const Frame& F, int l, int M) {
    moe_tables(F, l, M);
    const LAS int* rb = (const LAS int*)(F.lds + MISC_OFF + 64) + 72;
    const int shb = rb[NE];
    const int gw = F.bid * 8 + F.wave, lane = F.lane;
    const unsigned char* OS_ = (const unsigned char*)(F.ws + WS_R1);
    const int* tokr = (const int*)(F.ws + WS_TOKR); const float* tokw = (const float*)(F.ws + WS_TOKW);
    float* xres = F.out; float* cres = (float*)(F.ws + WS_CTXS);
    bf16_t* H = (bf16_t*)(F.ws + WS_R2 + (DRY ? (size_t)40 * 1024 * 1024 : 0));
    const int per = M / (GRID * 8);
    const int tbeg = gw * per;
    int mr_cur = -1;
    float g2v[16], shv[16], scv[16], gnv[16];
    if (l == 0) load_row_f32(F.in[I_G1] + D, lane, gnv); else load_row_f32(F.in[I_GF], lane, gnv);
    int4 nr0, nr1; f32x4 nw0, nw1; float xn[16];
    { const int t = tbeg; nr0 = *(const int4*)(tokr + (size_t)t * 8); nr1 = *(const int4*)(tokr + (size_t)t * 8 + 4); nw0 = *(const f32x4*)(tokw + (size_t)t * 8); nw1 = *(const f32x4*)(tokw + (size_t)t * 8 + 4);
      load_row_f32(t >= TL ? cres + (size_t)(t - TL) * D : xres + (size_t)t * D, lane, xn); }
#pragma unroll 1
    for (int k = 0; k < per; ++k) {
        const int t = tbeg + k;
        const bool isctx = t >= TL; const int mr = isctx ? 8 : t / SEQ;
        if (mr != mr_cur) { mr_cur = mr; load_row_f32(modp(F, l, mr, 5), lane, g2v); if (l == 0) { load_row_f32(modp(F, 1, mr, 0), lane, shv); load_row_f32(modp(F, 1, mr, 1), lane, scv); } }
        const int rows[8] = {nr0.x, nr0.y, nr0.z, nr0.w, nr1.x, nr1.y, nr1.z, nr1.w};
        const float wts[8] = {nw0[0], nw0[1], nw0[2], nw0[3], nw1[0], nw1[1], nw1[2], nw1[3]};
        float x[16];
#pragma unroll
        for (int i = 0; i < 16; ++i) x[i] = xn[i];
        u32x2 v[9][2];
#pragma unroll
        for (int i = 0; i < 2; ++i) v[8][i] = *(const u32x2*)(OS_ + (size_t)(shb + t) * D + 8 * lane + 512 * i);
#pragma unroll
        for (int j = 0; j < 8; ++j)
#pragma unroll
            for (int i = 0; i < 2; ++i) v[j][i] = *(const u32x2*)(OS_ + (size_t)rows[j] * D + 8 * lane + 512 * i);
        if (k + 1 < per) { const int tn = t + 1; nr0 = *(const int4*)(tokr + (size_t)tn * 8); nr1 = *(const int4*)(tokr + (size_t)tn * 8 + 4); nw0 = *(const f32x4*)(tokw + (size_t)tn * 8); nw1 = *(const f32x4*)(tokw + (size_t)tn * 8 + 4);
            load_row_f32(tn >= TL ? cres + (size_t)(tn - TL) * D : xres + (size_t)tn * D, lane, xn); }
        float y[16];
#pragma unroll
        for (int i = 0; i < 2; ++i) { const u32x2 a = v[8][i];
            y[8 * i + 0] = __builtin_amdgcn_cvt_f32_fp8((int)a.x, 0); y[8 * i + 1] = __builtin_amdgcn_cvt_f32_fp8((int)a.x, 1); y[8 * i + 2] = __builtin_amdgcn_cvt_f32_fp8((int)a.x, 2); y[8 * i + 3] = __builtin_amdgcn_cvt_f32_fp8((int)a.x, 3);
            y[8 * i + 4] = __builtin_amdgcn_cvt_f32_fp8((int)a.y, 0); y[8 * i + 5] = __builtin_amdgcn_cvt_f32_fp8((int)a.y, 1); y[8 * i + 6] = __builtin_amdgcn_cvt_f32_fp8((int)a.y, 2); y[8 * i + 7] = __builtin_amdgcn_cvt_f32_fp8((int)a.y, 3); }
#pragma unroll
        for (int j = 0; j < DBG_NROUTED; ++j) { const float w = wts[j];
#pragma unroll
            for (int i = 0; i < 2; ++i) { const u32x2 a = v[j][i];
                y[8 * i + 0] += w * __builtin_amdgcn_cvt_f32_fp8((int)a.x, 0); y[8 * i + 1] += w * __builtin_amdgcn_cvt_f32_fp8((int)a.x, 1); y[8 * i + 2] += w * __builtin_amdgcn_cvt_f32_fp8((int)a.x, 2); y[8 * i + 3] += w * __builtin_amdgcn_cvt_f32_fp8((int)a.x, 3);
                y[8 * i + 4] += w * __builtin_amdgcn_cvt_f32_fp8((int)a.y, 0); y[8 * i + 5] += w * __builtin_amdgcn_cvt_f32_fp8((int)a.y, 1); y[8 * i + 6] += w * __builtin_amdgcn_cvt_f32_fp8((int)a.y, 2); y[8 * i + 7] += w * __builtin_amdgcn_cvt_f32_fp8((int)a.y, 3); } }
        float* xr = isctx ? cres + (size_t)(t - TL) * D : xres + (size_t)t * D;
#pragma unroll
        for (int i = 0; i < 16; ++i) x[i] += g2v[i] * y[i];
        float ss = 0.f;
#pragma unroll
        for (int i = 0; i < 16; ++i) ss += x[i] * x[i];
        const float rstd = rsqrtf(wave_sum(ss) * (1.0f / D) + RMS_EPS);
        if (l == 0) {
            if (!DRY) store_row_f32(xr, lane, x);
            float h[16];
#pragma unroll
            for (int i = 0; i < 16; ++i) h[i] = x[i] * rstd * gnv[i] * (1.0f + scv[i]) + shv[i];
            store_row_bf16(H + (size_t)t * D, lane, h);
        } else {
#pragma unroll
            for (int i = 0; i < 16; ++i) x[i] = x[i] * rstd * gnv[i];
            if (!DRY) store_row_f32(xr, lane, x); else store_row_bf16(H + (size_t)t * D, lane, x);
        }
    }
}

constexpr int PH_PER_LAYER = 10, N_PHASES = 2 + 2 * PH_PER_LAYER;
template <class T> DI T* opaque_ptr(T* p) {
    unsigned long long v = (unsigned long long)p; unsigned lo = (unsigned)v, hi = (unsigned)(v >> 32);
    asm volatile("" : "+s"(lo), "+s"(hi)); return (T*)(__attribute__((address_space(1))) T*)(((unsigned long long)hi << 32) | lo);
}
template <int KIND> DI void run_phase(const Frame& F0, const int l0) {
    Frame F = F0; int l = l0; asm volatile("" : "+s"(l));
    F.ws = opaque_ptr(F0.ws); F.out = opaque_ptr(F0.out);
    { int t = F0.tid; asm volatile("" : "+v"(t)); F.tid = t; F.lane = t & 63; F.wave = __builtin_amdgcn_readfirstlane(t >> 6); }
    unsigned char* const ws = F.ws;
    const bool ctx_out = (l == 0);
    const int M = ctx_out ? TA : TL;
    if constexpr (KIND == 0) { mod_vectors(F); conv_router(F); conv_gate_w(F); conv_small(F, 0); conv_down(F, 0, (bf16_t*)(ws + WS_WBS + WB_WD)); }
    if constexpr (KIND == 1) { phase_norm1_first(F); }
    if constexpr (KIND == 2) {
        pg8::RectSched<37> S{(const char*)(ws + WS_R2), (const char*)(ws + wbs_base(l) + WB_WIN), D, D, ctx_out ? 72 : 64, ctx_out ? 0 : 8, ctx_out ? 0 : 11, 64, F.G, F.bid};
        pg8::EpiStoreBf16 E{(bf16_t*)(ws + WS_R1), ZS};
        pg8::gemm_phase<false>(F.lds, F.tid, D, D, D, S, E);
    }
    if constexpr (KIND == 3) {
#pragma unroll 1
        for (int t = F.bid; t < NB * 4 * 36; t += F.G) gla_prep(F, l, t);
        phase_na(F, l, ctx_out);
        phase_conv(F, l, M);
    }
    if constexpr (KIND == 12) {
#pragma unroll 1
        for (int ch = F.bid; ch < 256; ch += F.G) gla_chain(F, l, ch, ctx_out);
    }
    if constexpr (KIND == 4) { phase_gla_fin(F, l, M); }
    if constexpr (KIND == 5) {
        const char* Ob = (const char*)(ws + WS_R1 + R1_O); bf16_t* Y = (bf16_t*)(ws + WS_R2); const bf16_t* Zb = (const bf16_t*)(ws + WS_R1);
        { pg8::RectSched<4> S{Ob, (const char*)(ws + wbs_base(l) + WB_WNA), OS, 512, M / 256, 0, 0, 0, F.G, F.bid}; pg8::EpiGate<0> E{Y, Zb, C_MERGE}; pg8::gemm_phase<false>(F.lds, F.tid, 512, OS, 512, S, E); }
        { pg8::RectSched<4> S{Ob + 512 * 2, (const char*)(ws + wbs_base(l) + WB_WSC), OS, 512, M / 256, 0, 0, 0, F.G, F.bid}; pg8::EpiGate<1> E{Y, Zb, C_MERGE + 1024}; pg8::gemm_phase<false>(F.lds, F.tid, 512, OS, 512, S, E); }
        { pg8::RectSched<4> S{Ob + 1024 * 2, (const char*)(ws + wbs_base(l) + WB_WGLA), OS, D, M / 256, 0, 0, 0, F.G, F.bid}; pg8::EpiGate<1> E{Y, Zb, C_MERGE + 2048}; pg8::gemm_phase<false>(F.lds, F.tid, D, OS, D, S, E); }
        if (l == 0) conv_small(F, 1, 32);
    }
    if constexpr (KIND == 6) {
        pg8::RectSched<4> S{(const char*)(ws + WS_R2), (const char*)(ws + wbs_base(l) + WB_WOUT), D, D, M / 256, 0, 0, 0, F.G, F.bid};
        pg8::EpiResid E{l == 0 ? F.in[I_X] : F.out, F.out, l == 0 ? F.in[I_CTX] : (const float*)(ws + WS_CTXS), (float*)(ws + WS_CTXS), modp(F, l, 0, 2)};
        pg8::gemm_phase<false>(F.lds, F.tid, D, D, D, S, E);
    }
    if constexpr (KIND == 7) {
#if REPEAT_KIND == 71
        phase_router<true>(F, l, M);
#endif
        phase_router(F, l, M); conv_gu(F, l, (bf16_t*)(ws + WS_R1));
#if REPEAT_KIND == 72
        conv_gu(F, l, (bf16_t*)(ws + WS_R1));
#endif
    }
    if constexpr (KIND == 8) { phase_route_tables(F, l, M); }
    if constexpr (KIND == 9) {
        moe_tables(F, l, M);
        const LAS int* tb = (const LAS int*)(F.lds + MISC_OFF + 64);
        pg8::MoeSched<true, 2> S{tb, tb + 72, tb + 144, (const char*)(ws + WS_R1 + R1_H2), (const int*)(ws + WS_ROWL), (const char*)(ws + WS_R1), (size_t)512 * D * 2, D, D, F.G, F.bid};
        pg8::EpiSwiGLU E{(bf16_t*)(ws + WS_R2)};
        pg8::gemm_phase<true>(F.lds, F.tid, D, D, D, S, E);
    }
    if constexpr (KIND == 10) {
        moe_tables(F, l, M);
        const LAS int* tb = (const LAS int*)(F.lds + MISC_OFF + 64);
        pg8::MoeSched<false, 4> S{tb, tb + 72, tb + 144, (const char*)(ws + WS_R2), nullptr, (const char*)(ws + WS_WBS + WB_WD), (size_t)D * FF * 2, FF, FF, F.G, F.bid};
        pg8::EpiDown E{(unsigned char*)(ws + WS_R1), 0x7fffffff};
        pg8::gemm_phase<false>(F.lds, F.tid, FF, FF, FF, S, E);
    }
    if constexpr (KIND == 11) {
#if REPEAT_KIND == 111
        phase_combine<true>(F, l, M);
#endif
        phase_combine(F, l, M); if (l == 0) conv_down(F, 1, (bf16_t*)(ws + WS_WBS + WB_WD));
    }
}
DI void make_frame(Frame& F, const Args& args, unsigned char* lds_raw) {
    F.lds = (LAS unsigned char*)lds_raw; F.ws = args.ws; F.in = args.in; F.out = args.out;
    F.tid = threadIdx.x; F.lane = F.tid & 63; F.wave = __builtin_amdgcn_readfirstlane(F.tid >> 6); F.G = GRID; F.bid = blockIdx.x;
}
template <int KIND> __global__ void __launch_bounds__(512, 2) fwd_k(Args args) {
    extern __shared__ __attribute__((aligned(16))) unsigned char lds_raw[];
    Frame F; make_frame(F, args, lds_raw);
    run_phase<KIND>(F, args.ph_lo);
}
#if MK_ONE_LAUNCH
__global__ void __launch_bounds__(512, 2) fwd(Args args) {
    extern __shared__ __attribute__((aligned(16))) unsigned char lds_raw[];
    Frame F; make_frame(F, args, lds_raw);
    volatile LAS unsigned* MISC = (volatile LAS unsigned*)(F.lds + MISC_OFF);
    if (F.tid < 4) MISC[F.tid] = 0u;
    __syncthreads();
    XcdBarrier bar = xcd_barrier_post((unsigned*)(F.ws + WS_CTL) + CW_BAR, MISC);
    run_phase<0>(F, 0); xcd_barrier(bar); if (REPEAT_KIND == 99) xcd_barrier(bar); if (REPEAT_KIND == 0) { run_phase<0>(F, 0); xcd_barrier(bar); }
    run_phase<1>(F, 0); xcd_barrier(bar); if (REPEAT_KIND == 99) xcd_barrier(bar); if (REPEAT_KIND == 1) { run_phase<1>(F, 0); xcd_barrier(bar); }
#pragma unroll 1
    for (int l = 0; l < 2; ++l) {
        run_phase<2>(F, l); xcd_barrier(bar); if (REPEAT_KIND == 99) xcd_barrier(bar); if (REPEAT_KIND == 2) { run_phase<2>(F, l); xcd_barrier(bar); }
        run_phase<3>(F, l); xcd_barrier(bar); if (REPEAT_KIND == 99) xcd_barrier(bar);
        run_phase<12>(F, l); xcd_barrier(bar); if (REPEAT_KIND == 99) xcd_barrier(bar); if (REPEAT_KIND == 12) { run_phase<12>(F, l); xcd_barrier(bar); }
        run_phase<4>(F, l); xcd_barrier(bar); if (REPEAT_KIND == 99) xcd_barrier(bar); if (REPEAT_KIND == 4) { run_phase<4>(F, l); xcd_barrier(bar); }
        run_phase<5>(F, l); xcd_barrier(bar); if (REPEAT_KIND == 99) xcd_barrier(bar); if (REPEAT_KIND == 5) { run_phase<5>(F, l); xcd_barrier(bar); }
        run_phase<6>(F, l); xcd_barrier(bar); if (REPEAT_KIND == 99) xcd_barrier(bar); if (REPEAT_KIND == 6) { run_phase<6>(F, l); xcd_barrier(bar); }
        run_phase<7>(F, l); xcd_barrier(bar); if (REPEAT_KIND == 99) xcd_barrier(bar); if (REPEAT_KIND == 7) { run_phase<7>(F, l); xcd_barrier(bar); }
        run_phase<8>(F, l); xcd_barrier(bar); if (REPEAT_KIND == 99) xcd_barrier(bar); if (REPEAT_KIND == 8) { run_phase<8>(F, l); xcd_barrier(bar); }
        run_phase<9>(F, l); xcd_barrier(bar); if (REPEAT_KIND == 99) xcd_barrier(bar); if (REPEAT_KIND == 9) { run_phase<9>(F, l); xcd_barrier(bar); }
        run_phase<10>(F, l); xcd_barrier(bar); if (REPEAT_KIND == 99) xcd_barrier(bar); if (REPEAT_KIND == 10) { run_phase<10>(F, l); xcd_barrier(bar); }
        run_phase<11>(F, l); xcd_barrier(bar); if (REPEAT_KIND == 99) xcd_barrier(bar); if (REPEAT_KIND == 11) { run_phase<11>(F, l); xcd_barrier(bar); }
    }
}
#endif

template <int KIND> static bool prep_kernel() { return hipFuncSetAttribute((const void*)fwd_k<KIND>, hipFuncAttributeMaxDynamicSharedMemorySize, LDS_BYTES) == hipSuccess; }
template <int KIND> static void launch_k(int grid, hipStream_t stream, Args a, int l) { a.ph_lo = l; a.ph_hi = KIND; hipLaunchKernelGGL(fwd_k<KIND>, dim3(grid), dim3(512), LDS_BYTES, stream, a); }
extern "C" void kernel_launch(void* const* d_in, const int* in_sizes, int n_in, void* d_out, int out_size, void* d_ws, size_t ws_size, hipStream_t stream) {
    static int grid = 0;
    if (grid == 0) {
        if (n_in != N_INPUTS || ws_size < WS_END) { fprintf(stderr, "kernel_launch: need %d inputs and %zu bytes of workspace; got %d, %zu\n", N_INPUTS, (size_t)WS_END, n_in, ws_size); grid = -1; return; }
        int dev = 0, cus = 0;
        if (hipGetDevice(&dev) != hipSuccess || hipDeviceGetAttribute(&cus, hipDeviceAttributeMultiprocessorCount, dev) != hipSuccess) { grid = -1; return; }
#if MK_ONE_LAUNCH
        if (hipFuncSetAttribute((const void*)fwd, hipFuncAttributeMaxDynamicSharedMemorySize, LDS_BYTES) != hipSuccess) { grid = -1; return; }
#else
        bool ok = prep_kernel<0>() && prep_kernel<1>() && prep_kernel<2>() && prep_kernel<3>() && prep_kernel<4>() && prep_kernel<5>() && prep_kernel<6>() && prep_kernel<7>() && prep_kernel<8>() && prep_kernel<9>() && prep_kernel<10>() && prep_kernel<11>() && prep_kernel<12>();
        if (!ok) { fprintf(stderr, "kernel_launch: hipFuncSetAttribute failed\n"); grid = -1; return; }
#endif
        (void)hipGetLastError();
        if (cus < GRID) { fprintf(stderr, "kernel_launch: built for a %d-CU device, found %d CUs\n", GRID, cus); grid = -1; return; }
        grid = GRID;
    }
    if (grid < 0) return;
    if (hipMemsetAsync((char*)d_ws + WS_CTL, 0, ZERO_BYTES, stream) != hipSuccess) return;
    Args a{};
    for (int i = 0; i < N_INPUTS; ++i) a.in[i] = (const float*)d_in[i];
    a.out = (float*)d_out; a.ws = (unsigned char*)d_ws;
#if MK_ONE_LAUNCH
    a.ph_lo = 0; a.ph_hi = N_PHASES;
    hipLaunchKernelGGL(fwd, dim3(grid), dim3(512), LDS_BYTES, stream, a);
#else
    launch_k<0>(grid, stream, a, 0); launch_k<1>(grid, stream, a, 0);
    for (int l = 0; l < 2; ++l) {
        launch_k<2>(grid, stream, a, l); launch_k<3>(grid, stream, a, l); launch_k<12>(grid, stream, a, l); launch_k<4>(grid, stream, a, l); launch_k<5>(grid, stream, a, l); launch_k<6>(grid, stream, a, l);
#ifdef DBG_STOP6
        break;
#endif
        launch_k<7>(grid, stream, a, l); launch_k<8>(grid, stream, a, l); launch_k<9>(grid, stream, a, l); launch_k<10>(grid, stream, a, l); launch_k<11>(grid, stream, a, l);
#ifdef DBG_STOP11
        break;
#endif
    }
#endif
}
```

```cpp
#include <hip/hip_runtime.h>
#include <cstdio>
#include <cstdint>

#define DBG_NROUTED 8
#ifndef REPEAT_KIND
#define REPEAT_KIND -1
#endif
#ifndef PG8_SP2
#define PG8_SP2 1
#endif
#ifndef PG8_ALIGN
#define PG8_ALIGN 1
#endif
#ifndef MK_ONE_LAUNCH
#define MK_ONE_LAUNCH 1
#endif

#define LAS __attribute__((address_space(3)))
#define DI __device__ __forceinline__
typedef unsigned short bf16_t;
typedef short bf16x8 __attribute__((ext_vector_type(8)));
typedef short s16x4 __attribute__((ext_vector_type(4)));
typedef float f32x4 __attribute__((ext_vector_type(4)));
typedef float f32x16 __attribute__((ext_vector_type(16)));
typedef unsigned u32x4 __attribute__((ext_vector_type(4)));
typedef unsigned u32x2 __attribute__((ext_vector_type(2)));
typedef __bf16 bf16x2_t __attribute__((ext_vector_type(2)));
typedef float f32x2_t __attribute__((ext_vector_type(2)));

DI unsigned pk2(float lo, float hi) { f32x2_t v = {lo, hi}; bf16x2_t b = __builtin_convertvector(v, bf16x2_t); return __builtin_bit_cast(unsigned, b); }
DI float bf_lo(unsigned u) { return __uint_as_float(u << 16); }
DI float bf_hi(unsigned u) { return __uint_as_float(u & 0xffff0000u); }
DI float bf2f(bf16_t b) { return __uint_as_float(((unsigned)b) << 16); }
DI bf16_t f2bf(float f) { return (bf16_t)(pk2(f, 0.f) & 0xffffu); }
DI float wave_sum(float v) {
#pragma unroll
    for (int o = 1; o < 64; o <<= 1) v += __shfl_xor(v, o);
    return v;
}
DI float sigmoidf_(float x) { return __builtin_amdgcn_rcpf(1.0f + __builtin_amdgcn_exp2f(-1.4426950408889634f * x)); }
DI float siluf_(float x) { return x * __builtin_amdgcn_rcpf(1.0f + __builtin_amdgcn_exp2f(-1.4426950408889634f * x)); }

constexpr int D = 1024, NB = 8, SEQ = 2048, CTXL = 256, TL = NB * SEQ, TC = NB * CTXL, TA = TL + TC;
constexpr int NIN = 9248, ZS = 9472  , NKV = 2592;
constexpr int C_KNA = 0, C_VNA = 512, C_KGLA = 1024, C_VGLA = 1536, C_GATE = 2560, C_QNA = 2592, C_BSC = 3104, C_CSC = 3616, C_XSC = 4128, C_QGLA = 4640, C_RGLA = 5152, C_MERGE = 6176;
constexpr int OS = 2048;
constexpr int NE = 64, NEX = 65  , FF = 256, TOPK = 8;
constexpr float RMS_EPS = 1e-6f;

enum { I_X = 0, I_C, I_CTX, I_CCTX, I_WMOD, I_BMOD, I_G1, I_G2, I_WIN, I_RPB, I_WNA, I_CONVW, I_WSC, I_GGW, I_GGB, I_GNG, I_WGLA, I_WOUT, I_WR, I_BR, I_WEG, I_WEU, I_WED, I_WSG, I_WSU, I_WSD, I_GF, N_INPUTS };

constexpr size_t WS_CTL = 0;
constexpr size_t CTL_BYTES = 65536;
constexpr int CW_BAR = 0, CW_CNT = 8192;
constexpr size_t WS_MOD = WS_CTL + CTL_BYTES;
constexpr size_t MOD_BYTES = 2 * 9 * 6 * 1024 * 4;
constexpr size_t ZERO_BYTES = CTL_BYTES + 458752;
constexpr size_t WS_CTXS = WS_CTL + ZERO_BYTES;
constexpr size_t WS_TOKE = WS_CTXS + (size_t)TC * D * 4;
constexpr size_t WS_TOKP = WS_TOKE + (size_t)TA * 8 * 4;
constexpr size_t WS_TOKW = WS_TOKP + (size_t)TA * 8 * 4;
constexpr size_t WS_TOKR = WS_TOKW + (size_t)TA * 8 * 4;
constexpr size_t WS_ROWL = WS_TOKR + (size_t)TA * 8 * 4;
constexpr size_t ROWL_BYTES = ((size_t)TA * 9 + 256) * 4;
constexpr size_t WS_WRT = (WS_ROWL + ROWL_BYTES + 255) & ~(size_t)255;
constexpr size_t WRT_BYTES = (size_t)2 * 2 * NE * D * 2;
constexpr size_t WS_WBS = WS_WRT + WRT_BYTES;
constexpr size_t WB_WIN = 0, WB_WNA = WB_WIN + (size_t)ZS * D * 2, WB_WSC = WB_WNA + (size_t)D * 512 * 2, WB_WGLA = WB_WSC + (size_t)D * 512 * 2,
                 WB_WOUT = WB_WGLA + (size_t)D * D * 2, WB_WD = WB_WOUT + (size_t)D * D * 2, WBS_BYTES = WB_WD + (size_t)NEX * D * FF * 2;
constexpr size_t WS_R2 = WS_WBS + WBS_BYTES;
constexpr size_t HID_ROWS = (size_t)TA * 9 + 256;
constexpr size_t R2_BYTES = HID_ROWS * FF * 2;
constexpr size_t R2_OB = (size_t)TA * D * 2;
constexpr size_t WS_R1 = WS_R2 + R2_BYTES;
constexpr size_t R1_O = (size_t)TA * ZS * 2;
constexpr size_t R1_BYTES = R1_O + (size_t)TA * OS * 2;
constexpr size_t R1_H2 = R1_O;
constexpr size_t WS_WBS1 = WS_R1 + R1_BYTES;
constexpr size_t WS_DECB = WS_WBS1 + WB_WD;
constexpr size_t WS_W2TG = WS_DECB + (size_t)NB * 4 * 2 * 36 * 128 * 4;
constexpr size_t WS_END = WS_W2TG + (size_t)2 * 2 * 512 * 16 * 2;
static_assert(HID_ROWS * D * 2 <= R1_O + 0, "out_slot must fit below H2");
static_assert((size_t)NEX * 512 * D * 2 <= R1_O, "WguT fits");

constexpr int LDS_BYTES = 147456, MISC_OFF = 143360;
constexpr int GRID = 256;

#define XB_TMO      128
#define XB_XCNT(j)  (256  + 64 * (j))
#define XB_XSUB(j)  (1280 + 64 * (j))
#define XB_XGEN(j)  (2304 + 64 * (j))
#define XB_TOP      3328
#define XB_TOPGEN   3392
#define XCD_BAR_WORDS 3456
#define XB_SPIN_CAP (1u << 22)
DI unsigned xb_ld(unsigned* p)              { return __hip_atomic_load(p, __ATOMIC_RELAXED, __HIP_MEMORY_SCOPE_AGENT); }
DI unsigned xb_add(unsigned* p, unsigned v) { return __hip_atomic_fetch_add(p, v, __ATOMIC_RELAXED, __HIP_MEMORY_SCOPE_AGENT); }
DI unsigned xb_xcc_id() { return (unsigned)__builtin_amdgcn_s_getreg((3 << 11) | 20) & 0xFu; }
#define XB_SPIN(cond, bar) do { unsigned _sp = 0; while (cond) { __builtin_amdgcn_s_sleep(1); \
    if ((++_sp & 255u) == 0u) { if (xb_ld(&(bar)[XB_TMO])) break; if (_sp > XB_SPIN_CAP) { atomicAdd(&(bar)[XB_TMO], 1u); break; } } } } while (0)
struct XcdBarrier { unsigned* bar; unsigned x; volatile LAS unsigned* st; };
DI XcdBarrier xcd_barrier_post(unsigned* bar, volatile LAS unsigned* st) {
    XcdBarrier b; b.bar = bar; b.x = xb_xcc_id(); b.st = st;
    if (threadIdx.x == 0) (void)xb_add(&bar[XB_XCNT(b.x)], 1u);
    return b;
}
DI void xcd_barrier_complete(unsigned* bar, unsigned x, unsigned& nloc, unsigned& nx) {
    const unsigned G = gridDim.x * gridDim.y * gridDim.z;
    unsigned sum, cnt, mine, sp = 0u;
    for (;;) {
        sum = 0u; cnt = 0u; mine = 0u;
#pragma unroll
        for (unsigned j = 0; j < 16; ++j) { const unsigned c = xb_ld(&bar[XB_XCNT(j)]); sum += c; cnt += (c > 0u) ? 1u : 0u; mine = (j == x) ? c : mine; }
        if (sum == G) break;
        __builtin_amdgcn_s_sleep(1);
        if ((++sp & 255u) == 0u) { if (xb_ld(&bar[XB_TMO])) break; if (sp > XB_SPIN_CAP) { atomicAdd(&bar[XB_TMO], 1u); break; } }
    }
    nloc = mine > 0u ? mine : 1u; nx = cnt > 0u ? cnt : 1u;
}
DI void xcd_barrier(const XcdBarrier& b) {
    asm volatile("s_waitcnt vmcnt(0)" ::: "memory");
    __syncthreads();
    if (threadIdx.x == 0) {
        unsigned* bar = b.bar;
        __builtin_amdgcn_s_waitcnt(0);
        const unsigned bx = xb_xcc_id();
        unsigned nloc = b.st[0], nx = b.st[1];
        if (nloc == 0u) { xcd_barrier_complete(bar, bx, nloc, nx); b.st[0] = nloc; b.st[1] = nx; }
        const unsigned old = xb_add(&bar[XB_XSUB(bx)], 1u);
        const unsigned gen = old / nloc;
        if (old + 1u == (gen + 1u) * nloc) {
            __builtin_amdgcn_fence(__ATOMIC_RELEASE, "agent");
            asm volatile("s_waitcnt vmcnt(0)" ::: "memory");
            const unsigned og = xb_add(&bar[XB_TOP], 1u);
            const unsigned tg = og / nx;
            if (og + 1u == (tg + 1u) * nx) xb_add(&bar[XB_TOPGEN], 1u);
            else XB_SPIN(xb_ld(&bar[XB_TOPGEN]) == tg, bar);
            __builtin_amdgcn_fence(__ATOMIC_ACQUIRE, "agent");
            xb_add(&bar[XB_XGEN(bx)], 1u);
            asm volatile("s_waitcnt vmcnt(0)" ::: "memory");
        } else {
            XB_SPIN(xb_ld(&bar[XB_XGEN(bx)]) == gen, bar);
            __builtin_amdgcn_fence(__ATOMIC_ACQUIRE, "agent");
            asm volatile("s_waitcnt vmcnt(0)" ::: "memory");
        }
    }
    __syncthreads();
}

namespace pg8 {
constexpr int BM = 256, BK = 64, HALF = 128, HTB = HALF * BK * 2, STAGE_BYTES = 8 * HTB;
DI int lds_byte(int r, int c) { const int st = (r >> 4) * 2 + (c >> 5), rr = r & 15, cc = c & 31, ob = rr * 64 + cc * 2; return st * 1024 + (ob ^ (((ob >> 9) & 1) << 5)); }
DI void stage_rc(int b, int& R, int& C) { const int st = b / 1024, sb = b % 1024, swz = sb ^ (((sb >> 9) & 1) << 5); R = (st >> 1) * 16 + swz / 64; C = (st & 1) * 32 + (swz % 64) / 2; }
DI int perm32(int rho) { const int n = rho >> 4, i = rho & 15; return 8 * (i >> 2) + 4 * n + (i & 3); }

struct GUnit {
    const char* A;
    const char* B;
    const int* rows;
    int pm, pn;
    int valid;
    int aux;
};

template <bool GATHER, class Epi, class Sched>
DI void gemm_phase(LAS unsigned char* lds, const int tid_, const int K_, const int lda, const int ldb, const Sched& S, const Epi& E) {
    int K = K_; asm volatile("" : "+s"(K));
    int tid = tid_; asm volatile("" : "+v"(tid));
    const int wid = __builtin_amdgcn_readfirstlane(tid >> 6), lane = tid & 63, wr = wid >> 2, wc = wid & 3, fr = lane & 15, fq = lane >> 4;
    const int nt = K / BK;
    unsigned voffA, voffB, cc2, ro;
    { int R, C; stage_rc(tid * 16, R, C); ro = (unsigned)R * 4u; cc2 = (unsigned)C * 2u; const int Rb = Epi::PERM ? ((R & ~31) + perm32(R & 31)) : R;
      voffA = (unsigned)(R * lda + C) * 2u; voffB = (unsigned)(Rb * ldb + C) * 2u; }
    const size_t hstepA = (size_t)HALF * lda * 2, qstepA = (size_t)64 * lda * 2, qstepB = (size_t)64 * ldb * 2;
    const unsigned rowb = (unsigned)lda * 2u;
    const size_t kstep = (size_t)(BK * 2);
    const size_t hstepB = (size_t)HALF * ldb * 2;
    const unsigned ldsw = (unsigned)wid * 1024u;
    const int aoff = lds_byte(wr * 64 + fr, fq * 8), boff = lds_byte(wc * 32 + fr, fq * 8);
#define PG8_SA(b, h) (((b) * 2 + (h)) * HTB)
#define PG8_SB(b, h) ((4 + (b) * 2 + (h)) * HTB)
#define PG8_STAGE2(bufoff, gbase, o0, o1) do { \
        __builtin_amdgcn_global_load_lds((const unsigned*)((const char*)(gbase) + (o0)), (LAS unsigned*)(lds + (bufoff) + ldsw), 16, 0, 0); \
        __builtin_amdgcn_global_load_lds((const unsigned*)((const char*)(gbase) + (o1)), (LAS unsigned*)(lds + (bufoff) + ldsw + 8192), 16, 0, 0); } while (0)
#define PG8_STAGEB(bufoff, gbase) do { unsigned _vo = voffB; asm volatile("" : "+v"(_vo));     \
        __builtin_amdgcn_global_load_lds((const unsigned*)((const char*)(gbase) + _vo), (LAS unsigned*)(lds + (bufoff) + ldsw), 16, 0, 0); \
        __builtin_amdgcn_global_load_lds((const unsigned*)((const char*)(gbase) + qstepB + _vo), (LAS unsigned*)(lds + (bufoff) + ldsw + 8192), 16, 0, 0); } while (0)
#define PG8_LDA(dst, b, h) do { _Pragma("unroll") for (int m = 0; m < 4; ++m) _Pragma("unroll") for (int k = 0; k < 2; ++k) dst[m][k] = *(const LAS bf16x8*)(lds + PG8_SA(b, h) + aoff + m * 2048 + k * 1024); } while (0)
#define PG8_LDB(dst, b, h) do { _Pragma("unroll") for (int n = 0; n < 2; ++n) _Pragma("unroll") for (int k = 0; k < 2; ++k) dst[n][k] = *(const LAS bf16x8*)(lds + PG8_SB(b, h) + boff + n * 2048 + k * 1024); } while (0)
#define PG8_MMA(ai, bj, At, Bt) do { __builtin_amdgcn_s_setprio(1); _Pragma("unroll") for (int m = 0; m < 4; ++m) _Pragma("unroll") for (int n = 0; n < 2; ++n) _Pragma("unroll") for (int k = 0; k < 2; ++k) \
        acc[ai][bj][m][n] = __builtin_amdgcn_mfma_f32_16x16x32_bf16(Bt[n][k], At[m][k], acc[ai][bj][m][n], 0, 0, 0); __builtin_amdgcn_s_setprio(0); } while (0)
#define PG8_WAIT_V(n) asm volatile("s_waitcnt vmcnt(" #n ")" ::: "memory")
#define PG8_WAIT_L(n) asm volatile("s_waitcnt lgkmcnt(" #n ")" ::: "memory")
#define PG8_BAR __builtin_amdgcn_s_barrier()
#define PG8_SCHED __builtin_amdgcn_sched_barrier(0)
#define PG8_RIDX(u, p0, p1) do { if (GATHER) { const char* _rb = (const char*)(u).rows; \
        p0 = (unsigned)*(const int*)(_rb + ro) | ((unsigned)*(const int*)(_rb + ro + HALF * 4) << 16); p1 = (unsigned)*(const int*)(_rb + ro + 64 * 4) | ((unsigned)*(const int*)(_rb + ro + (64 + HALF) * 4) << 16); } } while (0)
#define PG8_STAGEA(bufoff, gbase, h, p0, p1) do { if (GATHER) { const unsigned _o0 = (((p0) >> (16 * (h))) & 0xffffu) * rowb + cc2, _o1 = (((p1) >> (16 * (h))) & 0xffffu) * rowb + cc2; PG8_STAGE2(bufoff, gbase, _o0, _o1); } \
        else { unsigned _va = voffA; asm volatile("" : "+v"(_va)); \
               __builtin_amdgcn_global_load_lds((const unsigned*)((const char*)(gbase) + (h) * hstepA + _va), (LAS unsigned*)(lds + (bufoff) + ldsw), 16, 0, 0); \
               __builtin_amdgcn_global_load_lds((const unsigned*)((const char*)(gbase) + (h) * hstepA + qstepA + _va), (LAS unsigned*)(lds + (bufoff) + ldsw + 8192), 16, 0, 0); } } while (0)
    GUnit cur, nxt; int ui = 0;
    if (!S.next(0, cur)) return;
    f32x4 acc[2][2][4][2];
#pragma unroll
    for (int a = 0; a < 2; ++a)
#pragma unroll
        for (int b = 0; b < 2; ++b)
#pragma unroll
            for (int m = 0; m < 4; ++m)
#pragma unroll
                for (int n = 0; n < 2; ++n) acc[a][b][m][n] = (f32x4){0.f, 0.f, 0.f, 0.f};
    bf16x8 At[4][2], B0[2][2], B1[2][2];
    const char* cA = cur.A; const char* cB = cur.B;
    unsigned cp0 = 0u, cp1 = 0u; PG8_RIDX(cur, cp0, cp1);
#if PG8_SP2
    PG8_STAGEB(PG8_SB(0, 0), cB); PG8_STAGEB(PG8_SB(0, 1), cB + hstepB); PG8_STAGEA(PG8_SA(0, 0), cA, 0, cp0, cp1); PG8_STAGEA(PG8_SA(0, 1), cA, 1, cp0, cp1);
    if (wr == 1) PG8_BAR;
    PG8_WAIT_V(2); PG8_BAR;
    PG8_STAGEB(PG8_SB(1, 0), cB + kstep); PG8_STAGEA(PG8_SA(1, 0), cA + kstep, 0, cp0, cp1); PG8_STAGEB(PG8_SB(1, 1), cB + hstepB + kstep);
    PG8_WAIT_V(6); PG8_BAR;
#else
    PG8_STAGEB(PG8_SB(0, 0), cB); PG8_STAGEA(PG8_SA(0, 0), cA, 0, cp0, cp1); PG8_STAGEB(PG8_SB(0, 1), cB + hstepB); PG8_STAGEA(PG8_SA(0, 1), cA, 1, cp0, cp1);
    if (wr == 1) PG8_BAR;
    PG8_WAIT_V(4); PG8_BAR;
    PG8_STAGEB(PG8_SB(1, 0), cB + kstep); PG8_STAGEA(PG8_SA(1, 0), cA + kstep, 0, cp0, cp1); PG8_STAGEB(PG8_SB(1, 1), cB + hstepB + kstep);
    PG8_WAIT_V(6); PG8_BAR;
#endif
    for (;;) {
        const bool has_next = S.next(ui + 1, nxt);
        const char* nA = has_next ? nxt.A : cA; const char* nB = has_next ? nxt.B : cB;
        unsigned np0 = cp0, np1 = cp1;
        if (has_next) PG8_RIDX(nxt, np0, np1);
        for (int t = 0; t < nt; t += 2) {
            const bool last = (t == nt - 2);
            const char* a1 = cA + (size_t)(t + 1) * kstep;
            const char* a2 = last ? nA : cA + (size_t)(t + 2) * kstep; const char* b2 = last ? nB : cB + (size_t)(t + 2) * kstep;
            const char* a3 = a2 + kstep; const char* b3 = b2 + kstep;
            unsigned xp0 = cp0, xp1 = cp1;
            if (GATHER && last) { asm volatile("" : "+v"(np0), "+v"(np1)); xp0 = np0; xp1 = np1; }
#if PG8_SP2
            const bool after_epi = (Epi::NSTORE > 0) && (t == 0) && (ui > 0);
            PG8_LDB(B0, 0, 0); PG8_LDB(B1, 0, 1); PG8_SCHED; PG8_LDA(At, 0, 0); PG8_STAGEA(PG8_SA(1, 1), a1, 1, cp0, cp1);
            if (after_epi) { if constexpr (Epi::NSTORE == 16) PG8_WAIT_V(24); else if constexpr (Epi::NSTORE == 8) PG8_WAIT_V(16); else PG8_WAIT_V(8); } else PG8_WAIT_V(8);
            PG8_WAIT_L(0); PG8_BAR; PG8_MMA(0, 0, At, B0); PG8_MMA(0, 1, At, B1); PG8_BAR; PG8_SCHED;
            PG8_LDA(At, 0, 1); PG8_STAGEB(PG8_SB(0, 0), b2); PG8_STAGEB(PG8_SB(0, 1), b2 + hstepB); PG8_STAGEA(PG8_SA(0, 0), a2, 0, xp0, xp1);
            if (after_epi) { if constexpr (Epi::NSTORE == 16) PG8_WAIT_V(24); else if constexpr (Epi::NSTORE == 8) PG8_WAIT_V(16); else PG8_WAIT_V(8); } else PG8_WAIT_V(8);
            PG8_WAIT_L(0); PG8_BAR; PG8_MMA(1, 0, At, B0); PG8_MMA(1, 1, At, B1); PG8_BAR; PG8_SCHED;
            PG8_LDB(B0, 1, 0); PG8_LDB(B1, 1, 1); PG8_SCHED; PG8_LDA(At, 1, 0); PG8_STAGEA(PG8_SA(0, 1), a2, 1, xp0, xp1);
            PG8_WAIT_V(8); PG8_WAIT_L(0); PG8_BAR; PG8_MMA(0, 0, At, B0); PG8_MMA(0, 1, At, B1); PG8_BAR; PG8_SCHED;
            PG8_LDA(At, 1, 1); PG8_STAGEB(PG8_SB(1, 0), b3); PG8_STAGEB(PG8_SB(1, 1), b3 + hstepB); PG8_STAGEA(PG8_SA(1, 0), a3, 0, xp0, xp1);
            PG8_WAIT_V(8); PG8_WAIT_L(0); PG8_BAR; PG8_MMA(1, 0, At, B0); PG8_MMA(1, 1, At, B1); PG8_BAR; PG8_SCHED;
#else
            PG8_LDB(B0, 0, 0); PG8_SCHED; PG8_LDA(At, 0, 0); PG8_STAGEA(PG8_SA(1, 1), a1, 1, cp0, cp1);
            PG8_WAIT_L(8); PG8_BAR; PG8_WAIT_L(0); PG8_MMA(0, 0, At, B0); PG8_BAR; PG8_SCHED;
            PG8_LDB(B1, 0, 1); PG8_STAGEB(PG8_SB(0, 0), b2);
            PG8_BAR; PG8_WAIT_L(0); PG8_MMA(0, 1, At, B1); PG8_BAR;
            PG8_LDA(At, 0, 1); PG8_STAGEA(PG8_SA(0, 0), a2, 0, xp0, xp1);
            PG8_BAR; PG8_WAIT_L(0); PG8_MMA(1, 0, At, B0); PG8_BAR; PG8_SCHED;
            PG8_STAGEB(PG8_SB(0, 1), b2 + hstepB);
            PG8_WAIT_V(6); PG8_BAR; PG8_MMA(1, 1, At, B1); PG8_BAR;
            PG8_LDB(B0, 1, 0); PG8_SCHED; PG8_LDA(At, 1, 0); PG8_STAGEA(PG8_SA(0, 1), a2, 1, xp0, xp1);
            PG8_WAIT_L(8); PG8_BAR; PG8_WAIT_L(0); PG8_MMA(0, 0, At, B0); PG8_BAR; PG8_SCHED;
            PG8_LDB(B1, 1, 1); PG8_STAGEB(PG8_SB(1, 0), b3);
            PG8_BAR; PG8_WAIT_L(0); PG8_MMA(0, 1, At, B1); PG8_BAR;
            PG8_LDA(At, 1, 1); PG8_STAGEA(PG8_SA(1, 0), a3, 0, xp0, xp1);
            PG8_BAR; PG8_WAIT_L(0); PG8_MMA(1, 0, At, B0); PG8_BAR; PG8_SCHED;
            PG8_STAGEB(PG8_SB(1, 1), b3 + hstepB);
            PG8_WAIT_V(6); PG8_BAR; PG8_MMA(1, 1, At, B1); PG8_BAR;
        #endif
        }
#if PG8_ALIGN
        if (wr == 0) PG8_BAR;
#endif
        E(acc, cur, wr, wc, fr, fq);
        if (!has_next) break;
#pragma unroll
        for (int a = 0; a < 2; ++a)
#pragma unroll
            for (int b = 0; b < 2; ++b)
#pragma unroll
                for (int m = 0; m < 4; ++m)
#pragma unroll
                    for (int n = 0; n < 2; ++n) acc[a][b][m][n] = (f32x4){0.f, 0.f, 0.f, 0.f};
        cur = nxt; cA = nA; cB = nB; cp0 = np0; cp1 = np1; ++ui;
#if PG8_ALIGN
        if (wr == 1) PG8_BAR;
#endif
    }
    PG8_WAIT_V(0);
#if !PG8_ALIGN
    if (wr == 0) PG8_BAR;
#endif
    PG8_BAR;
#undef PG8_SA
#undef PG8_SB
#undef PG8_STAGE2
#undef PG8_STAGEB
#undef PG8_LDA
#undef PG8_LDB
#undef PG8_MMA
#undef PG8_WAIT_V
#undef PG8_WAIT_L
#undef PG8_BAR
#undef PG8_SCHED
#undef PG8_RIDX
#undef PG8_STAGEA
}

struct EpiStoreBf16 {
    static constexpr bool PERM = true; static constexpr int NSTORE = 16;
    bf16_t* O; int ldc;
    DI void operator()(const f32x4 (&acc)[2][2][4][2], const GUnit& u, int wr, int wc, int fr, int fq) const {
        const int row0 = u.pm * BM + wr * 64 + fr, col0 = u.pn * BM + wc * 32 + 8 * fq;
#pragma unroll
        for (int ai = 0; ai < 2; ++ai)
#pragma unroll
            for (int m = 0; m < 4; ++m) { bf16_t* rowp = O + (size_t)(row0 + ai * HALF + m * 16) * ldc + col0;
#pragma unroll
                for (int bj = 0; bj < 2; ++bj) { const f32x4 v0 = acc[ai][bj][m][0], v1 = acc[ai][bj][m][1];
                    u32x4 w; w.x = pk2(v0[0], v0[1]); w.y = pk2(v0[2], v0[3]); w.z = pk2(v1[0], v1[1]); w.w = pk2(v1[2], v1[3]);
                    *(u32x4*)(rowp + bj * HALF) = w; } }
    }
};
template <int MODE> struct EpiGate {
    static constexpr bool PERM = true; static constexpr int NSTORE = 0;
    bf16_t* Y; const bf16_t* Zg; int gcol0;
    DI void operator()(const f32x4 (&acc)[2][2][4][2], const GUnit& u, int wr, int wc, int fr, int fq) const {
        const int row0 = u.pm * BM + wr * 64 + fr, col0 = u.pn * BM + wc * 32 + 8 * fq;
#pragma unroll
        for (int ai = 0; ai < 2; ++ai) {
            u32x4 g[4][2], o[4][2];
#pragma unroll
            for (int m = 0; m < 4; ++m) { const size_t row = (size_t)(row0 + ai * HALF + m * 16);
#pragma unroll
                for (int bj = 0; bj < 2; ++bj) { g[m][bj] = *(const u32x4*)(Zg + row * ZS + gcol0 + col0 + bj * HALF); if (MODE == 1) o[m][bj] = *(const u32x4*)(Y + row * D + col0 + bj * HALF); } }
#pragma unroll
            for (int m = 0; m < 4; ++m) { const size_t row = (size_t)(row0 + ai * HALF + m * 16); bf16_t* rowp = Y + row * D + col0;
#pragma unroll
                for (int bj = 0; bj < 2; ++bj) { const f32x4 v0 = acc[ai][bj][m][0], v1 = acc[ai][bj][m][1]; const u32x4 gg = g[m][bj];
                    float r[8];
                    r[0] = v0[0] * sigmoidf_(bf_lo(gg.x)); r[1] = v0[1] * sigmoidf_(bf_hi(gg.x)); r[2] = v0[2] * sigmoidf_(bf_lo(gg.y)); r[3] = v0[3] * sigmoidf_(bf_hi(gg.y));
                    r[4] = v1[0] * sigmoidf_(bf_lo(gg.z)); r[5] = v1[1] * sigmoidf_(bf_hi(gg.z)); r[6] = v1[2] * sigmoidf_(bf_lo(gg.w)); r[7] = v1[3] * sigmoidf_(bf_hi(gg.w));
                    if (MODE == 1) { const u32x4 oo = o[m][bj];
                        r[0] += bf_lo(oo.x); r[1] += bf_hi(oo.x); r[2] += bf_lo(oo.y); r[3] += bf_hi(oo.y); r[4] += bf_lo(oo.z); r[5] += bf_hi(oo.z); r[6] += bf_lo(oo.w); r[7] += bf_hi(oo.w); }
                    u32x4 w; w.x = pk2(r[0], r[1]); w.y = pk2(r[2], r[3]); w.z = pk2(r[4], r[5]); w.w = pk2(r[6], r[7]);
                    *(u32x4*)(rowp + bj * HALF) = w; } }
        }
    }
};
struct EpiResid {
    static constexpr bool PERM = false; static constexpr int NSTORE = 0;
    const float* xsrc; float* xdst; const float* csrc; float* cdst; const float* gate;
    DI void operator()(const f32x4 (&acc)[2][2][4][2], const GUnit& u, int wr, int wc, int fr, int fq) const {
        const int row0 = u.pm * BM + wr * 64 + fr, col0 = u.pn * BM + wc * 32 + 4 * fq;
        const bool isctx = (u.pm * BM) >= TL;
        const int mrow = isctx ? 8 : (u.pm * BM) / SEQ;
        const float* gp = gate + (size_t)mrow * 6144 + col0;
        f32x4 gv[2][2];
#pragma unroll
        for (int bj = 0; bj < 2; ++bj)
#pragma unroll
            for (int n = 0; n < 2; ++n) gv[bj][n] = *(const f32x4*)(gp + bj * HALF + n * 16);
        const float* sb = isctx ? csrc - (size_t)TL * D : xsrc; float* db = isctx ? cdst - (size_t)TL * D : xdst;
#pragma unroll
        for (int ai = 0; ai < 2; ++ai) {
            f32x4 s[4][2][2];
#pragma unroll
            for (int m = 0; m < 4; ++m) { const size_t off = (size_t)(row0 + ai * HALF + m * 16) * D + col0;
#pragma unroll
                for (int bj = 0; bj < 2; ++bj)
#pragma unroll
                    for (int n = 0; n < 2; ++n) s[m][bj][n] = *(const f32x4*)(sb + off + bj * HALF + n * 16); }
#pragma unroll
            for (int m = 0; m < 4; ++m) { const size_t off = (size_t)(row0 + ai * HALF + m * 16) * D + col0;
#pragma unroll
                for (int bj = 0; bj < 2; ++bj)
#pragma unroll
                    for (int n = 0; n < 2; ++n) *(f32x4*)(db + off + bj * HALF + n * 16) = s[m][bj][n] + gv[bj][n] * acc[ai][bj][m][n]; }
        }
    }
};
struct EpiSwiGLU {
    static constexpr bool PERM = true; static constexpr int NSTORE = 0;
    bf16_t* Hd;
    DI void operator()(const f32x4 (&acc)[2][2][4][2], const GUnit& u, int wr, int wc, int fr, int fq) const {
        const int r0 = wr * 64 + fr, col0 = u.pn * HALF + wc * 32 + 8 * fq;
#pragma unroll
        for (int ai = 0; ai < 2; ++ai)
#pragma unroll
            for (int m = 0; m < 4; ++m) { const int r = r0 + ai * HALF + m * 16;
                const f32x4 g0 = acc[ai][0][m][0], g1 = acc[ai][0][m][1], u0 = acc[ai][1][m][0], u1 = acc[ai][1][m][1];
                u32x4 w; w.x = pk2(siluf_(g0[0]) * u0[0], siluf_(g0[1]) * u0[1]); w.y = pk2(siluf_(g0[2]) * u0[2], siluf_(g0[3]) * u0[3]);
                w.z = pk2(siluf_(g1[0]) * u1[0], siluf_(g1[1]) * u1[1]); w.w = pk2(siluf_(g1[2]) * u1[2], siluf_(g1[3]) * u1[3]);
                if (r < u.valid) *(u32x4*)(Hd + (size_t)(u.aux + r) * FF + col0) = w; }
    }
};
DI unsigned pk4_fp8(float a, float b, float c, float d) { int p = 0; p = __builtin_amdgcn_cvt_pk_fp8_f32(a, b, p, false); p = __builtin_amdgcn_cvt_pk_fp8_f32(c, d, p, true); return (unsigned)p; }
struct EpiDown {
    static constexpr bool PERM = true; static constexpr int NSTORE = 0;
    unsigned char* Os; int rmask;
    DI void operator()(const f32x4 (&acc)[2][2][4][2], const GUnit& u, int wr, int wc, int fr, int fq) const {
        const int r0 = wr * 64 + fr, col0 = u.pn * BM + wc * 32 + 8 * fq;
#pragma unroll
        for (int ai = 0; ai < 2; ++ai)
#pragma unroll
            for (int m = 0; m < 4; ++m) { const int r = r0 + ai * HALF + m * 16; unsigned char* rowp = Os + (size_t)((u.aux + r) & rmask) * D + col0;
#pragma unroll
                for (int bj = 0; bj < 2; ++bj) { const f32x4 v0 = acc[ai][bj][m][0], v1 = acc[ai][bj][m][1];
                    u32x2 w; w.x = pk4_fp8(v0[0], v0[1], v0[2], v0[3]); w.y = pk4_fp8(v1[0], v1[1], v1[2], v1[3]);
                    if (r < u.valid) *(u32x2*)(rowp + bj * HALF) = w; } }
    }
};

template <int nN> struct RectSched {
    const char* A; const char* B; int lda, ldb; int nM, exM, exN, exPm0, G, c;
    DI bool next(int i, GUnit& u) const {
        const int L = i * G + c; const int nmain = nM * nN;
        int pm, pn;
        if (L < nmain) { const int W = (L & 7) * (nmain >> 3) + (L >> 3);
            const int grp = W / (8 * nN), rem = W % (8 * nN); pm = grp * 8 + (rem & 7); pn = rem >> 3; }
        else { const int L2 = L - nmain; if (L2 >= exM * exN) return false; pm = exPm0 + (L2 & 7); pn = L2 >> 3; }
        u.A = A + (size_t)pm * BM * lda * 2; u.B = B + (size_t)pn * BM * ldb * 2; u.rows = nullptr; u.pm = pm; u.pn = pn; u.valid = BM; u.aux = 0; return true;
    }
};
template <bool GATHER, int npn> struct MoeSched {
    const LAS int* tb; const LAS int* rb; const LAS int* cn;
    const char* A; const int* rowl; const char* B; size_t bstride; int lda, ldb, G, c;
    DI bool next(int i, GUnit& u) const {
        const int L0 = i * G + c; const int ntile = __builtin_amdgcn_readfirstlane(tb[NEX]); const int nwg = ntile * npn;
        if (L0 >= nwg) return false;
        const int q = nwg >> 3, rr = nwg & 7, xcd = L0 & 7, off = L0 >> 3;
        const int L = (xcd < rr ? xcd * (q + 1) : rr * (q + 1) + (xcd - rr) * q) + off;
        const int T = L / npn, pn = L % npn;
        const int e = __builtin_amdgcn_readfirstlane((int)((const LAS unsigned char*)(tb + 216))[T]);
        const int ti = T - __builtin_amdgcn_readfirstlane(tb[e]), row0 = __builtin_amdgcn_readfirstlane(rb[e]) + ti * BM;
        u.B = B + (size_t)e * bstride + (size_t)pn * BM * ldb * 2;
        if (GATHER) { u.A = A; u.rows = rowl + row0; } else { u.A = A + (size_t)row0 * lda * 2; u.rows = nullptr; }
        u.pm = T; u.pn = pn; const int rem = __builtin_amdgcn_readfirstlane(cn[e]) - ti * BM; u.valid = rem < BM ? rem : BM; u.aux = row0; return true;
    }
};
}

struct Args { const float* in[N_INPUTS]; float* out; unsigned char* ws; int ph_lo, ph_hi; };
struct Frame {
    LAS unsigned char* lds; unsigned char* ws; const float* const* in; float* out;
    int tid, lane, wave, G, bid;
};
DI const float* modp(const Frame& F, int l, int r, int which) { return (const float*)(F.ws + WS_MOD) + ((size_t)(l * 9 + r) * 6 + which) * 1024; }

DI void tr_item(const float* W, int ldw, bf16_t* WT, int ldt, int k0, int n0, int drow0, LAS float* scr, int lane) {
    float tmp[32];
#pragma unroll
    for (int i = 0; i < 32; ++i) { const int kk = 2 * i + (lane >> 5); tmp[i] = W[(size_t)(k0 + kk) * ldw + n0 + (lane & 31)]; }
#pragma unroll
    for (int i = 0; i < 32; ++i) { const int kk = 2 * i + (lane >> 5); scr[kk * 33 + (lane & 31)] = tmp[i]; }
    asm volatile("s_waitcnt lgkmcnt(0)" ::: "memory");
    const int c = lane & 7;
#pragma unroll
    for (int j = 0; j < 4; ++j) { const int n = (lane >> 3) + 8 * j; const LAS float* s = scr + (8 * c) * 33 + n;
        u32x4 o; o.x = pk2(s[0 * 33], s[1 * 33]); o.y = pk2(s[2 * 33], s[3 * 33]); o.z = pk2(s[4 * 33], s[5 * 33]); o.w = pk2(s[6 * 33], s[7 * 33]);
        *(u32x4*)(WT + (size_t)(drow0 + n) * ldt + k0 + 8 * c) = o; }
    asm volatile("s_waitcnt lgkmcnt(0)" ::: "memory");
}
template <int K, int N> DI void conv_plain(const Frame& F, const float* W, bf16_t* WT, int rot, int blk0 = 0) {
    LAS float* scr = (LAS float*)(F.lds + F.wave * 16384);
    const int NGW = (F.G - blk0) * 8, gw = ((F.bid - blk0) * 8 + F.wave + rot) % NGW;
    constexpr int nblk = N / 32, nit = (K / 64) * nblk;
    for (int it = gw; it < nit; it += NGW) { const int kb = it / nblk, nb = it % nblk; tr_item(W, N, WT, K, kb * 64, nb * 32, nb * 32, scr, F.lane); }
}
DI void conv_gu(const Frame& F, int l, bf16_t* WT, int blk0 = 0) {
    if (F.bid < blk0) return;
    LAS float* scr = (LAS float*)(F.lds + F.wave * 16384);
    const int NGW = (F.G - blk0) * 8, gw = (F.bid - blk0) * 8 + F.wave;
    const int nit = NEX * 2 * 128;
    for (int it = gw; it < nit; it += NGW) {
        const int e = it / 256, r = it % 256, isup = r / 128, r2 = r % 128, kb = r2 / 8, nb = r2 % 8, n0 = nb * 32;
        const float* W = (e < NE) ? F.in[isup ? I_WEU : I_WEG] + ((size_t)l * NE + e) * D * FF : F.in[isup ? I_WSU : I_WSG] + (size_t)l * D * FF;
        const int drow0 = ((n0 >> 7) << 8) + (n0 & 127) + (isup ? 128 : 0);
        tr_item(W, FF, WT + (size_t)e * 512 * D, D, kb * 64, n0, drow0, scr, F.lane);
    }
}
DI void conv_down(const Frame& F, int l, bf16_t* WT) {
    LAS float* scr = (LAS float*)(F.lds + F.wave * 16384);
    const int NGW = F.G * 8, gw = F.bid * 8 + F.wave;
    const int nit = NEX * 128;
    for (int it = gw; it < nit; it += NGW) {
        const int e = it / 128, r = it % 128, kb = r / 32, nb = r % 32;
        const float* W = (e < NE) ? F.in[I_WED] + ((size_t)l * NE + e) * FF * D : F.in[I_WSD] + (size_t)l * FF * D;
        tr_item(W, D, WT + (size_t)e * D * FF, FF, kb * 64, nb * 32, nb * 32, scr, F.lane);
    }
}
DI size_t wbs_base(int l) { return l == 0 ? WS_WBS : WS_WBS1; }
DI void conv_small(const Frame& F, int l, int blk0 = 0) {
    if (F.bid < blk0) return;
    bf16_t* wb = (bf16_t*)(F.ws + wbs_base(l));
    conv_plain<D, NIN>(F, F.in[I_WIN] + (size_t)l * D * NIN, (bf16_t*)((char*)wb + WB_WIN), 0, blk0);
    conv_plain<512, D>(F, F.in[I_WNA] + (size_t)l * 512 * D, (bf16_t*)((char*)wb + WB_WNA), 600, blk0);
    conv_plain<512, D>(F, F.in[I_WSC] + (size_t)l * 512 * D, (bf16_t*)((char*)wb + WB_WSC), 900, blk0);
    conv_plain<D, D>(F, F.in[I_WGLA] + (size_t)l * D * D, (bf16_t*)((char*)wb + WB_WGLA), 1200, blk0);
    conv_plain<D, D>(F, F.in[I_WOUT] + (size_t)l * D * D, (bf16_t*)((char*)wb + WB_WOUT), 1700, blk0);
    u32x4* z = (u32x4*)((char*)wb + WB_WIN + (size_t)NIN * D * 2);
    const int nz = (ZS - NIN) * D * 2 / 16;
    unsigned zz = 0u; asm volatile("" : "+v"(zz));
    for (int i = (F.bid - blk0) * 512 + F.tid; i < nz; i += (F.G - blk0) * 512) z[i] = (u32x4){zz, zz, zz, zz};
}
DI void conv_gate_w(const Frame& F) {
    bf16_t* wt = (bf16_t*)(F.ws + WS_W2TG);
    for (int i = F.bid * 512 + F.tid; i < 2 * 2 * 512 * 16; i += F.G * 512) { const int ld = i >> 13, rr = i & 8191, d = rr >> 4, ii = rr & 15; wt[i] = f2bf(F.in[I_GGW][((size_t)ld * 16 + ii) * 512 + d]); }
}
DI void conv_router(const Frame& F) {
    bf16_t* wrt = (bf16_t*)(F.ws + WS_WRT);
    for (int i = F.bid * 512 + F.tid; i < 2 * NE * D; i += F.G * 512) {
        const int l = i / (NE * D), r = i % (NE * D), e = r / D, k = r % D;
        const float w = F.in[I_WR][(size_t)l * D * NE + (size_t)k * NE + e];
        const bf16_t hi = f2bf(w); const bf16_t lo = f2bf(w - bf2f(hi));
        wrt[((size_t)(l * 2 + 0) * NE + e) * D + k] = hi; wrt[((size_t)(l * 2 + 1) * NE + e) * D + k] = lo;
    }
}
DI void mod_vectors(const Frame& F) {
    float* mod = (float*)(F.ws + WS_MOD);
    LAS float* SL = (LAS float*)F.lds;
    LAS float* PART = SL + 9 * 1024;
    __syncthreads();
    for (int i = F.tid; i < 9 * 1024; i += 512) { const float c = (i < 8 * 1024) ? F.in[I_C][i] : F.in[I_CCTX][i - 8 * 1024]; SL[i] = siluf_(c); }
    __syncthreads();
    for (int it = F.bid; it < 2 * 96; it += F.G) {
        const int l = it / 96, cb = it % 96, j = cb * 64 + F.lane;
        const float* W = F.in[I_WMOD] + (size_t)l * D * 6144 + j;
        float acc[9];
#pragma unroll
        for (int q = 0; q < 9; ++q) acc[q] = 0.f;
#pragma unroll 8
        for (int k = F.wave * 128; k < F.wave * 128 + 128; ++k) {
            const float w = W[(size_t)k * 6144];
#pragma unroll
            for (int q = 0; q < 9; ++q) acc[q] += SL[q * 1024 + k] * w;
        }
#pragma unroll
        for (int q = 0; q < 9; ++q) PART[(F.wave * 9 + q) * 64 + F.lane] = acc[q];
        __syncthreads();
        for (int q = F.wave; q < 9; q += 8) {
            float s = F.in[I_BMOD][l * 6144 + j];
#pragma unroll
            for (int w = 0; w < 8; ++w) s += PART[(w * 9 + q) * 64 + F.lane];
            mod[((size_t)(l * 9 + q)) * 6144 + j] = s;
        }
        __syncthreads();
    }
}

DI void load_row_f32(const float* p, int lane, float (&v)[16]) {
#pragma unroll
    for (int i = 0; i < 2; ++i) { const f32x4 a = *(const f32x4*)(p + 8 * lane + 512 * i), b = *(const f32x4*)(p + 8 * lane + 512 * i + 4);
        v[8 * i + 0] = a[0]; v[8 * i + 1] = a[1]; v[8 * i + 2] = a[2]; v[8 * i + 3] = a[3]; v[8 * i + 4] = b[0]; v[8 * i + 5] = b[1]; v[8 * i + 6] = b[2]; v[8 * i + 7] = b[3]; }
}
DI void store_row_f32(float* p, int lane, const float (&v)[16]) {
#pragma unroll
    for (int i = 0; i < 2; ++i) { *(f32x4*)(p + 8 * lane + 512 * i) = (f32x4){v[8 * i], v[8 * i + 1], v[8 * i + 2], v[8 * i + 3]}; *(f32x4*)(p + 8 * lane + 512 * i + 4) = (f32x4){v[8 * i + 4], v[8 * i + 5], v[8 * i + 6], v[8 * i + 7]}; }
}
DI void load_row_bf16(const bf16_t* p, int lane, float (&v)[16]) {
#pragma unroll
    for (int i = 0; i < 2; ++i) { const u32x4 a = *(const u32x4*)(p + 8 * lane + 512 * i);
        v[8 * i + 0] = bf_lo(a.x); v[8 * i + 1] = bf_hi(a.x); v[8 * i + 2] = bf_lo(a.y); v[8 * i + 3] = bf_hi(a.y); v[8 * i + 4] = bf_lo(a.z); v[8 * i + 5] = bf_hi(a.z); v[8 * i + 6] = bf_lo(a.w); v[8 * i + 7] = bf_hi(a.w); }
}
DI void store_row_bf16(bf16_t* p, int lane, const float (&v)[16]) {
#pragma unroll
    for (int i = 0; i < 2; ++i) { u32x4 w; w.x = pk2(v[8 * i], v[8 * i + 1]); w.y = pk2(v[8 * i + 2], v[8 * i + 3]); w.z = pk2(v[8 * i + 4], v[8 * i + 5]); w.w = pk2(v[8 * i + 6], v[8 * i + 7]);
        *(u32x4*)(p + 8 * lane + 512 * i) = w; }
}
DI void norm_mod(const float (&x)[16], const float* g, const float* shift, const float* scale, int lane, float (&h)[16]) {
    float ss = 0.f;
#pragma unroll
    for (int i = 0; i < 16; ++i) ss += x[i] * x[i];
    const float rstd = rsqrtf(wave_sum(ss) * (1.0f / D) + RMS_EPS);
    float gg[16], sh[16], sc[16]; load_row_f32(g, lane, gg); load_row_f32(shift, lane, sh); load_row_f32(scale, lane, sc);
#pragma unroll
    for (int i = 0; i < 16; ++i) h[i] = x[i] * rstd * gg[i] * (1.0f + sc[i]) + sh[i];
}

DI void phase_norm1_first(const Frame& F) {
    const int NGW = F.G * 8, gw = F.bid * 8 + F.wave;
    bf16_t* H = (bf16_t*)(F.ws + WS_R2);
    for (int t = gw; t < TA; t += NGW) {
        const bool isctx = t >= TL; const int r = isctx ? 8 : t / SEQ;
        const float* xr = isctx ? F.in[I_CTX] + (size_t)(t - TL) * D : F.in[I_X] + (size_t)t * D;
        float x[16], h[16]; load_row_f32(xr, F.lane, x);
        norm_mod(x, F.in[I_G1], modp(F, 0, r, 0), modp(F, 0, r, 1), F.lane, h);
        store_row_bf16(H + (size_t)t * D, F.lane, h);
    }
}

DI void phase_conv(const Frame& F, int l, int M) {
    const bf16_t* Z = (const bf16_t*)(F.ws + WS_R1); bf16_t* O = (bf16_t*)(F.ws + WS_R1 + R1_O);
    const float* cw = F.in[I_CONVW] + (size_t)l * 3 * 512;
    for (int it = F.bid * 512 + F.tid; it < M * 64; it += F.G * 512) {
        const int t = it >> 6, c0 = (it & 63) * 8;
        const int L = (t >= TL) ? CTXL : SEQ, pos = (t >= TL) ? (t - TL) % CTXL : t % SEQ;
        const bf16_t* zr = Z + (size_t)t * ZS;
        float u0[8], u1[8], u2[8], bb[8];
        { const u32x4 c = *(const u32x4*)(zr + C_CSC + c0), x = *(const u32x4*)(zr + C_XSC + c0), b = *(const u32x4*)(zr + C_BSC + c0);
          u1[0] = bf_lo(c.x) * bf_lo(x.x); u1[1] = bf_hi(c.x) * bf_hi(x.x); u1[2] = bf_lo(c.y) * bf_lo(x.y); u1[3] = bf_hi(c.y) * bf_hi(x.y);
          u1[4] = bf_lo(c.z) * bf_lo(x.z); u1[5] = bf_hi(c.z) * bf_hi(x.z); u1[6] = bf_lo(c.w) * bf_lo(x.w); u1[7] = bf_hi(c.w) * bf_hi(x.w);
          bb[0] = bf_lo(b.x); bb[1] = bf_hi(b.x); bb[2] = bf_lo(b.y); bb[3] = bf_hi(b.y); bb[4] = bf_lo(b.z); bb[5] = bf_hi(b.z); bb[6] = bf_lo(b.w); bb[7] = bf_hi(b.w); }
        if (pos > 0) { const u32x4 c = *(const u32x4*)(zr - ZS + C_CSC + c0), x = *(const u32x4*)(zr - ZS + C_XSC + c0);
          u0[0] = bf_lo(c.x) * bf_lo(x.x); u0[1] = bf_hi(c.x) * bf_hi(x.x); u0[2] = bf_lo(c.y) * bf_lo(x.y); u0[3] = bf_hi(c.y) * bf_hi(x.y);
          u0[4] = bf_lo(c.z) * bf_lo(x.z); u0[5] = bf_hi(c.z) * bf_hi(x.z); u0[6] = bf_lo(c.w) * bf_lo(x.w); u0[7] = bf_hi(c.w) * bf_hi(x.w); }
        else {
#pragma unroll
            for (int j = 0; j < 8; ++j) u0[j] = 0.f; }
        if (pos < L - 1) { const u32x4 c = *(const u32x4*)(zr + ZS + C_CSC + c0), x = *(const u32x4*)(zr + ZS + C_XSC + c0);
          u2[0] = bf_lo(c.x) * bf_lo(x.x); u2[1] = bf_hi(c.x) * bf_hi(x.x); u2[2] = bf_lo(c.y) * bf_lo(x.y); u2[3] = bf_hi(c.y) * bf_hi(x.y);
          u2[4] = bf_lo(c.z) * bf_lo(x.z); u2[5] = bf_hi(c.z) * bf_hi(x.z); u2[6] = bf_lo(c.w) * bf_lo(x.w); u2[7] = bf_hi(c.w) * bf_hi(x.w); }
        else {
#pragma unroll
            for (int j = 0; j < 8; ++j) u2[j] = 0.f; }
        float o[8];
#pragma unroll
        for (int j = 0; j < 8; ++j) o[j] = bb[j] * (u0[j] * cw[c0 + j] + u1[j] * cw[512 + c0 + j] + u2[j] * cw[1024 + c0 + j]);
        u32x4 w; w.x = pk2(o[0], o[1]); w.y = pk2(o[2], o[3]); w.z = pk2(o[4], o[5]); w.w = pk2(o[6], o[7]);
        *(u32x4*)(O + (size_t)t * OS + 512 + c0) = w;
    }
}

#define MFMA32(a, b, c) __builtin_amdgcn_mfma_f32_32x32x16_bf16((a), (b), (c), 0, 0, 0)
DI int crow(int reg, int h) { return (reg & 3) + 8 * (reg >> 2) + 4 * h; }
DI bf16x8 pack_step(const f32x16& x, int s) {
    u32x4 p; p.x = pk2(x[8 * s], x[8 * s + 1]); p.y = pk2(x[8 * s + 2], x[8 * s + 3]); p.z = pk2(x[8 * s + 4], x[8 * s + 5]); p.w = pk2(x[8 * s + 6], x[8 * s + 7]);
    return __builtin_bit_cast(bf16x8, p);
}
DI bf16x8 cat4(u32x2 a, u32x2 b) { u32x4 p; p.x = a.x; p.y = a.y; p.z = b.x; p.w = b.y; return __builtin_bit_cast(bf16x8, p); }

typedef __attribute__((address_space(3))) s16x4 lds_s16x4;
DI bf16x8 tr8(const LAS bf16_t* p0, const LAS bf16_t* p1) {
    const s16x4 a = __builtin_amdgcn_ds_read_tr16_b64_v4i16((lds_s16x4*)p0), b = __builtin_amdgcn_ds_read_tr16_b64_v4i16((lds_s16x4*)p1);
    return (bf16x8){a[0], a[1], a[2], a[3], b[0], b[1], b[2], b[3]};
}
constexpr int NA_VS = 72;
constexpr int NA_TAB = 8 * NA_VS * 64 * 2;
constexpr float NA_L2E = 1.4426950408889634f;
constexpr int NA_KOFF = 0, NA_VOFF = 2 * 64 * NA_VS * 2;
constexpr int NA_TAB2 = 4 * 64 * NA_VS * 2;
DI void na_block_unit(const Frame& F, const bf16_t* Z, bf16_t* O, const LAS float* tab, int head, bool isctxu, int b, int rg) {
    const int tid = F.tid, lane = F.lane, wave = F.wave, r = lane & 31, h = lane >> 5;
    const int trq = (lane & 15) >> 2, trc = 16 * ((lane >> 4) & 1) + 4 * (lane & 3);
    LAS bf16_t* KR = (LAS bf16_t*)(F.lds + NA_KOFF); LAS bf16_t* VR = (LAS bf16_t*)(F.lds + NA_VOFF);
    const int qrow_g = isctxu ? 0 : 4 * rg + (wave >> 1), qcol0 = isctxu ? 0 : 32 * (wave & 1);
    const int qrow0 = isctxu ? TL + b * CTXL + 32 * wave : b * SEQ + qrow_g * 64 + qcol0;
    int rs = qrow_g - 4; rs = rs < 0 ? 0 : (rs > 24 ? 24 : rs);
    int rs_lo = 4 * rg - 4; rs_lo = rs_lo < 0 ? 0 : (rs_lo > 24 ? 24 : rs_lo); int rs_hi = 4 * rg + 3 - 4; rs_hi = rs_hi < 0 ? 0 : (rs_hi > 24 ? 24 : rs_hi);
    const int nwin = isctxu ? 0 : rs_hi + 8 - rs_lo, ntile = nwin + 4;
    const int winrow0 = b * SEQ + rs_lo * 64, ctxrow0 = TL + b * CTXL;
    bf16x8 qf[4];
    { const bf16_t* qp = Z + (size_t)(qrow0 + r) * ZS + C_QNA + head * 64 + 8 * h;
#pragma unroll
      for (int ks = 0; ks < 4; ++ks) qf[ks] = *(const bf16x8*)(qp + 16 * ks); }
    unsigned ix0[4], ix1[4];
    { const int qc = qcol0 + r; int cs = qc - 8; cs = cs < 0 ? 0 : (cs > 48 ? 48 : cs);
#pragma unroll
      for (int g = 0; g < 4; ++g) { unsigned p0 = 0u, p1 = 0u;
#pragma unroll
          for (int e = 0; e < 4; ++e) { const int kc0 = crow(4 * g + e, h), kc1 = 32 + kc0;
              int d0 = kc0 - qc; d0 = d0 < -15 ? -15 : (d0 > 15 ? 15 : d0); int d1 = kc1 - qc; d1 = d1 < -15 ? -15 : (d1 > 15 ? 15 : d1);
              const unsigned c0 = (kc0 < cs || kc0 >= cs + 16) ? 31u : (unsigned)(d0 + 15), c1 = (kc1 < cs || kc1 >= cs + 16) ? 31u : (unsigned)(d1 + 15);
              p0 |= c0 << (8 * e); p1 |= c1 << (8 * e); }
          ix0[g] = p0; ix1[g] = p1; } }
    f32x16 o0, o1;
#pragma unroll
    for (int i = 0; i < 16; ++i) { o0[i] = 0.f; o1[i] = 0.f; }
    float mrun = -1e30f, lrun = 0.f;
    const int lkey = tid >> 3, lseg = tid & 7;
#define NA_TROW(j_) ((j_) < nwin ? winrow0 + (j_) * 64 : ctxrow0 + ((j_) - nwin) * 64)
#define NA_LD(j_, kk_, vv_) do { const bf16_t* zp = Z + (size_t)(NA_TROW(j_) + lkey) * ZS + head * 64 + 8 * lseg; kk_ = *(const u32x4*)(zp + C_KNA); vv_ = *(const u32x4*)(zp + C_VNA); } while (0)
#define NA_ST(slot_, kk_, vv_) do { *(LAS u32x4*)(KR + ((slot_) * 64 + lkey) * NA_VS + 8 * lseg) = kk_; *(LAS u32x4*)(VR + ((slot_) * 64 + lkey) * NA_VS + 8 * lseg) = vv_; } while (0)
    u32x4 sk, sv;
    __syncthreads();
    NA_LD(0, sk, sv); NA_ST(0, sk, sv); NA_LD(1, sk, sv);
#pragma unroll 1
    for (int j = 0; j < ntile; ++j) {
        __syncthreads();
        if (j + 1 < ntile) { NA_ST((j + 1) & 1, sk, sv); const int j2 = j + 2 < ntile ? j + 2 : ntile - 1; NA_LD(j2, sk, sv); }
        const bool isw = j < nwin;
        const int krow_g = rs_lo + j;
        if (isw && (krow_g < rs || krow_g >= rs + 8)) continue;
        const LAS bf16_t* kt = KR + (j & 1) * 64 * NA_VS; const LAS bf16_t* vt = VR + (j & 1) * 64 * NA_VS;
        f32x16 s0, s1;
#pragma unroll
        for (int i = 0; i < 16; ++i) { s0[i] = 0.f; s1[i] = 0.f; }
#pragma unroll
        for (int ks = 0; ks < 4; ++ks) { const bf16x8 k0 = *(const LAS bf16x8*)(kt + r * NA_VS + 16 * ks + 8 * h), k1 = *(const LAS bf16x8*)(kt + (32 + r) * NA_VS + 16 * ks + 8 * h);
            s0 = MFMA32(k0, qf[ks], s0); s1 = MFMA32(k1, qf[ks], s1); }
        const int drow = isw ? (krow_g - qrow_g + 7) : 15;
        const LAS float* trow = tab + (head * 16 + drow) * 32;
#pragma unroll
        for (int g = 0; g < 4; ++g) asm volatile("" : "+v"(ix0[g]), "+v"(ix1[g]));
        float tmax = -1e30f;
#pragma unroll
        for (int i = 0; i < 16; ++i) {
            const float a = s0[i] * (0.125f * NA_L2E) + trow[(ix0[i >> 2] >> (8 * (i & 3))) & 0xffu];
            const float bq = s1[i] * (0.125f * NA_L2E) + trow[(ix1[i >> 2] >> (8 * (i & 3))) & 0xffu];
            s0[i] = a; s1[i] = bq; tmax = fmaxf(tmax, fmaxf(a, bq));
        }
        tmax = fmaxf(tmax, __shfl_xor(tmax, 32));
        const float mnew = fmaxf(mrun, tmax), alpha = __builtin_amdgcn_exp2f(mrun - mnew);
        float psum = 0.f;
#pragma unroll
        for (int i = 0; i < 16; ++i) { const float a = __builtin_amdgcn_exp2f(s0[i] - mnew), bq = __builtin_amdgcn_exp2f(s1[i] - mnew); s0[i] = a; s1[i] = bq; psum += a + bq; }
        psum += __shfl_xor(psum, 32);
        lrun = lrun * alpha + psum; mrun = mnew;
#pragma unroll
        for (int i = 0; i < 16; ++i) { o0[i] *= alpha; o1[i] *= alpha; }
#pragma unroll
        for (int nb = 0; nb < 2; ++nb)
#pragma unroll
            for (int s = 0; s < 2; ++s) {
                const bf16x8 pf = pack_step(nb ? s1 : s0, s);
                const LAS bf16_t* vp = vt + (32 * nb + 16 * s + 4 * h + trq) * NA_VS + trc;
                o0 = MFMA32(tr8(vp, vp + 8 * NA_VS), pf, o0); o1 = MFMA32(tr8(vp + 32, vp + 32 + 8 * NA_VS), pf, o1);
            }
    }
#undef NA_TROW
#undef NA_LD
#undef NA_ST
    const float inv = 1.0f / lrun;
    bf16_t* op = O + (size_t)(qrow0 + r) * OS + head * 64 + 4 * h;
#pragma unroll
    for (int g = 0; g < 4; ++g) {
        u32x2 w0, w1; w0.x = pk2(o0[4 * g] * inv, o0[4 * g + 1] * inv); w0.y = pk2(o0[4 * g + 2] * inv, o0[4 * g + 3] * inv);
        w1.x = pk2(o1[4 * g] * inv, o1[4 * g + 1] * inv); w1.y = pk2(o1[4 * g + 2] * inv, o1[4 * g + 3] * inv);
        *(u32x2*)(op + 8 * g) = w0; *(u32x2*)(op + 32 + 8 * g) = w1;
    }
}
DI void phase_na(const Frame& F, int l, bool ctx_out) {
    const bf16_t* Z = (const bf16_t*)(F.ws + WS_R1); bf16_t* O = (bf16_t*)(F.ws + WS_R1 + R1_O);
    LAS float* tab = (LAS float*)(F.lds + NA_TAB2);
    __syncthreads();
    for (int i = F.tid; i < 8 * 16 * 32; i += 512) { const int hh = i >> 9, dr = (i >> 5) & 15, dc = i & 31;
        tab[i] = (dr == 15) ? 0.f : ((dc == 31) ? -1e30f : F.in[I_RPB][(size_t)l * 8 * 15 * 31 + (hh * 15 + dr) * 31 + dc] * NA_L2E); }
    __syncthreads();
    const int nlat = NB * 8 * 8, ntot = nlat + (ctx_out ? NB * 8 : 0);
#pragma unroll 1
    for (int u = F.bid; u < ntot; u += F.G) {
        if (u < nlat) na_block_unit(F, Z, O, tab, u & 7, false, u >> 6, (u >> 3) & 7);
        else { const int v = u - nlat; na_block_unit(F, Z, O, tab, v & 7, true, v >> 3, 0); }
    }
    __syncthreads();
}

constexpr int GP_CUM = 0, GL_CUMS = 132, GP_W2T = 33792  , GP_B2 = GP_W2T + 2 * 128 * 24 * 2  , GP_SEG = GP_B2 + 1024  ;
DI size_t gl_chunk_row(int b, int cn) { return cn < 4 ? (size_t)(TL + b * CTXL + cn * 64) : (size_t)(b * SEQ + (cn - 4) * 64); }
DI void gla_prep(const Frame& F, int l, int task) {
    const int cn = task % 36, hd = (task / 36) & 3, b = task / 144;
    bf16_t* Z = (bf16_t*)(F.ws + WS_R1); bf16_t* O = (bf16_t*)(F.ws + WS_R1 + R1_O); float* DECB = (float*)(F.ws + WS_DECB);
    LAS float* CUM = (LAS float*)(F.lds + GP_CUM); LAS float* SEG = (LAS float*)(F.lds + GP_SEG);
    const int tid = F.tid, lane = F.lane, wave = F.wave, r = lane & 31, h = lane >> 5;
    const size_t row0 = gl_chunk_row(b, cn);
    const bf16_t* W2G = (const bf16_t*)(F.ws + WS_W2TG);
    __syncthreads();
    const int tt = tid >> 3, seg = tid & 7, d0 = seg * 16;
    const int atb = wave & 1, adb = wave >> 1;
    const bf16_t* zr = Z + (row0 + tt) * ZS;
    const u32x4 q0 = *(const u32x4*)(zr + C_QGLA + hd * 128 + d0), q1 = *(const u32x4*)(zr + C_QGLA + hd * 128 + d0 + 8);
    const u32x4 k0 = *(const u32x4*)(zr + C_KGLA + hd * 128 + d0), k1 = *(const u32x4*)(zr + C_KGLA + hd * 128 + d0 + 8);
    float qv[16], kv[16];
    qv[0] = bf_lo(q0.x); qv[1] = bf_hi(q0.x); qv[2] = bf_lo(q0.y); qv[3] = bf_hi(q0.y); qv[4] = bf_lo(q0.z); qv[5] = bf_hi(q0.z); qv[6] = bf_lo(q0.w); qv[7] = bf_hi(q0.w);
    qv[8] = bf_lo(q1.x); qv[9] = bf_hi(q1.x); qv[10] = bf_lo(q1.y); qv[11] = bf_hi(q1.y); qv[12] = bf_lo(q1.z); qv[13] = bf_hi(q1.z); qv[14] = bf_lo(q1.w); qv[15] = bf_hi(q1.w);
    kv[0] = bf_lo(k0.x); kv[1] = bf_hi(k0.x); kv[2] = bf_lo(k0.y); kv[3] = bf_hi(k0.y); kv[4] = bf_lo(k0.z); kv[5] = bf_hi(k0.z); kv[6] = bf_lo(k0.w); kv[7] = bf_hi(k0.w);
    kv[8] = bf_lo(k1.x); kv[9] = bf_hi(k1.x); kv[10] = bf_lo(k1.y); kv[11] = bf_hi(k1.y); kv[12] = bf_lo(k1.z); kv[13] = bf_hi(k1.z); kv[14] = bf_lo(k1.w); kv[15] = bf_hi(k1.w);
    __syncthreads();
#pragma unroll 1
    for (int dir = 0; dir < 2; ++dir) {
        {
            const int tl = 32 * atb + r, tn = dir ? 63 - tl : tl;
            const bf16x8 lrf = *(const bf16x8*)(Z + (row0 + tn) * ZS + C_GATE + dir * 16 + 8 * h);
            const bf16x8 w2f = *(const bf16x8*)(W2G + ((size_t)(l * 2 + dir) * 512 + hd * 128 + 32 * adb + r) * 16 + 8 * h);
            const float b2v = F.in[I_GGB][(size_t)(l * 2 + dir) * 512 + hd * 128 + 32 * adb + r];
            f32x16 ga;
#pragma unroll
            for (int i = 0; i < 16; ++i) ga[i] = 0.f;
            ga = MFMA32(lrf, w2f, ga);
            float sg[4];
#pragma unroll
            for (int g = 0; g < 4; ++g) {
                float run = 0.f;
#pragma unroll
                for (int e = 0; e < 4; ++e) { const float x = ga[4 * g + e] + b2v; run += (fminf(x, 0.f) - __logf(1.0f + __expf(-fabsf(x)))) * (1.0f / 16.0f); ga[4 * g + e] = run; }
                sg[g] = run;
            }
            float off = 0.f;
#pragma unroll
            for (int g = 0; g < 4; ++g) { const float ps = __shfl_xor(sg[g], 32); const float o = off + (h ? ps : 0.f);
#pragma unroll
                for (int e = 0; e < 4; ++e) CUM[(32 * atb + 8 * g + 4 * h + e) * GL_CUMS + 32 * adb + r] = ga[4 * g + e] + o;
                off += sg[g] + ps; }
            if (h == 0) SEG[atb * 128 + 32 * adb + r] = off;
        }
        __syncthreads();
        {
            const int tau = dir ? 63 - tt : tt;
            float qs[16], ks[16];
#pragma unroll
            for (int j = 0; j < 4; ++j) {
                const f32x4 e0 = *(const LAS f32x4*)(SEG + d0 + 4 * j), e1 = *(const LAS f32x4*)(SEG + 128 + d0 + 4 * j);
                const f32x4 cl = *(const LAS f32x4*)(CUM + tau * GL_CUMS + d0 + 4 * j);
#pragma unroll
                for (int e = 0; e < 4; ++e) {
                    const float cum = cl[e] + (tau >= 32 ? e0[e] : 0.f);
                    const int jj = 4 * j + e;
                    const float ex = __expf(cum), inv = __builtin_amdgcn_rcpf(ex);
                    qs[jj] = qv[jj] * 0.08838834764831845f * ex;
                    ks[jj] = kv[jj] * inv;
                }
                if (tt == 0) { f32x4 dv;
#pragma unroll
                    for (int e = 0; e < 4; ++e) dv[e] = __expf(e0[e] + e1[e]);
                    *(f32x4*)(DECB + ((size_t)((b * 4 + hd) * 2 + dir) * 36 + cn) * 128 + d0 + 4 * j) = dv; }
            }
            bf16_t* qd = dir ? O + (row0 + tt) * OS + 1024 + hd * 128 + d0 : Z + (row0 + tt) * ZS + C_QGLA + hd * 128 + d0;
            bf16_t* kd = dir ? O + (row0 + tt) * OS + 1536 + hd * 128 + d0 : Z + (row0 + tt) * ZS + C_KGLA + hd * 128 + d0;
            u32x4 w;
            w.x = pk2(qs[0], qs[1]); w.y = pk2(qs[2], qs[3]); w.z = pk2(qs[4], qs[5]); w.w = pk2(qs[6], qs[7]); *(u32x4*)qd = w;
            w.x = pk2(qs[8], qs[9]); w.y = pk2(qs[10], qs[11]); w.z = pk2(qs[12], qs[13]); w.w = pk2(qs[14], qs[15]); *(u32x4*)(qd + 8) = w;
            w.x = pk2(ks[0], ks[1]); w.y = pk2(ks[2], ks[3]); w.z = pk2(ks[4], ks[5]); w.w = pk2(ks[6], ks[7]); *(u32x4*)kd = w;
            w.x = pk2(ks[8], ks[9]); w.y = pk2(ks[10], ks[11]); w.z = pk2(ks[12], ks[13]); w.w = pk2(ks[14], ks[15]); *(u32x4*)(kd + 8) = w;
        }
        __syncthreads();
    }
}
constexpr int GL_RS = 136, GL_VS = 72, GC_QS = 0, GC_KS = GC_QS + 2 * 64 * GL_RS * 2, GC_V = GC_KS + 2 * 64 * GL_RS * 2, GC_ST = GC_V + 2 * 64 * GL_VS * 2, GC_DEC = GC_ST + 2 * 128 * GL_VS * 2;
static_assert(GC_DEC + 2 * 128 * 4 <= MISC_OFF, "GLA chain LDS");
DI void gla_chain(const Frame& F, int l, int chain, bool ctx_out) {
    const int vs = chain & 3, dir = (chain >> 2) & 1, hd = (chain >> 3) & 3, b = chain >> 5;
    const bf16_t* Z = (const bf16_t*)(F.ws + WS_R1); const bf16_t* O = (const bf16_t*)(F.ws + WS_R1 + R1_O); const float* DECB = (const float*)(F.ws + WS_DECB);
    bf16_t* OD = (bf16_t*)(F.ws + WS_R2 + (dir ? R2_OB : 0));
    const int tid = F.tid, lane = F.lane, wave = F.wave, r = lane & 31, h = lane >> 5;
    const int trq = (lane & 15) >> 2, trc = 16 * ((lane >> 4) & 1) + 4 * (lane & 3);
    const int tau = tid >> 3, seg = tid & 7, d0 = seg * 16;
#define GL_CN(s_) ((s_) < 4 ? (dir ? 3 - (s_) : (s_)) : 4 + (dir ? 31 - ((s_) - 4) : ((s_) - 4)))
#define GL_ROW(s_, t_) (gl_chunk_row(b, GL_CN(s_)) + (dir ? 63 - (t_) : (t_)))
    const bf16_t* qbase = dir ? O + 1024 + hd * 128 + d0 : Z + C_QGLA + hd * 128 + d0; const bf16_t* kbase = dir ? O + 1536 + hd * 128 + d0 : Z + C_KGLA + hd * 128 + d0;
    const size_t qstr = dir ? OS : ZS;
    const bf16_t* vbase = Z + C_VGLA + hd * 256 + vs * 64 + seg * 8;
    const float* dbase = DECB + (size_t)((b * 4 + hd) * 2 + dir) * 36 * 128;
    __syncthreads();
    for (int i = tid; i < 128 * GL_VS / 2; i += 512) ((LAS unsigned*)(F.lds + GC_ST))[i] = 0u;
    f32x16 S0, S1;
#pragma unroll
    for (int i = 0; i < 16; ++i) { S0[i] = 0.f; S1[i] = 0.f; }
    u32x4 nq0, nq1, nk0, nk1, nvv; float ndec = 0.f;
#define GL_LOAD(s_) do { const size_t rw = GL_ROW(s_, tau); nq0 = *(const u32x4*)(qbase + rw * qstr); nq1 = *(const u32x4*)(qbase + rw * qstr + 8); nk0 = *(const u32x4*)(kbase + rw * qstr); nk1 = *(const u32x4*)(kbase + rw * qstr + 8); \
        nvv = *(const u32x4*)(vbase + rw * ZS); if (tid < 128) ndec = dbase[GL_CN(s_) * 128 + tid]; } while (0)
#define GL_PUT(p_) do { LAS bf16_t* qd = (LAS bf16_t*)(F.lds + GC_QS) + ((p_) * 64 + tau) * GL_RS + d0; LAS bf16_t* kd = (LAS bf16_t*)(F.lds + GC_KS) + ((p_) * 64 + tau) * GL_RS + d0; \
        *(LAS u32x4*)qd = nq0; *(LAS u32x4*)(qd + 8) = nq1; *(LAS u32x4*)kd = nk0; *(LAS u32x4*)(kd + 8) = nk1; *(LAS u32x4*)((LAS bf16_t*)(F.lds + GC_V) + ((p_) * 64 + tau) * GL_VS + seg * 8) = nvv; \
        if (tid < 128) ((LAS float*)(F.lds + GC_DEC))[(p_) * 128 + tid] = ndec; } while (0)
    GL_LOAD(0); GL_PUT(0); GL_LOAD(1);
    __syncthreads();
#pragma unroll 1
    for (int s = 0; s < 36; ++s) {
        const int p = s & 1;
        const bool emit = (s >= 4) || ctx_out;
        const LAS bf16_t* QS = (const LAS bf16_t*)(F.lds + GC_QS) + p * 64 * GL_RS; const LAS bf16_t* KS = (const LAS bf16_t*)(F.lds + GC_KS) + p * 64 * GL_RS;
        const LAS bf16_t* VV = (const LAS bf16_t*)(F.lds + GC_V) + p * 64 * GL_VS;
        const LAS bf16_t* STo = (const LAS bf16_t*)(F.lds + GC_ST) + p * 128 * GL_VS; LAS bf16_t* STn = (LAS bf16_t*)(F.lds + GC_ST) + (p ^ 1) * 128 * GL_VS;
        if (wave < 4) {
            if (emit) {
                const int vb = wave & 1, tb = wave >> 1;
                f32x16 a0, a1, oo, oi;
#pragma unroll
                for (int i = 0; i < 16; ++i) { a0[i] = 0.f; a1[i] = 0.f; oo[i] = 0.f; oi[i] = 0.f; }
#pragma unroll
                for (int kk = 0; kk < 8; ++kk) {
                    const bf16x8 qf = *(const LAS bf16x8*)(QS + (32 * tb + r) * GL_RS + 16 * kk + 8 * h);
                    const bf16x8 kf0 = *(const LAS bf16x8*)(KS + r * GL_RS + 16 * kk + 8 * h);
                    const LAS bf16_t* sp = STo + (16 * kk + 8 * h + trq) * GL_VS + 32 * vb + trc;
                    a0 = MFMA32(kf0, qf, a0);
                    oi = MFMA32(tr8(sp, sp + 4 * GL_VS), qf, oi);
                    if (tb == 1) { const bf16x8 kf1 = *(const LAS bf16x8*)(KS + (32 + r) * GL_RS + 16 * kk + 8 * h); a1 = MFMA32(kf1, qf, a1); }
                }
                const int tt = 32 * tb + r;
#pragma unroll
                for (int i = 0; i < 16; ++i) { const int sg0 = crow(i, h); if (sg0 > tt) a0[i] = 0.f; if (32 + sg0 > tt) a1[i] = 0.f; }
#pragma unroll
                for (int sb = 0; sb < 2; ++sb)
#pragma unroll
                    for (int st = 0; st < 2; ++st) {
                        if (sb == 1 && tb == 0) continue;
                        const bf16x8 pf = pack_step(sb ? a1 : a0, st);
                        const LAS bf16_t* vp = VV + (32 * sb + 16 * st + 4 * h + trq) * GL_VS + 32 * vb + trc;
                        oo = MFMA32(tr8(vp, vp + 8 * GL_VS), pf, oo);
                    }
#pragma unroll
                for (int i = 0; i < 16; ++i) oo[i] += oi[i];
                const size_t orow = GL_ROW(s, tt);
                bf16_t* op = OD + orow * D + hd * 256 + vs * 64 + 32 * vb + 4 * h;
#pragma unroll
                for (int g = 0; g < 4; ++g) { u32x2 w; w.x = pk2(oo[4 * g], oo[4 * g + 1]); w.y = pk2(oo[4 * g + 2], oo[4 * g + 3]); *(u32x2*)(op + 8 * g) = w; }
            }
        } else {
            const int db = wave - 4, dd = 32 * db + r;
            const float dec = ((const LAS float*)(F.lds + GC_DEC))[p * 128 + dd];
#pragma unroll
            for (int kk = 0; kk < 4; ++kk) {
                const LAS bf16_t* kp = KS + (16 * kk + 8 * h + trq) * GL_RS + 32 * db + trc;
                const LAS bf16_t* v0p = VV + (16 * kk + 8 * h + trq) * GL_VS + trc;
                const bf16x8 kf = tr8(kp, kp + 4 * GL_RS);
                S0 = MFMA32(tr8(v0p, v0p + 4 * GL_VS), kf, S0); S1 = MFMA32(tr8(v0p + 32, v0p + 32 + 4 * GL_VS), kf, S1);
            }
#pragma unroll
            for (int i = 0; i < 16; ++i) { S0[i] *= dec; S1[i] *= dec; }
#pragma unroll
            for (int g = 0; g < 4; ++g) {
                u32x2 w0, w1; w0.x = pk2(S0[4 * g], S0[4 * g + 1]); w0.y = pk2(S0[4 * g + 2], S0[4 * g + 3]); w1.x = pk2(S1[4 * g], S1[4 * g + 1]); w1.y = pk2(S1[4 * g + 2], S1[4 * g + 3]);
                *(LAS u32x2*)(STn + dd * GL_VS + 8 * g + 4 * h) = w0; *(LAS u32x2*)(STn + dd * GL_VS + 32 + 8 * g + 4 * h) = w1;
            }
        }
        if (s + 1 < 36) { GL_PUT(p ^ 1); const int s2 = s + 2 < 36 ? s + 2 : 35; GL_LOAD(s2); }
        __syncthreads();
    }
#undef GL_ROW
#undef GL_CN
#undef GL_LOAD
#undef GL_PUT
}
DI void phase_gla_fin(const Frame& F, int l, int M) {
    const int NGW = F.G * 8, gw = F.bid * 8 + F.wave, lane = F.lane;
    const bf16_t* Z = (const bf16_t*)(F.ws + WS_R1); bf16_t* O = (bf16_t*)(F.ws + WS_R1 + R1_O);
    const bf16_t* OFp = (const bf16_t*)(F.ws + WS_R2); const bf16_t* OBp = (const bf16_t*)(F.ws + WS_R2 + R2_OB);
    const float* gn = F.in[I_GNG] + (size_t)l * 256;
    for (int t = gw; t < M; t += NGW) {
        const u32x4 a0 = *(const u32x4*)(OFp + (size_t)t * D + 16 * lane), a1 = *(const u32x4*)(OFp + (size_t)t * D + 16 * lane + 8);
        const u32x4 b0 = *(const u32x4*)(OBp + (size_t)t * D + 16 * lane), b1 = *(const u32x4*)(OBp + (size_t)t * D + 16 * lane + 8);
        const u32x4 r0 = *(const u32x4*)(Z + (size_t)t * ZS + C_RGLA + 16 * lane), r1 = *(const u32x4*)(Z + (size_t)t * ZS + C_RGLA + 16 * lane + 8);
        float o[16], rr[16];
        o[0] = bf_lo(a0.x) + bf_lo(b0.x); o[1] = bf_hi(a0.x) + bf_hi(b0.x); o[2] = bf_lo(a0.y) + bf_lo(b0.y); o[3] = bf_hi(a0.y) + bf_hi(b0.y);
        o[4] = bf_lo(a0.z) + bf_lo(b0.z); o[5] = bf_hi(a0.z) + bf_hi(b0.z); o[6] = bf_lo(a0.w) + bf_lo(b0.w); o[7] = bf_hi(a0.w) + bf_hi(b0.w);
        o[8] = bf_lo(a1.x) + bf_lo(b1.x); o[9] = bf_hi(a1.x) + bf_hi(b1.x); o[10] = bf_lo(a1.y) + bf_lo(b1.y); o[11] = bf_hi(a1.y) + bf_hi(b1.y);
        o[12] = bf_lo(a1.z) + bf_lo(b1.z); o[13] = bf_hi(a1.z) + bf_hi(b1.z); o[14] = bf_lo(a1.w) + bf_lo(b1.w); o[15] = bf_hi(a1.w) + bf_hi(b1.w);
        rr[0] = bf_lo(r0.x); rr[1] = bf_hi(r0.x); rr[2] = bf_lo(r0.y); rr[3] = bf_hi(r0.y); rr[4] = bf_lo(r0.z); rr[5] = bf_hi(r0.z); rr[6] = bf_lo(r0.w); rr[7] = bf_hi(r0.w);
        rr[8] = bf_lo(r1.x); rr[9] = bf_hi(r1.x); rr[10] = bf_lo(r1.y); rr[11] = bf_hi(r1.y); rr[12] = bf_lo(r1.z); rr[13] = bf_hi(r1.z); rr[14] = bf_lo(r1.w); rr[15] = bf_hi(r1.w);
        float ss = 0.f;
#pragma unroll
        for (int i = 0; i < 16; ++i) ss += o[i] * o[i];
        ss += __shfl_xor(ss, 1); ss += __shfl_xor(ss, 2); ss += __shfl_xor(ss, 4); ss += __shfl_xor(ss, 8);
        const float rstd = rsqrtf(ss * (1.0f / 256.0f) + RMS_EPS);
        const int v0 = (lane & 15) * 16;
        float y[16];
#pragma unroll
        for (int i = 0; i < 16; ++i) y[i] = o[i] * rstd * gn[v0 + i] * siluf_(rr[i]);
        u32x4 w0, w1; w0.x = pk2(y[0], y[1]); w0.y = pk2(y[2], y[3]); w0.z = pk2(y[4], y[5]); w0.w = pk2(y[6], y[7]);
        w1.x = pk2(y[8], y[9]); w1.y = pk2(y[10], y[11]); w1.z = pk2(y[12], y[13]); w1.w = pk2(y[14], y[15]);
        *(u32x4*)(O + (size_t)t * OS + 1024 + 16 * lane) = w0; *(u32x4*)(O + (size_t)t * OS + 1024 + 16 * lane + 8) = w1;
    }
}

constexpr int RT_HS = 1032;
template <bool DRY = false> DI void phase_router(const Frame& F, int l, int M) {
    LAS bf16_t* HH = (LAS bf16_t*)F.lds;
    LAS bf16_t* HL = HH + 32 * RT_HS;
    LAS float* H2F = (LAS float*)F.lds;
    bf16_t* H2 = (bf16_t*)(F.ws + WS_R1 + R1_H2);
    const float* xres = F.out; const float* cres = (const float*)(F.ws + WS_CTXS);
    const bf16_t* WRH = (const bf16_t*)(F.ws + WS_WRT) + (size_t)(l * 2) * NE * D; const bf16_t* WRL = WRH + (size_t)NE * D;
    int* toke = (int*)(F.ws + WS_TOKE); int* tokp = (int*)(F.ws + (DRY ? WS_TOKR : WS_TOKP)); float* tokw = (float*)(F.ws + WS_TOKW);
    unsigned* cnt = (unsigned*)(F.ws + WS_CTL) + CW_CNT + 4096 * l + (DRY ? 32 : 0);
    const int lane = F.lane, wave = F.wave, r = lane & 31, hh = lane >> 5;
    const float brt = F.in[I_BR][l * NE + lane];
    const int npass = (M + 31) / 32;
    float xr[4][16];
#pragma unroll
    for (int rr = 0; rr < 4; ++rr) { const int t = F.bid * 32 + 4 * wave + rr;
        if (F.bid < npass && t < M) load_row_f32(t >= TL ? cres + (size_t)(t - TL) * D : xres + (size_t)t * D, lane, xr[rr]);
        else {
#pragma unroll
            for (int i = 0; i < 16; ++i) xr[rr][i] = 0.f; } }
    float gg[16]; load_row_f32(F.in[I_G2] + (size_t)l * D, lane, gg);
#pragma unroll 1
    for (int ps = F.bid; ps < npass; ps += F.G) {
        __syncthreads();
        { const int t0 = ps * 32; const int mr = t0 >= TL ? 8 : t0 / SEQ;
          float sh[16], sc[16]; load_row_f32(modp(F, l, mr, 3), lane, sh); load_row_f32(modp(F, l, mr, 4), lane, sc);
#pragma unroll
          for (int rr = 0; rr < 4; ++rr) {
            const int row = 4 * wave + rr, t = ps * 32 + row;
            float h[16]; float ss = 0.f;
#pragma unroll
            for (int i = 0; i < 16; ++i) ss += xr[rr][i] * xr[rr][i];
            const float rstd = rsqrtf(wave_sum(ss) * (1.0f / D) + RMS_EPS);
#pragma unroll
            for (int i = 0; i < 16; ++i) h[i] = (t < M) ? xr[rr][i] * rstd * gg[i] * (1.0f + sc[i]) + sh[i] : 0.f;
            if (t < M) store_row_bf16(H2 + (size_t)t * D, lane, h);
#pragma unroll
            for (int i = 0; i < 2; ++i) {
                u32x4 whi; whi.x = pk2(h[8 * i], h[8 * i + 1]); whi.y = pk2(h[8 * i + 2], h[8 * i + 3]); whi.z = pk2(h[8 * i + 4], h[8 * i + 5]); whi.w = pk2(h[8 * i + 6], h[8 * i + 7]);
                u32x4 wlo; wlo.x = pk2(h[8 * i] - bf_lo(whi.x), h[8 * i + 1] - bf_hi(whi.x)); wlo.y = pk2(h[8 * i + 2] - bf_lo(whi.y), h[8 * i + 3] - bf_hi(whi.y));
                wlo.z = pk2(h[8 * i + 4] - bf_lo(whi.z), h[8 * i + 5] - bf_hi(whi.z)); wlo.w = pk2(h[8 * i + 6] - bf_lo(whi.w), h[8 * i + 7] - bf_hi(whi.w));
                *(LAS u32x4*)(HH + row * RT_HS + 8 * lane + 512 * i) = whi; *(LAS u32x4*)(HL + row * RT_HS + 8 * lane + 512 * i) = wlo; }
          }
          const int pn = ps + F.G;
#pragma unroll
          for (int rr = 0; rr < 4; ++rr) { const int t = pn * 32 + 4 * wave + rr;
              if (pn < npass && t < M) load_row_f32(t >= TL ? cres + (size_t)(t - TL) * D : xres + (size_t)t * D, lane, xr[rr]); }
        }
        __syncthreads();
        f32x16 a0, a1;
#pragma unroll
        for (int i = 0; i < 16; ++i) { a0[i] = 0.f; a1[i] = 0.f; }
        {
            const LAS bf16_t* hp = HH + r * RT_HS + 128 * wave + 8 * hh; const LAS bf16_t* lp = HL + r * RT_HS + 128 * wave + 8 * hh;
            const bf16_t* w0h = WRH + (size_t)r * D + 128 * wave + 8 * hh; const bf16_t* w1h = w0h + (size_t)32 * D;
            const bf16_t* w0l = WRL + (size_t)r * D + 128 * wave + 8 * hh; const bf16_t* w1l = w0l + (size_t)32 * D;
#pragma unroll
            for (int ks = 0; ks < 8; ++ks) {
                const bf16x8 ah = *(const LAS bf16x8*)(hp + 16 * ks), al = *(const LAS bf16x8*)(lp + 16 * ks);
                const bf16x8 b0h = *(const bf16x8*)(w0h + 16 * ks), b1h = *(const bf16x8*)(w1h + 16 * ks), b0l = *(const bf16x8*)(w0l + 16 * ks), b1l = *(const bf16x8*)(w1l + 16 * ks);
                a0 = MFMA32(ah, b0h, a0); a1 = MFMA32(ah, b1h, a1);
                a0 = MFMA32(al, b0h, a0); a1 = MFMA32(al, b1h, a1);
                a0 = MFMA32(ah, b0l, a0); a1 = MFMA32(ah, b1l, a1);
            }
        }
        __syncthreads();
#pragma unroll
        for (int i = 0; i < 16; ++i) { const int tk = crow(i, hh); H2F[(wave * 32 + tk) * 64 + r] = a0[i]; H2F[(wave * 32 + tk) * 64 + 32 + r] = a1[i]; }
        __syncthreads();
        LAS unsigned* lcnt = (LAS unsigned*)(F.lds + MISC_OFF + 2048);
        if (F.tid < 64) lcnt[F.tid] = 0u;
        __syncthreads();
        int myj[4]; unsigned mylp[4]; float myw[4];
#pragma unroll
        for (int rr = 0; rr < 4; ++rr) {
            const int row = 4 * wave + rr, t = ps * 32 + row;
            myj[rr] = -1; mylp[rr] = 0u; myw[rr] = 0.f;
            if (t >= M) continue;
            float logit = 0.f;
#pragma unroll
            for (int w = 0; w < 8; ++w) logit += H2F[(w * 32 + row) * 64 + lane];
            const float score = sigmoidf_(logit), sel = score + brt;
            float g1 = sel; g1 = fmaxf(g1, __shfl_xor(g1, 1)); g1 = fmaxf(g1, __shfl_xor(g1, 2)); g1 = fmaxf(g1, __shfl_xor(g1, 4));
            const unsigned long long bm = __ballot(sel == g1);
            const unsigned gm = (unsigned)((bm >> (lane & ~7)) & 0xffull);
            const int first = __builtin_ctz(gm);
            float g2 = ((lane & 7) == first) ? -INFINITY : sel; g2 = fmaxf(g2, __shfl_xor(g2, 1)); g2 = fmaxf(g2, __shfl_xor(g2, 2)); g2 = fmaxf(g2, __shfl_xor(g2, 4));
            const float gs = g1 + g2; const int g = lane >> 3;
            int grank = 0;
#pragma unroll
            for (int j = 0; j < 8; ++j) { const float o = __shfl(gs, 8 * j); grank += (o > gs || (o == gs && j < g)) ? 1 : 0; }
            const bool gsel = grank < 4;
            const float ms = gsel ? sel : -INFINITY;
            int rank = 0;
#pragma unroll 4
            for (int j = 0; j < 64; ++j) { const float o = __int_as_float(__builtin_amdgcn_readlane(__float_as_int(ms), j)); rank += (o > ms || (o == ms && j < lane)) ? 1 : 0; }
            const bool chosen = gsel && rank < 8;
            const unsigned long long cb = __ballot(chosen);
            const float ssum = wave_sum(chosen ? score : 0.f);
            if (chosen) {
                const int j = __builtin_popcountll(cb & ((1ull << lane) - 1ull));
                if (j < 8) { myj[rr] = j; mylp[rr] = __hip_atomic_fetch_add(&lcnt[lane], 1u, __ATOMIC_RELAXED, __HIP_MEMORY_SCOPE_WORKGROUP); myw[rr] = score * __builtin_amdgcn_rcpf(ssum) * 2.5f; }
            }
        }
        __syncthreads();
        if (F.tid < 64) { const unsigned c = lcnt[F.tid]; lcnt[64 + F.tid] = c ? atomicAdd(cnt + F.tid * 64, c) : 0u; }
        __syncthreads();
#pragma unroll
        for (int rr = 0; rr < 4; ++rr) {
            const int t = ps * 32 + 4 * wave + rr;
            if (myj[rr] >= 0) { const size_t o = (size_t)t * 8 + myj[rr]; toke[o] = lane; tokp[o] = (int)(lcnt[64 + lane] + mylp[rr]); tokw[o] = myw[rr]; }
        }
    }
    __syncthreads();
}
DI void moe_tables(const Frame& F, int l, int M) {
    LAS int* tb = (LAS int*)(F.lds + MISC_OFF + 64); LAS int* rb = tb + 72; LAS int* cn = rb + 72;
    const unsigned* cnt = (const unsigned*)(F.ws + WS_CTL) + CW_CNT + 4096 * l;
    __syncthreads();
    if (F.tid < NE) cn[F.tid] = (int)__hip_atomic_load(cnt + F.tid * 64, __ATOMIC_RELAXED, __HIP_MEMORY_SCOPE_AGENT);
    if (F.tid == NE) cn[NE] = M;
    __syncthreads();
    if (F.tid == 0) { int t = 0, r = 0; for (int e = 0; e < NEX; ++e) { tb[e] = t; rb[e] = r; t += (cn[e] + 255) >> 8; r += cn[e]; } tb[NEX] = t; }
    __syncthreads();
    LAS unsigned char* te = (LAS unsigned char*)(cn + 72);
    if (F.tid < NEX) { const int t0 = tb[F.tid], t1 = tb[F.tid + 1]; for (int t = t0; t < t1; ++t) te[t] = (unsigned char)F.tid; }
    __syncthreads();
}
DI void phase_route_tables(const Frame& F, int l, int M) {
    moe_tables(F, l, M);
    const LAS int* rb = (const LAS int*)(F.lds + MISC_OFF + 64) + 72;
    const int* toke = (const int*)(F.ws + WS_TOKE); const int* tokp = (const int*)(F.ws + WS_TOKP);
    int* tokr = (int*)(F.ws + WS_TOKR); int* rowl = (int*)(F.ws + WS_ROWL);
    for (int i = F.bid * 512 + F.tid; i < M * 8; i += F.G * 512) { const int row = rb[toke[i]] + tokp[i]; tokr[i] = row; rowl[row] = i >> 3; }
    const int shb = rb[NE];
    for (int i = F.bid * 512 + F.tid; i < M + 256; i += F.G * 512) rowl[shb + i] = (i < M) ? i : 0;
}
template <bool DRY = false> DI void phase_combine(const Frame& F, int l, int M) {
    moe_tables(F, l, M);
    const LAS int* rb = (const LAS int*)(F.lds + MISC_OFF + 64) + 72;
    const int shb = rb[NE];
    const int gw = F.bid * 8 + F.wave, lane = F.lane;
    const unsigned char* OS_ = (const unsigned char*)(F.ws + WS_R1);
    const int* tokr = (const int*)(F.ws + WS_TOKR); const float* tokw = (const float*)(F.ws + WS_TOKW);
    float* xres = F.out; float* cres = (float*)(F.ws + WS_CTXS);
    bf16_t* H = (bf16_t*)(F.ws + WS_R2 + (DRY ? (size_t)40 * 1024 * 1024 : 0));
    const int per = M / (GRID * 8);
    const int tbeg = gw * per;
    int mr_cur = -1;
    float g2v[16], shv[16], scv[16], gnv[16];
    if (l == 0) load_row_f32(F.in[I_G1] + D, lane, gnv); else load_row_f32(F.in[I_GF], lane, gnv);
    int4 nr0, nr1; f32x4 nw0, nw1; float xn[16];
    { const int t = tbeg; nr0 = *(const int4*)(tokr + (size_t)t * 8); nr1 = *(const int4*)(tokr + (size_t)t * 8 + 4); nw0 = *(const f32x4*)(tokw + (size_t)t * 8); nw1 = *(const f32x4*)(tokw + (size_t)t * 8 + 4);
      load_row_f32(t >= TL ? cres + (size_t)(t - TL) * D : xres + (size_t)t * D, lane, xn); }
#pragma unroll 1
    for (int k = 0; k < per; ++k) {
        const int t = tbeg + k;
        const bool isctx = t >= TL; const int mr = isctx ? 8 : t / SEQ;
        if (mr != mr_cur) { mr_cur = mr; load_row_f32(modp(F, l, mr, 5), lane, g2v); if (l == 0) { load_row_f32(modp(F, 1, mr, 0), lane, shv); load_row_f32(modp(F, 1, mr, 1), lane, scv); } }
        const int rows[8] = {nr0.x, nr0.y, nr0.z, nr0.w, nr1.x, nr1.y, nr1.z, nr1.w};
        const float wts[8] = {nw0[0], nw0[1], nw0[2], nw0[3], nw1[0], nw1[1], nw1[2], nw1[3]};
        float x[16];
#pragma unroll
        for (int i = 0; i < 16; ++i) x[i] = xn[i];
        u32x2 v[9][2];
#pragma unroll
        for (int i = 0; i < 2; ++i) v[8][i] = *(const u32x2*)(OS_ + (size_t)(shb + t) * D + 8 * lane + 512 * i);
#pragma unroll
        for (int j = 0; j < 8; ++j)
#pragma unroll
            for (int i = 0; i < 2; ++i) v[j][i] = *(const u32x2*)(OS_ + (size_t)rows[j] * D + 8 * lane + 512 * i);
        if (k + 1 < per) { const int tn = t + 1; nr0 = *(const int4*)(tokr + (size_t)tn * 8); nr1 = *(const int4*)(tokr + (size_t)tn * 8 + 4); nw0 = *(const f32x4*)(tokw + (size_t)tn * 8); nw1 = *(const f32x4*)(tokw + (size_t)tn * 8 + 4);
            load_row_f32(tn >= TL ? cres + (size_t)(tn - TL) * D : xres + (size_t)tn * D, lane, xn); }
        float y[16];
#pragma unroll
        for (int i = 0; i < 2; ++i) { const u32x2 a = v[8][i];
            y[8 * i + 0] = __builtin_amdgcn_cvt_f32_fp8((int)a.x, 0); y[8 * i + 1] = __builtin_amdgcn_cvt_f32_fp8((int)a.x, 1); y[8 * i + 2] = __builtin_amdgcn_cvt_f32_fp8((int)a.x, 2); y[8 * i + 3] = __builtin_amdgcn_cvt_f32_fp8((int)a.x, 3);
            y[8 * i + 4] = __builtin_amdgcn_cvt_f32_fp8((int)a.y, 0); y[8 * i + 5] = __builtin_amdgcn_cvt_f32_fp8((int)a.y, 1); y[8 * i + 6] = __builtin_amdgcn_cvt_f32_fp8((int)a.y, 2); y[8 * i + 7] = __builtin_amdgcn_cvt_f32_fp8((int)a.y, 3); }
#pragma unroll
        for (int j = 0; j < DBG_NROUTED; ++j) { const float w = wts[j];
#pragma unroll
            for (int i = 0; i < 2; ++i) { const u32x2 a = v[j][i];
                y[8 * i + 0] += w * __builtin_amdgcn_cvt_f32_fp8((int)a.x, 0); y[8 * i + 1] += w * __builtin_amdgcn_cvt_f32_fp8((int)a.x, 1); y[8 * i + 2] += w * __builtin_amdgcn_cvt_f32_fp8((int)a.x, 2); y[8 * i + 3] += w * __builtin_amdgcn_cvt_f32_fp8((int)a.x, 3);
                y[8 * i + 4] += w * __builtin_amdgcn_cvt_f32_fp8((int)a.y, 0); y[8 * i + 5] += w * __builtin_amdgcn_cvt_f32_fp8((int)a.y, 1); y[8 * i + 6] += w * __builtin_amdgcn_cvt_f32_fp8((int)a.y, 2); y[8 * i + 7] += w * __builtin_amdgcn_cvt_f32_fp8((int)a.y, 3); } }
        float* xr = isctx ? cres + (size_t)(t - TL) * D : xres + (size_t)t * D;
#pragma unroll
        for (int i = 0; i < 16; ++i) x[i] += g2v[i] * y[i];
        float ss = 0.f;
#pragma unroll
        for (int i = 0; i < 16; ++i) ss += x[i] * x[i];
        const float rstd = rsqrtf(wave_sum(ss) * (1.0f / D) + RMS_EPS);
        if (l == 0) {
            if (!DRY) store_row_f32(xr, lane, x);
            float h[16];
#pragma unroll
            for (int i = 0; i < 16; ++i) h[i] = x[i] * rstd * gnv[i] * (1.0f + scv[i]) + shv[i];
            store_row_bf16(H + (size_t)t * D, lane, h);
        } else {
#pragma unroll
            for (int i = 0; i < 16; ++i) x[i] = x[i] * rstd * gnv[i];
            if (!DRY) store_row_f32(xr, lane, x); else store_row_bf16(H + (size_t)t * D, lane, x);
        }
    }
}

constexpr int PH_PER_LAYER = 10, N_PHASES = 2 + 2 * PH_PER_LAYER;
template <class T> DI T* opaque_ptr(T* p) {
    unsigned long long v = (unsigned long long)p; unsigned lo = (unsigned)v, hi = (unsigned)(v >> 32);
    asm volatile("" : "+s"(lo), "+s"(hi)); return (T*)(__attribute__((address_space(1))) T*)(((unsigned long long)hi << 32) | lo);
}
template <int KIND> DI void run_phase(const Frame& F0, const int l0) {
    Frame F = F0; int l = l0; asm volatile("" : "+s"(l));
    F.ws = opaque_ptr(F0.ws); F.out = opaque_ptr(F0.out);
    { int t = F0.tid; asm volatile("" : "+v"(t)); F.tid = t; F.lane = t & 63; F.wave = __builtin_amdgcn_readfirstlane(t >> 6); }
    unsigned char* const ws = F.ws;
    const bool ctx_out = (l == 0);
    const int M = ctx_out ? TA : TL;
    if constexpr (KIND == 0) { mod_vectors(F); conv_router(F); conv_gate_w(F); conv_small(F, 0); conv_down(F, 0, (bf16_t*)(ws + WS_WBS + WB_WD)); }
    if constexpr (KIND == 1) { phase_norm1_first(F); }
    if constexpr (KIND == 2) {
        pg8::RectSched<37> S{(const char*)(ws + WS_R2), (const char*)(ws + wbs_base(l) + WB_WIN), D, D, ctx_out ? 72 : 64, ctx_out ? 0 : 8, ctx_out ? 0 : 11, 64, F.G, F.bid};
        pg8::EpiStoreBf16 E{(bf16_t*)(ws + WS_R1), ZS};
        pg8::gemm_phase<false>(F.lds, F.tid, D, D, D, S, E);
    }
    if constexpr (KIND == 3) {
#pragma unroll 1
        for (int t = F.bid; t < NB * 4 * 36; t += F.G) gla_prep(F, l, t);
        phase_na(F, l, ctx_out);
        phase_conv(F, l, M);
    }
    if constexpr (KIND == 12) {
#pragma unroll 1
        for (int ch = F.bid; ch < 256; ch += F.G) gla_chain(F, l, ch, ctx_out);
    }
    if constexpr (KIND == 4) { phase_gla_fin(F, l, M); }
    if constexpr (KIND == 5) {
        const char* Ob = (const char*)(ws + WS_R1 + R1_O); bf16_t* Y = (bf16_t*)(ws + WS_R2); const bf16_t* Zb = (const bf16_t*)(ws + WS_R1);
        { pg8::RectSched<4> S{Ob, (const char*)(ws + wbs_base(l) + WB_WNA), OS, 512, M / 256, 0, 0, 0, F.G, F.bid}; pg8::EpiGate<0> E{Y, Zb, C_MERGE}; pg8::gemm_phase<false>(F.lds, F.tid, 512, OS, 512, S, E); }
        { pg8::RectSched<4> S{Ob + 512 * 2, (const char*)(ws + wbs_base(l) + WB_WSC), OS, 512, M / 256, 0, 0, 0, F.G, F.bid}; pg8::EpiGate<1> E{Y, Zb, C_MERGE + 1024}; pg8::gemm_phase<false>(F.lds, F.tid, 512, OS, 512, S, E); }
        { pg8::RectSched<4> S{Ob + 1024 * 2, (const char*)(ws + wbs_base(l) + WB_WGLA), OS, D, M / 256, 0, 0, 0, F.G, F.bid}; pg8::EpiGate<1> E{Y, Zb, C_MERGE + 2048}; pg8::gemm_phase<false>(F.lds, F.tid, D, OS, D, S, E); }
        if (l == 0) conv_small(F, 1, 32);
    }
    if constexpr (KIND == 6) {
        pg8::RectSched<4> S{(const char*)(ws + WS_R2), (const char*)(ws + wbs_base(l) + WB_WOUT), D, D, M / 256, 0, 0, 0, F.G, F.bid};
        pg8::EpiResid E{l == 0 ? F.in[I_X] : F.out, F.out, l == 0 ? F.in[I_CTX] : (const float*)(ws + WS_CTXS), (float*)(ws + WS_CTXS), modp(F, l, 0, 2)};
        pg8::gemm_phase<false>(F.lds, F.tid, D, D, D, S, E);
        if (l == 0) conv_gu(F, 0, (bf16_t*)(ws + WS_R1), 32);
    }
    if constexpr (KIND == 7) {
#if REPEAT_KIND == 71
        phase_router<true>(F, l, M);
#endif
        phase_router(F, l, M); if (l != 0) conv_gu(F, l, (bf16_t*)(ws + WS_R1));
#if REPEAT_KIND == 72
        conv_gu(F, l, (bf16_t*)(ws + WS_R1));
#endif
    }
    if constexpr (KIND == 8) { phase_route_tables(F, l, M); }
    if constexpr (KIND == 9) {
        moe_tables(F, l, M);
        const LAS int* tb = (const LAS int*)(F.lds + MISC_OFF + 64);
        pg8::MoeSched<true, 2> S{tb, tb + 72, tb + 144, (const char*)(ws + WS_R1 + R1_H2), (const int*)(ws + WS_ROWL), (const char*)(ws + WS_R1), (size_t)512 * D * 2, D, D, F.G, F.bid};
        pg8::EpiSwiGLU E{(bf16_t*)(ws + WS_R2)};
        pg8::gemm_phase<true>(F.lds, F.tid, D, D, D, S, E);
    }
    if constexpr (KIND == 10) {
        moe_tables(F, l, M);
        const LAS int* tb = (const LAS int*)(F.lds + MISC_OFF + 64);
        pg8::MoeSched<false, 4> S{tb, tb + 72, tb + 144, (const char*)(ws + WS_R2), nullptr, (const char*)(ws + WS_WBS + WB_WD), (size_t)D * FF * 2, FF, FF, F.G, F.bid};
        pg8::EpiDown E{(unsigned char*)(ws + WS_R1), 0x7fffffff};
        pg8::gemm_phase<false>(F.lds, F.tid, FF, FF, FF, S, E);
    }
    if constexpr (KIND == 11) {
#if REPEAT_KIND == 111
        phase_combine<true>(F, l, M);
#endif
        phase_combine(F, l, M); if (l == 0) conv_down(F, 1, (bf16_t*)(ws + WS_WBS + WB_WD));
    }
}
DI void make_frame(Frame& F, const Args& args, unsigned char* lds_raw) {
    F.lds = (LAS unsigned char*)lds_raw; F.ws = args.ws; F.in = args.in; F.out = args.out;
    F.tid = threadIdx.x; F.lane = F.tid & 63; F.wave = __builtin_amdgcn_readfirstlane(F.tid >> 6); F.G = GRID; F.bid = blockIdx.x;
}
template <int KIND> __global__ void __launch_bounds__(512, 2) fwd_k(Args args) {
    extern __shared__ __attribute__((aligned(16))) unsigned char lds_raw[];
    Frame F; make_frame(F, args, lds_raw);
    run_phase<KIND>(F, args.ph_lo);
}
#if MK_ONE_LAUNCH
__global__ void __launch_bounds__(512, 2) fwd(Args args) {
    extern __shared__ __attribute__((aligned(16))) unsigned char lds_raw[];
    Frame F; make_frame(F, args, lds_raw);
    volatile LAS unsigned* MISC = (volatile LAS unsigned*)(F.lds + MISC_OFF);
    if (F.tid < 4) MISC[F.tid] = 0u;
    __syncthreads();
    XcdBarrier bar = xcd_barrier_post((unsigned*)(F.ws + WS_CTL) + CW_BAR, MISC);
    run_phase<0>(F, 0); xcd_barrier(bar); if (REPEAT_KIND == 99) xcd_barrier(bar); if (REPEAT_KIND == 0) { run_phase<0>(F, 0); xcd_barrier(bar); }
    run_phase<1>(F, 0); xcd_barrier(bar); if (REPEAT_KIND == 99) xcd_barrier(bar); if (REPEAT_KIND == 1) { run_phase<1>(F, 0); xcd_barrier(bar); }
#pragma unroll 1
    for (int l = 0; l < 2; ++l) {
        run_phase<2>(F, l); xcd_barrier(bar); if (REPEAT_KIND == 99) xcd_barrier(bar); if (REPEAT_KIND == 2) { run_phase<2>(F, l); xcd_barrier(bar); }
        run_phase<3>(F, l); xcd_barrier(bar); if (REPEAT_KIND == 99) xcd_barrier(bar);
        run_phase<12>(F, l); xcd_barrier(bar); if (REPEAT_KIND == 99) xcd_barrier(bar); if (REPEAT_KIND == 12) { run_phase<12>(F, l); xcd_barrier(bar); }
        run_phase<4>(F, l); xcd_barrier(bar); if (REPEAT_KIND == 99) xcd_barrier(bar); if (REPEAT_KIND == 4) { run_phase<4>(F, l); xcd_barrier(bar); }
        run_phase<5>(F, l); xcd_barrier(bar); if (REPEAT_KIND == 99) xcd_barrier(bar); if (REPEAT_KIND == 5) { run_phase<5>(F, l); xcd_barrier(bar); }
        run_phase<6>(F, l); xcd_barrier(bar); if (REPEAT_KIND == 99) xcd_barrier(bar); if (REPEAT_KIND == 6) { run_phase<6>(F, l); xcd_barrier(bar); }
        run_phase<7>(F, l); xcd_barrier(bar); if (REPEAT_KIND == 99) xcd_barrier(bar); if (REPEAT_KIND == 7) { run_phase<7>(F, l); xcd_barrier(bar); }
        run_phase<8>(F, l); xcd_barrier(bar); if (REPEAT_KIND == 99) xcd_barrier(bar); if (REPEAT_KIND == 8) { run_phase<8>(F, l); xcd_barrier(bar); }
        run_phase<9>(F, l); xcd_barrier(bar); if (REPEAT_KIND == 99) xcd_barrier(bar); if (REPEAT_KIND == 9) { run_phase<9>(F, l); xcd_barrier(bar); }
        run_phase<10>(F, l); xcd_barrier(bar); if (REPEAT_KIND == 99) xcd_barrier(bar); if (REPEAT_KIND == 10) { run_phase<10>(F, l); xcd_barrier(bar); }
        run_phase<11>(F, l); xcd_barrier(bar); if (REPEAT_KIND == 99) xcd_barrier(bar); if (REPEAT_KIND == 11) { run_phase<11>(F, l); xcd_barrier(bar); }
    }
}
#endif

template <int KIND> static bool prep_kernel() { return hipFuncSetAttribute((const void*)fwd_k<KIND>, hipFuncAttributeMaxDynamicSharedMemorySize, LDS_BYTES) == hipSuccess; }
template <int KIND> static void launch_k(int grid, hipStream_t stream, Args a, int l) { a.ph_lo = l; a.ph_hi = KIND; hipLaunchKernelGGL(fwd_k<KIND>, dim3(grid), dim3(512), LDS_BYTES, stream, a); }
extern "C" void kernel_launch(void* const* d_in, const int* in_sizes, int n_in, void* d_out, int out_size, void* d_ws, size_t ws_size, hipStream_t stream) {
    static int grid = 0;
    if (grid == 0) {
        if (n_in != N_INPUTS || ws_size < WS_END) { fprintf(stderr, "kernel_launch: need %d inputs and %zu bytes of workspace; got %d, %zu\n", N_INPUTS, (size_t)WS_END, n_in, ws_size); grid = -1; return; }
        int dev = 0, cus = 0;
        if (hipGetDevice(&dev) != hipSuccess || hipDeviceGetAttribute(&cus, hipDeviceAttributeMultiprocessorCount, dev) != hipSuccess) { grid = -1; return; }
#if MK_ONE_LAUNCH
        if (hipFuncSetAttribute((const void*)fwd, hipFuncAttributeMaxDynamicSharedMemorySize, LDS_BYTES) != hipSuccess) { grid = -1; return; }
#else
        bool ok = prep_kernel<0>() && prep_kernel<1>() && prep_kernel<2>() && prep_kernel<3>() && prep_kernel<4>() && prep_kernel<5>() && prep_kernel<6>() && prep_kernel<7>() && prep_kernel<8>() && prep_kernel<9>() && prep_kernel<10>() && prep_kernel<11>() && prep_kernel<12>();
        if (!ok) { fprintf(stderr, "kernel_launch: hipFuncSetAttribute failed\n"); grid = -1; return; }
#endif
        (void)hipGetLastError();
        if (cus < GRID) { fprintf(stderr, "kernel_launch: built for a %d-CU device, found %d CUs\n", GRID, cus); grid = -1; return; }
        grid = GRID;
    }
    if (grid < 0) return;
    if (hipMemsetAsync((char*)d_ws + WS_CTL, 0, ZERO_BYTES, stream) != hipSuccess) return;
    Args a{};
    for (int i = 0; i < N_INPUTS; ++i) a.in[i] = (const float*)d_in[i];
    a.out = (float*)d_out; a.ws = (unsigned char*)d_ws;
#if MK_ONE_LAUNCH
    a.ph_lo = 0; a.ph_hi = N_PHASES;
    hipLaunchKernelGGL(fwd, dim3(grid), dim3(512), LDS_BYTES, stream, a);
#else
    launch_k<0>(grid, stream, a, 0); launch_k<1>(grid, stream, a, 0);
    for (int l = 0; l < 2; ++l) {
        launch_k<2>(grid, stream, a, l); launch_k<3>(grid, stream, a, l); launch_k<12>(grid, stream, a, l); launch_k<4>(grid, stream, a, l); launch_k<5>(grid, stream, a, l); launch_k<6>(grid, stream, a, l);
#ifdef DBG_STOP6
        break;
#endif
        launch_k<7>(grid, stream, a, l); launch_k<8>(grid, stream, a, l); launch_k<9>(grid, stream, a, l); launch_k<10>(grid, stream, a, l); launch_k<11>(grid, stream, a, l);
#ifdef DBG_STOP11
        break;
#endif
    }
#endif
}
```

```cpp
#include <hip/hip_runtime.h>
#include <cstdio>
#include <cstdint>

#define DBG_NROUTED 8
#ifndef RT_PROBE
#define RT_PROBE 0
#endif
#define RT_T0() const unsigned long long _rt0 = __builtin_amdgcn_s_memrealtime()
#define RT_AMP() do { const unsigned long long _d = __builtin_amdgcn_s_memrealtime() - _rt0; while (__builtin_amdgcn_s_memrealtime() - _rt0 < 5 * _d) __builtin_amdgcn_s_sleep(4); } while (0)
#ifndef REPEAT_KIND
#define REPEAT_KIND -1
#endif
#ifndef PG8_SP2
#define PG8_SP2 1
#endif
#ifndef PG8_ALIGN
#define PG8_ALIGN 1
#endif
#ifndef MK_ONE_LAUNCH
#define MK_ONE_LAUNCH 1
#endif

#define LAS __attribute__((address_space(3)))
#define DI __device__ __forceinline__
typedef unsigned short bf16_t;
typedef short bf16x8 __attribute__((ext_vector_type(8)));
typedef short s16x4 __attribute__((ext_vector_type(4)));
typedef float f32x4 __attribute__((ext_vector_type(4)));
typedef float f32x16 __attribute__((ext_vector_type(16)));
typedef unsigned u32x4 __attribute__((ext_vector_type(4)));
typedef unsigned u32x2 __attribute__((ext_vector_type(2)));
typedef __bf16 bf16x2_t __attribute__((ext_vector_type(2)));
typedef float f32x2_t __attribute__((ext_vector_type(2)));

DI unsigned pk2(float lo, float hi) { f32x2_t v = {lo, hi}; bf16x2_t b = __builtin_convertvector(v, bf16x2_t); return __builtin_bit_cast(unsigned, b); }
DI float bf_lo(unsigned u) { return __uint_as_float(u << 16); }
DI float bf_hi(unsigned u) { return __uint_as_float(u & 0xffff0000u); }
DI float bf2f(bf16_t b) { return __uint_as_float(((unsigned)b) << 16); }
DI bf16_t f2bf(float f) { return (bf16_t)(pk2(f, 0.f) & 0xffffu); }
template <int CTRL> DI float dpp_f(float x) { return __int_as_float(__builtin_amdgcn_update_dpp(0, __float_as_int(x), CTRL, 0xF, 0xF, true)); }
DI float row16_sum(float v) {
    v += dpp_f<0xB1>(v);
    v += dpp_f<0x4E>(v);
    v += dpp_f<0x141>(v);
    v += dpp_f<0x140>(v);
    return v;
}
DI float readlane_f(float x, int l) { return __int_as_float(__builtin_amdgcn_readlane(__float_as_int(x), l)); }
DI float wave_sum(float v) {
    v = row16_sum(v);
    return (readlane_f(v, 0) + readlane_f(v, 16)) + (readlane_f(v, 32) + readlane_f(v, 48));
}
DI float grp8_max(float v) {
    v = fmaxf(v, dpp_f<0xB1>(v)); v = fmaxf(v, dpp_f<0x4E>(v)); v = fmaxf(v, dpp_f<0x141>(v));
    return v;
}
DI float sigmoidf_(float x) { return __builtin_amdgcn_rcpf(1.0f + __builtin_amdgcn_exp2f(-1.4426950408889634f * x)); }
DI float siluf_(float x) { return x * __builtin_amdgcn_rcpf(1.0f + __builtin_amdgcn_exp2f(-1.4426950408889634f * x)); }

constexpr int D = 1024, NB = 8, SEQ = 2048, CTXL = 256, TL = NB * SEQ, TC = NB * CTXL, TA = TL + TC;
constexpr int NIN = 9248, ZS = 9472  , NKV = 2592;
constexpr int C_KNA = 0, C_VNA = 512, C_KGLA = 1024, C_VGLA = 1536, C_GATE = 2560, C_QNA = 2592, C_BSC = 3104, C_CSC = 3616, C_XSC = 4128, C_QGLA = 4640, C_RGLA = 5152, C_MERGE = 6176;
constexpr int OS = 2048;
constexpr int NE = 64, NEX = 65  , FF = 256, TOPK = 8;
constexpr float RMS_EPS = 1e-6f;

enum { I_X = 0, I_C, I_CTX, I_CCTX, I_WMOD, I_BMOD, I_G1, I_G2, I_WIN, I_RPB, I_WNA, I_CONVW, I_WSC, I_GGW, I_GGB, I_GNG, I_WGLA, I_WOUT, I_WR, I_BR, I_WEG, I_WEU, I_WED, I_WSG, I_WSU, I_WSD, I_GF, N_INPUTS };

constexpr size_t WS_CTL = 0;
constexpr size_t CTL_BYTES = 65536;
constexpr int CW_BAR = 0, CW_CNT = 8192;
constexpr size_t WS_MOD = WS_CTL + CTL_BYTES;
constexpr size_t MOD_BYTES = 2 * 9 * 6 * 1024 * 4;
constexpr size_t ZERO_BYTES = CTL_BYTES + 458752;
constexpr size_t WS_CTXS = WS_CTL + ZERO_BYTES;
constexpr size_t WS_TOKE = WS_CTXS + (size_t)TC * D * 4;
constexpr size_t WS_TOKP = WS_TOKE + (size_t)TA * 8 * 4;
constexpr size_t WS_TOKW = WS_TOKP + (size_t)TA * 8 * 4;
constexpr size_t WS_TOKR = WS_TOKW + (size_t)TA * 8 * 4;
constexpr size_t WS_ROWL = WS_TOKR + (size_t)TA * 8 * 4;
constexpr size_t ROWL_BYTES = ((size_t)TA * 9 + 256) * 4;
constexpr size_t WS_WRT = (WS_ROWL + ROWL_BYTES + 255) & ~(size_t)255;
constexpr size_t WRT_BYTES = (size_t)2 * 2 * NE * D * 2;
constexpr size_t WS_WBS = WS_WRT + WRT_BYTES;
constexpr size_t WB_WIN = 0, WB_WNA = WB_WIN + (size_t)ZS * D * 2, WB_WSC = WB_WNA + (size_t)D * 512 * 2, WB_WGLA = WB_WSC + (size_t)D * 512 * 2,
                 WB_WOUT = WB_WGLA + (size_t)D * D * 2, WB_WD = WB_WOUT + (size_t)D * D * 2, WBS_BYTES = WB_WD + (size_t)NEX * D * FF * 2;
constexpr size_t WS_R2 = WS_WBS + WBS_BYTES;
constexpr size_t HID_ROWS = (size_t)TA * 9 + 256;
constexpr size_t R2_BYTES = HID_ROWS * FF * 2;
constexpr size_t R2_OB = (size_t)TA * D * 2;
constexpr size_t WS_R1 = WS_R2 + R2_BYTES;
constexpr size_t R1_O = (size_t)TA * ZS * 2;
constexpr size_t R1_BYTES = R1_O + (size_t)TA * OS * 2;
constexpr size_t R1_H2 = R1_O;
constexpr size_t WS_WBS1 = WS_R1 + R1_BYTES;
constexpr size_t WS_DECB = WS_WBS1 + WB_WD;
constexpr size_t WS_W2TG = WS_DECB + (size_t)NB * 4 * 2 * 36 * 128 * 4;
constexpr size_t WS_END = WS_W2TG + (size_t)2 * 2 * 512 * 16 * 2;
static_assert(HID_ROWS * D * 2 <= R1_O + 0, "out_slot must fit below H2");
static_assert((size_t)NEX * 512 * D * 2 <= R1_O, "WguT fits");

constexpr int LDS_BYTES = 147456, MISC_OFF = 143360;
constexpr int GRID = 256;

#define XB_TMO      128
#define XB_XCNT(j)  (256  + 64 * (j))
#define XB_XSUB(j)  (1280 + 64 * (j))
#define XB_XGEN(j)  (2304 + 64 * (j))
#define XB_TOP      3328
#define XB_TOPGEN   3392
#define XCD_BAR_WORDS 3456
#define XB_SPIN_CAP (1u << 22)
DI unsigned xb_ld(unsigned* p)              { return __hip_atomic_load(p, __ATOMIC_RELAXED, __HIP_MEMORY_SCOPE_AGENT); }
DI unsigned xb_add(unsigned* p, unsigned v) { return __hip_atomic_fetch_add(p, v, __ATOMIC_RELAXED, __HIP_MEMORY_SCOPE_AGENT); }
DI unsigned xb_xcc_id() { return (unsigned)__builtin_amdgcn_s_getreg((3 << 11) | 20) & 0xFu; }
#define XB_SPIN(cond, bar) do { unsigned _sp = 0; while (cond) { __builtin_amdgcn_s_sleep(1); \
    if ((++_sp & 255u) == 0u) { if (xb_ld(&(bar)[XB_TMO])) break; if (_sp > XB_SPIN_CAP) { atomicAdd(&(bar)[XB_TMO], 1u); break; } } } } while (0)
struct XcdBarrier { unsigned* bar; unsigned x; volatile LAS unsigned* st; };
DI XcdBarrier xcd_barrier_post(unsigned* bar, volatile LAS unsigned* st) {
    XcdBarrier b; b.bar = bar; b.x = xb_xcc_id(); b.st = st;
    if (threadIdx.x == 0) (void)xb_add(&bar[XB_XCNT(b.x)], 1u);
    return b;
}
DI void xcd_barrier_complete(unsigned* bar, unsigned x, unsigned& nloc, unsigned& nx) {
    const unsigned G = gridDim.x * gridDim.y * gridDim.z;
    unsigned sum, cnt, mine, sp = 0u;
    for (;;) {
        sum = 0u; cnt = 0u; mine = 0u;
#pragma unroll
        for (unsigned j = 0; j < 16; ++j) { const unsigned c = xb_ld(&bar[XB_XCNT(j)]); sum += c; cnt += (c > 0u) ? 1u : 0u; mine = (j == x) ? c : mine; }
        if (sum == G) break;
        __builtin_amdgcn_s_sleep(1);
        if ((++sp & 255u) == 0u) { if (xb_ld(&bar[XB_TMO])) break; if (sp > XB_SPIN_CAP) { atomicAdd(&bar[XB_TMO], 1u); break; } }
    }
    nloc = mine > 0u ? mine : 1u; nx = cnt > 0u ? cnt : 1u;
}
DI void xcd_barrier(const XcdBarrier& b) {
    asm volatile("s_waitcnt vmcnt(0)" ::: "memory");
    __syncthreads();
    if (threadIdx.x == 0) {
        unsigned* bar = b.bar;
        __builtin_amdgcn_s_waitcnt(0);
        const unsigned bx = xb_xcc_id();
        unsigned nloc = b.st[0], nx = b.st[1];
        if (nloc == 0u) { xcd_barrier_complete(bar, bx, nloc, nx); b.st[0] = nloc; b.st[1] = nx; }
        const unsigned old = xb_add(&bar[XB_XSUB(bx)], 1u);
        const unsigned gen = old / nloc;
        if (old + 1u == (gen + 1u) * nloc) {
            __builtin_amdgcn_fence(__ATOMIC_RELEASE, "agent");
            asm volatile("s_waitcnt vmcnt(0)" ::: "memory");
            const unsigned og = xb_add(&bar[XB_TOP], 1u);
            const unsigned tg = og / nx;
            if (og + 1u == (tg + 1u) * nx) xb_add(&bar[XB_TOPGEN], 1u);
            else XB_SPIN(xb_ld(&bar[XB_TOPGEN]) == tg, bar);
            __builtin_amdgcn_fence(__ATOMIC_ACQUIRE, "agent");
            xb_add(&bar[XB_XGEN(bx)], 1u);
            asm volatile("s_waitcnt vmcnt(0)" ::: "memory");
        } else {
            XB_SPIN(xb_ld(&bar[XB_XGEN(bx)]) == gen, bar);
            __builtin_amdgcn_fence(__ATOMIC_ACQUIRE, "agent");
            asm volatile("s_waitcnt vmcnt(0)" ::: "memory");
        }
    }
    __syncthreads();
}

namespace pg8 {
constexpr int BM = 256, BK = 64, HALF = 128, HTB = HALF * BK * 2, STAGE_BYTES = 8 * HTB;
DI int lds_byte(int r, int c) { const int st = (r >> 4) * 2 + (c >> 5), rr = r & 15, cc = c & 31, ob = rr * 64 + cc * 2; return st * 1024 + (ob ^ (((ob >> 9) & 1) << 5)); }
DI void stage_rc(int b, int& R, int& C) { const int st = b / 1024, sb = b % 1024, swz = sb ^ (((sb >> 9) & 1) << 5); R = (st >> 1) * 16 + swz / 64; C = (st & 1) * 32 + (swz % 64) / 2; }
DI int perm32(int rho) { const int n = rho >> 4, i = rho & 15; return 8 * (i >> 2) + 4 * n + (i & 3); }

struct GUnit {
    const char* A;
    const char* B;
    const int* rows;
    int pm, pn;
    int valid;
    int aux;
};

template <bool GATHER, class Epi, class Sched>
DI void gemm_phase(LAS unsigned char* lds, const int tid_, const int K_, const int lda, const int ldb, const Sched& S, const Epi& E) {
    int K = K_; asm volatile("" : "+s"(K));
    int tid = tid_; asm volatile("" : "+v"(tid));
    const int wid = __builtin_amdgcn_readfirstlane(tid >> 6), lane = tid & 63, wr = wid >> 2, wc = wid & 3, fr = lane & 15, fq = lane >> 4;
    const int nt = K / BK;
    unsigned voffA, voffB, cc2, ro;
    { int R, C; stage_rc(tid * 16, R, C); ro = (unsigned)R * 4u; cc2 = (unsigned)C * 2u; const int Rb = Epi::PERM ? ((R & ~31) + perm32(R & 31)) : R;
      voffA = (unsigned)(R * lda + C) * 2u; voffB = (unsigned)(Rb * ldb + C) * 2u; }
    const size_t hstepA = (size_t)HALF * lda * 2, qstepA = (size_t)64 * lda * 2, qstepB = (size_t)64 * ldb * 2;
    const unsigned rowb = (unsigned)lda * 2u;
    const size_t kstep = (size_t)(BK * 2);
    const size_t hstepB = (size_t)HALF * ldb * 2;
    const unsigned ldsw = (unsigned)wid * 1024u;
    const int aoff = lds_byte(wr * 64 + fr, fq * 8), boff = lds_byte(wc * 32 + fr, fq * 8);
#define PG8_SA(b, h) (((b) * 2 + (h)) * HTB)
#define PG8_SB(b, h) ((4 + (b) * 2 + (h)) * HTB)
#define PG8_STAGE2(bufoff, gbase, o0, o1) do { \
        __builtin_amdgcn_global_load_lds((const unsigned*)((const char*)(gbase) + (o0)), (LAS unsigned*)(lds + (bufoff) + ldsw), 16, 0, 0); \
        __builtin_amdgcn_global_load_lds((const unsigned*)((const char*)(gbase) + (o1)), (LAS unsigned*)(lds + (bufoff) + ldsw + 8192), 16, 0, 0); } while (0)
#define PG8_STAGEB(bufoff, gbase) do { unsigned _vo = voffB; asm volatile("" : "+v"(_vo));     \
        __builtin_amdgcn_global_load_lds((const unsigned*)((const char*)(gbase) + _vo), (LAS unsigned*)(lds + (bufoff) + ldsw), 16, 0, 0); \
        __builtin_amdgcn_global_load_lds((const unsigned*)((const char*)(gbase) + qstepB + _vo), (LAS unsigned*)(lds + (bufoff) + ldsw + 8192), 16, 0, 0); } while (0)
#define PG8_LDA(dst, b, h) do { _Pragma("unroll") for (int m = 0; m < 4; ++m) _Pragma("unroll") for (int k = 0; k < 2; ++k) dst[m][k] = *(const LAS bf16x8*)(lds + PG8_SA(b, h) + aoff + m * 2048 + k * 1024); } while (0)
#define PG8_LDB(dst, b, h) do { _Pragma("unroll") for (int n = 0; n < 2; ++n) _Pragma("unroll") for (int k = 0; k < 2; ++k) dst[n][k] = *(const LAS bf16x8*)(lds + PG8_SB(b, h) + boff + n * 2048 + k * 1024); } while (0)
#define PG8_MMA(ai, bj, At, Bt) do { __builtin_amdgcn_s_setprio(1); _Pragma("unroll") for (int m = 0; m < 4; ++m) _Pragma("unroll") for (int n = 0; n < 2; ++n) _Pragma("unroll") for (int k = 0; k < 2; ++k) \
        acc[ai][bj][m][n] = __builtin_amdgcn_mfma_f32_16x16x32_bf16(Bt[n][k], At[m][k], acc[ai][bj][m][n], 0, 0, 0); __builtin_amdgcn_s_setprio(0); } while (0)
#define PG8_WAIT_V(n) asm volatile("s_waitcnt vmcnt(" #n ")" ::: "memory")
#define PG8_WAIT_L(n) asm volatile("s_waitcnt lgkmcnt(" #n ")" ::: "memory")
#define PG8_BAR __builtin_amdgcn_s_barrier()
#define PG8_SCHED __builtin_amdgcn_sched_barrier(0)
#define PG8_RIDX(u, p0, p1) do { if (GATHER) { const char* _rb = (const char*)(u).rows; \
        p0 = (unsigned)*(const int*)(_rb + ro) | ((unsigned)*(const int*)(_rb + ro + HALF * 4) << 16); p1 = (unsigned)*(const int*)(_rb + ro + 64 * 4) | ((unsigned)*(const int*)(_rb + ro + (64 + HALF) * 4) << 16); } } while (0)
#define PG8_STAGEA(bufoff, gbase, h, p0, p1) do { if (GATHER) { const unsigned _o0 = (((p0) >> (16 * (h))) & 0xffffu) * rowb + cc2, _o1 = (((p1) >> (16 * (h))) & 0xffffu) * rowb + cc2; PG8_STAGE2(bufoff, gbase, _o0, _o1); } \
        else { unsigned _va = voffA; asm volatile("" : "+v"(_va)); \
               __builtin_amdgcn_global_load_lds((const unsigned*)((const char*)(gbase) + (h) * hstepA + _va), (LAS unsigned*)(lds + (bufoff) + ldsw), 16, 0, 0); \
               __builtin_amdgcn_global_load_lds((const unsigned*)((const char*)(gbase) + (h) * hstepA + qstepA + _va), (LAS unsigned*)(lds + (bufoff) + ldsw + 8192), 16, 0, 0); } } while (0)
    GUnit cur, nxt; int ui = 0;
    if (!S.next(0, cur)) return;
    f32x4 acc[2][2][4][2];
#pragma unroll
    for (int a = 0; a < 2; ++a)
#pragma unroll
        for (int b = 0; b < 2; ++b)
#pragma unroll
            for (int m = 0; m < 4; ++m)
#pragma unroll
                for (int n = 0; n < 2; ++n) acc[a][b][m][n] = (f32x4){0.f, 0.f, 0.f, 0.f};
    bf16x8 At[4][2], B0[2][2], B1[2][2];
    const char* cA = cur.A; const char* cB = cur.B;
    unsigned cp0 = 0u, cp1 = 0u; PG8_RIDX(cur, cp0, cp1);
#if PG8_SP2
    PG8_STAGEB(PG8_SB(0, 0), cB); PG8_STAGEB(PG8_SB(0, 1), cB + hstepB); PG8_STAGEA(PG8_SA(0, 0), cA, 0, cp0, cp1); PG8_STAGEA(PG8_SA(0, 1), cA, 1, cp0, cp1);
    if (wr == 1) PG8_BAR;
    PG8_WAIT_V(2); PG8_BAR;
    PG8_STAGEB(PG8_SB(1, 0), cB + kstep); PG8_STAGEA(PG8_SA(1, 0), cA + kstep, 0, cp0, cp1); PG8_STAGEB(PG8_SB(1, 1), cB + hstepB + kstep);
    PG8_WAIT_V(6); PG8_BAR;
#else
    PG8_STAGEB(PG8_SB(0, 0), cB); PG8_STAGEA(PG8_SA(0, 0), cA, 0, cp0, cp1); PG8_STAGEB(PG8_SB(0, 1), cB + hstepB); PG8_STAGEA(PG8_SA(0, 1), cA, 1, cp0, cp1);
    if (wr == 1) PG8_BAR;
    PG8_WAIT_V(4); PG8_BAR;
    PG8_STAGEB(PG8_SB(1, 0), cB + kstep); PG8_STAGEA(PG8_SA(1, 0), cA + kstep, 0, cp0, cp1); PG8_STAGEB(PG8_SB(1, 1), cB + hstepB + kstep);
    PG8_WAIT_V(6); PG8_BAR;
#endif
    for (;;) {
        const bool has_next = S.next(ui + 1, nxt);
        const char* nA = has_next ? nxt.A : cA; const char* nB = has_next ? nxt.B : cB;
        unsigned np0 = cp0, np1 = cp1;
        if (has_next) PG8_RIDX(nxt, np0, np1);
        for (int t = 0; t < nt; t += 2) {
            const bool last = (t == nt - 2);
            const char* a1 = cA + (size_t)(t + 1) * kstep;
            const char* a2 = last ? nA : cA + (size_t)(t + 2) * kstep; const char* b2 = last ? nB : cB + (size_t)(t + 2) * kstep;
            const char* a3 = a2 + kstep; const char* b3 = b2 + kstep;
            unsigned xp0 = cp0, xp1 = cp1;
            if (GATHER && last) { asm volatile("" : "+v"(np0), "+v"(np1)); xp0 = np0; xp1 = np1; }
#if PG8_SP2
            const bool after_epi = (Epi::NSTORE > 0) && (t == 0) && (ui > 0);
            PG8_LDB(B0, 0, 0); PG8_LDB(B1, 0, 1); PG8_SCHED; PG8_LDA(At, 0, 0); PG8_STAGEA(PG8_SA(1, 1), a1, 1, cp0, cp1);
            if (after_epi) { if constexpr (Epi::NSTORE == 16) PG8_WAIT_V(24); else if constexpr (Epi::NSTORE == 8) PG8_WAIT_V(16); else PG8_WAIT_V(8); } else PG8_WAIT_V(8);
            PG8_WAIT_L(0); PG8_BAR; PG8_MMA(0, 0, At, B0); PG8_MMA(0, 1, At, B1); PG8_BAR; PG8_SCHED;
            PG8_LDA(At, 0, 1); PG8_STAGEB(PG8_SB(0, 0), b2); PG8_STAGEB(PG8_SB(0, 1), b2 + hstepB); PG8_STAGEA(PG8_SA(0, 0), a2, 0, xp0, xp1);
            if (after_epi) { if constexpr (Epi::NSTORE == 16) PG8_WAIT_V(24); else if constexpr (Epi::NSTORE == 8) PG8_WAIT_V(16); else PG8_WAIT_V(8); } else PG8_WAIT_V(8);
            PG8_WAIT_L(0); PG8_BAR; PG8_MMA(1, 0, At, B0); PG8_MMA(1, 1, At, B1); PG8_BAR; PG8_SCHED;
            PG8_LDB(B0, 1, 0); PG8_LDB(B1, 1, 1); PG8_SCHED; PG8_LDA(At, 1, 0); PG8_STAGEA(PG8_SA(0, 1), a2, 1, xp0, xp1);
            PG8_WAIT_V(8); PG8_WAIT_L(0); PG8_BAR; PG8_MMA(0, 0, At, B0); PG8_MMA(0, 1, At, B1); PG8_BAR; PG8_SCHED;
            PG8_LDA(At, 1, 1); PG8_STAGEB(PG8_SB(1, 0), b3); PG8_STAGEB(PG8_SB(1, 1), b3 + hstepB); PG8_STAGEA(PG8_SA(1, 0), a3, 0, xp0, xp1);
            PG8_WAIT_V(8); PG8_WAIT_L(0); PG8_BAR; PG8_MMA(1, 0, At, B0); PG8_MMA(1, 1, At, B1); PG8_BAR; PG8_SCHED;
#else
            PG8_LDB(B0, 0, 0); PG8_SCHED; PG8_LDA(At, 0, 0); PG8_STAGEA(PG8_SA(1, 1), a1, 1, cp0, cp1);
            PG8_WAIT_L(8); PG8_BAR; PG8_WAIT_L(0); PG8_MMA(0, 0, At, B0); PG8_BAR; PG8_SCHED;
            PG8_LDB(B1, 0, 1); PG8_STAGEB(PG8_SB(0, 0), b2);
            PG8_BAR; PG8_WAIT_L(0); PG8_MMA(0, 1, At, B1); PG8_BAR;
            PG8_LDA(At, 0, 1); PG8_STAGEA(PG8_SA(0, 0), a2, 0, xp0, xp1);
            PG8_BAR; PG8_WAIT_L(0); PG8_MMA(1, 0, At, B0); PG8_BAR; PG8_SCHED;
            PG8_STAGEB(PG8_SB(0, 1), b2 + hstepB);
            PG8_WAIT_V(6); PG8_BAR; PG8_MMA(1, 1, At, B1); PG8_BAR;
            PG8_LDB(B0, 1, 0); PG8_SCHED; PG8_LDA(At, 1, 0); PG8_STAGEA(PG8_SA(0, 1), a2, 1, xp0, xp1);
            PG8_WAIT_L(8); PG8_BAR; PG8_WAIT_L(0); PG8_MMA(0, 0, At, B0); PG8_BAR; PG8_SCHED;
            PG8_LDB(B1, 1, 1); PG8_STAGEB(PG8_SB(1, 0), b3);
            PG8_BAR; PG8_WAIT_L(0); PG8_MMA(0, 1, At, B1); PG8_BAR;
            PG8_LDA(At, 1, 1); PG8_STAGEA(PG8_SA(1, 0), a3, 0, xp0, xp1);
            PG8_BAR; PG8_WAIT_L(0); PG8_MMA(1, 0, At, B0); PG8_BAR; PG8_SCHED;
            PG8_STAGEB(PG8_SB(1, 1), b3 + hstepB);
            PG8_WAIT_V(6); PG8_BAR; PG8_MMA(1, 1, At, B1); PG8_BAR;
        #endif
        }
#if PG8_ALIGN
        if (wr == 0) PG8_BAR;
#endif
        E(acc, cur, wr, wc, fr, fq);
        if (!has_next) break;
#pragma unroll
        for (int a = 0; a < 2; ++a)
#pragma unroll
            for (int b = 0; b < 2; ++b)
#pragma unroll
                for (int m = 0; m < 4; ++m)
#pragma unroll
                    for (int n = 0; n < 2; ++n) acc[a][b][m][n] = (f32x4){0.f, 0.f, 0.f, 0.f};
        cur = nxt; cA = nA; cB = nB; cp0 = np0; cp1 = np1; ++ui;
#if PG8_ALIGN
        if (wr == 1) PG8_BAR;
#endif
    }
    PG8_WAIT_V(0);
#if !PG8_ALIGN
    if (wr == 0) PG8_BAR;
#endif
    PG8_BAR;
#undef PG8_SA
#undef PG8_SB
#undef PG8_STAGE2
#undef PG8_STAGEB
#undef PG8_LDA
#undef PG8_LDB
#undef PG8_MMA
#undef PG8_WAIT_V
#undef PG8_WAIT_L
#undef PG8_BAR
#undef PG8_SCHED
#undef PG8_RIDX
#undef PG8_STAGEA
}

struct EpiStoreBf16 {
    static constexpr bool PERM = true; static constexpr int NSTORE = 16;
    bf16_t* O; int ldc;
    DI void operator()(const f32x4 (&acc)[2][2][4][2], const GUnit& u, int wr, int wc, int fr, int fq) const {
        const int row0 = u.pm * BM + wr * 64 + fr, col0 = u.pn * BM + wc * 32 + 8 * fq;
#pragma unroll
        for (int ai = 0; ai < 2; ++ai)
#pragma unroll
            for (int m = 0; m < 4; ++m) { bf16_t* rowp = O + (size_t)(row0 + ai * HALF + m * 16) * ldc + col0;
#pragma unroll
                for (int bj = 0; bj < 2; ++bj) { const f32x4 v0 = acc[ai][bj][m][0], v1 = acc[ai][bj][m][1];
                    u32x4 w; w.x = pk2(v0[0], v0[1]); w.y = pk2(v0[2], v0[3]); w.z = pk2(v1[0], v1[1]); w.w = pk2(v1[2], v1[3]);
                    *(u32x4*)(rowp + bj * HALF) = w; } }
    }
};
template <int MODE> struct EpiGate {
    static constexpr bool PERM = true; static constexpr int NSTORE = 0;
    bf16_t* Y; const bf16_t* Zg; int gcol0;
    DI void operator()(const f32x4 (&acc)[2][2][4][2], const GUnit& u, int wr, int wc, int fr, int fq) const {
        const int row0 = u.pm * BM + wr * 64 + fr, col0 = u.pn * BM + wc * 32 + 8 * fq;
#pragma unroll
        for (int ai = 0; ai < 2; ++ai) {
            u32x4 g[4][2], o[4][2];
#pragma unroll
            for (int m = 0; m < 4; ++m) { const size_t row = (size_t)(row0 + ai * HALF + m * 16);
#pragma unroll
                for (int bj = 0; bj < 2; ++bj) { g[m][bj] = *(const u32x4*)(Zg + row * ZS + gcol0 + col0 + bj * HALF); if (MODE == 1) o[m][bj] = *(const u32x4*)(Y + row * D + col0 + bj * HALF); } }
#pragma unroll
            for (int m = 0; m < 4; ++m) { const size_t row = (size_t)(row0 + ai * HALF + m * 16); bf16_t* rowp = Y + row * D + col0;
#pragma unroll
                for (int bj = 0; bj < 2; ++bj) { const f32x4 v0 = acc[ai][bj][m][0], v1 = acc[ai][bj][m][1]; const u32x4 gg = g[m][bj];
                    float r[8];
                    r[0] = v0[0] * sigmoidf_(bf_lo(gg.x)); r[1] = v0[1] * sigmoidf_(bf_hi(gg.x)); r[2] = v0[2] * sigmoidf_(bf_lo(gg.y)); r[3] = v0[3] * sigmoidf_(bf_hi(gg.y));
                    r[4] = v1[0] * sigmoidf_(bf_lo(gg.z)); r[5] = v1[1] * sigmoidf_(bf_hi(gg.z)); r[6] = v1[2] * sigmoidf_(bf_lo(gg.w)); r[7] = v1[3] * sigmoidf_(bf_hi(gg.w));
                    if (MODE == 1) { const u32x4 oo = o[m][bj];
                        r[0] += bf_lo(oo.x); r[1] += bf_hi(oo.x); r[2] += bf_lo(oo.y); r[3] += bf_hi(oo.y); r[4] += bf_lo(oo.z); r[5] += bf_hi(oo.z); r[6] += bf_lo(oo.w); r[7] += bf_hi(oo.w); }
                    u32x4 w; w.x = pk2(r[0], r[1]); w.y = pk2(r[2], r[3]); w.z = pk2(r[4], r[5]); w.w = pk2(r[6], r[7]);
                    *(u32x4*)(rowp + bj * HALF) = w; } }
        }
    }
};
struct EpiResid {
    static constexpr bool PERM = false; static constexpr int NSTORE = 0;
    const float* xsrc; float* xdst; const float* csrc; float* cdst; const float* gate;
    DI void operator()(const f32x4 (&acc)[2][2][4][2], const GUnit& u, int wr, int wc, int fr, int fq) const {
        const int row0 = u.pm * BM + wr * 64 + fr, col0 = u.pn * BM + wc * 32 + 4 * fq;
        const bool isctx = (u.pm * BM) >= TL;
        const int mrow = isctx ? 8 : (u.pm * BM) / SEQ;
        const float* gp = gate + (size_t)mrow * 6144 + col0;
        f32x4 gv[2][2];
#pragma unroll
        for (int bj = 0; bj < 2; ++bj)
#pragma unroll
            for (int n = 0; n < 2; ++n) gv[bj][n] = *(const f32x4*)(gp + bj * HALF + n * 16);
        const float* sb = isctx ? csrc - (size_t)TL * D : xsrc; float* db = isctx ? cdst - (size_t)TL * D : xdst;
#pragma unroll
        for (int ai = 0; ai < 2; ++ai) {
            f32x4 s[4][2][2];
#pragma unroll
            for (int m = 0; m < 4; ++m) { const size_t off = (size_t)(row0 + ai * HALF + m * 16) * D + col0;
#pragma unroll
                for (int bj = 0; bj < 2; ++bj)
#pragma unroll
                    for (int n = 0; n < 2; ++n) s[m][bj][n] = *(const f32x4*)(sb + off + bj * HALF + n * 16); }
#pragma unroll
            for (int m = 0; m < 4; ++m) { const size_t off = (size_t)(row0 + ai * HALF + m * 16) * D + col0;
#pragma unroll
                for (int bj = 0; bj < 2; ++bj)
#pragma unroll
                    for (int n = 0; n < 2; ++n) *(f32x4*)(db + off + bj * HALF + n * 16) = s[m][bj][n] + gv[bj][n] * acc[ai][bj][m][n]; }
        }
    }
};
struct EpiSwiGLU {
    static constexpr bool PERM = true; static constexpr int NSTORE = 0;
    bf16_t* Hd;
    DI void operator()(const f32x4 (&acc)[2][2][4][2], const GUnit& u, int wr, int wc, int fr, int fq) const {
        const int r0 = wr * 64 + fr, col0 = u.pn * HALF + wc * 32 + 8 * fq;
#pragma unroll
        for (int ai = 0; ai < 2; ++ai)
#pragma unroll
            for (int m = 0; m < 4; ++m) { const int r = r0 + ai * HALF + m * 16;
                const f32x4 g0 = acc[ai][0][m][0], g1 = acc[ai][0][m][1], u0 = acc[ai][1][m][0], u1 = acc[ai][1][m][1];
                u32x4 w; w.x = pk2(siluf_(g0[0]) * u0[0], siluf_(g0[1]) * u0[1]); w.y = pk2(siluf_(g0[2]) * u0[2], siluf_(g0[3]) * u0[3]);
                w.z = pk2(siluf_(g1[0]) * u1[0], siluf_(g1[1]) * u1[1]); w.w = pk2(siluf_(g1[2]) * u1[2], siluf_(g1[3]) * u1[3]);
                if (r < u.valid) *(u32x4*)(Hd + (size_t)(u.aux + r) * FF + col0) = w; }
    }
};
DI unsigned pk4_fp8(float a, float b, float c, float d) { int p = 0; p = __builtin_amdgcn_cvt_pk_fp8_f32(a, b, p, false); p = __builtin_amdgcn_cvt_pk_fp8_f32(c, d, p, true); return (unsigned)p; }
struct EpiDown {
    static constexpr bool PERM = true; static constexpr int NSTORE = 0;
    unsigned char* Os; int rmask;
    DI void operator()(const f32x4 (&acc)[2][2][4][2], const GUnit& u, int wr, int wc, int fr, int fq) const {
        const int r0 = wr * 64 + fr, col0 = u.pn * BM + wc * 32 + 8 * fq;
#pragma unroll
        for (int ai = 0; ai < 2; ++ai)
#pragma unroll
            for (int m = 0; m < 4; ++m) { const int r = r0 + ai * HALF + m * 16; unsigned char* rowp = Os + (size_t)((u.aux + r) & rmask) * D + col0;
#pragma unroll
                for (int bj = 0; bj < 2; ++bj) { const f32x4 v0 = acc[ai][bj][m][0], v1 = acc[ai][bj][m][1];
                    u32x2 w; w.x = pk4_fp8(v0[0], v0[1], v0[2], v0[3]); w.y = pk4_fp8(v1[0], v1[1], v1[2], v1[3]);
                    if (r < u.valid) *(u32x2*)(rowp + bj * HALF) = w; } }
    }
};

template <int nN> struct RectSched {
    const char* A; const char* B; int lda, ldb; int nM, exM, exN, exPm0, G, c;
    DI bool next(int i, GUnit& u) const {
        const int L = i * G + c; const int nmain = nM * nN;
        int pm, pn;
        if (L < nmain) { const int W = (L & 7) * (nmain >> 3) + (L >> 3);
            const int grp = W / (8 * nN), rem = W % (8 * nN); pm = grp * 8 + (rem & 7); pn = rem >> 3; }
        else { const int L2 = L - nmain; if (L2 >= exM * exN) return false; pm = exPm0 + (L2 & 7); pn = L2 >> 3; }
        u.A = A + (size_t)pm * BM * lda * 2; u.B = B + (size_t)pn * BM * ldb * 2; u.rows = nullptr; u.pm = pm; u.pn = pn; u.valid = BM; u.aux = 0; return true;
    }
};
template <bool GATHER, int npn> struct MoeSched {
    const LAS int* tb; const LAS int* rb; const LAS int* cn;
    const char* A; const int* rowl; const char* B; size_t bstride; int lda, ldb, G, c;
    DI bool next(int i, GUnit& u) const {
        const int L0 = i * G + c; const int ntile = __builtin_amdgcn_readfirstlane(tb[NEX]); const int nwg = ntile * npn;
        if (L0 >= nwg) return false;
        const int q = nwg >> 3, rr = nwg & 7, xcd = L0 & 7, off = L0 >> 3;
        const int L = (xcd < rr ? xcd * (q + 1) : rr * (q + 1) + (xcd - rr) * q) + off;
        const int T = L / npn, pn = L % npn;
        const int e = __builtin_amdgcn_readfirstlane((int)((const LAS unsigned char*)(tb + 216))[T]);
        const int ti = T - __builtin_amdgcn_readfirstlane(tb[e]), row0 = __builtin_amdgcn_readfirstlane(rb[e]) + ti * BM;
        u.B = B + (size_t)e * bstride + (size_t)pn * BM * ldb * 2;
        if (GATHER) { u.A = A; u.rows = rowl + row0; } else { u.A = A + (size_t)row0 * lda * 2; u.rows = nullptr; }
        u.pm = T; u.pn = pn; const int rem = __builtin_amdgcn_readfirstlane(cn[e]) - ti * BM; u.valid = rem < BM ? rem : BM; u.aux = row0; return true;
    }
};
}

struct Args { const float* in[N_INPUTS]; float* out; unsigned char* ws; int ph_lo, ph_hi; };
struct Frame {
    LAS unsigned char* lds; unsigned char* ws; const float* const* in; float* out;
    int tid, lane, wave, G, bid;
};
DI const float* modp(const Frame& F, int l, int r, int which) { return (const float*)(F.ws + WS_MOD) + ((size_t)(l * 9 + r) * 6 + which) * 1024; }

DI void tr_item(const float* W, int ldw, bf16_t* WT, int ldt, int k0, int n0, int drow0, LAS float* scr, int lane) {
    float tmp[32];
#pragma unroll
    for (int i = 0; i < 32; ++i) { const int kk = 2 * i + (lane >> 5); tmp[i] = W[(size_t)(k0 + kk) * ldw + n0 + (lane & 31)]; }
#pragma unroll
    for (int i = 0; i < 32; ++i) { const int kk = 2 * i + (lane >> 5); scr[kk * 33 + (lane & 31)] = tmp[i]; }
    asm volatile("s_waitcnt lgkmcnt(0)" ::: "memory");
    const int c = lane & 7;
#pragma unroll
    for (int j = 0; j < 4; ++j) { const int n = (lane >> 3) + 8 * j; const LAS float* s = scr + (8 * c) * 33 + n;
        u32x4 o; o.x = pk2(s[0 * 33], s[1 * 33]); o.y = pk2(s[2 * 33], s[3 * 33]); o.z = pk2(s[4 * 33], s[5 * 33]); o.w = pk2(s[6 * 33], s[7 * 33]);
        *(u32x4*)(WT + (size_t)(drow0 + n) * ldt + k0 + 8 * c) = o; }
    asm volatile("s_waitcnt lgkmcnt(0)" ::: "memory");
}
template <int K, int N> DI void conv_plain(const Frame& F, const float* W, bf16_t* WT, int rot, int blk0 = 0) {
    LAS float* scr = (LAS float*)(F.lds + F.wave * 16384);
    const int NGW = (F.G - blk0) * 8, gw = ((F.bid - blk0) * 8 + F.wave + rot) % NGW;
    constexpr int nblk = N / 32, nit = (K / 64) * nblk;
    for (int it = gw; it < nit; it += NGW) { const int kb = it / nblk, nb = it % nblk; tr_item(W, N, WT, K, kb * 64, nb * 32, nb * 32, scr, F.lane); }
}
DI void conv_gu(const Frame& F, int l, bf16_t* WT, int blk0 = 0) {
    if (F.bid < blk0) return;
    LAS float* scr = (LAS float*)(F.lds + F.wave * 16384);
    const int NGW = (F.G - blk0) * 8, gw = (F.bid - blk0) * 8 + F.wave;
    const int nit = NEX * 2 * 128;
    for (int it = gw; it < nit; it += NGW) {
        const int e = it / 256, r = it % 256, isup = r / 128, r2 = r % 128, kb = r2 / 8, nb = r2 % 8, n0 = nb * 32;
        const float* W = (e < NE) ? F.in[isup ? I_WEU : I_WEG] + ((size_t)l * NE + e) * D * FF : F.in[isup ? I_WSU : I_WSG] + (size_t)l * D * FF;
        const int drow0 = ((n0 >> 7) << 8) + (n0 & 127) + (isup ? 128 : 0);
        tr_item(W, FF, WT + (size_t)e * 512 * D, D, kb * 64, n0, drow0, scr, F.lane);
    }
}
DI void conv_down(const Frame& F, int l, bf16_t* WT) {
    LAS float* scr = (LAS float*)(F.lds + F.wave * 16384);
    const int NGW = F.G * 8, gw = F.bid * 8 + F.wave;
    const int nit = NEX * 128;
    for (int it = gw; it < nit; it += NGW) {
        const int e = it / 128, r = it % 128, kb = r / 32, nb = r % 32;
        const float* W = (e < NE) ? F.in[I_WED] + ((size_t)l * NE + e) * FF * D : F.in[I_WSD] + (size_t)l * FF * D;
        tr_item(W, D, WT + (size_t)e * D * FF, FF, kb * 64, nb * 32, nb * 32, scr, F.lane);
    }
}
DI size_t wbs_base(int l) { return l == 0 ? WS_WBS : WS_WBS1; }
DI void conv_small(const Frame& F, int l, int blk0 = 0) {
    if (F.bid < blk0) return;
    bf16_t* wb = (bf16_t*)(F.ws + wbs_base(l));
    conv_plain<D, NIN>(F, F.in[I_WIN] + (size_t)l * D * NIN, (bf16_t*)((char*)wb + WB_WIN), 0, blk0);
    conv_plain<512, D>(F, F.in[I_WNA] + (size_t)l * 512 * D, (bf16_t*)((char*)wb + WB_WNA), 600, blk0);
    conv_plain<512, D>(F, F.in[I_WSC] + (size_t)l * 512 * D, (bf16_t*)((char*)wb + WB_WSC), 900, blk0);
    conv_plain<D, D>(F, F.in[I_WGLA] + (size_t)l * D * D, (bf16_t*)((char*)wb + WB_WGLA), 1200, blk0);
    conv_plain<D, D>(F, F.in[I_WOUT] + (size_t)l * D * D, (bf16_t*)((char*)wb + WB_WOUT), 1700, blk0);
    u32x4* z = (u32x4*)((char*)wb + WB_WIN + (size_t)NIN * D * 2);
    const int nz = (ZS - NIN) * D * 2 / 16;
    unsigned zz = 0u; asm volatile("" : "+v"(zz));
    for (int i = (F.bid - blk0) * 512 + F.tid; i < nz; i += (F.G - blk0) * 512) z[i] = (u32x4){zz, zz, zz, zz};
}
DI void conv_gate_w(const Frame& F) {
    bf16_t* wt = (bf16_t*)(F.ws + WS_W2TG);
    for (int i = F.bid * 512 + F.tid; i < 2 * 2 * 512 * 16; i += F.G * 512) { const int ld = i >> 13, rr = i & 8191, d = rr >> 4, ii = rr & 15; wt[i] = f2bf(F.in[I_GGW][((size_t)ld * 16 + ii) * 512 + d]); }
}
DI void conv_router(const Frame& F) {
    bf16_t* wrt = (bf16_t*)(F.ws + WS_WRT);
    for (int i = F.bid * 512 + F.tid; i < 2 * NE * D; i += F.G * 512) {
        const int l = i / (NE * D), r = i % (NE * D), e = r / D, k = r % D;
        const float w = F.in[I_WR][(size_t)l * D * NE + (size_t)k * NE + e];
        const bf16_t hi = f2bf(w); const bf16_t lo = f2bf(w - bf2f(hi));
        wrt[((size_t)(l * 2 + 0) * NE + e) * D + k] = hi; wrt[((size_t)(l * 2 + 1) * NE + e) * D + k] = lo;
    }
}
DI void mod_vectors(const Frame& F) {
    float* mod = (float*)(F.ws + WS_MOD);
    LAS float* SL = (LAS float*)F.lds;
    LAS float* PART = SL + 9 * 1024;
    __syncthreads();
    for (int i = F.tid; i < 9 * 1024; i += 512) { const float c = (i < 8 * 1024) ? F.in[I_C][i] : F.in[I_CCTX][i - 8 * 1024]; SL[i] = siluf_(c); }
    __syncthreads();
    for (int it = F.bid; it < 2 * 96; it += F.G) {
        const int l = it / 96, cb = it % 96, j = cb * 64 + F.lane;
        const float* W = F.in[I_WMOD] + (size_t)l * D * 6144 + j;
        float acc[9];
#pragma unroll
        for (int q = 0; q < 9; ++q) acc[q] = 0.f;
#pragma unroll 8
        for (int k = F.wave * 128; k < F.wave * 128 + 128; ++k) {
            const float w = W[(size_t)k * 6144];
#pragma unroll
            for (int q = 0; q < 9; ++q) acc[q] += SL[q * 1024 + k] * w;
        }
#pragma unroll
        for (int q = 0; q < 9; ++q) PART[(F.wave * 9 + q) * 64 + F.lane] = acc[q];
        __syncthreads();
        for (int q = F.wave; q < 9; q += 8) {
            float s = F.in[I_BMOD][l * 6144 + j];
#pragma unroll
            for (int w = 0; w < 8; ++w) s += PART[(w * 9 + q) * 64 + F.lane];
            mod[((size_t)(l * 9 + q)) * 6144 + j] = s;
        }
        __syncthreads();
    }
}

DI void load_row_f32(const float* p, int lane, float (&v)[16]) {
#pragma unroll
    for (int i = 0; i < 2; ++i) { const f32x4 a = *(const f32x4*)(p + 8 * lane + 512 * i), b = *(const f32x4*)(p + 8 * lane + 512 * i + 4);
        v[8 * i + 0] = a[0]; v[8 * i + 1] = a[1]; v[8 * i + 2] = a[2]; v[8 * i + 3] = a[3]; v[8 * i + 4] = b[0]; v[8 * i + 5] = b[1]; v[8 * i + 6] = b[2]; v[8 * i + 7] = b[3]; }
}
DI void store_row_f32(float* p, int lane, const float (&v)[16]) {
#pragma unroll
    for (int i = 0; i < 2; ++i) { *(f32x4*)(p + 8 * lane + 512 * i) = (f32x4){v[8 * i], v[8 * i + 1], v[8 * i + 2], v[8 * i + 3]}; *(f32x4*)(p + 8 * lane + 512 * i + 4) = (f32x4){v[8 * i + 4], v[8 * i + 5], v[8 * i + 6], v[8 * i + 7]}; }
}
DI void load_row_bf16(const bf16_t* p, int lane, float (&v)[16]) {
#pragma unroll
    for (int i = 0; i < 2; ++i) { const u32x4 a = *(const u32x4*)(p + 8 * lane + 512 * i);
        v[8 * i + 0] = bf_lo(a.x); v[8 * i + 1] = bf_hi(a.x); v[8 * i + 2] = bf_lo(a.y); v[8 * i + 3] = bf_hi(a.y); v[8 * i + 4] = bf_lo(a.z); v[8 * i + 5] = bf_hi(a.z); v[8 * i + 6] = bf_lo(a.w); v[8 * i + 7] = bf_hi(a.w); }
}
DI void store_row_bf16(bf16_t* p, int lane, const float (&v)[16]) {
#pragma unroll
    for (int i = 0; i < 2; ++i) { u32x4 w; w.x = pk2(v[8 * i], v[8 * i + 1]); w.y = pk2(v[8 * i + 2], v[8 * i + 3]); w.z = pk2(v[8 * i + 4], v[8 * i + 5]); w.w = pk2(v[8 * i + 6], v[8 * i + 7]);
        *(u32x4*)(p + 8 * lane + 512 * i) = w; }
}
DI void norm_mod(const float (&x)[16], const float* g, const float* shift, const float* scale, int lane, float (&h)[16]) {
    float ss = 0.f;
#pragma unroll
    for (int i = 0; i < 16; ++i) ss += x[i] * x[i];
    const float rstd = rsqrtf(wave_sum(ss) * (1.0f / D) + RMS_EPS);
    float gg[16], sh[16], sc[16]; load_row_f32(g, lane, gg); load_row_f32(shift, lane, sh); load_row_f32(scale, lane, sc);
#pragma unroll
    for (int i = 0; i < 16; ++i) h[i] = x[i] * rstd * gg[i] * (1.0f + sc[i]) + sh[i];
}

DI void phase_norm1_first(const Frame& F) {
    const int NGW = F.G * 8, gw = F.bid * 8 + F.wave;
    bf16_t* H = (bf16_t*)(F.ws + WS_R2);
    for (int t = gw; t < TA; t += NGW) {
        const bool isctx = t >= TL; const int r = isctx ? 8 : t / SEQ;
        const float* xr = isctx ? F.in[I_CTX] + (size_t)(t - TL) * D : F.in[I_X] + (size_t)t * D;
        float x[16], h[16]; load_row_f32(xr, F.lane, x);
        norm_mod(x, F.in[I_G1], modp(F, 0, r, 0), modp(F, 0, r, 1), F.lane, h);
        store_row_bf16(H + (size_t)t * D, F.lane, h);
    }
}

DI void phase_conv(const Frame& F, int l, int M) {
    const bf16_t* Z = (const bf16_t*)(F.ws + WS_R1); bf16_t* O = (bf16_t*)(F.ws + WS_R1 + R1_O);
    const float* cw = F.in[I_CONVW] + (size_t)l * 3 * 512;
    for (int it = F.bid * 512 + F.tid; it < M * 64; it += F.G * 512) {
        const int t = it >> 6, c0 = (it & 63) * 8;
        const int L = (t >= TL) ? CTXL : SEQ, pos = (t >= TL) ? (t - TL) % CTXL : t % SEQ;
        const bf16_t* zr = Z + (size_t)t * ZS;
        float u0[8], u1[8], u2[8], bb[8];
        { const u32x4 c = *(const u32x4*)(zr + C_CSC + c0), x = *(const u32x4*)(zr + C_XSC + c0), b = *(const u32x4*)(zr + C_BSC + c0);
          u1[0] = bf_lo(c.x) * bf_lo(x.x); u1[1] = bf_hi(c.x) * bf_hi(x.x); u1[2] = bf_lo(c.y) * bf_lo(x.y); u1[3] = bf_hi(c.y) * bf_hi(x.y);
          u1[4] = bf_lo(c.z) * bf_lo(x.z); u1[5] = bf_hi(c.z) * bf_hi(x.z); u1[6] = bf_lo(c.w) * bf_lo(x.w); u1[7] = bf_hi(c.w) * bf_hi(x.w);
          bb[0] = bf_lo(b.x); bb[1] = bf_hi(b.x); bb[2] = bf_lo(b.y); bb[3] = bf_hi(b.y); bb[4] = bf_lo(b.z); bb[5] = bf_hi(b.z); bb[6] = bf_lo(b.w); bb[7] = bf_hi(b.w); }
        if (pos > 0) { const u32x4 c = *(const u32x4*)(zr - ZS + C_CSC + c0), x = *(const u32x4*)(zr - ZS + C_XSC + c0);
          u0[0] = bf_lo(c.x) * bf_lo(x.x); u0[1] = bf_hi(c.x) * bf_hi(x.x); u0[2] = bf_lo(c.y) * bf_lo(x.y); u0[3] = bf_hi(c.y) * bf_hi(x.y);
          u0[4] = bf_lo(c.z) * bf_lo(x.z); u0[5] = bf_hi(c.z) * bf_hi(x.z); u0[6] = bf_lo(c.w) * bf_lo(x.w); u0[7] = bf_hi(c.w) * bf_hi(x.w); }
        else {
#pragma unroll
            for (int j = 0; j < 8; ++j) u0[j] = 0.f; }
        if (pos < L - 1) { const u32x4 c = *(const u32x4*)(zr + ZS + C_CSC + c0), x = *(const u32x4*)(zr + ZS + C_XSC + c0);
          u2[0] = bf_lo(c.x) * bf_lo(x.x); u2[1] = bf_hi(c.x) * bf_hi(x.x); u2[2] = bf_lo(c.y) * bf_lo(x.y); u2[3] = bf_hi(c.y) * bf_hi(x.y);
          u2[4] = bf_lo(c.z) * bf_lo(x.z); u2[5] = bf_hi(c.z) * bf_hi(x.z); u2[6] = bf_lo(c.w) * bf_lo(x.w); u2[7] = bf_hi(c.w) * bf_hi(x.w); }
        else {
#pragma unroll
            for (int j = 0; j < 8; ++j) u2[j] = 0.f; }
        float o[8];
#pragma unroll
        for (int j = 0; j < 8; ++j) o[j] = bb[j] * (u0[j] * cw[c0 + j] + u1[j] * cw[512 + c0 + j] + u2[j] * cw[1024 + c0 + j]);
        u32x4 w; w.x = pk2(o[0], o[1]); w.y = pk2(o[2], o[3]); w.z = pk2(o[4], o[5]); w.w = pk2(o[6], o[7]);
        *(u32x4*)(O + (size_t)t * OS + 512 + c0) = w;
    }
}

#define MFMA32(a, b, c) __builtin_amdgcn_mfma_f32_32x32x16_bf16((a), (b), (c), 0, 0, 0)
DI int crow(int reg, int h) { return (reg & 3) + 8 * (reg >> 2) + 4 * h; }
DI bf16x8 pack_step(const f32x16& x, int s) {
    u32x4 p; p.x = pk2(x[8 * s], x[8 * s + 1]); p.y = pk2(x[8 * s + 2], x[8 * s + 3]); p.z = pk2(x[8 * s + 4], x[8 * s + 5]); p.w = pk2(x[8 * s + 6], x[8 * s + 7]);
    return __builtin_bit_cast(bf16x8, p);
}
DI bf16x8 cat4(u32x2 a, u32x2 b) { u32x4 p; p.x = a.x; p.y = a.y; p.z = b.x; p.w = b.y; return __builtin_bit_cast(bf16x8, p); }

typedef __attribute__((address_space(3))) s16x4 lds_s16x4;
DI bf16x8 tr8(const LAS bf16_t* p0, const LAS bf16_t* p1) {
    const s16x4 a = __builtin_amdgcn_ds_read_tr16_b64_v4i16((lds_s16x4*)p0), b = __builtin_amdgcn_ds_read_tr16_b64_v4i16((lds_s16x4*)p1);
    return (bf16x8){a[0], a[1], a[2], a[3], b[0], b[1], b[2], b[3]};
}
constexpr int NA_VS = 72;
constexpr int NA_TAB = 8 * NA_VS * 64 * 2;
constexpr float NA_L2E = 1.4426950408889634f;
constexpr int NA_KOFF = 0, NA_VOFF = 2 * 64 * NA_VS * 2;
constexpr int NA_TAB2 = 4 * 64 * NA_VS * 2;
DI void na_block_unit(const Frame& F, const bf16_t* Z, bf16_t* O, const LAS float* tab, int head, bool isctxu, int b, int rg) {
    const int tid = F.tid, lane = F.lane, wave = F.wave, r = lane & 31, h = lane >> 5;
    const int trq = (lane & 15) >> 2, trc = 16 * ((lane >> 4) & 1) + 4 * (lane & 3);
    LAS bf16_t* KR = (LAS bf16_t*)(F.lds + NA_KOFF); LAS bf16_t* VR = (LAS bf16_t*)(F.lds + NA_VOFF);
    const int qrow_g = isctxu ? 0 : 4 * rg + (wave >> 1), qcol0 = isctxu ? 0 : 32 * (wave & 1);
    const int qrow0 = isctxu ? TL + b * CTXL + 32 * wave : b * SEQ + qrow_g * 64 + qcol0;
    int rs = qrow_g - 4; rs = rs < 0 ? 0 : (rs > 24 ? 24 : rs);
    int rs_lo = 4 * rg - 4; rs_lo = rs_lo < 0 ? 0 : (rs_lo > 24 ? 24 : rs_lo); int rs_hi = 4 * rg + 3 - 4; rs_hi = rs_hi < 0 ? 0 : (rs_hi > 24 ? 24 : rs_hi);
    const int nwin = isctxu ? 0 : rs_hi + 8 - rs_lo, ntile = nwin + 4;
    const int winrow0 = b * SEQ + rs_lo * 64, ctxrow0 = TL + b * CTXL;
    bf16x8 qf[4];
    { const bf16_t* qp = Z + (size_t)(qrow0 + r) * ZS + C_QNA + head * 64 + 8 * h;
#pragma unroll
      for (int ks = 0; ks < 4; ++ks) qf[ks] = *(const bf16x8*)(qp + 16 * ks); }
    unsigned ix0[4], ix1[4];
    { const int qc = qcol0 + r; int cs = qc - 8; cs = cs < 0 ? 0 : (cs > 48 ? 48 : cs);
#pragma unroll
      for (int g = 0; g < 4; ++g) { unsigned p0 = 0u, p1 = 0u;
#pragma unroll
          for (int e = 0; e < 4; ++e) { const int kc0 = crow(4 * g + e, h), kc1 = 32 + kc0;
              int d0 = kc0 - qc; d0 = d0 < -15 ? -15 : (d0 > 15 ? 15 : d0); int d1 = kc1 - qc; d1 = d1 < -15 ? -15 : (d1 > 15 ? 15 : d1);
              const unsigned c0 = (kc0 < cs || kc0 >= cs + 16) ? 31u : (unsigned)(d0 + 15), c1 = (kc1 < cs || kc1 >= cs + 16) ? 31u : (unsigned)(d1 + 15);
              p0 |= c0 << (8 * e); p1 |= c1 << (8 * e); }
          ix0[g] = p0; ix1[g] = p1; } }
    f32x16 o0, o1;
#pragma unroll
    for (int i = 0; i < 16; ++i) { o0[i] = 0.f; o1[i] = 0.f; }
    float mrun = -1e30f, lrun = 0.f;
    const int lkey = tid >> 3, lseg = tid & 7;
#define NA_TROW(j_) ((j_) < nwin ? winrow0 + (j_) * 64 : ctxrow0 + ((j_) - nwin) * 64)
#define NA_LD(j_, kk_, vv_) do { const bf16_t* zp = Z + (size_t)(NA_TROW(j_) + lkey) * ZS + head * 64 + 8 * lseg; kk_ = *(const u32x4*)(zp + C_KNA); vv_ = *(const u32x4*)(zp + C_VNA); } while (0)
#define NA_ST(slot_, kk_, vv_) do { *(LAS u32x4*)(KR + ((slot_) * 64 + lkey) * NA_VS + 8 * lseg) = kk_; *(LAS u32x4*)(VR + ((slot_) * 64 + lkey) * NA_VS + 8 * lseg) = vv_; } while (0)
    u32x4 sk, sv;
    __syncthreads();
    NA_LD(0, sk, sv); NA_ST(0, sk, sv); NA_LD(1, sk, sv);
#pragma unroll 1
    for (int j = 0; j < ntile; ++j) {
        __syncthreads();
        if (j + 1 < ntile) { NA_ST((j + 1) & 1, sk, sv); const int j2 = j + 2 < ntile ? j + 2 : ntile - 1; NA_LD(j2, sk, sv); }
        const bool isw = j < nwin;
        const int krow_g = rs_lo + j;
        if (isw && (krow_g < rs || krow_g >= rs + 8)) continue;
        const LAS bf16_t* kt = KR + (j & 1) * 64 * NA_VS; const LAS bf16_t* vt = VR + (j & 1) * 64 * NA_VS;
        f32x16 s0, s1;
#pragma unroll
        for (int i = 0; i < 16; ++i) { s0[i] = 0.f; s1[i] = 0.f; }
#pragma unroll
        for (int ks = 0; ks < 4; ++ks) { const bf16x8 k0 = *(const LAS bf16x8*)(kt + r * NA_VS + 16 * ks + 8 * h), k1 = *(const LAS bf16x8*)(kt + (32 + r) * NA_VS + 16 * ks + 8 * h);
            s0 = MFMA32(k0, qf[ks], s0); s1 = MFMA32(k1, qf[ks], s1); }
        const int drow = isw ? (krow_g - qrow_g + 7) : 15;
        const LAS float* trow = tab + (head * 16 + drow) * 32;
#pragma unroll
        for (int g = 0; g < 4; ++g) asm volatile("" : "+v"(ix0[g]), "+v"(ix1[g]));
        float tmax = -1e30f;
#pragma unroll
        for (int i = 0; i < 16; ++i) {
            const float a = s0[i] * (0.125f * NA_L2E) + trow[(ix0[i >> 2] >> (8 * (i & 3))) & 0xffu];
            const float bq = s1[i] * (0.125f * NA_L2E) + trow[(ix1[i >> 2] >> (8 * (i & 3))) & 0xffu];
            s0[i] = a; s1[i] = bq; tmax = fmaxf(tmax, fmaxf(a, bq));
        }
        tmax = fmaxf(tmax, __shfl_xor(tmax, 32));
        const float mnew = fmaxf(mrun, tmax), alpha = __builtin_amdgcn_exp2f(mrun - mnew);
        float psum = 0.f;
#pragma unroll
        for (int i = 0; i < 16; ++i) { const float a = __builtin_amdgcn_exp2f(s0[i] - mnew), bq = __builtin_amdgcn_exp2f(s1[i] - mnew); s0[i] = a; s1[i] = bq; psum += a + bq; }
        psum += __shfl_xor(psum, 32);
        lrun = lrun * alpha + psum; mrun = mnew;
#pragma unroll
        for (int i = 0; i < 16; ++i) { o0[i] *= alpha; o1[i] *= alpha; }
#pragma unroll
        for (int nb = 0; nb < 2; ++nb)
#pragma unroll
            for (int s = 0; s < 2; ++s) {
                const bf16x8 pf = pack_step(nb ? s1 : s0, s);
                const LAS bf16_t* vp = vt + (32 * nb + 16 * s + 4 * h + trq) * NA_VS + trc;
                o0 = MFMA32(tr8(vp, vp + 8 * NA_VS), pf, o0); o1 = MFMA32(tr8(vp + 32, vp + 32 + 8 * NA_VS), pf, o1);
            }
    }
#undef NA_TROW
#undef NA_LD
#undef NA_ST
    const float inv = 1.0f / lrun;
    bf16_t* op = O + (size_t)(qrow0 + r) * OS + head * 64 + 4 * h;
#pragma unroll
    for (int g = 0; g < 4; ++g) {
        u32x2 w0, w1; w0.x = pk2(o0[4 * g] * inv, o0[4 * g + 1] * inv); w0.y = pk2(o0[4 * g + 2] * inv, o0[4 * g + 3] * inv);
        w1.x = pk2(o1[4 * g] * inv, o1[4 * g + 1] * inv); w1.y = pk2(o1[4 * g + 2] * inv, o1[4 * g + 3] * inv);
        *(u32x2*)(op + 8 * g) = w0; *(u32x2*)(op + 32 + 8 * g) = w1;
    }
}
DI void phase_na(const Frame& F, int l, bool ctx_out) {
    const bf16_t* Z = (const bf16_t*)(F.ws + WS_R1); bf16_t* O = (bf16_t*)(F.ws + WS_R1 + R1_O);
    LAS float* tab = (LAS float*)(F.lds + NA_TAB2);
    __syncthreads();
    for (int i = F.tid; i < 8 * 16 * 32; i += 512) { const int hh = i >> 9, dr = (i >> 5) & 15, dc = i & 31;
        tab[i] = (dr == 15) ? 0.f : ((dc == 31) ? -1e30f : F.in[I_RPB][(size_t)l * 8 * 15 * 31 + (hh * 15 + dr) * 31 + dc] * NA_L2E); }
    __syncthreads();
    const int nlat = NB * 8 * 8, ntot = nlat + (ctx_out ? NB * 8 : 0);
#pragma unroll 1
    for (int u = F.bid; u < ntot; u += F.G) {
        if (u < nlat) na_block_unit(F, Z, O, tab, u & 7, false, u >> 6, (u >> 3) & 7);
        else { const int v = u - nlat; na_block_unit(F, Z, O, tab, v & 7, true, v >> 3, 0); }
    }
    __syncthreads();
}

constexpr int GP_CUM = 0, GL_CUMS = 132, GP_W2T = 33792  , GP_B2 = GP_W2T + 2 * 128 * 24 * 2  , GP_SEG = GP_B2 + 1024  ;
DI size_t gl_chunk_row(int b, int cn) { return cn < 4 ? (size_t)(TL + b * CTXL + cn * 64) : (size_t)(b * SEQ + (cn - 4) * 64); }
DI void gla_prep(const Frame& F, int l, int task) {
    const int cn = task % 36, hd = (task / 36) & 3, b = task / 144;
    bf16_t* Z = (bf16_t*)(F.ws + WS_R1); bf16_t* O = (bf16_t*)(F.ws + WS_R1 + R1_O); float* DECB = (float*)(F.ws + WS_DECB);
    LAS float* CUM = (LAS float*)(F.lds + GP_CUM); LAS float* SEG = (LAS float*)(F.lds + GP_SEG);
    const int tid = F.tid, lane = F.lane, wave = F.wave, r = lane & 31, h = lane >> 5;
    const size_t row0 = gl_chunk_row(b, cn);
    const bf16_t* W2G = (const bf16_t*)(F.ws + WS_W2TG);
    __syncthreads();
    const int tt = tid >> 3, seg = tid & 7, d0 = seg * 16;
    const int atb = wave & 1, adb = wave >> 1;
    const bf16_t* zr = Z + (row0 + tt) * ZS;
    const u32x4 q0 = *(const u32x4*)(zr + C_QGLA + hd * 128 + d0), q1 = *(const u32x4*)(zr + C_QGLA + hd * 128 + d0 + 8);
    const u32x4 k0 = *(const u32x4*)(zr + C_KGLA + hd * 128 + d0), k1 = *(const u32x4*)(zr + C_KGLA + hd * 128 + d0 + 8);
    float qv[16], kv[16];
    qv[0] = bf_lo(q0.x); qv[1] = bf_hi(q0.x); qv[2] = bf_lo(q0.y); qv[3] = bf_hi(q0.y); qv[4] = bf_lo(q0.z); qv[5] = bf_hi(q0.z); qv[6] = bf_lo(q0.w); qv[7] = bf_hi(q0.w);
    qv[8] = bf_lo(q1.x); qv[9] = bf_hi(q1.x); qv[10] = bf_lo(q1.y); qv[11] = bf_hi(q1.y); qv[12] = bf_lo(q1.z); qv[13] = bf_hi(q1.z); qv[14] = bf_lo(q1.w); qv[15] = bf_hi(q1.w);
    kv[0] = bf_lo(k0.x); kv[1] = bf_hi(k0.x); kv[2] = bf_lo(k0.y); kv[3] = bf_hi(k0.y); kv[4] = bf_lo(k0.z); kv[5] = bf_hi(k0.z); kv[6] = bf_lo(k0.w); kv[7] = bf_hi(k0.w);
    kv[8] = bf_lo(k1.x); kv[9] = bf_hi(k1.x); kv[10] = bf_lo(k1.y); kv[11] = bf_hi(k1.y); kv[12] = bf_lo(k1.z); kv[13] = bf_hi(k1.z); kv[14] = bf_lo(k1.w); kv[15] = bf_hi(k1.w);
    __syncthreads();
#pragma unroll 1
    for (int dir = 0; dir < 2; ++dir) {
        {
            const int tl = 32 * atb + r, tn = dir ? 63 - tl : tl;
            const bf16x8 lrf = *(const bf16x8*)(Z + (row0 + tn) * ZS + C_GATE + dir * 16 + 8 * h);
            const bf16x8 w2f = *(const bf16x8*)(W2G + ((size_t)(l * 2 + dir) * 512 + hd * 128 + 32 * adb + r) * 16 + 8 * h);
            const float b2v = F.in[I_GGB][(size_t)(l * 2 + dir) * 512 + hd * 128 + 32 * adb + r];
            f32x16 ga;
#pragma unroll
            for (int i = 0; i < 16; ++i) ga[i] = 0.f;
            ga = MFMA32(lrf, w2f, ga);
            float sg[4];
#pragma unroll
            for (int g = 0; g < 4; ++g) {
                float run = 0.f;
#pragma unroll
                for (int e = 0; e < 4; ++e) { const float x = ga[4 * g + e] + b2v; run += (fminf(x, 0.f) - __logf(1.0f + __expf(-fabsf(x)))) * (1.0f / 16.0f); ga[4 * g + e] = run; }
                sg[g] = run;
            }
            float off = 0.f;
#pragma unroll
            for (int g = 0; g < 4; ++g) { const float ps = __shfl_xor(sg[g], 32); const float o = off + (h ? ps : 0.f);
#pragma unroll
                for (int e = 0; e < 4; ++e) CUM[(32 * atb + 8 * g + 4 * h + e) * GL_CUMS + 32 * adb + r] = ga[4 * g + e] + o;
                off += sg[g] + ps; }
            if (h == 0) SEG[atb * 128 + 32 * adb + r] = off;
        }
        __syncthreads();
        {
            const int tau = dir ? 63 - tt : tt;
            float qs[16], ks[16];
#pragma unroll
            for (int j = 0; j < 4; ++j) {
                const f32x4 e0 = *(const LAS f32x4*)(SEG + d0 + 4 * j), e1 = *(const LAS f32x4*)(SEG + 128 + d0 + 4 * j);
                const f32x4 cl = *(const LAS f32x4*)(CUM + tau * GL_CUMS + d0 + 4 * j);
#pragma unroll
                for (int e = 0; e < 4; ++e) {
                    const float cum = cl[e] + (tau >= 32 ? e0[e] : 0.f);
                    const int jj = 4 * j + e;
                    const float ex = __expf(cum), inv = __builtin_amdgcn_rcpf(ex);
                    qs[jj] = qv[jj] * 0.08838834764831845f * ex;
                    ks[jj] = kv[jj] * inv;
                }
                if (tt == 0) { f32x4 dv;
#pragma unroll
                    for (int e = 0; e < 4; ++e) dv[e] = __expf(e0[e] + e1[e]);
                    *(f32x4*)(DECB + ((size_t)((b * 4 + hd) * 2 + dir) * 36 + cn) * 128 + d0 + 4 * j) = dv; }
            }
            bf16_t* qd = dir ? O + (row0 + tt) * OS + 1024 + hd * 128 + d0 : Z + (row0 + tt) * ZS + C_QGLA + hd * 128 + d0;
            bf16_t* kd = dir ? O + (row0 + tt) * OS + 1536 + hd * 128 + d0 : Z + (row0 + tt) * ZS + C_KGLA + hd * 128 + d0;
            u32x4 w;
            w.x = pk2(qs[0], qs[1]); w.y = pk2(qs[2], qs[3]); w.z = pk2(qs[4], qs[5]); w.w = pk2(qs[6], qs[7]); *(u32x4*)qd = w;
            w.x = pk2(qs[8], qs[9]); w.y = pk2(qs[10], qs[11]); w.z = pk2(qs[12], qs[13]); w.w = pk2(qs[14], qs[15]); *(u32x4*)(qd + 8) = w;
            w.x = pk2(ks[0], ks[1]); w.y = pk2(ks[2], ks[3]); w.z = pk2(ks[4], ks[5]); w.w = pk2(ks[6], ks[7]); *(u32x4*)kd = w;
            w.x = pk2(ks[8], ks[9]); w.y = pk2(ks[10], ks[11]); w.z = pk2(ks[12], ks[13]); w.w = pk2(ks[14], ks[15]); *(u32x4*)(kd + 8) = w;
        }
        __syncthreads();
    }
}
constexpr int GL_RS = 136, GL_VS = 72, GC_QS = 0, GC_KS = GC_QS + 2 * 64 * GL_RS * 2, GC_V = GC_KS + 2 * 64 * GL_RS * 2, GC_ST = GC_V + 2 * 64 * GL_VS * 2, GC_DEC = GC_ST + 2 * 128 * GL_VS * 2;
static_assert(GC_DEC + 2 * 128 * 4 <= MISC_OFF, "GLA chain LDS");
DI void gla_chain(const Frame& F, int l, int chain, bool ctx_out) {
    const int vs = chain & 3, dir = (chain >> 2) & 1, hd = (chain >> 3) & 3, b = chain >> 5;
    const bf16_t* Z = (const bf16_t*)(F.ws + WS_R1); const bf16_t* O = (const bf16_t*)(F.ws + WS_R1 + R1_O); const float* DECB = (const float*)(F.ws + WS_DECB);
    bf16_t* OD = (bf16_t*)(F.ws + WS_R2 + (dir ? R2_OB : 0));
    const int tid = F.tid, lane = F.lane, wave = F.wave, r = lane & 31, h = lane >> 5;
    const int trq = (lane & 15) >> 2, trc = 16 * ((lane >> 4) & 1) + 4 * (lane & 3);
    const int tau = tid >> 3, seg = tid & 7, d0 = seg * 16;
#define GL_CN(s_) ((s_) < 4 ? (dir ? 3 - (s_) : (s_)) : 4 + (dir ? 31 - ((s_) - 4) : ((s_) - 4)))
#define GL_ROW(s_, t_) (gl_chunk_row(b, GL_CN(s_)) + (dir ? 63 - (t_) : (t_)))
    const bf16_t* qbase = dir ? O + 1024 + hd * 128 + d0 : Z + C_QGLA + hd * 128 + d0; const bf16_t* kbase = dir ? O + 1536 + hd * 128 + d0 : Z + C_KGLA + hd * 128 + d0;
    const size_t qstr = dir ? OS : ZS;
    const bf16_t* vbase = Z + C_VGLA + hd * 256 + vs * 64 + seg * 8;
    const float* dbase = DECB + (size_t)((b * 4 + hd) * 2 + dir) * 36 * 128;
    __syncthreads();
    for (int i = tid; i < 128 * GL_VS / 2; i += 512) ((LAS unsigned*)(F.lds + GC_ST))[i] = 0u;
    f32x16 S0, S1;
#pragma unroll
    for (int i = 0; i < 16; ++i) { S0[i] = 0.f; S1[i] = 0.f; }
    u32x4 nq0, nq1, nk0, nk1, nvv; float ndec = 0.f;
#define GL_LOAD(s_) do { const size_t rw = GL_ROW(s_, tau); nq0 = *(const u32x4*)(qbase + rw * qstr); nq1 = *(const u32x4*)(qbase + rw * qstr + 8); nk0 = *(const u32x4*)(kbase + rw * qstr); nk1 = *(const u32x4*)(kbase + rw * qstr + 8); \
        nvv = *(const u32x4*)(vbase + rw * ZS); if (tid < 128) ndec = dbase[GL_CN(s_) * 128 + tid]; } while (0)
#define GL_PUT(p_) do { LAS bf16_t* qd = (LAS bf16_t*)(F.lds + GC_QS) + ((p_) * 64 + tau) * GL_RS + d0; LAS bf16_t* kd = (LAS bf16_t*)(F.lds + GC_KS) + ((p_) * 64 + tau) * GL_RS + d0; \
        *(LAS u32x4*)qd = nq0; *(LAS u32x4*)(qd + 8) = nq1; *(LAS u32x4*)kd = nk0; *(LAS u32x4*)(kd + 8) = nk1; *(LAS u32x4*)((LAS bf16_t*)(F.lds + GC_V) + ((p_) * 64 + tau) * GL_VS + seg * 8) = nvv; \
        if (tid < 128) ((LAS float*)(F.lds + GC_DEC))[(p_) * 128 + tid] = ndec; } while (0)
    GL_LOAD(0); GL_PUT(0); GL_LOAD(1);
    __syncthreads();
#pragma unroll 1
    for (int s = 0; s < 36; ++s) {
        const int p = s & 1;
        const bool emit = (s >= 4) || ctx_out;
        const LAS bf16_t* QS = (const LAS bf16_t*)(F.lds + GC_QS) + p * 64 * GL_RS; const LAS bf16_t* KS = (const LAS bf16_t*)(F.lds + GC_KS) + p * 64 * GL_RS;
        const LAS bf16_t* VV = (const LAS bf16_t*)(F.lds + GC_V) + p * 64 * GL_VS;
        const LAS bf16_t* STo = (const LAS bf16_t*)(F.lds + GC_ST) + p * 128 * GL_VS; LAS bf16_t* STn = (LAS bf16_t*)(F.lds + GC_ST) + (p ^ 1) * 128 * GL_VS;
        if (wave < 4) {
            if (emit) {
                const int vb = wave & 1, tb = wave >> 1;
                f32x16 a0, a1, oo, oi;
#pragma unroll
                for (int i = 0; i < 16; ++i) { a0[i] = 0.f; a1[i] = 0.f; oo[i] = 0.f; oi[i] = 0.f; }
#pragma unroll
                for (int kk = 0; kk < 8; ++kk) {
                    const bf16x8 qf = *(const LAS bf16x8*)(QS + (32 * tb + r) * GL_RS + 16 * kk + 8 * h);
                    const bf16x8 kf0 = *(const LAS bf16x8*)(KS + r * GL_RS + 16 * kk + 8 * h);
                    const LAS bf16_t* sp = STo + (16 * kk + 8 * h + trq) * GL_VS + 32 * vb + trc;
                    a0 = MFMA32(kf0, qf, a0);
                    oi = MFMA32(tr8(sp, sp + 4 * GL_VS), qf, oi);
                    if (tb == 1) { const bf16x8 kf1 = *(const LAS bf16x8*)(KS + (32 + r) * GL_RS + 16 * kk + 8 * h); a1 = MFMA32(kf1, qf, a1); }
                }
                const int tt = 32 * tb + r;
#pragma unroll
                for (int i = 0; i < 16; ++i) { const int sg0 = crow(i, h); if (sg0 > tt) a0[i] = 0.f; if (32 + sg0 > tt) a1[i] = 0.f; }
#pragma unroll
                for (int sb = 0; sb < 2; ++sb)
#pragma unroll
                    for (int st = 0; st < 2; ++st) {
                        if (sb == 1 && tb == 0) continue;
                        const bf16x8 pf = pack_step(sb ? a1 : a0, st);
                        const LAS bf16_t* vp = VV + (32 * sb + 16 * st + 4 * h + trq) * GL_VS + 32 * vb + trc;
                        oo = MFMA32(tr8(vp, vp + 8 * GL_VS), pf, oo);
                    }
#pragma unroll
                for (int i = 0; i < 16; ++i) oo[i] += oi[i];
                const size_t orow = GL_ROW(s, tt);
                bf16_t* op = OD + orow * D + hd * 256 + vs * 64 + 32 * vb + 4 * h;
#pragma unroll
                for (int g = 0; g < 4; ++g) { u32x2 w; w.x = pk2(oo[4 * g], oo[4 * g + 1]); w.y = pk2(oo[4 * g + 2], oo[4 * g + 3]); *(u32x2*)(op + 8 * g) = w; }
            }
        } else {
            const int db = wave - 4, dd = 32 * db + r;
            const float dec = ((const LAS float*)(F.lds + GC_DEC))[p * 128 + dd];
#pragma unroll
            for (int kk = 0; kk < 4; ++kk) {
                const LAS bf16_t* kp = KS + (16 * kk + 8 * h + trq) * GL_RS + 32 * db + trc;
                const LAS bf16_t* v0p = VV + (16 * kk + 8 * h + trq) * GL_VS + trc;
                const bf16x8 kf = tr8(kp, kp + 4 * GL_RS);
                S0 = MFMA32(tr8(v0p, v0p + 4 * GL_VS), kf, S0); S1 = MFMA32(tr8(v0p + 32, v0p + 32 + 4 * GL_VS), kf, S1);
            }
#pragma unroll
            for (int i = 0; i < 16; ++i) { S0[i] *= dec; S1[i] *= dec; }
#pragma unroll
            for (int g = 0; g < 4; ++g) {
                u32x2 w0, w1; w0.x = pk2(S0[4 * g], S0[4 * g + 1]); w0.y = pk2(S0[4 * g + 2], S0[4 * g + 3]); w1.x = pk2(S1[4 * g], S1[4 * g + 1]); w1.y = pk2(S1[4 * g + 2], S1[4 * g + 3]);
                *(LAS u32x2*)(STn + dd * GL_VS + 8 * g + 4 * h) = w0; *(LAS u32x2*)(STn + dd * GL_VS + 32 + 8 * g + 4 * h) = w1;
            }
        }
        if (s + 1 < 36) { GL_PUT(p ^ 1); const int s2 = s + 2 < 36 ? s + 2 : 35; GL_LOAD(s2); }
        __syncthreads();
    }
#undef GL_ROW
#undef GL_CN
#undef GL_LOAD
#undef GL_PUT
}
DI void phase_gla_fin(const Frame& F, int l, int M) {
    const int NGW = F.G * 8, gw = F.bid * 8 + F.wave, lane = F.lane;
    const bf16_t* Z = (const bf16_t*)(F.ws + WS_R1); bf16_t* O = (bf16_t*)(F.ws + WS_R1 + R1_O);
    const bf16_t* OFp = (const bf16_t*)(F.ws + WS_R2); const bf16_t* OBp = (const bf16_t*)(F.ws + WS_R2 + R2_OB);
    const float* gn = F.in[I_GNG] + (size_t)l * 256;
    for (int t = gw; t < M; t += NGW) {
        const u32x4 a0 = *(const u32x4*)(OFp + (size_t)t * D + 16 * lane), a1 = *(const u32x4*)(OFp + (size_t)t * D + 16 * lane + 8);
        const u32x4 b0 = *(const u32x4*)(OBp + (size_t)t * D + 16 * lane), b1 = *(const u32x4*)(OBp + (size_t)t * D + 16 * lane + 8);
        const u32x4 r0 = *(const u32x4*)(Z + (size_t)t * ZS + C_RGLA + 16 * lane), r1 = *(const u32x4*)(Z + (size_t)t * ZS + C_RGLA + 16 * lane + 8);
        float o[16], rr[16];
        o[0] = bf_lo(a0.x) + bf_lo(b0.x); o[1] = bf_hi(a0.x) + bf_hi(b0.x); o[2] = bf_lo(a0.y) + bf_lo(b0.y); o[3] = bf_hi(a0.y) + bf_hi(b0.y);
        o[4] = bf_lo(a0.z) + bf_lo(b0.z); o[5] = bf_hi(a0.z) + bf_hi(b0.z); o[6] = bf_lo(a0.w) + bf_lo(b0.w); o[7] = bf_hi(a0.w) + bf_hi(b0.w);
        o[8] = bf_lo(a1.x) + bf_lo(b1.x); o[9] = bf_hi(a1.x) + bf_hi(b1.x); o[10] = bf_lo(a1.y) + bf_lo(b1.y); o[11] = bf_hi(a1.y) + bf_hi(b1.y);
        o[12] = bf_lo(a1.z) + bf_lo(b1.z); o[13] = bf_hi(a1.z) + bf_hi(b1.z); o[14] = bf_lo(a1.w) + bf_lo(b1.w); o[15] = bf_hi(a1.w) + bf_hi(b1.w);
        rr[0] = bf_lo(r0.x); rr[1] = bf_hi(r0.x); rr[2] = bf_lo(r0.y); rr[3] = bf_hi(r0.y); rr[4] = bf_lo(r0.z); rr[5] = bf_hi(r0.z); rr[6] = bf_lo(r0.w); rr[7] = bf_hi(r0.w);
        rr[8] = bf_lo(r1.x); rr[9] = bf_hi(r1.x); rr[10] = bf_lo(r1.y); rr[11] = bf_hi(r1.y); rr[12] = bf_lo(r1.z); rr[13] = bf_hi(r1.z); rr[14] = bf_lo(r1.w); rr[15] = bf_hi(r1.w);
        float ss = 0.f;
#pragma unroll
        for (int i = 0; i < 16; ++i) ss += o[i] * o[i];
        ss += __shfl_xor(ss, 1); ss += __shfl_xor(ss, 2); ss += __shfl_xor(ss, 4); ss += __shfl_xor(ss, 8);
        const float rstd = rsqrtf(ss * (1.0f / 256.0f) + RMS_EPS);
        const int v0 = (lane & 15) * 16;
        float y[16];
#pragma unroll
        for (int i = 0; i < 16; ++i) y[i] = o[i] * rstd * gn[v0 + i] * siluf_(rr[i]);
        u32x4 w0, w1; w0.x = pk2(y[0], y[1]); w0.y = pk2(y[2], y[3]); w0.z = pk2(y[4], y[5]); w0.w = pk2(y[6], y[7]);
        w1.x = pk2(y[8], y[9]); w1.y = pk2(y[10], y[11]); w1.z = pk2(y[12], y[13]); w1.w = pk2(y[14], y[15]);
        *(u32x4*)(O + (size_t)t * OS + 1024 + 16 * lane) = w0; *(u32x4*)(O + (size_t)t * OS + 1024 + 16 * lane + 8) = w1;
    }
}

constexpr int RT_HS = 1032;
template <bool DRY = false> DI void phase_router(const Frame& F, int l, int M) {
    LAS bf16_t* HH = (LAS bf16_t*)F.lds;
    LAS bf16_t* HL = HH + 32 * RT_HS;
    LAS float* H2F = (LAS float*)F.lds;
    bf16_t* H2 = (bf16_t*)(F.ws + WS_R1 + R1_H2);
    const float* xres = F.out; const float* cres = (const float*)(F.ws + WS_CTXS);
    const bf16_t* WRH = (const bf16_t*)(F.ws + WS_WRT) + (size_t)(l * 2) * NE * D; const bf16_t* WRL = WRH + (size_t)NE * D;
    int* toke = (int*)(F.ws + WS_TOKE); int* tokp = (int*)(F.ws + (DRY ? WS_TOKR : WS_TOKP)); float* tokw = (float*)(F.ws + WS_TOKW);
    unsigned* cnt = (unsigned*)(F.ws + WS_CTL) + CW_CNT + 4096 * l + (DRY ? 32 : 0);
    const int lane = F.lane, wave = F.wave, r = lane & 31, hh = lane >> 5;
    const float brt = F.in[I_BR][l * NE + lane];
    const int npass = (M + 31) / 32;
    float xr[4][16];
#pragma unroll
    for (int rr = 0; rr < 4; ++rr) { const int t = F.bid * 32 + 4 * wave + rr;
        if (F.bid < npass && t < M) load_row_f32(t >= TL ? cres + (size_t)(t - TL) * D : xres + (size_t)t * D, lane, xr[rr]);
        else {
#pragma unroll
            for (int i = 0; i < 16; ++i) xr[rr][i] = 0.f; } }
    float gg[16]; load_row_f32(F.in[I_G2] + (size_t)l * D, lane, gg);
#pragma unroll 1
    for (int ps = F.bid; ps < npass; ps += F.G) {
        __syncthreads();
#if RT_PROBE == 1
        RT_T0();
#endif
        { const int t0 = ps * 32; const int mr = t0 >= TL ? 8 : t0 / SEQ;
          float sh[16], sc[16]; load_row_f32(modp(F, l, mr, 3), lane, sh); load_row_f32(modp(F, l, mr, 4), lane, sc);
#pragma unroll
          for (int rr = 0; rr < 4; ++rr) {
            const int row = 4 * wave + rr, t = ps * 32 + row;
            float h[16]; float ss = 0.f;
#pragma unroll
            for (int i = 0; i < 16; ++i) ss += xr[rr][i] * xr[rr][i];
            const float rstd = rsqrtf(wave_sum(ss) * (1.0f / D) + RMS_EPS);
#pragma unroll
            for (int i = 0; i < 16; ++i) h[i] = (t < M) ? xr[rr][i] * rstd * gg[i] * (1.0f + sc[i]) + sh[i] : 0.f;
            if (t < M) store_row_bf16(H2 + (size_t)t * D, lane, h);
#pragma unroll
            for (int i = 0; i < 2; ++i) {
                u32x4 whi; whi.x = pk2(h[8 * i], h[8 * i + 1]); whi.y = pk2(h[8 * i + 2], h[8 * i + 3]); whi.z = pk2(h[8 * i + 4], h[8 * i + 5]); whi.w = pk2(h[8 * i + 6], h[8 * i + 7]);
                u32x4 wlo; wlo.x = pk2(h[8 * i] - bf_lo(whi.x), h[8 * i + 1] - bf_hi(whi.x)); wlo.y = pk2(h[8 * i + 2] - bf_lo(whi.y), h[8 * i + 3] - bf_hi(whi.y));
                wlo.z = pk2(h[8 * i + 4] - bf_lo(whi.z), h[8 * i + 5] - bf_hi(whi.z)); wlo.w = pk2(h[8 * i + 6] - bf_lo(whi.w), h[8 * i + 7] - bf_hi(whi.w));
                *(LAS u32x4*)(HH + row * RT_HS + 8 * lane + 512 * i) = whi; *(LAS u32x4*)(HL + row * RT_HS + 8 * lane + 512 * i) = wlo; }
          }
          const int pn = ps + F.G;
#pragma unroll
          for (int rr = 0; rr < 4; ++rr) { const int t = pn * 32 + 4 * wave + rr;
              if (pn < npass && t < M) load_row_f32(t >= TL ? cres + (size_t)(t - TL) * D : xres + (size_t)t * D, lane, xr[rr]); }
        }
#if RT_PROBE == 1
        RT_AMP();
#endif
        __syncthreads();
#if RT_PROBE == 2
        RT_T0();
#endif
        f32x16 a0, a1;
#pragma unroll
        for (int i = 0; i < 16; ++i) { a0[i] = 0.f; a1[i] = 0.f; }
        {
            const LAS bf16_t* hp = HH + r * RT_HS + 128 * wave + 8 * hh; const LAS bf16_t* lp = HL + r * RT_HS + 128 * wave + 8 * hh;
            const bf16_t* w0h = WRH + (size_t)r * D + 128 * wave + 8 * hh; const bf16_t* w1h = w0h + (size_t)32 * D;
            const bf16_t* w0l = WRL + (size_t)r * D + 128 * wave + 8 * hh; const bf16_t* w1l = w0l + (size_t)32 * D;
#pragma unroll
            for (int ks = 0; ks < 8; ++ks) {
                const bf16x8 ah = *(const LAS bf16x8*)(hp + 16 * ks), al = *(const LAS bf16x8*)(lp + 16 * ks);
                const bf16x8 b0h = *(const bf16x8*)(w0h + 16 * ks), b1h = *(const bf16x8*)(w1h + 16 * ks), b0l = *(const bf16x8*)(w0l + 16 * ks), b1l = *(const bf16x8*)(w1l + 16 * ks);
                a0 = MFMA32(ah, b0h, a0); a1 = MFMA32(ah, b1h, a1);
                a0 = MFMA32(al, b0h, a0); a1 = MFMA32(al, b1h, a1);
                a0 = MFMA32(ah, b0l, a0); a1 = MFMA32(ah, b1l, a1);
            }
        }
        __syncthreads();
#pragma unroll
        for (int i = 0; i < 16; ++i) { const int tk = crow(i, hh); H2F[(wave * 32 + tk) * 64 + r] = a0[i]; H2F[(wave * 32 + tk) * 64 + 32 + r] = a1[i]; }
        __syncthreads();
#if RT_PROBE == 2
        RT_AMP();
#endif
#if RT_PROBE == 4
        RT_T0();
#endif
        LAS unsigned* lcnt = (LAS unsigned*)(F.lds + MISC_OFF + 2048);
        if (F.tid < 64) lcnt[F.tid] = 0u;
        __syncthreads();
        int myj[4]; unsigned mylp[4]; float myw[4];
#pragma unroll
        for (int rr = 0; rr < 4; ++rr) {
            const int row = 4 * wave + rr, t = ps * 32 + row;
            myj[rr] = -1; mylp[rr] = 0u; myw[rr] = 0.f;
            if (t >= M) continue;
            float logit = 0.f;
#pragma unroll
            for (int w = 0; w < 8; ++w) logit += H2F[(w * 32 + row) * 64 + lane];
            const float score = sigmoidf_(logit), sel = score + brt;
            const float g1 = grp8_max(sel);
            const unsigned long long bm = __ballot(sel == g1);
            const unsigned gm = (unsigned)((bm >> (lane & ~7)) & 0xffull);
            const int first = __builtin_ctz(gm);
            const float g2 = grp8_max(((lane & 7) == first) ? -INFINITY : sel);
            const float gs = g1 + g2; const int g = lane >> 3;
            int grank = 0;
#pragma unroll
            for (int j = 0; j < 8; ++j) { const float o = readlane_f(gs, 8 * j); grank += (o > gs || (o == gs && j < g)) ? 1 : 0; }
            const bool gsel = grank < 4;
            const float ms = gsel ? sel : -INFINITY;
            unsigned long long cb = 0ull; float cur = ms;
#pragma unroll
            for (int rnd = 0; rnd < TOPK; ++rnd) {
                float mx = cur; mx = fmaxf(mx, dpp_f<0xB1>(mx)); mx = fmaxf(mx, dpp_f<0x4E>(mx)); mx = fmaxf(mx, dpp_f<0x141>(mx)); mx = fmaxf(mx, dpp_f<0x140>(mx));
                const float wm = fmaxf(fmaxf(readlane_f(mx, 0), readlane_f(mx, 16)), fmaxf(readlane_f(mx, 32), readlane_f(mx, 48)));
                const unsigned long long bm2 = __ballot(cur == wm);
                const int ls = __builtin_ctzll(bm2);
                cb |= 1ull << ls;
                if (lane == ls) cur = -INFINITY;
            }
            const bool chosen = (cb >> lane) & 1ull;
            const float ssum = wave_sum(chosen ? score : 0.f);
            if (chosen) {
                const int j = __builtin_popcountll(cb & ((1ull << lane) - 1ull));
                if (j < 8) { myj[rr] = j; mylp[rr] = __hip_atomic_fetch_add(&lcnt[lane], 1u, __ATOMIC_RELAXED, __HIP_MEMORY_SCOPE_WORKGROUP); myw[rr] = score * __builtin_amdgcn_rcpf(ssum) * 2.5f; }
            }
        }
#if RT_PROBE == 4
        RT_AMP();
#endif
        __syncthreads();
#if RT_PROBE == 5
        RT_T0();
#endif
        if (F.tid < 64) { const unsigned c = lcnt[F.tid]; lcnt[64 + F.tid] = c ? atomicAdd(cnt + F.tid * 64, c) : 0u; }
        __syncthreads();
#pragma unroll
        for (int rr = 0; rr < 4; ++rr) {
            const int t = ps * 32 + 4 * wave + rr;
            if (myj[rr] >= 0) { const size_t o = (size_t)t * 8 + myj[rr]; toke[o] = lane; tokp[o] = (int)(lcnt[64 + lane] + mylp[rr]); tokw[o] = myw[rr]; }
        }
#if RT_PROBE == 5
        RT_AMP();
#endif
    }
    __syncthreads();
}
DI void moe_tables(const Frame& F, int l, int M) {
    LAS int* tb = (LAS int*)(F.lds + MISC_OFF + 64); LAS int* rb = tb + 72; LAS int* cn = rb + 72;
    const unsigned* cnt = (const unsigned*)(F.ws + WS_CTL) + CW_CNT + 4096 * l;
    __syncthreads();
    if (F.tid < NE) cn[F.tid] = (int)__hip_atomic_load(cnt + F.tid * 64, __ATOMIC_RELAXED, __HIP_MEMORY_SCOPE_AGENT);
    if (F.tid == NE) cn[NE] = M;
    __syncthreads();
    if (F.tid == 0) { int t = 0, r = 0; for (int e = 0; e < NEX; ++e) { tb[e] = t; rb[e] = r; t += (cn[e] + 255) >> 8; r += cn[e]; } tb[NEX] = t; }
    __syncthreads();
    LAS unsigned char* te = (LAS unsigned char*)(cn + 72);
    if (F.tid < NEX) { const int t0 = tb[F.tid], t1 = tb[F.tid + 1]; for (int t = t0; t < t1; ++t) te[t] = (unsigned char)F.tid; }
    __syncthreads();
}
DI void phase_route_tables(const Frame& F, int l, int M) {
    moe_tables(F, l, M);
    const LAS int* rb = (const LAS int*)(F.lds + MISC_OFF + 64) + 72;
    const int* toke = (const int*)(F.ws + WS_TOKE); const int* tokp = (const int*)(F.ws + WS_TOKP);
    int* tokr = (int*)(F.ws + WS_TOKR); int* rowl = (int*)(F.ws + WS_ROWL);
    for (int i = F.bid * 512 + F.tid; i < M * 8; i += F.G * 512) { const int row = rb[toke[i]] + tokp[i]; tokr[i] = row; rowl[row] = i >> 3; }
    const int shb = rb[NE];
    for (int i = F.bid * 512 + F.tid; i < M + 256; i += F.G * 512) rowl[shb + i] = (i < M) ? i : 0;
}
template <bool DRY = false> DI void phase_combine(const Frame& F, int l, int M) {
    moe_tables(F, l, M);
    const LAS int* rb = (const LAS int*)(F.lds + MISC_OFF + 64) + 72;
    const int shb = rb[NE];
    const int gw = F.bid * 8 + F.wave, lane = F.lane;
    const unsigned char* OS_ = (const unsigned char*)(F.ws + WS_R1);
    const int* tokr = (const int*)(F.ws + WS_TOKR); const float* tokw = (const float*)(F.ws + WS_TOKW);
    float* xres = F.out; float* cres = (float*)(F.ws + WS_CTXS);
    bf16_t* H = (bf16_t*)(F.ws + WS_R2 + (DRY ? (size_t)40 * 1024 * 1024 : 0));
    const int per = M / (GRID * 8);
    const int tbeg = gw * per;
    int mr_cur = -1;
    float g2v[16], shv[16], scv[16], gnv[16];
    if (l == 0) load_row_f32(F.in[I_G1] + D, lane, gnv); else load_row_f32(F.in[I_GF], lane, gnv);
    int4 nr0, nr1; f32x4 nw0, nw1; float xn[16];
    { const int t = tbeg; nr0 = *(const int4*)(tokr + (size_t)t * 8); nr1 = *(const int4*)(tokr + (size_t)t * 8 + 4); nw0 = *(const f32x4*)(tokw + (size_t)t * 8); nw1 = *(const f32x4*)(tokw + (size_t)t * 8 + 4);
      load_row_f32(t >= TL ? cres + (size_t)(t - TL) * D : xres + (size_t)t * D, lane, xn); }
#pragma unroll 1
    for (int k = 0; k < per; ++k) {
        const int t = tbeg + k;
        const bool isctx = t >= TL; const int mr = isctx ? 8 : t / SEQ;
        if (mr != mr_cur) { mr_cur = mr; load_row_f32(modp(F, l, mr, 5), lane, g2v); if (l == 0) { load_row_f32(modp(F, 1, mr, 0), lane, shv); load_row_f32(modp(F, 1, mr, 1), lane, scv); } }
        const int rows[8] = {nr0.x, nr0.y, nr0.z, nr0.w, nr1.x, nr1.y, nr1.z, nr1.w};
        const float wts[8] = {nw0[0], nw0[1], nw0[2], nw0[3], nw1[0], nw1[1], nw1[2], nw1[3]};
        float x[16];
#pragma unroll
        for (int i = 0; i < 16; ++i) x[i] = xn[i];
        u32x2 v[9][2];
#pragma unroll
        for (int i = 0; i < 2; ++i) v[8][i] = *(const u32x2*)(OS_ + (size_t)(shb + t) * D + 8 * lane + 512 * i);
#pragma unroll
        for (int j = 0; j < 8; ++j)
#pragma unroll
            for (int i = 0; i < 2; ++i) v[j][i] = *(const u32x2*)(OS_ + (size_t)rows[j] * D + 8 * lane + 512 * i);
        if (k + 1 < per) { const int tn = t + 1; nr0 = *(const int4*)(tokr + (size_t)tn * 8); nr1 = *(const int4*)(tokr + (size_t)tn * 8 + 4); nw0 = *(const f32x4*)(tokw + (size_t)tn * 8); nw1 = *(const f32x4*)(tokw + (size_t)tn * 8 + 4);
            load_row_f32(tn >= TL ? cres + (size_t)(tn - TL) * D : xres + (size_t)tn * D, lane, xn); }
        float y[16];
#pragma unroll
        for (int i = 0; i < 2; ++i) { const u32x2 a = v[8][i];
            y[8 * i + 0] = __builtin_amdgcn_cvt_f32_fp8((int)a.x, 0); y[8 * i + 1] = __builtin_amdgcn_cvt_f32_fp8((int)a.x, 1); y[8 * i + 2] = __builtin_amdgcn_cvt_f32_fp8((int)a.x, 2); y[8 * i + 3] = __builtin_amdgcn_cvt_f32_fp8((int)a.x, 3);
            y[8 * i + 4] = __builtin_amdgcn_cvt_f32_fp8((int)a.y, 0); y[8 * i + 5] = __builtin_amdgcn_cvt_f32_fp8((int)a.y, 1); y[8 * i + 6] = __builtin_amdgcn_cvt_f32_fp8((int)a.y, 2); y[8 * i + 7] = __builtin_amdgcn_cvt_f32_fp8((int)a.y, 3); }
#pragma unroll
        for (int j = 0; j < DBG_NROUTED; ++j) { const float w = wts[j];
#pragma unroll
            for (int i = 0; i < 2; ++i) { const u32x2 a = v[j][i];
                y[8 * i + 0] += w * __builtin_amdgcn_cvt_f32_fp8((int)a.x, 0); y[8 * i + 1] += w * __builtin_amdgcn_cvt_f32_fp8((int)a.x, 1); y[8 * i + 2] += w * __builtin_amdgcn_cvt_f32_fp8((int)a.x, 2); y[8 * i + 3] += w * __builtin_amdgcn_cvt_f32_fp8((int)a.x, 3);
                y[8 * i + 4] += w * __builtin_amdgcn_cvt_f32_fp8((int)a.y, 0); y[8 * i + 5] += w * __builtin_amdgcn_cvt_f32_fp8((int)a.y, 1); y[8 * i + 6] += w * __builtin_amdgcn_cvt_f32_fp8((int)a.y, 2); y[8 * i + 7] += w * __builtin_amdgcn_cvt_f32_fp8((int)a.y, 3); } }
        float* xr = isctx ? cres + (size_t)(t - TL) * D : xres + (size_t)t * D;
#pragma unroll
        for (int i = 0; i < 16; ++i) x[i] += g2v[i] * y[i];
        float ss = 0.f;
#pragma unroll
        for (int i = 0; i < 16; ++i) ss += x[i] * x[i];
        const float rstd = rsqrtf(wave_sum(ss) * (1.0f / D) + RMS_EPS);
        if (l == 0) {
            if (!DRY) store_row_f32(xr, lane, x);
            float h[16];
#pragma unroll
            for (int i = 0; i < 16; ++i) h[i] = x[i] * rstd * gnv[i] * (1.0f + scv[i]) + shv[i];
            store_row_bf16(H + (size_t)t * D, lane, h);
        } else {
#pragma unroll
            for (int i = 0; i < 16; ++i) x[i] = x[i] * rstd * gnv[i];
            if (!DRY) store_row_f32(xr, lane, x); else store_row_bf16(H + (size_t)t * D, lane, x);
        }
    }
}

constexpr int PH_PER_LAYER = 10, N_PHASES = 2 + 2 * PH_PER_LAYER;
template <class T> DI T* opaque_ptr(T* p) {
    unsigned long long v = (unsigned long long)p; unsigned lo = (unsigned)v, hi = (unsigned)(v >> 32);
    asm volatile("" : "+s"(lo), "+s"(hi)); return (T*)(__attribute__((address_space(1))) T*)(((unsigned long long)hi << 32) | lo);
}
template <int KIND> DI void run_phase(const Frame& F0, const int l0) {
    Frame F = F0; int l = l0; asm volatile("" : "+s"(l));
    F.ws = opaque_ptr(F0.ws); F.out = opaque_ptr(F0.out);
    { int t = F0.tid; asm volatile("" : "+v"(t)); F.tid = t; F.lane = t & 63; F.wave = __builtin_amdgcn_readfirstlane(t >> 6); }
    unsigned char* const ws = F.ws;
    const bool ctx_out = (l == 0);
    const int M = ctx_out ? TA : TL;
    if constexpr (KIND == 0) { mod_vectors(F); conv_router(F); conv_gate_w(F); conv_small(F, 0); conv_down(F, 0, (bf16_t*)(ws + WS_WBS + WB_WD)); }
    if constexpr (KIND == 1) { phase_norm1_first(F); }
    if constexpr (KIND == 2) {
        pg8::RectSched<37> S{(const char*)(ws + WS_R2), (const char*)(ws + wbs_base(l) + WB_WIN), D, D, ctx_out ? 72 : 64, ctx_out ? 0 : 8, ctx_out ? 0 : 11, 64, F.G, F.bid};
        pg8::EpiStoreBf16 E{(bf16_t*)(ws + WS_R1), ZS};
        pg8::gemm_phase<false>(F.lds, F.tid, D, D, D, S, E);
    }
    if constexpr (KIND == 3) {
#pragma unroll 1
        for (int t = F.bid; t < NB * 4 * 36; t += F.G) gla_prep(F, l, t);
        phase_na(F, l, ctx_out);
        phase_conv(F, l, M);
    }
    if constexpr (KIND == 12) {
#pragma unroll 1
        for (int ch = F.bid; ch < 256; ch += F.G) gla_chain(F, l, ch, ctx_out);
    }
    if constexpr (KIND == 4) { phase_gla_fin(F, l, M); }
    if constexpr (KIND == 5) {
        const char* Ob = (const char*)(ws + WS_R1 + R1_O); bf16_t* Y = (bf16_t*)(ws + WS_R2); const bf16_t* Zb = (const bf16_t*)(ws + WS_R1);
        { pg8::RectSched<4> S{Ob, (const char*)(ws + wbs_base(l) + WB_WNA), OS, 512, M / 256, 0, 0, 0, F.G, F.bid}; pg8::EpiGate<0> E{Y, Zb, C_MERGE}; pg8::gemm_phase<false>(F.lds, F.tid, 512, OS, 512, S, E); }
        { pg8::RectSched<4> S{Ob + 512 * 2, (const char*)(ws + wbs_base(l) + WB_WSC), OS, 512, M / 256, 0, 0, 0, F.G, F.bid}; pg8::EpiGate<1> E{Y, Zb, C_MERGE + 1024}; pg8::gemm_phase<false>(F.lds, F.tid, 512, OS, 512, S, E); }
        { pg8::RectSched<4> S{Ob + 1024 * 2, (const char*)(ws + wbs_base(l) + WB_WGLA), OS, D, M / 256, 0, 0, 0, F.G, F.bid}; pg8::EpiGate<1> E{Y, Zb, C_MERGE + 2048}; pg8::gemm_phase<false>(F.lds, F.tid, D, OS, D, S, E); }
        if (l == 0) conv_small(F, 1, 32);
    }
    if constexpr (KIND == 6) {
        pg8::RectSched<4> S{(const char*)(ws + WS_R2), (const char*)(ws + wbs_base(l) + WB_WOUT), D, D, M / 256, 0, 0, 0, F.G, F.bid};
        pg8::EpiResid E{l == 0 ? F.in[I_X] : F.out, F.out, l == 0 ? F.in[I_CTX] : (const float*)(ws + WS_CTXS), (float*)(ws + WS_CTXS), modp(F, l, 0, 2)};
        pg8::gemm_phase<false>(F.lds, F.tid, D, D, D, S, E);
        if (l == 0) conv_gu(F, 0, (bf16_t*)(ws + WS_R1), 32);
    }
    if constexpr (KIND == 7) {
#if REPEAT_KIND == 71
        phase_router<true>(F, l, M);
#endif
        phase_router(F, l, M); if (l != 0) conv_gu(F, l, (bf16_t*)(ws + WS_R1));
#if REPEAT_KIND == 72
        conv_gu(F, l, (bf16_t*)(ws + WS_R1));
#endif
    }
    if constexpr (KIND == 8) { phase_route_tables(F, l, M); }
    if constexpr (KIND == 9) {
        moe_tables(F, l, M);
        const LAS int* tb = (const LAS int*)(F.lds + MISC_OFF + 64);
        pg8::MoeSched<true, 2> S{tb, tb + 72, tb + 144, (const char*)(ws + WS_R1 + R1_H2), (const int*)(ws + WS_ROWL), (const char*)(ws + WS_R1), (size_t)512 * D * 2, D, D, F.G, F.bid};
        pg8::EpiSwiGLU E{(bf16_t*)(ws + WS_R2)};
        pg8::gemm_phase<true>(F.lds, F.tid, D, D, D, S, E);
    }
    if constexpr (KIND == 10) {
        moe_tables(F, l, M);
        const LAS int* tb = (const LAS int*)(F.lds + MISC_OFF + 64);
        pg8::MoeSched<false, 4> S{tb, tb + 72, tb + 144, (const char*)(ws + WS_R2), nullptr, (const char*)(ws + WS_WBS + WB_WD), (size_t)D * FF * 2, FF, FF, F.G, F.bid};
        pg8::EpiDown E{(unsigned char*)(ws + WS_R1), 0x7fffffff};
        pg8::gemm_phase<false>(F.lds, F.tid, FF, FF, FF, S, E);
    }
    if constexpr (KIND == 11) {
#if REPEAT_KIND == 111
        phase_combine<true>(F, l, M);
#endif
        phase_combine(F, l, M); if (l == 0) conv_down(F, 1, (bf16_t*)(ws + WS_WBS + WB_WD));
    }
}
DI void make_frame(Frame& F, const Args& args, unsigned char* lds_raw) {
    F.lds = (LAS unsigned char*)lds_raw; F.ws = args.ws; F.in = args.in; F.out = args.out;
    F.tid = threadIdx.x; F.lane = F.tid & 63; F.wave = __builtin_amdgcn_readfirstlane(F.tid >> 6); F.G = GRID; F.bid = blockIdx.x;
}
template <int KIND> __global__ void __launch_bounds__(512, 2) fwd_k(Args args) {
    extern __shared__ __attribute__((aligned(16))) unsigned char lds_raw[];
    Frame F; make_frame(F, args, lds_raw);
    run_phase<KIND>(F, args.ph_lo);
}
#if MK_ONE_LAUNCH
#ifndef TPROBE_KIND
#define TPROBE_KIND -1
#endif
#ifndef TPROBE_LAYER
#define TPROBE_LAYER -1
#endif
#define TPROBE_MULT 4
#define PHASE(k, lyr) do { unsigned long long _t0 = 0; const bool _pr = (TPROBE_KIND == (k)) && (TPROBE_LAYER < 0 || TPROBE_LAYER == (lyr)); if (_pr) _t0 = __builtin_amdgcn_s_memrealtime(); \
        run_phase<k>(F, lyr); xcd_barrier(bar); \
        if (_pr) { const unsigned long long _dt = __builtin_amdgcn_s_memrealtime() - _t0; while (__builtin_amdgcn_s_memrealtime() - _t0 < (TPROBE_MULT + 1) * _dt) __builtin_amdgcn_s_sleep(16); } \
        if (REPEAT_KIND == (k)) { run_phase<k>(F, lyr); xcd_barrier(bar); } } while (0)
__global__ void __launch_bounds__(512, 2) fwd(Args args) {
    extern __shared__ __attribute__((aligned(16))) unsigned char lds_raw[];
    Frame F; make_frame(F, args, lds_raw);
    volatile LAS unsigned* MISC = (volatile LAS unsigned*)(F.lds + MISC_OFF);
    if (F.tid < 4) MISC[F.tid] = 0u;
    __syncthreads();
    XcdBarrier bar = xcd_barrier_post((unsigned*)(F.ws + WS_CTL) + CW_BAR, MISC);
    PHASE(0, 0);
    PHASE(1, 0);
#pragma unroll 1
    for (int l = 0; l < 2; ++l) {
        PHASE(2, l); PHASE(3, l); PHASE(12, l); PHASE(4, l); PHASE(5, l); PHASE(6, l); PHASE(7, l); PHASE(8, l); PHASE(9, l); PHASE(10, l); PHASE(11, l);
    }
}
#endif

template <int KIND> static bool prep_kernel() { return hipFuncSetAttribute((const void*)fwd_k<KIND>, hipFuncAttributeMaxDynamicSharedMemorySize, LDS_BYTES) == hipSuccess; }
template <int KIND> static void launch_k(int grid, hipStream_t stream, Args a, int l) { a.ph_lo = l; a.ph_hi = KIND; hipLaunchKernelGGL(fwd_k<KIND>, dim3(grid), dim3(512), LDS_BYTES, stream, a); }
extern "C" void kernel_launch(void* const* d_in, const int* in_sizes, int n_in, void* d_out, int out_size, void* d_ws, size_t ws_size, hipStream_t stream) {
    static int grid = 0;
    if (grid == 0) {
        if (n_in != N_INPUTS || ws_size < WS_END) { fprintf(stderr, "kernel_launch: need %d inputs and %zu bytes of workspace; got %d, %zu\n", N_INPUTS, (size_t)WS_END, n_in, ws_size); grid = -1; return; }
        int dev = 0, cus = 0;
        if (hipGetDevice(&dev) != hipSuccess || hipDeviceGetAttribute(&cus, hipDeviceAttributeMultiprocessorCount, dev) != hipSuccess) { grid = -1; return; }
#if MK_ONE_LAUNCH
        if (hipFuncSetAttribute((const void*)fwd, hipFuncAttributeMaxDynamicSharedMemorySize, LDS_BYTES) != hipSuccess) { grid = -1; return; }
#else
        bool ok = prep_kernel<0>() && prep_kernel<1>() && prep_kernel<2>() && prep_kernel<3>() && prep_kernel<4>() && prep_kernel<5>() && prep_kernel<6>() && prep_kernel<7>() && prep_kernel<8>() && prep_kernel<9>() && prep_kernel<10>() && prep_kernel<11>() && prep_kernel<12>();
        if (!ok) { fprintf(stderr, "kernel_launch: hipFuncSetAttribute failed\n"); grid = -1; return; }
#endif
        (void)hipGetLastError();
        if (cus < GRID) { fprintf(stderr, "kernel_launch: built for a %d-CU device, found %d CUs\n", GRID, cus); grid = -1; return; }
        grid = GRID;
    }
    if (grid < 0) return;
    if (hipMemsetAsync((char*)d_ws + WS_CTL, 0, ZERO_BYTES, stream) != hipSuccess) return;
    Args a{};
    for (int i = 0; i < N_INPUTS; ++i) a.in[i] = (const float*)d_in[i];
    a.out = (float*)d_out; a.ws = (unsigned char*)d_ws;
#if MK_ONE_LAUNCH
    a.ph_lo = 0; a.ph_hi = N_PHASES;
    hipLaunchKernelGGL(fwd, dim3(grid), dim3(512), LDS_BYTES, stream, a);
#else
    launch_k<0>(grid, stream, a, 0); launch_k<1>(grid, stream, a, 0);
    for (int l = 0; l < 2; ++l) {
        launch_k<2>(grid, stream, a, l); launch_k<3>(grid, stream, a, l); launch_k<12>(grid, stream, a, l); launch_k<4>(grid, stream, a, l); launch_k<5>(grid, stream, a, l); launch_k<6>(grid, stream, a, l);
#ifdef DBG_STOP6
        break;
#endif
        launch_k<7>(grid, stream, a, l); launch_k<8>(grid, stream, a, l); launch_k<9>(grid, stream, a, l); launch_k<10>(grid, stream, a, l); launch_k<11>(grid, stream, a, l);
#ifdef DBG_STOP11
        break;
#endif
    }
#endif
}
```

```cpp
#include <hip/hip_runtime.h>
#include <cstdio>
#include <cstdint>

#define DBG_NROUTED 8
#ifndef RT_PROBE
#define RT_PROBE 0
#endif
#define RT_T0() const unsigned long long _rt0 = __builtin_amdgcn_s_memrealtime()
#define RT_AMP() do { const unsigned long long _d = __builtin_amdgcn_s_memrealtime() - _rt0; while (__builtin_amdgcn_s_memrealtime() - _rt0 < 5 * _d) __builtin_amdgcn_s_sleep(4); } while (0)
#ifndef REPEAT_KIND
#define REPEAT_KIND -1
#endif
#ifndef PG8_SP2
#define PG8_SP2 1
#endif
#ifndef PG8_ALIGN
#define PG8_ALIGN 1
#endif
#ifndef MK_ONE_LAUNCH
#define MK_ONE_LAUNCH 1
#ifndef W8A8
#define W8A8 1
#endif
#define MIX_T0 12
#define MIX_NT 7
#ifndef OG8
#define OG8 1
#endif
#define OG8_SCALE 4.0f
#ifndef ONA8
#define ONA8 1
#endif
#define ONA8_SCALE 16.0f
#define H8_SCALE 16.0f
#define W8_SCALE 1024.0f
#endif

#define LAS __attribute__((address_space(3)))
#define DI __device__ __forceinline__
typedef unsigned short bf16_t;
typedef short bf16x8 __attribute__((ext_vector_type(8)));
typedef short s16x4 __attribute__((ext_vector_type(4)));
typedef float f32x4 __attribute__((ext_vector_type(4)));
typedef float f32x16 __attribute__((ext_vector_type(16)));
typedef unsigned u32x4 __attribute__((ext_vector_type(4)));
typedef unsigned u32x2 __attribute__((ext_vector_type(2)));
typedef __bf16 bf16x2_t __attribute__((ext_vector_type(2)));
typedef float f32x2_t __attribute__((ext_vector_type(2)));

DI unsigned pk2(float lo, float hi) { f32x2_t v = {lo, hi}; bf16x2_t b = __builtin_convertvector(v, bf16x2_t); return __builtin_bit_cast(unsigned, b); }
DI float bf_lo(unsigned u) { return __uint_as_float(u << 16); }
DI float bf_hi(unsigned u) { return __uint_as_float(u & 0xffff0000u); }
DI float bf2f(bf16_t b) { return __uint_as_float(((unsigned)b) << 16); }
DI bf16_t f2bf(float f) { return (bf16_t)(pk2(f, 0.f) & 0xffffu); }
template <int CTRL> DI float dpp_f(float x) { return __int_as_float(__builtin_amdgcn_update_dpp(0, __float_as_int(x), CTRL, 0xF, 0xF, true)); }
DI float row16_sum(float v) {
    v += dpp_f<0xB1>(v);
    v += dpp_f<0x4E>(v);
    v += dpp_f<0x141>(v);
    v += dpp_f<0x140>(v);
    return v;
}
DI float readlane_f(float x, int l) { return __int_as_float(__builtin_amdgcn_readlane(__float_as_int(x), l)); }
DI float wave_sum(float v) {
    v = row16_sum(v);
    return (readlane_f(v, 0) + readlane_f(v, 16)) + (readlane_f(v, 32) + readlane_f(v, 48));
}
DI float grp8_max(float v) {
    v = fmaxf(v, dpp_f<0xB1>(v)); v = fmaxf(v, dpp_f<0x4E>(v)); v = fmaxf(v, dpp_f<0x141>(v));
    return v;
}
DI float sigmoidf_(float x) { return __builtin_amdgcn_rcpf(1.0f + __builtin_amdgcn_exp2f(-1.4426950408889634f * x)); }
DI float siluf_(float x) { return x * __builtin_amdgcn_rcpf(1.0f + __builtin_amdgcn_exp2f(-1.4426950408889634f * x)); }

constexpr int D = 1024, NB = 8, SEQ = 2048, CTXL = 256, TL = NB * SEQ, TC = NB * CTXL, TA = TL + TC;
constexpr int NIN = 9248, ZS = 9472  , NKV = 2592;
constexpr int C_KNA = 0, C_VNA = 512, C_KGLA = 1024, C_VGLA = 1536, C_GATE = 2560, C_QNA = 2592, C_BSC = 3104, C_CSC = 3616, C_XSC = 4128, C_QGLA = 4640, C_RGLA = 5152, C_MERGE = 6176;
constexpr int OS = 2048;
constexpr int NE = 64, NEX = 65  , FF = 256, TOPK = 8;
constexpr float RMS_EPS = 1e-6f;

enum { I_X = 0, I_C, I_CTX, I_CCTX, I_WMOD, I_BMOD, I_G1, I_G2, I_WIN, I_RPB, I_WNA, I_CONVW, I_WSC, I_GGW, I_GGB, I_GNG, I_WGLA, I_WOUT, I_WR, I_BR, I_WEG, I_WEU, I_WED, I_WSG, I_WSU, I_WSD, I_GF, N_INPUTS };

constexpr size_t WS_CTL = 0;
constexpr size_t CTL_BYTES = 65536;
constexpr int CW_BAR = 0, CW_CNT = 8192;
constexpr size_t WS_MOD = WS_CTL + CTL_BYTES;
constexpr size_t MOD_BYTES = 2 * 9 * 6 * 1024 * 4;
constexpr size_t ZERO_BYTES = CTL_BYTES + 458752;
constexpr size_t WS_CTXS = WS_CTL + ZERO_BYTES;
constexpr size_t WS_TOKE = WS_CTXS + (size_t)TC * D * 4;
constexpr size_t WS_TOKP = WS_TOKE + (size_t)TA * 8 * 4;
constexpr size_t WS_TOKW = WS_TOKP + (size_t)TA * 8 * 4;
constexpr size_t WS_TOKR = WS_TOKW + (size_t)TA * 8 * 4;
constexpr size_t WS_ROWL = WS_TOKR + (size_t)TA * 8 * 4;
constexpr int RCAP = TA;
constexpr size_t ROWL_BYTES = (size_t)(NE + 1) * RCAP * 4;
constexpr size_t WS_WRT = (WS_ROWL + ROWL_BYTES + 255) & ~(size_t)255;
constexpr size_t WRT_BYTES = (size_t)2 * 2 * NE * D * 2;
constexpr size_t WS_WBS = WS_WRT + WRT_BYTES;
constexpr size_t WB_WIN = 0, WB_WNA = WB_WIN + (size_t)ZS * D * 2, WB_WSC = WB_WNA + (size_t)D * 512 * 2, WB_WGLA = WB_WSC + (size_t)D * 512 * 2,
                 WB_WOUT = WB_WGLA + (size_t)D * D * 2, WB_WD = WB_WOUT + (size_t)D * D * 2, WBS_BYTES = WB_WD + (size_t)NEX * D * FF * 2;
constexpr size_t WS_R2 = WS_WBS + WBS_BYTES;
constexpr size_t HID_ROWS = (size_t)TA * 9 + 256;
constexpr size_t R2_BYTES = HID_ROWS * FF * 2;
constexpr size_t R2_OB = (size_t)TA * D * 2;
constexpr size_t WS_R1 = WS_R2 + R2_BYTES;
constexpr size_t R1_O = (size_t)TA * ZS * 2;
constexpr size_t R1_BYTES = R1_O + (size_t)TA * OS * 2;
constexpr size_t R1_H2 = R1_O;
constexpr size_t WS_WBS1 = WS_R1 + R1_BYTES;
constexpr size_t WS_DECB = WS_WBS1 + WB_WD;
constexpr size_t WS_W2TG = WS_DECB + (size_t)NB * 4 * 2 * 36 * 128 * 4;
constexpr size_t WS_W8L0 = (WS_W2TG + (size_t)2 * 2 * 512 * 16 * 2 + 255) & ~(size_t)255;
constexpr size_t WS_NATAB = (WS_W8L0 + (size_t)ZS * D + 255) & ~(size_t)255;
constexpr size_t WS_END = WS_NATAB + (size_t)2 * 4096 * 4;
static_assert(HID_ROWS * D * 2 <= R1_O + 0, "out_slot must fit below H2");
static_assert((size_t)NEX * 512 * D * 2 <= R1_O, "WguT fits");

constexpr int LDS_BYTES = 147456, MISC_OFF = 143360;
constexpr int GRID = 256;

#define XB_TMO      128
#define XB_XCNT(j)  (256  + 64 * (j))
#define XB_XSUB(j)  (1280 + 64 * (j))
#define XB_XGEN(j)  (2304 + 64 * (j))
#define XB_TOP      3328
#define XB_TOPGEN   3392
#define XCD_BAR_WORDS 3456
#define XB_SPIN_CAP (1u << 22)
DI unsigned xb_ld(unsigned* p)              { return __hip_atomic_load(p, __ATOMIC_RELAXED, __HIP_MEMORY_SCOPE_AGENT); }
DI unsigned xb_add(unsigned* p, unsigned v) { return __hip_atomic_fetch_add(p, v, __ATOMIC_RELAXED, __HIP_MEMORY_SCOPE_AGENT); }
DI unsigned xb_xcc_id() { return (unsigned)__builtin_amdgcn_s_getreg((3 << 11) | 20) & 0xFu; }
#define XB_SPIN(cond, bar) do { unsigned _sp = 0; while (cond) { __builtin_amdgcn_s_sleep(1); \
    if ((++_sp & 255u) == 0u) { if (xb_ld(&(bar)[XB_TMO])) break; if (_sp > XB_SPIN_CAP) { atomicAdd(&(bar)[XB_TMO], 1u); break; } } } } while (0)
struct XcdBarrier { unsigned* bar; unsigned x; volatile LAS unsigned* st; };
DI XcdBarrier xcd_barrier_post(unsigned* bar, volatile LAS unsigned* st) {
    XcdBarrier b; b.bar = bar; b.x = xb_xcc_id(); b.st = st;
    if (threadIdx.x == 0) (void)xb_add(&bar[XB_XCNT(b.x)], 1u);
    return b;
}
DI void xcd_barrier_complete(unsigned* bar, unsigned x, unsigned& nloc, unsigned& nx) {
    const unsigned G = gridDim.x * gridDim.y * gridDim.z;
    unsigned sum, cnt, mine, sp = 0u;
    for (;;) {
        sum = 0u; cnt = 0u; mine = 0u;
#pragma unroll
        for (unsigned j = 0; j < 16; ++j) { const unsigned c = xb_ld(&bar[XB_XCNT(j)]); sum += c; cnt += (c > 0u) ? 1u : 0u; mine = (j == x) ? c : mine; }
        if (sum == G) break;
        __builtin_amdgcn_s_sleep(1);
        if ((++sp & 255u) == 0u) { if (xb_ld(&bar[XB_TMO])) break; if (sp > XB_SPIN_CAP) { atomicAdd(&bar[XB_TMO], 1u); break; } }
    }
    nloc = mine > 0u ? mine : 1u; nx = cnt > 0u ? cnt : 1u;
}
DI int lane_id_() { int ln; asm volatile("v_mbcnt_lo_u32_b32 %0, -1, 0\n\tv_mbcnt_hi_u32_b32 %0, -1, %0" : "=v"(ln)); return ln; }
DI void xcd_barrier(const XcdBarrier& b, int wave) {
    asm volatile("s_waitcnt vmcnt(0)" ::: "memory");
    __syncthreads();
    if (wave == 0 && lane_id_() == 0) {
        unsigned* bar = b.bar;
        __builtin_amdgcn_s_waitcnt(0);
        const unsigned bx = xb_xcc_id();
        unsigned nloc = b.st[0], nx = b.st[1];
        if (nloc == 0u) { xcd_barrier_complete(bar, bx, nloc, nx); b.st[0] = nloc; b.st[1] = nx; }
        const unsigned old = xb_add(&bar[XB_XSUB(bx)], 1u);
        const unsigned gen = old / nloc;
        if (old + 1u == (gen + 1u) * nloc) {
            __builtin_amdgcn_fence(__ATOMIC_RELEASE, "agent");
            asm volatile("s_waitcnt vmcnt(0)" ::: "memory");
            const unsigned og = xb_add(&bar[XB_TOP], 1u);
            const unsigned tg = og / nx;
            if (og + 1u == (tg + 1u) * nx) xb_add(&bar[XB_TOPGEN], 1u);
            else XB_SPIN(xb_ld(&bar[XB_TOPGEN]) == tg, bar);
            __builtin_amdgcn_fence(__ATOMIC_ACQUIRE, "agent");
            xb_add(&bar[XB_XGEN(bx)], 1u);
            asm volatile("s_waitcnt vmcnt(0)" ::: "memory");
        } else {
            XB_SPIN(xb_ld(&bar[XB_XGEN(bx)]) == gen, bar);
            __builtin_amdgcn_fence(__ATOMIC_ACQUIRE, "agent");
            asm volatile("s_waitcnt vmcnt(0)" ::: "memory");
        }
    }
    __syncthreads();
}

typedef int i32x4 __attribute__((ext_vector_type(4)));
typedef int i32x8 __attribute__((ext_vector_type(8)));
namespace pg8 {
constexpr int BM = 256, BK = 64, HALF = 128, HTB = HALF * BK * 2, STAGE_BYTES = 8 * HTB;
DI int lds_byte(int r, int c) { const int st = (r >> 4) * 2 + (c >> 5), rr = r & 15, cc = c & 31, ob = rr * 64 + cc * 2; return st * 1024 + (ob ^ (((ob >> 9) & 1) << 5)); }
DI void stage_rc(int b, int& R, int& C) { const int st = b / 1024, sb = b % 1024, swz = sb ^ (((sb >> 9) & 1) << 5); R = (st >> 1) * 16 + swz / 64; C = (st & 1) * 32 + (swz % 64) / 2; }
DI int perm32(int rho) { const int n = rho >> 4, i = rho & 15; return 8 * (i >> 2) + 4 * n + (i & 3); }

struct GUnit {
    const char* A;
    const char* B;
    const int* rows;
    int pm, pn;
    int valid;
    int aux;
};

template <bool GATHER, class Epi, class Sched>
DI void gemm_phase(LAS unsigned char* lds, const int tid_, const int K_, const int lda, const int ldb, const Sched& S, const Epi& E) {
    int K = K_; asm volatile("" : "+s"(K));
    int tid = tid_; asm volatile("" : "+v"(tid));
    const int wid = __builtin_amdgcn_readfirstlane(tid >> 6), lane = tid & 63, wr = wid >> 2, wc = wid & 3, fr = lane & 15, fq = lane >> 4;
    const int nt = K / BK;
    unsigned voffA, voffB, cc2, ro;
    { int R, C; stage_rc(tid * 16, R, C); ro = (unsigned)R * 4u; cc2 = (unsigned)C * 2u; const int Rb = Epi::PERM ? ((R & ~31) + perm32(R & 31)) : R;
      voffA = (unsigned)(R * lda + C) * 2u; voffB = (unsigned)(Rb * ldb + C) * 2u; }
    const size_t hstepA = (size_t)HALF * lda * 2, qstepA = (size_t)64 * lda * 2, qstepB = (size_t)64 * ldb * 2;
    const unsigned rowb = (unsigned)lda * 2u;
    const size_t kstep = (size_t)(BK * 2);
    const size_t hstepB = (size_t)HALF * ldb * 2;
    const unsigned ldsw = (unsigned)wid * 1024u;
    const int aoff = lds_byte(wr * 64 + fr, fq * 8), boff = lds_byte(wc * 32 + fr, fq * 8);
#define PG8_SA(b, h) (((b) * 2 + (h)) * HTB)
#define PG8_SB(b, h) ((4 + (b) * 2 + (h)) * HTB)
#define PG8_STAGE2(bufoff, gbase, o0, o1) do { \
        __builtin_amdgcn_global_load_lds((const unsigned*)((const char*)(gbase) + (o0)), (LAS unsigned*)(lds + (bufoff) + ldsw), 16, 0, 0); \
        __builtin_amdgcn_global_load_lds((const unsigned*)((const char*)(gbase) + (o1)), (LAS unsigned*)(lds + (bufoff) + ldsw + 8192), 16, 0, 0); } while (0)
#define PG8_STAGEB(bufoff, gbase) do { unsigned _vo = voffB; asm volatile("" : "+v"(_vo));     \
        __builtin_amdgcn_global_load_lds((const unsigned*)((const char*)(gbase) + _vo), (LAS unsigned*)(lds + (bufoff) + ldsw), 16, 0, 0); \
        __builtin_amdgcn_global_load_lds((const unsigned*)((const char*)(gbase) + qstepB + _vo), (LAS unsigned*)(lds + (bufoff) + ldsw + 8192), 16, 0, 0); } while (0)
#define PG8_CAT8(p_) __builtin_shufflevector(*(const LAS i32x4*)(p_), *(const LAS i32x4*)((p_) + 1024), 0, 1, 2, 3, 4, 5, 6, 7)
#define PG8_LDA(dst, b, h) do { if constexpr (Epi::FP8) { _Pragma("unroll") for (int m = 0; m < 4; ++m) dst##8[m] = PG8_CAT8(lds + PG8_SA(b, h) + aoff + m * 2048); } \
        else { _Pragma("unroll") for (int m = 0; m < 4; ++m) _Pragma("unroll") for (int k = 0; k < 2; ++k) dst[m][k] = *(const LAS bf16x8*)(lds + PG8_SA(b, h) + aoff + m * 2048 + k * 1024); } } while (0)
#define PG8_LDB(dst, b, h) do { if constexpr (Epi::FP8) { _Pragma("unroll") for (int n = 0; n < 2; ++n) dst##8[n] = PG8_CAT8(lds + PG8_SB(b, h) + boff + n * 2048); } \
        else { _Pragma("unroll") for (int n = 0; n < 2; ++n) _Pragma("unroll") for (int k = 0; k < 2; ++k) dst[n][k] = *(const LAS bf16x8*)(lds + PG8_SB(b, h) + boff + n * 2048 + k * 1024); } } while (0)
#define PG8_MMA(ai, bj, At, Bt) do { __builtin_amdgcn_s_setprio(1); _Pragma("unroll") for (int m = 0; m < 4; ++m) _Pragma("unroll") for (int n = 0; n < 2; ++n) { \
        if constexpr (Epi::FP8) acc[ai][bj][m][n] = __builtin_amdgcn_mfma_scale_f32_16x16x128_f8f6f4(Bt##8[n], At##8[m], acc[ai][bj][m][n], 0, 0, 0, 0, 0, 0); \
        else { _Pragma("unroll") for (int k = 0; k < 2; ++k) acc[ai][bj][m][n] = __builtin_amdgcn_mfma_f32_16x16x32_bf16(Bt[n][k], At[m][k], acc[ai][bj][m][n], 0, 0, 0); } } \
        __builtin_amdgcn_s_setprio(0); } while (0)
#define PG8_WAIT_V(n) asm volatile("s_waitcnt vmcnt(" #n ")" ::: "memory")
#define PG8_WAIT_L(n) asm volatile("s_waitcnt lgkmcnt(" #n ")" ::: "memory")
#define PG8_BAR __builtin_amdgcn_s_barrier()
#define PG8_SCHED __builtin_amdgcn_sched_barrier(0)
#define PG8_CL(x_) (((x_) < (unsigned)(TA - 1)) ? (x_) : (unsigned)(TA - 1))
#define PG8_RIDX(u, p0, p1) do { if (GATHER) { const char* _rb = (const char*)(u).rows; \
        p0 = PG8_CL(*(const unsigned*)(_rb + ro)) | (PG8_CL(*(const unsigned*)(_rb + ro + HALF * 4)) << 16); p1 = PG8_CL(*(const unsigned*)(_rb + ro + 64 * 4)) | (PG8_CL(*(const unsigned*)(_rb + ro + (64 + HALF) * 4)) << 16); } } while (0)
#define PG8_STAGEA(bufoff, gbase, h, p0, p1) do { if (GATHER) { const unsigned _o0 = (((p0) >> (16 * (h))) & 0xffffu) * rowb + cc2, _o1 = (((p1) >> (16 * (h))) & 0xffffu) * rowb + cc2; PG8_STAGE2(bufoff, gbase, _o0, _o1); } \
        else { unsigned _va = voffA; asm volatile("" : "+v"(_va)); \
               __builtin_amdgcn_global_load_lds((const unsigned*)((const char*)(gbase) + (h) * hstepA + _va), (LAS unsigned*)(lds + (bufoff) + ldsw), 16, 0, 0); \
               __builtin_amdgcn_global_load_lds((const unsigned*)((const char*)(gbase) + (h) * hstepA + qstepA + _va), (LAS unsigned*)(lds + (bufoff) + ldsw + 8192), 16, 0, 0); } } while (0)
    GUnit cur, nxt; int ui = 0;
    if (!S.next(0, cur)) return;
    f32x4 acc[2][2][4][2];
#pragma unroll
    for (int a = 0; a < 2; ++a)
#pragma unroll
        for (int b = 0; b < 2; ++b)
#pragma unroll
            for (int m = 0; m < 4; ++m)
#pragma unroll
                for (int n = 0; n < 2; ++n) acc[a][b][m][n] = (f32x4){0.f, 0.f, 0.f, 0.f};
    bf16x8 At[4][2], B0[2][2], B1[2][2];
    i32x8 At8[4], B08[2], B18[2];
    const char* cA = cur.A; const char* cB = cur.B;
    unsigned cp0 = 0u, cp1 = 0u; PG8_RIDX(cur, cp0, cp1);
#if PG8_SP2
    PG8_STAGEB(PG8_SB(0, 0), cB); PG8_STAGEB(PG8_SB(0, 1), cB + hstepB); PG8_STAGEA(PG8_SA(0, 0), cA, 0, cp0, cp1); PG8_STAGEA(PG8_SA(0, 1), cA, 1, cp0, cp1);
    if (wr == 1) PG8_BAR;
    PG8_WAIT_V(2); PG8_BAR;
    PG8_STAGEB(PG8_SB(1, 0), cB + kstep); PG8_STAGEA(PG8_SA(1, 0), cA + kstep, 0, cp0, cp1); PG8_STAGEB(PG8_SB(1, 1), cB + hstepB + kstep);
    PG8_WAIT_V(6); PG8_BAR;
#else
    PG8_STAGEB(PG8_SB(0, 0), cB); PG8_STAGEA(PG8_SA(0, 0), cA, 0, cp0, cp1); PG8_STAGEB(PG8_SB(0, 1), cB + hstepB); PG8_STAGEA(PG8_SA(0, 1), cA, 1, cp0, cp1);
    if (wr == 1) PG8_BAR;
    PG8_WAIT_V(4); PG8_BAR;
    PG8_STAGEB(PG8_SB(1, 0), cB + kstep); PG8_STAGEA(PG8_SA(1, 0), cA + kstep, 0, cp0, cp1); PG8_STAGEB(PG8_SB(1, 1), cB + hstepB + kstep);
    PG8_WAIT_V(6); PG8_BAR;
#endif
    int epi_flag = 0; asm volatile("" : "+s"(epi_flag));
    for (;;) {
        const bool has_next = S.next(ui + 1, nxt);
        const char* nA = has_next ? nxt.A : cA; const char* nB = has_next ? nxt.B : cB;
        unsigned np0 = cp0, np1 = cp1;
        if (has_next) PG8_RIDX(nxt, np0, np1);
        for (int t = 0; t < nt; t += 2) {
            const bool last = (t == nt - 2);
            const char* a1 = cA + (size_t)(t + 1) * kstep;
            const char* a2 = last ? nA : cA + (size_t)(t + 2) * kstep; const char* b2 = last ? nB : cB + (size_t)(t + 2) * kstep;
            const char* a3 = a2 + kstep; const char* b3 = b2 + kstep;
            unsigned xp0 = cp0, xp1 = cp1;
            if (GATHER && last) { asm volatile("" : "+v"(np0), "+v"(np1)); xp0 = np0; xp1 = np1; }
#if PG8_SP2
            const bool after_epi = (Epi::NSTORE > 0) && (epi_flag != 0);
            PG8_LDB(B0, 0, 0); PG8_LDB(B1, 0, 1); PG8_SCHED; PG8_LDA(At, 0, 0); PG8_STAGEA(PG8_SA(1, 1), a1, 1, cp0, cp1);
            if (after_epi) { if constexpr (Epi::NSTORE == 16) PG8_WAIT_V(24); else if constexpr (Epi::NSTORE == 8) PG8_WAIT_V(16); else PG8_WAIT_V(8); } else PG8_WAIT_V(8);
            PG8_WAIT_L(0); PG8_BAR; PG8_MMA(0, 0, At, B0); PG8_MMA(0, 1, At, B1); PG8_BAR; PG8_SCHED;
            PG8_LDA(At, 0, 1); PG8_STAGEB(PG8_SB(0, 0), b2); PG8_STAGEB(PG8_SB(0, 1), b2 + hstepB); PG8_STAGEA(PG8_SA(0, 0), a2, 0, xp0, xp1);
            if (after_epi) { if constexpr (Epi::NSTORE == 16) PG8_WAIT_V(24); else if constexpr (Epi::NSTORE == 8) PG8_WAIT_V(16); else PG8_WAIT_V(8); } else PG8_WAIT_V(8);
            PG8_WAIT_L(0); PG8_BAR; PG8_MMA(1, 0, At, B0); PG8_MMA(1, 1, At, B1); PG8_BAR; PG8_SCHED;
            PG8_LDB(B0, 1, 0); PG8_LDB(B1, 1, 1); PG8_SCHED; PG8_LDA(At, 1, 0); PG8_STAGEA(PG8_SA(0, 1), a2, 1, xp0, xp1);
            PG8_WAIT_V(8); PG8_WAIT_L(0); PG8_BAR; PG8_MMA(0, 0, At, B0); PG8_MMA(0, 1, At, B1); PG8_BAR; PG8_SCHED;
            PG8_LDA(At, 1, 1); PG8_STAGEB(PG8_SB(1, 0), b3); PG8_STAGEB(PG8_SB(1, 1), b3 + hstepB); PG8_STAGEA(PG8_SA(1, 0), a3, 0, xp0, xp1);
            PG8_WAIT_V(8); PG8_WAIT_L(0); PG8_BAR; PG8_MMA(1, 0, At, B0); PG8_MMA(1, 1, At, B1); PG8_BAR; PG8_SCHED;
            if (Epi::NSTORE > 0) { epi_flag = 0; asm volatile("" : "+s"(epi_flag)); }
#else
            PG8_LDB(B0, 0, 0); PG8_SCHED; PG8_LDA(At, 0, 0); PG8_STAGEA(PG8_SA(1, 1), a1, 1, cp0, cp1);
            PG8_WAIT_L(8); PG8_BAR; PG8_WAIT_L(0); PG8_MMA(0, 0, At, B0); PG8_BAR; PG8_SCHED;
            PG8_LDB(B1, 0, 1); PG8_STAGEB(PG8_SB(0, 0), b2);
            PG8_BAR; PG8_WAIT_L(0); PG8_MMA(0, 1, At, B1); PG8_BAR;
            PG8_LDA(At, 0, 1); PG8_STAGEA(PG8_SA(0, 0), a2, 0, xp0, xp1);
            PG8_BAR; PG8_WAIT_L(0); PG8_MMA(1, 0, At, B0); PG8_BAR; PG8_SCHED;
            PG8_STAGEB(PG8_SB(0, 1), b2 + hstepB);
            PG8_WAIT_V(6); PG8_BAR; PG8_MMA(1, 1, At, B1); PG8_BAR;
            PG8_LDB(B0, 1, 0); PG8_SCHED; PG8_LDA(At, 1, 0); PG8_STAGEA(PG8_SA(0, 1), a2, 1, xp0, xp1);
            PG8_WAIT_L(8); PG8_BAR; PG8_WAIT_L(0); PG8_MMA(0, 0, At, B0); PG8_BAR; PG8_SCHED;
            PG8_LDB(B1, 1, 1); PG8_STAGEB(PG8_SB(1, 0), b3);
            PG8_BAR; PG8_WAIT_L(0); PG8_MMA(0, 1, At, B1); PG8_BAR;
            PG8_LDA(At, 1, 1); PG8_STAGEA(PG8_SA(1, 0), a3, 0, xp0, xp1);
            PG8_BAR; PG8_WAIT_L(0); PG8_MMA(1, 0, At, B0); PG8_BAR; PG8_SCHED;
            PG8_STAGEB(PG8_SB(1, 1), b3 + hstepB);
            PG8_WAIT_V(6); PG8_BAR; PG8_MMA(1, 1, At, B1); PG8_BAR;
        #endif
        }
#if PG8_ALIGN
        if (wr == 0) PG8_BAR;
#endif
        E(acc, cur, wr, wc, fr, fq);
        if (!has_next) break;
#pragma unroll
        for (int a = 0; a < 2; ++a)
#pragma unroll
            for (int b = 0; b < 2; ++b)
#pragma unroll
                for (int m = 0; m < 4; ++m)
#pragma unroll
                    for (int n = 0; n < 2; ++n) acc[a][b][m][n] = (f32x4){0.f, 0.f, 0.f, 0.f};
        cur = nxt; cA = nA; cB = nB; cp0 = np0; cp1 = np1; ++ui;
        if (Epi::NSTORE > 0) { epi_flag = 1; asm volatile("" : "+s"(epi_flag)); }
#if PG8_ALIGN
        if (wr == 1) PG8_BAR;
#endif
    }
    PG8_WAIT_V(0);
#if !PG8_ALIGN
    if (wr == 0) PG8_BAR;
#endif
    PG8_BAR;
#undef PG8_SA
#undef PG8_SB
#undef PG8_STAGE2
#undef PG8_STAGEB
#undef PG8_LDA
#undef PG8_CAT8
#undef PG8_LDB
#undef PG8_MMA
#undef PG8_WAIT_V
#undef PG8_WAIT_L
#undef PG8_BAR
#undef PG8_SCHED
#undef PG8_RIDX
#undef PG8_CL
#undef PG8_STAGEA
}

template <bool F8> struct EpiStoreBf16T {
    static constexpr bool PERM = true; static constexpr int NSTORE = 16; static constexpr bool FP8 = F8;
    bf16_t* O; int ldc; float scl;
    DI void operator()(const f32x4 (&acc)[2][2][4][2], const GUnit& u, int wr, int wc, int fr, int fq) const {
        const int row0 = u.pm * BM + wr * 64 + fr, col0 = u.pn * BM + wc * 32 + 8 * fq;
#pragma unroll
        for (int ai = 0; ai < 2; ++ai)
#pragma unroll
            for (int m = 0; m < 4; ++m) { bf16_t* rowp = O + (size_t)(row0 + ai * HALF + m * 16) * ldc + col0;
#pragma unroll
                for (int bj = 0; bj < 2; ++bj) { const f32x4 v0 = acc[ai][bj][m][0] * scl, v1 = acc[ai][bj][m][1] * scl;
                    u32x4 w; w.x = pk2(v0[0], v0[1]); w.y = pk2(v0[2], v0[3]); w.z = pk2(v1[0], v1[1]); w.w = pk2(v1[2], v1[3]);
                    *(u32x4*)(rowp + bj * HALF) = w; } }
    }
};
template <int MODE, bool F8 = false> struct EpiGate {
    static constexpr bool PERM = true; static constexpr int NSTORE = 0; static constexpr bool FP8 = F8;
    bf16_t* Y; const bf16_t* Zg; int gcol0; float scl = 1.0f;
    unsigned* flg = nullptr; int wbase = -1, sbase = -1;
    DI void operator()(const f32x4 (&acc)[2][2][4][2], const GUnit& u, int wr, int wc, int fr, int fq) const {
        const int row0 = u.pm * BM + wr * 64 + fr, col0 = u.pn * BM + wc * 32 + 8 * fq;
        const bool lead = (wr == 0) && (wc == 0) && (fr == 0) && (fq == 0);
        if (u.aux != 0 && wbase >= 0) {
            if (lead) { unsigned* f = flg + 64 * (wbase + u.aux - 1); unsigned sp = 0;
                while (__hip_atomic_load(f, __ATOMIC_RELAXED, __HIP_MEMORY_SCOPE_AGENT) == 0u) { __builtin_amdgcn_s_sleep(2); if (++sp > (1u << 22)) break; }
                __builtin_amdgcn_fence(__ATOMIC_ACQUIRE, "agent"); asm volatile("s_waitcnt vmcnt(0)" ::: "memory"); }
            __syncthreads();
        }
#pragma unroll
        for (int ai = 0; ai < 2; ++ai) {
            u32x4 g[4][2], o[4][2];
#pragma unroll
            for (int m = 0; m < 4; ++m) { const size_t row = (size_t)(row0 + ai * HALF + m * 16);
#pragma unroll
                for (int bj = 0; bj < 2; ++bj) { g[m][bj] = *(const u32x4*)(Zg + row * ZS + gcol0 + col0 + bj * HALF); if (MODE == 1) o[m][bj] = *(const u32x4*)(Y + row * D + col0 + bj * HALF); } }
#pragma unroll
            for (int m = 0; m < 4; ++m) { const size_t row = (size_t)(row0 + ai * HALF + m * 16); bf16_t* rowp = Y + row * D + col0;
#pragma unroll
                for (int bj = 0; bj < 2; ++bj) { f32x4 v0 = acc[ai][bj][m][0], v1 = acc[ai][bj][m][1]; const u32x4 gg = g[m][bj];
                    if (F8) { v0 *= scl; v1 *= scl; }
                    float r[8];
                    r[0] = v0[0] * sigmoidf_(bf_lo(gg.x)); r[1] = v0[1] * sigmoidf_(bf_hi(gg.x)); r[2] = v0[2] * sigmoidf_(bf_lo(gg.y)); r[3] = v0[3] * sigmoidf_(bf_hi(gg.y));
                    r[4] = v1[0] * sigmoidf_(bf_lo(gg.z)); r[5] = v1[1] * sigmoidf_(bf_hi(gg.z)); r[6] = v1[2] * sigmoidf_(bf_lo(gg.w)); r[7] = v1[3] * sigmoidf_(bf_hi(gg.w));
                    if (MODE == 1) { const u32x4 oo = o[m][bj];
                        r[0] += bf_lo(oo.x); r[1] += bf_hi(oo.x); r[2] += bf_lo(oo.y); r[3] += bf_hi(oo.y); r[4] += bf_lo(oo.z); r[5] += bf_hi(oo.z); r[6] += bf_lo(oo.w); r[7] += bf_hi(oo.w); }
                    u32x4 w; w.x = pk2(r[0], r[1]); w.y = pk2(r[2], r[3]); w.z = pk2(r[4], r[5]); w.w = pk2(r[6], r[7]);
                    *(u32x4*)(rowp + bj * HALF) = w; } }
        }
        if (u.aux != 0 && sbase >= 0) {
            asm volatile("s_waitcnt vmcnt(0)" ::: "memory");
            __syncthreads();
            if (lead) { __builtin_amdgcn_fence(__ATOMIC_RELEASE, "agent"); asm volatile("s_waitcnt vmcnt(0)" ::: "memory");
                __hip_atomic_store(flg + 64 * (sbase + u.aux - 1), 1u, __ATOMIC_RELAXED, __HIP_MEMORY_SCOPE_AGENT); }
        }
    }
};
struct EpiResid {
    static constexpr bool PERM = false; static constexpr int NSTORE = 0; static constexpr bool FP8 = false;
    const float* xsrc; float* xdst; const float* csrc; float* cdst; const float* gate;
    DI void operator()(const f32x4 (&acc)[2][2][4][2], const GUnit& u, int wr, int wc, int fr, int fq) const {
        const int row0 = u.pm * BM + wr * 64 + fr, col0 = u.pn * BM + wc * 32 + 4 * fq;
        const bool isctx = (u.pm * BM) >= TL;
        const int mrow = isctx ? 8 : (u.pm * BM) / SEQ;
        const float* gp = gate + (size_t)mrow * 6144 + col0;
        f32x4 gv[2][2];
#pragma unroll
        for (int bj = 0; bj < 2; ++bj)
#pragma unroll
            for (int n = 0; n < 2; ++n) gv[bj][n] = *(const f32x4*)(gp + bj * HALF + n * 16);
        const float* sb = isctx ? csrc - (size_t)TL * D : xsrc; float* db = isctx ? cdst - (size_t)TL * D : xdst;
#pragma unroll
        for (int ai = 0; ai < 2; ++ai) {
            f32x4 s[4][2][2];
#pragma unroll
            for (int m = 0; m < 4; ++m) { const size_t off = (size_t)(row0 + ai * HALF + m * 16) * D + col0;
#pragma unroll
                for (int bj = 0; bj < 2; ++bj)
#pragma unroll
                    for (int n = 0; n < 2; ++n) s[m][bj][n] = *(const f32x4*)(sb + off + bj * HALF + n * 16); }
#pragma unroll
            for (int m = 0; m < 4; ++m) { const size_t off = (size_t)(row0 + ai * HALF + m * 16) * D + col0;
#pragma unroll
                for (int bj = 0; bj < 2; ++bj)
#pragma unroll
                    for (int n = 0; n < 2; ++n) *(f32x4*)(db + off + bj * HALF + n * 16) = s[m][bj][n] + gv[bj][n] * acc[ai][bj][m][n]; }
        }
    }
};
struct EpiSwiGLU {
    static constexpr bool PERM = true; static constexpr int NSTORE = 0; static constexpr bool FP8 = false;
    bf16_t* Hd;
    DI void operator()(const f32x4 (&acc)[2][2][4][2], const GUnit& u, int wr, int wc, int fr, int fq) const {
        const int r0 = wr * 64 + fr, col0 = u.pn * HALF + wc * 32 + 8 * fq;
#pragma unroll
        for (int ai = 0; ai < 2; ++ai)
#pragma unroll
            for (int m = 0; m < 4; ++m) { const int r = r0 + ai * HALF + m * 16;
                const f32x4 g0 = acc[ai][0][m][0], g1 = acc[ai][0][m][1], u0 = acc[ai][1][m][0], u1 = acc[ai][1][m][1];
                u32x4 w; w.x = pk2(siluf_(g0[0]) * u0[0], siluf_(g0[1]) * u0[1]); w.y = pk2(siluf_(g0[2]) * u0[2], siluf_(g0[3]) * u0[3]);
                w.z = pk2(siluf_(g1[0]) * u1[0], siluf_(g1[1]) * u1[1]); w.w = pk2(siluf_(g1[2]) * u1[2], siluf_(g1[3]) * u1[3]);
                if (r < u.valid) *(u32x4*)(Hd + (size_t)(u.aux + r) * FF + col0) = w; }
    }
};
DI unsigned pk4_fp8(float a, float b, float c, float d) { int p = 0; p = __builtin_amdgcn_cvt_pk_fp8_f32(a, b, p, false); p = __builtin_amdgcn_cvt_pk_fp8_f32(c, d, p, true); return (unsigned)p; }
DI float clamp448(float v) { return __builtin_amdgcn_fmed3f(v, -448.0f, 448.0f); }
DI unsigned pk4_fp8c(float a, float b, float c, float d) { return pk4_fp8(clamp448(a), clamp448(b), clamp448(c), clamp448(d)); }
struct EpiDown {
    static constexpr bool PERM = true; static constexpr int NSTORE = 0; static constexpr bool FP8 = false;
    unsigned char* Os; int rmask;
    DI void operator()(const f32x4 (&acc)[2][2][4][2], const GUnit& u, int wr, int wc, int fr, int fq) const {
        const int r0 = wr * 64 + fr, col0 = u.pn * BM + wc * 32 + 8 * fq;
#pragma unroll
        for (int ai = 0; ai < 2; ++ai)
#pragma unroll
            for (int m = 0; m < 4; ++m) { const int r = r0 + ai * HALF + m * 16; unsigned char* rowp = Os + (size_t)((u.aux + r) & rmask) * D + col0;
#pragma unroll
                for (int bj = 0; bj < 2; ++bj) { const f32x4 v0 = acc[ai][bj][m][0], v1 = acc[ai][bj][m][1];
                    u32x2 w; w.x = pk4_fp8(v0[0], v0[1], v0[2], v0[3]); w.y = pk4_fp8(v1[0], v1[1], v1[2], v1[3]);
                    if (r < u.valid) *(u32x2*)(rowp + bj * HALF) = w; } }
    }
};

template <int nN> struct RectSched {
    const char* A; const char* B; int lda, ldb; int nM, exM, exN, exPm0, G, c;
    int skip_from = 1 << 30, skip_n = 0;
    int r2shift = -1;
    DI bool next(int i, GUnit& u) const {
        const int nmain = nM * nN;
        int L = i * G + c, tag = 0;
        if (r2shift >= 0 && i >= 1) { const int c2 = c - r2shift; if (i > 1 || c2 < 0 || c2 >= nmain - G) return false; L = G + c2; tag = 1 + c2; }
        int pm, pn;
        if (L < nmain) { const int W = (L & 7) * (nmain >> 3) + (L >> 3);
            const int grp = W / (8 * nN), rem = W % (8 * nN); pm = grp * 8 + (rem & 7); pn = rem >> 3; }
        else { const int L2 = L - nmain; if (L2 >= exM * exN) return false; pm = exPm0 + (L2 & 7); pn = L2 >> 3; }
        if (pn >= skip_from) pn += skip_n;
        u.A = A + (size_t)pm * BM * lda * 2; u.B = B + (size_t)pn * BM * ldb * 2; u.rows = nullptr; u.pm = pm; u.pn = pn; u.valid = BM; u.aux = tag; return true;
    }
};
struct RectSchedR {
    const char* A; const char* B; int lda, ldb; int nM, exM, exN, exPm0, G, c; int nN, skip_from, skip_n;
    DI bool next(int i, GUnit& u) const {
        const int L = i * G + c; const int nmain = nM * nN;
        int pm, pn;
        if (L < nmain) { const int W = (L & 7) * (nmain >> 3) + (L >> 3);
            const int grp = W / (8 * nN), rem = W - grp * (8 * nN); pm = grp * 8 + (rem & 7); pn = rem >> 3; }
        else { const int L2 = L - nmain; if (L2 >= exM * exN) return false; pm = exPm0 + (L2 & 7); pn = L2 >> 3; }
        if (pn >= skip_from) pn += skip_n;
        u.A = A + (size_t)pm * BM * lda * 2; u.B = B + (size_t)pn * BM * ldb * 2; u.rows = nullptr; u.pm = pm; u.pn = pn; u.valid = BM; u.aux = 0; return true;
    }
};
template <bool GATHER, int npn> struct MoeSched {
    const LAS int* tb; const LAS int* rb; const LAS int* cn;
    const char* A; const int* rowl; const char* B; size_t bstride; int lda, ldb, G, c;
    DI bool next(int i, GUnit& u) const {
        const int L0 = i * G + c; const int ntile = __builtin_amdgcn_readfirstlane(tb[NEX]); const int nwg = ntile * npn;
        if (L0 >= nwg) return false;
        const int q = nwg >> 3, rr = nwg & 7, xcd = L0 & 7, off = L0 >> 3;
        const int L = (xcd < rr ? xcd * (q + 1) : rr * (q + 1) + (xcd - rr) * q) + off;
        const int T = L / npn, pn = L % npn;
        const int e = __builtin_amdgcn_readfirstlane((int)((const LAS unsigned char*)(tb + 216))[T]);
        const int ti = T - __builtin_amdgcn_readfirstlane(tb[e]), row0 = __builtin_amdgcn_readfirstlane(rb[e]) + ti * BM;
        u.B = B + (size_t)e * bstride + (size_t)pn * BM * ldb * 2;
        if (GATHER) { u.A = A; u.rows = rowl + e * RCAP + ti * BM; } else { u.A = A + (size_t)row0 * lda * 2; u.rows = nullptr; }
        u.pm = T; u.pn = pn; const int rem = __builtin_amdgcn_readfirstlane(cn[e]) - ti * BM; u.valid = rem < BM ? rem : BM; u.aux = row0; return true;
    }
};
}

struct Args { const float* in[N_INPUTS]; float* out; unsigned char* ws; int ph_lo, ph_hi; };
struct Frame {
    LAS unsigned char* lds; unsigned char* ws; const float* const* in; float* out;
    int tid, lane, wave, G, bid;
};
DI const float* modp(const Frame& F, int l, int r, int which) { return (const float*)(F.ws + WS_MOD) + ((size_t)(l * 9 + r) * 6 + which) * 1024; }

struct TrIt { const float* src; bf16_t* dst; };
DI void tr_load(float (&v)[32], const float* src, int ldw, int lane) {
#pragma unroll
    for (int i = 0; i < 32; ++i) v[i] = src[(size_t)(2 * i + (lane >> 5)) * ldw + (lane & 31)];
}
DI void tr_store(const float (&v)[32], bf16_t* dst, int ldt, LAS float* scr, int lane) {
#pragma unroll
    for (int i = 0; i < 32; ++i) scr[(2 * i + (lane >> 5)) * 33 + (lane & 31)] = v[i];
    asm volatile("s_waitcnt lgkmcnt(0)" ::: "memory");
    const int c = lane & 7;
#pragma unroll
    for (int j = 0; j < 4; ++j) { const int n = (lane >> 3) + 8 * j; const LAS float* s = scr + (8 * c) * 33 + n;
        u32x4 o; o.x = pk2(s[0 * 33], s[1 * 33]); o.y = pk2(s[2 * 33], s[3 * 33]); o.z = pk2(s[4 * 33], s[5 * 33]); o.w = pk2(s[6 * 33], s[7 * 33]);
        *(u32x4*)(dst + (size_t)n * ldt + 8 * c) = o; }
    asm volatile("s_waitcnt lgkmcnt(0)" ::: "memory");
}
DI void tr_store_f8(const float (&v)[32], unsigned char* dst, int ldt, LAS float* scr, int lane) {
#pragma unroll
    for (int i = 0; i < 32; ++i) scr[(2 * i + (lane >> 5)) * 33 + (lane & 31)] = v[i];
    asm volatile("s_waitcnt lgkmcnt(0)" ::: "memory");
    const int c = lane & 7;
#pragma unroll
    for (int j = 0; j < 4; ++j) { const int n = (lane >> 3) + 8 * j; const LAS float* s = scr + (8 * c) * 33 + n;
        u32x2 o; o.x = pg8::pk4_fp8c(s[0 * 33] * W8_SCALE, s[1 * 33] * W8_SCALE, s[2 * 33] * W8_SCALE, s[3 * 33] * W8_SCALE); o.y = pg8::pk4_fp8c(s[4 * 33] * W8_SCALE, s[5 * 33] * W8_SCALE, s[6 * 33] * W8_SCALE, s[7 * 33] * W8_SCALE);
        *(u32x2*)(dst + (size_t)n * ldt + 8 * c) = o; }
    asm volatile("s_waitcnt lgkmcnt(0)" ::: "memory");
}
template <bool F8 = false, class Dec> DI void tr_loop(int gw, int NGW, int nit, int ldw, int ldt, LAS float* scr, int lane, const Dec& dec) {
    if (gw >= nit) return;
    float cur[32], nxt[32];
    TrIt ci = dec(gw);
    tr_load(cur, ci.src, ldw, lane);
#pragma unroll 1
    for (int it = gw; it < nit; it += NGW) {
        const bool more = it + NGW < nit;
        TrIt ni = ci;
        if (more) { ni = dec(it + NGW); tr_load(nxt, ni.src, ldw, lane); }
        if constexpr (F8) tr_store_f8(cur, (unsigned char*)ci.dst, ldt, scr, lane); else tr_store(cur, ci.dst, ldt, scr, lane);
        if (more) {
#pragma unroll
            for (int i = 0; i < 32; ++i) cur[i] = nxt[i]; }
        ci = ni;
    }
}
template <int K, int N> DI void conv_plain(const Frame& F, const float* W, bf16_t* WT, int rot, int blk0 = 0) {
    LAS float* scr = (LAS float*)(F.lds + F.wave * 16384);
    const int NGW = (F.G - blk0) * 8, gw = ((F.bid - blk0) * 8 + F.wave + rot) % NGW;
    constexpr int nblk = N / 32, nit = (K / 64) * nblk;
    tr_loop(gw, NGW, nit, N, K, scr, F.lane, [&](int it) { const int kb = it / nblk, nb = it % nblk; return TrIt{W + (size_t)(kb * 64) * N + nb * 32, WT + (size_t)(nb * 32) * K + kb * 64}; });
}
template <int K, int N> DI void conv_plain_f8(const Frame& F, const float* W, unsigned char* WT, int rot, int blk0 = 0) {
    LAS float* scr = (LAS float*)(F.lds + F.wave * 16384);
    const int NGW = (F.G - blk0) * 8, gw = ((F.bid - blk0) * 8 + F.wave + rot) % NGW;
    constexpr int nblk = N / 32, nit = (K / 64) * nblk;
    tr_loop<true>(gw, NGW, nit, N, K, scr, F.lane, [&](int it) { const int kb = it / nblk, nb = it % nblk; return TrIt{W + (size_t)(kb * 64) * N + nb * 32, (bf16_t*)(WT + (size_t)(nb * 32) * K + kb * 64)}; });
}
DI void conv_gu(const Frame& F, int l, bf16_t* WT, int blk0 = 0) {
    if (F.bid < blk0) return;
    LAS float* scr = (LAS float*)(F.lds + F.wave * 16384);
    const int NGW = (F.G - blk0) * 8, gw = (F.bid - blk0) * 8 + F.wave;
    const int nit = NEX * 2 * 128;
    tr_loop(gw, NGW, nit, FF, D, scr, F.lane, [&](int it) {
        const int e = it / 256, r = it % 256, isup = r / 128, r2 = r % 128, kb = r2 / 8, nb = r2 % 8, n0 = nb * 32;
        const float* W = (e < NE) ? F.in[isup ? I_WEU : I_WEG] + ((size_t)l * NE + e) * D * FF : F.in[isup ? I_WSU : I_WSG] + (size_t)l * D * FF;
        const int drow0 = ((n0 >> 7) << 8) + (n0 & 127) + (isup ? 128 : 0);
        return TrIt{W + (size_t)(kb * 64) * FF + n0, WT + (size_t)e * 512 * D + (size_t)drow0 * D + kb * 64}; });
}
DI void conv_down(const Frame& F, int l, bf16_t* WT, int blk0 = 0) {
    if (F.bid < blk0) return;
    LAS float* scr = (LAS float*)(F.lds + F.wave * 16384);
    const int NGW = (F.G - blk0) * 8, gw = (F.bid - blk0) * 8 + F.wave;
    const int nit = NEX * 128;
    tr_loop(gw, NGW, nit, D, FF, scr, F.lane, [&](int it) {
        const int e = it / 128, r = it % 128, kb = r / 32, nb = r % 32;
        const float* W = (e < NE) ? F.in[I_WED] + ((size_t)l * NE + e) * FF * D : F.in[I_WSD] + (size_t)l * FF * D;
        return TrIt{W + (size_t)(kb * 64) * D + nb * 32, WT + (size_t)e * D * FF + (size_t)(nb * 32) * FF + kb * 64}; });
}
DI size_t wbs_base(int l) { return l == 0 ? WS_WBS : WS_WBS1; }
DI void conv_small(const Frame& F, int l, int blk0 = 0) {
    if (F.bid < blk0) return;
    bf16_t* wb = (bf16_t*)(F.ws + wbs_base(l));
    unsigned char* w8 = (l == 0) ? (unsigned char*)(F.ws + WS_W8L0) : (unsigned char*)wb + WB_WIN;
    conv_plain_f8<D, NIN>(F, F.in[I_WIN] + (size_t)l * D * NIN, w8, 0, blk0);
    if (l == 0) {
        LAS float* scr = (LAS float*)(F.lds + F.wave * 16384);
        const int NGW = (F.G - blk0) * 8, gw = ((F.bid - blk0) * 8 + F.wave + 300) % NGW;
        constexpr int nblk = MIX_NT * 8, nit = (D / 64) * nblk;
        const float* W = F.in[I_WIN] + MIX_T0 * 256; bf16_t* WT = (bf16_t*)((char*)wb + WB_WIN) + (size_t)MIX_T0 * 256 * D;
        tr_loop(gw, NGW, nit, NIN, D, scr, F.lane, [&](int it) { const int kb = it / nblk, nb = it % nblk; return TrIt{W + (size_t)(kb * 64) * NIN + nb * 32, WT + (size_t)(nb * 32) * D + kb * 64}; });
    }
#if ONA8
    conv_plain_f8<512, D>(F, F.in[I_WNA] + (size_t)l * 512 * D, (unsigned char*)wb + WB_WNA, 600, blk0);
#else
    conv_plain<512, D>(F, F.in[I_WNA] + (size_t)l * 512 * D, (bf16_t*)((char*)wb + WB_WNA), 600, blk0);
#endif
    conv_plain<512, D>(F, F.in[I_WSC] + (size_t)l * 512 * D, (bf16_t*)((char*)wb + WB_WSC), 900, blk0);
#if OG8
    conv_plain_f8<D, D>(F, F.in[I_WGLA] + (size_t)l * D * D, (unsigned char*)wb + WB_WGLA, 1200, blk0);
#else
    conv_plain<D, D>(F, F.in[I_WGLA] + (size_t)l * D * D, (bf16_t*)((char*)wb + WB_WGLA), 1200, blk0);
#endif
    conv_plain<D, D>(F, F.in[I_WOUT] + (size_t)l * D * D, (bf16_t*)((char*)wb + WB_WOUT), 1700, blk0);
    constexpr int WIN_EB = 1;
    u32x4* z = (u32x4*)(w8 + (size_t)NIN * D * WIN_EB);
    const int nz = (ZS - NIN) * D * WIN_EB / 16;
    unsigned zz = 0u; asm volatile("" : "+v"(zz));
    for (int i = (F.bid - blk0) * 512 + F.tid; i < nz; i += (F.G - blk0) * 512) z[i] = (u32x4){zz, zz, zz, zz};
}
DI void conv_gate_w(const Frame& F) {
    bf16_t* wt = (bf16_t*)(F.ws + WS_W2TG);
    for (int i = F.bid * 512 + F.tid; i < 2 * 2 * 512 * 16; i += F.G * 512) { const int ld = i >> 13, rr = i & 8191, d = rr >> 4, ii = rr & 15; wt[i] = f2bf(F.in[I_GGW][((size_t)ld * 16 + ii) * 512 + d]); }
}
DI void build_na_tab(const Frame& F) {
    float* tg = (float*)(F.ws + WS_NATAB);
    for (int i = F.bid * 512 + F.tid; i < 2 * 4096; i += F.G * 512) { const int l = i >> 12, j = i & 4095, hh = j >> 9, dr = (j >> 5) & 15, dc = j & 31;
        tg[i] = (dr == 15) ? 0.f : ((dc == 31) ? -1e30f : F.in[I_RPB][(size_t)l * 8 * 15 * 31 + (hh * 15 + dr) * 31 + dc] * 1.4426950408889634f); }
}
DI void conv_router(const Frame& F) {
    bf16_t* wrt = (bf16_t*)(F.ws + WS_WRT);
    for (int i = F.bid * 512 + F.tid; i < 2 * NE * D; i += F.G * 512) {
        const int l = i / (NE * D), r = i % (NE * D), e = r / D, k = r % D;
        const float w = F.in[I_WR][(size_t)l * D * NE + (size_t)k * NE + e];
        const bf16_t hi = f2bf(w); const bf16_t lo = f2bf(w - bf2f(hi));
        wrt[((size_t)(l * 2 + 0) * NE + e) * D + k] = hi; wrt[((size_t)(l * 2 + 1) * NE + e) * D + k] = lo;
    }
}
DI void mod_vectors(const Frame& F) {
    float* mod = (float*)(F.ws + WS_MOD);
    LAS float* SL = (LAS float*)F.lds;
    LAS float* PART = SL + 9 * 1024;
    if (F.bid >= 2 * 96) return;
    __syncthreads();
    { float cv[18];
#pragma unroll
      for (int j = 0; j < 18; ++j) cv[j] = (j < 16) ? F.in[I_C][F.tid + 512 * j] : F.in[I_CCTX][F.tid + 512 * (j - 16)];
#pragma unroll
      for (int j = 0; j < 18; ++j) SL[F.tid + 512 * j] = siluf_(cv[j]); }
    __syncthreads();
    for (int it = F.bid; it < 2 * 96; it += F.G) {
        const int l = it / 96, cb = it % 96, j = cb * 64 + F.lane;
        const float* W = F.in[I_WMOD] + (size_t)l * D * 6144 + j;
        float acc[9];
#pragma unroll
        for (int q = 0; q < 9; ++q) acc[q] = 0.f;
#pragma unroll 8
        for (int k = F.wave * 128; k < F.wave * 128 + 128; ++k) {
            const float w = W[(size_t)k * 6144];
#pragma unroll
            for (int q = 0; q < 9; ++q) acc[q] += SL[q * 1024 + k] * w;
        }
#pragma unroll
        for (int q = 0; q < 9; ++q) PART[(F.wave * 9 + q) * 64 + F.lane] = acc[q];
        __syncthreads();
        for (int q = F.wave; q < 9; q += 8) {
            float s = F.in[I_BMOD][l * 6144 + j];
#pragma unroll
            for (int w = 0; w < 8; ++w) s += PART[(w * 9 + q) * 64 + F.lane];
            mod[((size_t)(l * 9 + q)) * 6144 + j] = s;
        }
        __syncthreads();
    }
}

DI void load_row_f32(const float* p, int lane, float (&v)[16]) {
#pragma unroll
    for (int i = 0; i < 2; ++i) { const f32x4 a = *(const f32x4*)(p + 8 * lane + 512 * i), b = *(const f32x4*)(p + 8 * lane + 512 * i + 4);
        v[8 * i + 0] = a[0]; v[8 * i + 1] = a[1]; v[8 * i + 2] = a[2]; v[8 * i + 3] = a[3]; v[8 * i + 4] = b[0]; v[8 * i + 5] = b[1]; v[8 * i + 6] = b[2]; v[8 * i + 7] = b[3]; }
}
DI void store_row_f32(float* p, int lane, const float (&v)[16]) {
#pragma unroll
    for (int i = 0; i < 2; ++i) { *(f32x4*)(p + 8 * lane + 512 * i) = (f32x4){v[8 * i], v[8 * i + 1], v[8 * i + 2], v[8 * i + 3]}; *(f32x4*)(p + 8 * lane + 512 * i + 4) = (f32x4){v[8 * i + 4], v[8 * i + 5], v[8 * i + 6], v[8 * i + 7]}; }
}
DI void load_row_bf16(const bf16_t* p, int lane, float (&v)[16]) {
#pragma unroll
    for (int i = 0; i < 2; ++i) { const u32x4 a = *(const u32x4*)(p + 8 * lane + 512 * i);
        v[8 * i + 0] = bf_lo(a.x); v[8 * i + 1] = bf_hi(a.x); v[8 * i + 2] = bf_lo(a.y); v[8 * i + 3] = bf_hi(a.y); v[8 * i + 4] = bf_lo(a.z); v[8 * i + 5] = bf_hi(a.z); v[8 * i + 6] = bf_lo(a.w); v[8 * i + 7] = bf_hi(a.w); }
}
template <bool PRESCALED = false> DI void store_row_h(bf16_t* Hbase, size_t t, int lane, const float (&v)[16]);
DI void store_row_bf16(bf16_t* p, int lane, const float (&v)[16]) {
#pragma unroll
    for (int i = 0; i < 2; ++i) { u32x4 w; w.x = pk2(v[8 * i], v[8 * i + 1]); w.y = pk2(v[8 * i + 2], v[8 * i + 3]); w.z = pk2(v[8 * i + 4], v[8 * i + 5]); w.w = pk2(v[8 * i + 6], v[8 * i + 7]);
        *(u32x4*)(p + 8 * lane + 512 * i) = w; }
}
template <bool PRESCALED> DI void store_row_h(bf16_t* Hbase, size_t t, int lane, const float (&v)[16]) {
#if W8A8
    unsigned char* p = (unsigned char*)Hbase + t * D;
    constexpr float s = PRESCALED ? 1.0f : H8_SCALE;
#pragma unroll
    for (int i = 0; i < 2; ++i) { u32x2 w; w.x = pg8::pk4_fp8c(v[8 * i] * s, v[8 * i + 1] * s, v[8 * i + 2] * s, v[8 * i + 3] * s);
        w.y = pg8::pk4_fp8c(v[8 * i + 4] * s, v[8 * i + 5] * s, v[8 * i + 6] * s, v[8 * i + 7] * s);
        *(u32x2*)(p + 8 * lane + 512 * i) = w; }
#else
    store_row_bf16(Hbase + t * D, lane, v);
#endif
}
DI void norm_mod(const float (&x)[16], const float* g, const float* shift, const float* scale, int lane, float (&h)[16]) {
    float ss = 0.f;
#pragma unroll
    for (int i = 0; i < 16; ++i) ss += x[i] * x[i];
    const float rstd = rsqrtf(wave_sum(ss) * (1.0f / D) + RMS_EPS);
    float gg[16], sh[16], sc[16]; load_row_f32(g, lane, gg); load_row_f32(shift, lane, sh); load_row_f32(scale, lane, sc);
#pragma unroll
    for (int i = 0; i < 16; ++i) h[i] = x[i] * rstd * gg[i] * (1.0f + sc[i]) + sh[i];
}

DI void phase_norm1_first(const Frame& F) {
    const int gw = F.bid * 8 + F.wave, lane = F.lane;
    constexpr int per = TA / (GRID * 8);
    const int tbeg = gw * per;
    bf16_t* H = (bf16_t*)(F.ws + WS_R2);
    int rcur = -1; float ga[16], sb[16], xn[16];
    load_row_f32(tbeg >= TL ? F.in[I_CTX] + (size_t)(tbeg - TL) * D : F.in[I_X] + (size_t)tbeg * D, lane, xn);
#pragma unroll 1
    for (int k = 0; k < per; ++k) {
        const int t = tbeg + k;
        const int r = t >= TL ? 8 : t / SEQ;
        if (r != rcur) { rcur = r; float gg[16], sc[16]; load_row_f32(F.in[I_G1], lane, gg); load_row_f32(modp(F, 0, r, 1), lane, sc); load_row_f32(modp(F, 0, r, 0), lane, sb);
#pragma unroll
            for (int i = 0; i < 16; ++i) ga[i] = gg[i] * (1.0f + sc[i]); }
        float x[16], h[16];
#pragma unroll
        for (int i = 0; i < 16; ++i) x[i] = xn[i];
        if (k + 1 < per) { const int tn = t + 1; load_row_f32(tn >= TL ? F.in[I_CTX] + (size_t)(tn - TL) * D : F.in[I_X] + (size_t)tn * D, lane, xn); }
        float ss = 0.f;
#pragma unroll
        for (int i = 0; i < 16; ++i) ss += x[i] * x[i];
        const float rstd = rsqrtf(wave_sum(ss) * (1.0f / D) + RMS_EPS);
#pragma unroll
        for (int i = 0; i < 16; ++i) h[i] = x[i] * rstd * ga[i] + sb[i];
        store_row_h(H, (size_t)t, lane, h);
        store_row_bf16(H + (size_t)20 * 1024 * 1024 + (size_t)t * D, lane, h);
    }
}

DI void phase_conv(const Frame& F, int l, int M) {
    const bf16_t* Z = (const bf16_t*)(F.ws + WS_R1); bf16_t* O = (bf16_t*)(F.ws + WS_R1 + R1_O);
    const float* cw = F.in[I_CONVW] + (size_t)l * 3 * 512;
    int nch, ch0;
    if (M == TA) { if (F.bid < 64) { nch = 10; ch0 = F.bid * 10; } else if (F.bid < 128) { nch = 12; ch0 = 640 + (F.bid - 64) * 12; } else { nch = 7; ch0 = 1408 + (F.bid - 128) * 7; } }
    else { if (F.bid < 128) { nch = 10; ch0 = F.bid * 10; } else { nch = 6; ch0 = 1280 + (F.bid - 128) * 6; } }
    const int c0 = (F.tid & 63) * 8;
    float cwr[24];
#pragma unroll
    for (int j = 0; j < 8; ++j) { cwr[j] = cw[c0 + j]; cwr[8 + j] = cw[512 + c0 + j]; cwr[16 + j] = cw[1024 + c0 + j]; }
    u32x4 nc, nx, nb, ncp, nxp, ncn, nxn;
    auto ld = [&](int kc) {
        const int t = ((ch0 + kc) * 512 + F.tid) >> 6;
        const int L = (t >= TL) ? CTXL : SEQ, pos = (t >= TL) ? (t - TL) % CTXL : t % SEQ;
        const bf16_t* zr = Z + (size_t)t * ZS;
        const u32x4 z4 = {0u, 0u, 0u, 0u};
        nc = *(const u32x4*)(zr + C_CSC + c0); nx = *(const u32x4*)(zr + C_XSC + c0); nb = *(const u32x4*)(zr + C_BSC + c0);
        if (pos > 0) { ncp = *(const u32x4*)(zr - ZS + C_CSC + c0); nxp = *(const u32x4*)(zr - ZS + C_XSC + c0); } else { ncp = z4; nxp = z4; }
        if (pos < L - 1) { ncn = *(const u32x4*)(zr + ZS + C_CSC + c0); nxn = *(const u32x4*)(zr + ZS + C_XSC + c0); } else { ncn = z4; nxn = z4; } };
    if (nch > 0) ld(0);
#pragma unroll 1
    for (int kc = 0; kc < nch; ++kc) {
        const int t = ((ch0 + kc) * 512 + F.tid) >> 6;
        const u32x4 c1 = nc, x1 = nx, b1 = nb, c0v = ncp, x0v = nxp, c2 = ncn, x2 = nxn;
        if (kc + 1 < nch) ld(kc + 1);
        float u0[8], u1[8], u2[8], bb[8];
        u1[0] = bf_lo(c1.x) * bf_lo(x1.x); u1[1] = bf_hi(c1.x) * bf_hi(x1.x); u1[2] = bf_lo(c1.y) * bf_lo(x1.y); u1[3] = bf_hi(c1.y) * bf_hi(x1.y);
        u1[4] = bf_lo(c1.z) * bf_lo(x1.z); u1[5] = bf_hi(c1.z) * bf_hi(x1.z); u1[6] = bf_lo(c1.w) * bf_lo(x1.w); u1[7] = bf_hi(c1.w) * bf_hi(x1.w);
        bb[0] = bf_lo(b1.x); bb[1] = bf_hi(b1.x); bb[2] = bf_lo(b1.y); bb[3] = bf_hi(b1.y); bb[4] = bf_lo(b1.z); bb[5] = bf_hi(b1.z); bb[6] = bf_lo(b1.w); bb[7] = bf_hi(b1.w);
        u0[0] = bf_lo(c0v.x) * bf_lo(x0v.x); u0[1] = bf_hi(c0v.x) * bf_hi(x0v.x); u0[2] = bf_lo(c0v.y) * bf_lo(x0v.y); u0[3] = bf_hi(c0v.y) * bf_hi(x0v.y);
        u0[4] = bf_lo(c0v.z) * bf_lo(x0v.z); u0[5] = bf_hi(c0v.z) * bf_hi(x0v.z); u0[6] = bf_lo(c0v.w) * bf_lo(x0v.w); u0[7] = bf_hi(c0v.w) * bf_hi(x0v.w);
        u2[0] = bf_lo(c2.x) * bf_lo(x2.x); u2[1] = bf_hi(c2.x) * bf_hi(x2.x); u2[2] = bf_lo(c2.y) * bf_lo(x2.y); u2[3] = bf_hi(c2.y) * bf_hi(x2.y);
        u2[4] = bf_lo(c2.z) * bf_lo(x2.z); u2[5] = bf_hi(c2.z) * bf_hi(x2.z); u2[6] = bf_lo(c2.w) * bf_lo(x2.w); u2[7] = bf_hi(c2.w) * bf_hi(x2.w);
        float o[8];
#pragma unroll
        for (int j = 0; j < 8; ++j) o[j] = bb[j] * (u0[j] * cwr[j] + u1[j] * cwr[8 + j] + u2[j] * cwr[16 + j]);
        u32x4 w; w.x = pk2(o[0], o[1]); w.y = pk2(o[2], o[3]); w.z = pk2(o[4], o[5]); w.w = pk2(o[6], o[7]);
        *(u32x4*)(O + (size_t)t * OS + 512 + c0) = w;
    }
}

#define MFMA32(a, b, c) __builtin_amdgcn_mfma_f32_32x32x16_bf16((a), (b), (c), 0, 0, 0)
DI int crow(int reg, int h) { return (reg & 3) + 8 * (reg >> 2) + 4 * h; }
DI bf16x8 pack_step(const f32x16& x, int s) {
    u32x4 p; p.x = pk2(x[8 * s], x[8 * s + 1]); p.y = pk2(x[8 * s + 2], x[8 * s + 3]); p.z = pk2(x[8 * s + 4], x[8 * s + 5]); p.w = pk2(x[8 * s + 6], x[8 * s + 7]);
    return __builtin_bit_cast(bf16x8, p);
}
DI bf16x8 cat4(u32x2 a, u32x2 b) { u32x4 p; p.x = a.x; p.y = a.y; p.z = b.x; p.w = b.y; return __builtin_bit_cast(bf16x8, p); }

typedef __attribute__((address_space(3))) s16x4 lds_s16x4;
DI bf16x8 tr8(const LAS bf16_t* p0, const LAS bf16_t* p1) {
    const s16x4 a = __builtin_amdgcn_ds_read_tr16_b64_v4i16((lds_s16x4*)p0), b = __builtin_amdgcn_ds_read_tr16_b64_v4i16((lds_s16x4*)p1);
    return (bf16x8){a[0], a[1], a[2], a[3], b[0], b[1], b[2], b[3]};
}
constexpr int NA_VS = 72;
constexpr int NA_TAB = 8 * NA_VS * 64 * 2;
constexpr float NA_L2E = 1.4426950408889634f;
template <int V> struct IntC { static constexpr int value = V; };
constexpr int NA_KOFF = 0, NA_VOFF = 2 * 64 * NA_VS * 2;
constexpr int NA_TAB2 = 4 * 64 * NA_VS * 2;
DI void na_block_unit(const Frame& F, const bf16_t* Z, bf16_t* O, const LAS float* tab, int head, bool isctxu, int b, int rg) {
    const int tid = F.tid, lane = F.lane, wave = F.wave, r = lane & 31, h = lane >> 5;
    const int trq = (lane & 15) >> 2, trc = 16 * ((lane >> 4) & 1) + 4 * (lane & 3);
    LAS bf16_t* KR = (LAS bf16_t*)(F.lds + NA_KOFF); LAS bf16_t* VR = (LAS bf16_t*)(F.lds + NA_VOFF);
    const int qrow_g = isctxu ? 0 : 4 * rg + (wave >> 1), qcol0 = isctxu ? 0 : 32 * (wave & 1);
    const int qrow0 = isctxu ? TL + b * CTXL + 32 * wave : b * SEQ + qrow_g * 64 + qcol0;
    int rs = qrow_g - 4; rs = rs < 0 ? 0 : (rs > 24 ? 24 : rs);
    int rs_lo = 4 * rg - 4; rs_lo = rs_lo < 0 ? 0 : (rs_lo > 24 ? 24 : rs_lo); int rs_hi = 4 * rg + 3 - 4; rs_hi = rs_hi < 0 ? 0 : (rs_hi > 24 ? 24 : rs_hi);
    const int nwin = isctxu ? 0 : rs_hi + 8 - rs_lo, ntile = nwin + 4;
    const int winrow0 = b * SEQ + rs_lo * 64, ctxrow0 = TL + b * CTXL;
    bf16x8 qf[4];
    { const bf16_t* qp = Z + (size_t)(qrow0 + r) * ZS + C_QNA + head * 64 + 8 * h;
#pragma unroll
      for (int ks = 0; ks < 4; ++ks) qf[ks] = *(const bf16x8*)(qp + 16 * ks); }
    unsigned ix0[4], ix1[4];
    { const int qc = qcol0 + r; int cs = qc - 8; cs = cs < 0 ? 0 : (cs > 48 ? 48 : cs);
#pragma unroll
      for (int g = 0; g < 4; ++g) { unsigned p0 = 0u, p1 = 0u;
#pragma unroll
          for (int e = 0; e < 4; ++e) { const int kc0 = crow(4 * g + e, h), kc1 = 32 + kc0;
              int d0 = kc0 - qc; d0 = d0 < -15 ? -15 : (d0 > 15 ? 15 : d0); int d1 = kc1 - qc; d1 = d1 < -15 ? -15 : (d1 > 15 ? 15 : d1);
              const unsigned c0 = (kc0 < cs || kc0 >= cs + 16) ? 31u : (unsigned)(d0 + 15), c1 = (kc1 < cs || kc1 >= cs + 16) ? 31u : (unsigned)(d1 + 15);
              p0 |= c0 << (8 * e); p1 |= c1 << (8 * e); }
          ix0[g] = p0; ix1[g] = p1; } }
    f32x16 o0, o1;
#pragma unroll
    for (int i = 0; i < 16; ++i) { o0[i] = 0.f; o1[i] = 0.f; }
    float mrun = -1e30f, lrun = 0.f;
    const int lkey = tid >> 3, lseg = tid & 7;
#define NA_TROW(j_) ((j_) < nwin ? winrow0 + (j_) * 64 : ctxrow0 + ((j_) - nwin) * 64)
#define NA_LD(j_, kk_, vv_) do { const bf16_t* zp = Z + (size_t)(NA_TROW(j_) + lkey) * ZS + head * 64 + 8 * lseg; kk_ = *(const u32x4*)(zp + C_KNA); vv_ = *(const u32x4*)(zp + C_VNA); } while (0)
#define NA_ST(slot_, kk_, vv_) do { *(LAS u32x4*)(KR + ((slot_) * 64 + lkey) * NA_VS + 8 * lseg) = kk_; *(LAS u32x4*)(VR + ((slot_) * 64 + lkey) * NA_VS + 8 * lseg) = vv_; } while (0)
    u32x4 sk, sv;
    __syncthreads();
    NA_LD(0, sk, sv); NA_ST(0, sk, sv); NA_LD(1, sk, sv);
#pragma unroll 1
    for (int j = 0; j < ntile; ++j) {
        __syncthreads();
        if (j + 1 < ntile) { NA_ST((j + 1) & 1, sk, sv); const int j2 = j + 2 < ntile ? j + 2 : ntile - 1; NA_LD(j2, sk, sv); }
        const bool isw = j < nwin;
        const int krow_g = rs_lo + j;
        if (isw && (krow_g < rs || krow_g >= rs + 8)) continue;
        const LAS bf16_t* kt = KR + (j & 1) * 64 * NA_VS; const LAS bf16_t* vt = VR + (j & 1) * 64 * NA_VS;
        f32x16 s0, s1;
#pragma unroll
        for (int i = 0; i < 16; ++i) { s0[i] = 0.f; s1[i] = 0.f; }
#pragma unroll
        for (int ks = 0; ks < 4; ++ks) { const bf16x8 k0 = *(const LAS bf16x8*)(kt + r * NA_VS + 16 * ks + 8 * h), k1 = *(const LAS bf16x8*)(kt + (32 + r) * NA_VS + 16 * ks + 8 * h);
            s0 = MFMA32(k0, qf[ks], s0); s1 = MFMA32(k1, qf[ks], s1); }
        const int drow = isw ? (krow_g - qrow_g + 7) : 15;
        const LAS float* trow = tab + (head * 16 + drow) * 32;
#pragma unroll
        for (int g = 0; g < 4; ++g) asm volatile("" : "+v"(ix0[g]), "+v"(ix1[g]));
        auto body = [&](auto mode_) {
            constexpr int MODE = decltype(mode_)::value;
#define NA_U0(i_) (MODE == 0 || MODE == 1 || (i_) >= 12)
#define NA_U1(i_) (MODE == 0 || MODE == 2 || (i_) < 4)
            float tmax = -1e30f;
#pragma unroll
            for (int i = 0; i < 16; ++i) {
                if (MODE == 0) {
                    const float a = s0[i] * (0.125f * NA_L2E), bq = s1[i] * (0.125f * NA_L2E); s0[i] = a; s1[i] = bq; tmax = fmaxf(tmax, fmaxf(a, bq));
                } else {
                    if (NA_U0(i)) { const float a = s0[i] * (0.125f * NA_L2E) + trow[(ix0[i >> 2] >> (8 * (i & 3))) & 0xffu]; s0[i] = a; tmax = fmaxf(tmax, a); }
                    if (NA_U1(i)) { const float bq = s1[i] * (0.125f * NA_L2E) + trow[(ix1[i >> 2] >> (8 * (i & 3))) & 0xffu]; s1[i] = bq; tmax = fmaxf(tmax, bq); }
                }
            }
            tmax = fmaxf(tmax, __shfl_xor(tmax, 32));
            const float mnew = fmaxf(mrun, tmax), alpha = __builtin_amdgcn_exp2f(mrun - mnew);
            float psum = 0.f;
#pragma unroll
            for (int i = 0; i < 16; ++i) {
                if (NA_U0(i)) { const float a = __builtin_amdgcn_exp2f(s0[i] - mnew); s0[i] = a; psum += a; } else s0[i] = 0.f;
                if (NA_U1(i)) { const float bq = __builtin_amdgcn_exp2f(s1[i] - mnew); s1[i] = bq; psum += bq; } else s1[i] = 0.f;
            }
            psum += __shfl_xor(psum, 32);
            lrun = lrun * alpha + psum; mrun = mnew;
#pragma unroll
            for (int i = 0; i < 16; ++i) { o0[i] *= alpha; o1[i] *= alpha; }
#pragma unroll
            for (int nb = 0; nb < 2; ++nb)
#pragma unroll
                for (int s = 0; s < 2; ++s) {
                    if ((MODE == 1 && nb == 1 && s == 1) || (MODE == 2 && nb == 0 && s == 0)) continue;
                    const bf16x8 pf = pack_step(nb ? s1 : s0, s);
                    const LAS bf16_t* vp = vt + (32 * nb + 16 * s + 4 * h + trq) * NA_VS + trc;
                    o0 = MFMA32(tr8(vp, vp + 8 * NA_VS), pf, o0); o1 = MFMA32(tr8(vp + 32, vp + 32 + 8 * NA_VS), pf, o1);
                }
#undef NA_U0
#undef NA_U1
        };
        if (!isw) body(IntC<0>{}); else if ((wave & 1) == 0) body(IntC<1>{}); else body(IntC<2>{});
    }
#undef NA_TROW
#undef NA_LD
#undef NA_ST
#if ONA8
    const float inv = ONA8_SCALE / lrun;
    unsigned char* op = (unsigned char*)(O + (size_t)(qrow0 + r) * OS) + head * 64 + 4 * h;
#pragma unroll
    for (int g = 0; g < 4; ++g) {
        *(unsigned*)(op + 8 * g) = pg8::pk4_fp8c(o0[4 * g] * inv, o0[4 * g + 1] * inv, o0[4 * g + 2] * inv, o0[4 * g + 3] * inv);
        *(unsigned*)(op + 32 + 8 * g) = pg8::pk4_fp8c(o1[4 * g] * inv, o1[4 * g + 1] * inv, o1[4 * g + 2] * inv, o1[4 * g + 3] * inv);
    }
#else
    const float inv = 1.0f / lrun;
    bf16_t* op = O + (size_t)(qrow0 + r) * OS + head * 64 + 4 * h;
#pragma unroll
    for (int g = 0; g < 4; ++g) {
        u32x2 w0, w1; w0.x = pk2(o0[4 * g] * inv, o0[4 * g + 1] * inv); w0.y = pk2(o0[4 * g + 2] * inv, o0[4 * g + 3] * inv);
        w1.x = pk2(o1[4 * g] * inv, o1[4 * g + 1] * inv); w1.y = pk2(o1[4 * g + 2] * inv, o1[4 * g + 3] * inv);
        *(u32x2*)(op + 8 * g) = w0; *(u32x2*)(op + 32 + 8 * g) = w1;
    }
#endif
}
DI void phase_na(const Frame& F, int l, bool ctx_out) {
    const bf16_t* Z = (const bf16_t*)(F.ws + WS_R1); bf16_t* O = (bf16_t*)(F.ws + WS_R1 + R1_O);
    LAS float* tab = (LAS float*)(F.lds + NA_TAB2);
    __syncthreads();
    { const f32x4* tg = (const f32x4*)(F.ws + WS_NATAB) + (size_t)l * 1024;
      for (int i = F.tid; i < 1024; i += 512) ((LAS f32x4*)tab)[i] = tg[i]; }
    __syncthreads();
    const int nlat = NB * 8 * 8, ntot = nlat + (ctx_out ? NB * 8 : 0);
#pragma unroll 1
    for (int u = F.bid; u < ntot; u += F.G) {
        if (u < nlat) na_block_unit(F, Z, O, tab, u & 7, false, u >> 6, (u >> 3) & 7);
        else { const int v = u - nlat; na_block_unit(F, Z, O, tab, v & 7, true, v >> 3, 0); }
    }
    __syncthreads();
}

constexpr int GP_CUM = 0, GL_CUMS = 132, GP_W2T = 33792  , GP_B2 = GP_W2T + 2 * 128 * 24 * 2  , GP_SEG = GP_B2 + 1024  ;
DI size_t gl_chunk_row(int b, int cn) { return cn < 4 ? (size_t)(TL + b * CTXL + cn * 64) : (size_t)(b * SEQ + (cn - 4) * 64); }
DI void gla_prep(const Frame& F, int l, int task) {
    const int cn = task % 36, hd = (task / 36) & 3, b = task / 144;
    bf16_t* Z = (bf16_t*)(F.ws + WS_R1); bf16_t* O = (bf16_t*)(F.ws + WS_R1 + R1_O); float* DECB = (float*)(F.ws + WS_DECB);
    LAS float* CUM = (LAS float*)(F.lds + GP_CUM); LAS float* SEG = (LAS float*)(F.lds + GP_SEG);
    const int tid = F.tid, lane = F.lane, wave = F.wave, r = lane & 31, h = lane >> 5;
    const size_t row0 = gl_chunk_row(b, cn);
    const bf16_t* W2G = (const bf16_t*)(F.ws + WS_W2TG);
    __syncthreads();
    const int tt = tid >> 3, seg = tid & 7, d0 = seg * 16;
    const int atb = wave & 1, adb = wave >> 1;
    const bf16_t* zr = Z + (row0 + tt) * ZS;
    const u32x4 q0 = *(const u32x4*)(zr + C_QGLA + hd * 128 + d0), q1 = *(const u32x4*)(zr + C_QGLA + hd * 128 + d0 + 8);
    const u32x4 k0 = *(const u32x4*)(zr + C_KGLA + hd * 128 + d0), k1 = *(const u32x4*)(zr + C_KGLA + hd * 128 + d0 + 8);
    float qv[16], kv[16];
    qv[0] = bf_lo(q0.x); qv[1] = bf_hi(q0.x); qv[2] = bf_lo(q0.y); qv[3] = bf_hi(q0.y); qv[4] = bf_lo(q0.z); qv[5] = bf_hi(q0.z); qv[6] = bf_lo(q0.w); qv[7] = bf_hi(q0.w);
    qv[8] = bf_lo(q1.x); qv[9] = bf_hi(q1.x); qv[10] = bf_lo(q1.y); qv[11] = bf_hi(q1.y); qv[12] = bf_lo(q1.z); qv[13] = bf_hi(q1.z); qv[14] = bf_lo(q1.w); qv[15] = bf_hi(q1.w);
    kv[0] = bf_lo(k0.x); kv[1] = bf_hi(k0.x); kv[2] = bf_lo(k0.y); kv[3] = bf_hi(k0.y); kv[4] = bf_lo(k0.z); kv[5] = bf_hi(k0.z); kv[6] = bf_lo(k0.w); kv[7] = bf_hi(k0.w);
    kv[8] = bf_lo(k1.x); kv[9] = bf_hi(k1.x); kv[10] = bf_lo(k1.y); kv[11] = bf_hi(k1.y); kv[12] = bf_lo(k1.z); kv[13] = bf_hi(k1.z); kv[14] = bf_lo(k1.w); kv[15] = bf_hi(k1.w);
    __syncthreads();
#pragma unroll 1
    for (int dir = 0; dir < 2; ++dir) {
        {
            const int tl = 32 * atb + r, tn = dir ? 63 - tl : tl;
            const bf16x8 lrf = *(const bf16x8*)(Z + (row0 + tn) * ZS + C_GATE + dir * 16 + 8 * h);
            const bf16x8 w2f = *(const bf16x8*)(W2G + ((size_t)(l * 2 + dir) * 512 + hd * 128 + 32 * adb + r) * 16 + 8 * h);
            const float b2v = F.in[I_GGB][(size_t)(l * 2 + dir) * 512 + hd * 128 + 32 * adb + r];
            f32x16 ga;
#pragma unroll
            for (int i = 0; i < 16; ++i) ga[i] = 0.f;
            ga = MFMA32(lrf, w2f, ga);
            float sg[4];
#pragma unroll
            for (int g = 0; g < 4; ++g) {
                float run = 0.f;
#pragma unroll
                for (int e = 0; e < 4; ++e) { const float x = ga[4 * g + e] + b2v; run += (fminf(x, 0.f) - __logf(1.0f + __expf(-fabsf(x)))) * (1.0f / 16.0f); ga[4 * g + e] = run; }
                sg[g] = run;
            }
            float off = 0.f;
#pragma unroll
            for (int g = 0; g < 4; ++g) { const float ps = __shfl_xor(sg[g], 32); const float o = off + (h ? ps : 0.f);
#pragma unroll
                for (int e = 0; e < 4; ++e) CUM[(32 * atb + 8 * g + 4 * h + e) * GL_CUMS + 32 * adb + r] = ga[4 * g + e] + o;
                off += sg[g] + ps; }
            if (h == 0) SEG[atb * 128 + 32 * adb + r] = off;
        }
        __syncthreads();
        {
            const int tau = dir ? 63 - tt : tt;
            float qs[16], ks[16];
#pragma unroll
            for (int j = 0; j < 4; ++j) {
                const f32x4 e0 = *(const LAS f32x4*)(SEG + d0 + 4 * j), e1 = *(const LAS f32x4*)(SEG + 128 + d0 + 4 * j);
                const f32x4 cl = *(const LAS f32x4*)(CUM + tau * GL_CUMS + d0 + 4 * j);
#pragma unroll
                for (int e = 0; e < 4; ++e) {
                    const float cum = cl[e] + (tau >= 32 ? e0[e] : 0.f);
                    const int jj = 4 * j + e;
                    const float ex = __expf(cum), inv = __builtin_amdgcn_rcpf(ex);
                    qs[jj] = qv[jj] * 0.08838834764831845f * ex;
                    ks[jj] = kv[jj] * inv;
                }
                if (tt == 0) { f32x4 dv;
#pragma unroll
                    for (int e = 0; e < 4; ++e) dv[e] = __expf(e0[e] + e1[e]);
                    *(f32x4*)(DECB + ((size_t)((b * 4 + hd) * 2 + dir) * 36 + cn) * 128 + d0 + 4 * j) = dv; }
            }
            bf16_t* qd = dir ? O + (row0 + tt) * OS + 1024 + hd * 128 + d0 : Z + (row0 + tt) * ZS + C_QGLA + hd * 128 + d0;
            bf16_t* kd = dir ? O + (row0 + tt) * OS + 1536 + hd * 128 + d0 : Z + (row0 + tt) * ZS + C_KGLA + hd * 128 + d0;
            u32x4 w;
            w.x = pk2(qs[0], qs[1]); w.y = pk2(qs[2], qs[3]); w.z = pk2(qs[4], qs[5]); w.w = pk2(qs[6], qs[7]); *(u32x4*)qd = w;
            w.x = pk2(qs[8], qs[9]); w.y = pk2(qs[10], qs[11]); w.z = pk2(qs[12], qs[13]); w.w = pk2(qs[14], qs[15]); *(u32x4*)(qd + 8) = w;
            w.x = pk2(ks[0], ks[1]); w.y = pk2(ks[2], ks[3]); w.z = pk2(ks[4], ks[5]); w.w = pk2(ks[6], ks[7]); *(u32x4*)kd = w;
            w.x = pk2(ks[8], ks[9]); w.y = pk2(ks[10], ks[11]); w.z = pk2(ks[12], ks[13]); w.w = pk2(ks[14], ks[15]); *(u32x4*)(kd + 8) = w;
        }
        __syncthreads();
    }
}
constexpr int GL_RS = 136, GL_VS = 72, GC_QS = 0, GC_KS = GC_QS + 2 * 64 * GL_RS * 2, GC_V = GC_KS + 2 * 64 * GL_RS * 2, GC_ST = GC_V + 2 * 64 * GL_VS * 2, GC_DEC = GC_ST + 2 * 128 * GL_VS * 2;
static_assert(GC_DEC + 2 * 128 * 4 <= MISC_OFF, "GLA chain LDS");
DI void gla_chain(const Frame& F, int l, int chain, bool ctx_out) {
    const int vs = chain & 3, dir = (chain >> 2) & 1, hd = (chain >> 3) & 3, b = chain >> 5;
    const bf16_t* Z = (const bf16_t*)(F.ws + WS_R1); const bf16_t* O = (const bf16_t*)(F.ws + WS_R1 + R1_O); const float* DECB = (const float*)(F.ws + WS_DECB);
    bf16_t* OD = (bf16_t*)(F.ws + WS_R2 + (dir ? R2_OB : 0));
    const int tid = F.tid, lane = F.lane, wave = F.wave, r = lane & 31, h = lane >> 5;
    const int trq = (lane & 15) >> 2, trc = 16 * ((lane >> 4) & 1) + 4 * (lane & 3);
    const int tau = tid >> 3, seg = tid & 7, d0 = seg * 16;
#define GL_CN(s_) ((s_) < 4 ? (dir ? 3 - (s_) : (s_)) : 4 + (dir ? 31 - ((s_) - 4) : ((s_) - 4)))
#define GL_ROW(s_, t_) (gl_chunk_row(b, GL_CN(s_)) + (dir ? 63 - (t_) : (t_)))
    const bf16_t* qbase = dir ? O + 1024 + hd * 128 + d0 : Z + C_QGLA + hd * 128 + d0; const bf16_t* kbase = dir ? O + 1536 + hd * 128 + d0 : Z + C_KGLA + hd * 128 + d0;
    const size_t qstr = dir ? OS : ZS;
    const bf16_t* vbase = Z + C_VGLA + hd * 256 + vs * 64 + seg * 8;
    const float* dbase = DECB + (size_t)((b * 4 + hd) * 2 + dir) * 36 * 128;
    __syncthreads();
    for (int i = tid; i < 128 * GL_VS / 2; i += 512) ((LAS unsigned*)(F.lds + GC_ST))[i] = 0u;
    f32x16 S0, S1;
#pragma unroll
    for (int i = 0; i < 16; ++i) { S0[i] = 0.f; S1[i] = 0.f; }
    u32x4 nq0, nq1, nk0, nk1, nvv; float ndec = 0.f;
#define GL_LOAD(s_) do { const size_t rw = GL_ROW(s_, tau); nq0 = *(const u32x4*)(qbase + rw * qstr); nq1 = *(const u32x4*)(qbase + rw * qstr + 8); nk0 = *(const u32x4*)(kbase + rw * qstr); nk1 = *(const u32x4*)(kbase + rw * qstr + 8); \
        nvv = *(const u32x4*)(vbase + rw * ZS); if (tid < 128) ndec = dbase[GL_CN(s_) * 128 + tid]; } while (0)
#define GL_PUT(p_) do { LAS bf16_t* qd = (LAS bf16_t*)(F.lds + GC_QS) + ((p_) * 64 + tau) * GL_RS + d0; LAS bf16_t* kd = (LAS bf16_t*)(F.lds + GC_KS) + ((p_) * 64 + tau) * GL_RS + d0; \
        *(LAS u32x4*)qd = nq0; *(LAS u32x4*)(qd + 8) = nq1; *(LAS u32x4*)kd = nk0; *(LAS u32x4*)(kd + 8) = nk1; *(LAS u32x4*)((LAS bf16_t*)(F.lds + GC_V) + ((p_) * 64 + tau) * GL_VS + seg * 8) = nvv; \
        if (tid < 128) ((LAS float*)(F.lds + GC_DEC))[(p_) * 128 + tid] = ndec; } while (0)
    GL_LOAD(0); GL_PUT(0); GL_LOAD(1);
    __syncthreads();
#pragma unroll 1
    for (int s = 0; s < 36; ++s) {
        const int p = s & 1;
        const bool emit = (s >= 4) || ctx_out;
        const LAS bf16_t* QS = (const LAS bf16_t*)(F.lds + GC_QS) + p * 64 * GL_RS; const LAS bf16_t* KS = (const LAS bf16_t*)(F.lds + GC_KS) + p * 64 * GL_RS;
        const LAS bf16_t* VV = (const LAS bf16_t*)(F.lds + GC_V) + p * 64 * GL_VS;
        const LAS bf16_t* STo = (const LAS bf16_t*)(F.lds + GC_ST) + p * 128 * GL_VS; LAS bf16_t* STn = (LAS bf16_t*)(F.lds + GC_ST) + (p ^ 1) * 128 * GL_VS;
        if (wave < 4) {
            if (emit) {
                const int vb = wave & 1, tb = wave >> 1;
                f32x16 a0, a1, oo, oi;
#pragma unroll
                for (int i = 0; i < 16; ++i) { a0[i] = 0.f; a1[i] = 0.f; oo[i] = 0.f; oi[i] = 0.f; }
#pragma unroll
                for (int kk = 0; kk < 8; ++kk) {
                    const bf16x8 qf = *(const LAS bf16x8*)(QS + (32 * tb + r) * GL_RS + 16 * kk + 8 * h);
                    const bf16x8 kf0 = *(const LAS bf16x8*)(KS + r * GL_RS + 16 * kk + 8 * h);
                    const LAS bf16_t* sp = STo + (16 * kk + 8 * h + trq) * GL_VS + 32 * vb + trc;
                    a0 = MFMA32(kf0, qf, a0);
                    oi = MFMA32(tr8(sp, sp + 4 * GL_VS), qf, oi);
                    if (tb == 1) { const bf16x8 kf1 = *(const LAS bf16x8*)(KS + (32 + r) * GL_RS + 16 * kk + 8 * h); a1 = MFMA32(kf1, qf, a1); }
                }
                const int tt = 32 * tb + r;
#pragma unroll
                for (int i = 0; i < 16; ++i) { const int sg0 = crow(i, h); if (sg0 > tt) a0[i] = 0.f; if (32 + sg0 > tt) a1[i] = 0.f; }
#pragma unroll
                for (int sb = 0; sb < 2; ++sb)
#pragma unroll
                    for (int st = 0; st < 2; ++st) {
                        if (sb == 1 && tb == 0) continue;
                        const bf16x8 pf = pack_step(sb ? a1 : a0, st);
                        const LAS bf16_t* vp = VV + (32 * sb + 16 * st + 4 * h + trq) * GL_VS + 32 * vb + trc;
                        oo = MFMA32(tr8(vp, vp + 8 * GL_VS), pf, oo);
                    }
#pragma unroll
                for (int i = 0; i < 16; ++i) oo[i] += oi[i];
                const size_t orow = GL_ROW(s, tt);
                bf16_t* op = OD + orow * D + hd * 256 + vs * 64 + 32 * vb + 4 * h;
#pragma unroll
                for (int g = 0; g < 4; ++g) { u32x2 w; w.x = pk2(oo[4 * g], oo[4 * g + 1]); w.y = pk2(oo[4 * g + 2], oo[4 * g + 3]); *(u32x2*)(op + 8 * g) = w; }
            }
        } else {
            const int db = wave - 4, dd = 32 * db + r;
            const float dec = ((const LAS float*)(F.lds + GC_DEC))[p * 128 + dd];
#pragma unroll
            for (int kk = 0; kk < 4; ++kk) {
                const LAS bf16_t* kp = KS + (16 * kk + 8 * h + trq) * GL_RS + 32 * db + trc;
                const LAS bf16_t* v0p = VV + (16 * kk + 8 * h + trq) * GL_VS + trc;
                const bf16x8 kf = tr8(kp, kp + 4 * GL_RS);
                S0 = MFMA32(tr8(v0p, v0p + 4 * GL_VS), kf, S0); S1 = MFMA32(tr8(v0p + 32, v0p + 32 + 4 * GL_VS), kf, S1);
            }
#pragma unroll
            for (int i = 0; i < 16; ++i) { S0[i] *= dec; S1[i] *= dec; }
#pragma unroll
            for (int g = 0; g < 4; ++g) {
                u32x2 w0, w1; w0.x = pk2(S0[4 * g], S0[4 * g + 1]); w0.y = pk2(S0[4 * g + 2], S0[4 * g + 3]); w1.x = pk2(S1[4 * g], S1[4 * g + 1]); w1.y = pk2(S1[4 * g + 2], S1[4 * g + 3]);
                *(LAS u32x2*)(STn + dd * GL_VS + 8 * g + 4 * h) = w0; *(LAS u32x2*)(STn + dd * GL_VS + 32 + 8 * g + 4 * h) = w1;
            }
        }
        if (s + 1 < 36) { GL_PUT(p ^ 1); const int s2 = s + 2 < 36 ? s + 2 : 35; GL_LOAD(s2); }
        __syncthreads();
    }
#undef GL_ROW
#undef GL_CN
#undef GL_LOAD
#undef GL_PUT
}
DI void phase_gla_fin(const Frame& F, int l, int M) {
    const int NGW = F.G * 8, gw = F.bid * 8 + F.wave, lane = F.lane;
    const bf16_t* Z = (const bf16_t*)(F.ws + WS_R1); bf16_t* O = (bf16_t*)(F.ws + WS_R1 + R1_O);
    const bf16_t* OFp = (const bf16_t*)(F.ws + WS_R2); const bf16_t* OBp = (const bf16_t*)(F.ws + WS_R2 + R2_OB);
    bf16_t* Z8 = (bf16_t*)(F.ws + WS_R1);
    float gnr[16];
    { const float* gn = F.in[I_GNG] + (size_t)l * 256 + (lane & 15) * 16;
#pragma unroll
      for (int i = 0; i < 16; ++i) gnr[i] = gn[i]; }
    int t = gw;
    if (t >= M) return;
    u32x4 na0 = *(const u32x4*)(OFp + (size_t)t * D + 16 * lane), na1 = *(const u32x4*)(OFp + (size_t)t * D + 16 * lane + 8);
    u32x4 nb0 = *(const u32x4*)(OBp + (size_t)t * D + 16 * lane), nb1 = *(const u32x4*)(OBp + (size_t)t * D + 16 * lane + 8);
    u32x4 nr0 = *(const u32x4*)(Z + (size_t)t * ZS + C_RGLA + 16 * lane), nr1 = *(const u32x4*)(Z + (size_t)t * ZS + C_RGLA + 16 * lane + 8);
#pragma unroll 1
    for (; t < M; t += NGW) {
        const u32x4 a0 = na0, a1 = na1, b0 = nb0, b1 = nb1, r0 = nr0, r1 = nr1;
        { const int tn = t + NGW;
          if (tn < M) { na0 = *(const u32x4*)(OFp + (size_t)tn * D + 16 * lane); na1 = *(const u32x4*)(OFp + (size_t)tn * D + 16 * lane + 8);
                        nb0 = *(const u32x4*)(OBp + (size_t)tn * D + 16 * lane); nb1 = *(const u32x4*)(OBp + (size_t)tn * D + 16 * lane + 8);
                        nr0 = *(const u32x4*)(Z + (size_t)tn * ZS + C_RGLA + 16 * lane); nr1 = *(const u32x4*)(Z + (size_t)tn * ZS + C_RGLA + 16 * lane + 8); } }
        float o[16], rr[16];
        o[0] = bf_lo(a0.x) + bf_lo(b0.x); o[1] = bf_hi(a0.x) + bf_hi(b0.x); o[2] = bf_lo(a0.y) + bf_lo(b0.y); o[3] = bf_hi(a0.y) + bf_hi(b0.y);
        o[4] = bf_lo(a0.z) + bf_lo(b0.z); o[5] = bf_hi(a0.z) + bf_hi(b0.z); o[6] = bf_lo(a0.w) + bf_lo(b0.w); o[7] = bf_hi(a0.w) + bf_hi(b0.w);
        o[8] = bf_lo(a1.x) + bf_lo(b1.x); o[9] = bf_hi(a1.x) + bf_hi(b1.x); o[10] = bf_lo(a1.y) + bf_lo(b1.y); o[11] = bf_hi(a1.y) + bf_hi(b1.y);
        o[12] = bf_lo(a1.z) + bf_lo(b1.z); o[13] = bf_hi(a1.z) + bf_hi(b1.z); o[14] = bf_lo(a1.w) + bf_lo(b1.w); o[15] = bf_hi(a1.w) + bf_hi(b1.w);
        rr[0] = bf_lo(r0.x); rr[1] = bf_hi(r0.x); rr[2] = bf_lo(r0.y); rr[3] = bf_hi(r0.y); rr[4] = bf_lo(r0.z); rr[5] = bf_hi(r0.z); rr[6] = bf_lo(r0.w); rr[7] = bf_hi(r0.w);
        rr[8] = bf_lo(r1.x); rr[9] = bf_hi(r1.x); rr[10] = bf_lo(r1.y); rr[11] = bf_hi(r1.y); rr[12] = bf_lo(r1.z); rr[13] = bf_hi(r1.z); rr[14] = bf_lo(r1.w); rr[15] = bf_hi(r1.w);
        float ss = 0.f;
#pragma unroll
        for (int i = 0; i < 16; ++i) ss += o[i] * o[i];
        ss += __shfl_xor(ss, 1); ss += __shfl_xor(ss, 2); ss += __shfl_xor(ss, 4); ss += __shfl_xor(ss, 8);
        const float rstd = rsqrtf(ss * (1.0f / 256.0f) + RMS_EPS);
        float y[16];
#pragma unroll
        for (int i = 0; i < 16; ++i) y[i] = o[i] * rstd * gnr[i] * siluf_(rr[i]);
        u32x4 w0, w1; w0.x = pk2(y[0], y[1]); w0.y = pk2(y[2], y[3]); w0.z = pk2(y[4], y[5]); w0.w = pk2(y[6], y[7]);
        w1.x = pk2(y[8], y[9]); w1.y = pk2(y[10], y[11]); w1.z = pk2(y[12], y[13]); w1.w = pk2(y[14], y[15]);
#if OG8
        (void)w0; (void)w1;
        u32x4 w8; w8.x = pg8::pk4_fp8c(y[0] * OG8_SCALE, y[1] * OG8_SCALE, y[2] * OG8_SCALE, y[3] * OG8_SCALE); w8.y = pg8::pk4_fp8c(y[4] * OG8_SCALE, y[5] * OG8_SCALE, y[6] * OG8_SCALE, y[7] * OG8_SCALE);
        w8.z = pg8::pk4_fp8c(y[8] * OG8_SCALE, y[9] * OG8_SCALE, y[10] * OG8_SCALE, y[11] * OG8_SCALE); w8.w = pg8::pk4_fp8c(y[12] * OG8_SCALE, y[13] * OG8_SCALE, y[14] * OG8_SCALE, y[15] * OG8_SCALE);
        *(u32x4*)((unsigned char*)(Z8 + (size_t)t * ZS) + 16 * lane) = w8;
#else
        *(u32x4*)(O + (size_t)t * OS + 1024 + 16 * lane) = w0; *(u32x4*)(O + (size_t)t * OS + 1024 + 16 * lane + 8) = w1;
#endif
    }
}

constexpr int RT_HS = 1032;
template <bool DRY = false> DI void phase_router(const Frame& F, int l, int M) {
    LAS bf16_t* HH = (LAS bf16_t*)F.lds;
    LAS bf16_t* HL = HH + 32 * RT_HS;
    LAS float* H2F = (LAS float*)F.lds;
    bf16_t* H2 = (bf16_t*)(F.ws + WS_R1 + R1_H2);
    const float* xres = F.out; const float* cres = (const float*)(F.ws + WS_CTXS);
    const bf16_t* WRH = (const bf16_t*)(F.ws + WS_WRT) + (size_t)(l * 2) * NE * D; const bf16_t* WRL = WRH + (size_t)NE * D;
    int* toke = (int*)(F.ws + WS_TOKE); int* tokp = (int*)(F.ws + (DRY ? WS_TOKR : WS_TOKP)); float* tokw = (float*)(F.ws + WS_TOKW); int* rowl = (int*)(F.ws + WS_ROWL);
    unsigned* cnt = (unsigned*)(F.ws + WS_CTL) + CW_CNT + 4096 * l + (DRY ? 32 : 0);
    const int lane = F.lane, wave = F.wave, r = lane & 31, hh = lane >> 5;
    const float brt = F.in[I_BR][l * NE + lane];
    const int npass = (M + 31) / 32;
    float xr[4][16];
#pragma unroll
    for (int rr = 0; rr < 4; ++rr) { const int t = F.bid * 32 + 4 * wave + rr;
        if (F.bid < npass && t < M) load_row_f32(t >= TL ? cres + (size_t)(t - TL) * D : xres + (size_t)t * D, lane, xr[rr]);
        else {
#pragma unroll
            for (int i = 0; i < 16; ++i) xr[rr][i] = 0.f; } }
    float gg[16]; load_row_f32(F.in[I_G2] + (size_t)l * D, lane, gg);
#pragma unroll 1
    for (int ps = F.bid; ps < npass; ps += F.G) {
        __syncthreads();
#if RT_PROBE == 1
        RT_T0();
#endif
        { const int t0 = ps * 32; const int mr = t0 >= TL ? 8 : t0 / SEQ;
          float sh[16], sc[16]; load_row_f32(modp(F, l, mr, 3), lane, sh); load_row_f32(modp(F, l, mr, 4), lane, sc);
#pragma unroll
          for (int rr = 0; rr < 4; ++rr) {
            const int row = 4 * wave + rr, t = ps * 32 + row;
            float h[16]; float ss = 0.f;
#pragma unroll
            for (int i = 0; i < 16; ++i) ss += xr[rr][i] * xr[rr][i];
            const float rstd = rsqrtf(wave_sum(ss) * (1.0f / D) + RMS_EPS);
#pragma unroll
            for (int i = 0; i < 16; ++i) h[i] = (t < M) ? xr[rr][i] * rstd * gg[i] * (1.0f + sc[i]) + sh[i] : 0.f;
            if (t < M) store_row_bf16(H2 + (size_t)t * D, lane, h);
#pragma unroll
            for (int i = 0; i < 2; ++i) {
                u32x4 whi; whi.x = pk2(h[8 * i], h[8 * i + 1]); whi.y = pk2(h[8 * i + 2], h[8 * i + 3]); whi.z = pk2(h[8 * i + 4], h[8 * i + 5]); whi.w = pk2(h[8 * i + 6], h[8 * i + 7]);
                u32x4 wlo; wlo.x = pk2(h[8 * i] - bf_lo(whi.x), h[8 * i + 1] - bf_hi(whi.x)); wlo.y = pk2(h[8 * i + 2] - bf_lo(whi.y), h[8 * i + 3] - bf_hi(whi.y));
                wlo.z = pk2(h[8 * i + 4] - bf_lo(whi.z), h[8 * i + 5] - bf_hi(whi.z)); wlo.w = pk2(h[8 * i + 6] - bf_lo(whi.w), h[8 * i + 7] - bf_hi(whi.w));
                *(LAS u32x4*)(HH + row * RT_HS + 8 * lane + 512 * i) = whi; *(LAS u32x4*)(HL + row * RT_HS + 8 * lane + 512 * i) = wlo; }
          }
          const int pn = ps + F.G;
#pragma unroll
          for (int rr = 0; rr < 4; ++rr) { const int t = pn * 32 + 4 * wave + rr;
              if (pn < npass && t < M) load_row_f32(t >= TL ? cres + (size_t)(t - TL) * D : xres + (size_t)t * D, lane, xr[rr]); }
        }
#if RT_PROBE == 1
        RT_AMP();
#endif
        __syncthreads();
#if RT_PROBE == 2
        RT_T0();
#endif
        f32x16 a0, a1;
#pragma unroll
        for (int i = 0; i < 16; ++i) { a0[i] = 0.f; a1[i] = 0.f; }
        {
            const LAS bf16_t* hp = HH + r * RT_HS + 128 * wave + 8 * hh; const LAS bf16_t* lp = HL + r * RT_HS + 128 * wave + 8 * hh;
            const bf16_t* w0h = WRH + (size_t)r * D + 128 * wave + 8 * hh; const bf16_t* w1h = w0h + (size_t)32 * D;
            const bf16_t* w0l = WRL + (size_t)r * D + 128 * wave + 8 * hh; const bf16_t* w1l = w0l + (size_t)32 * D;
#pragma unroll
            for (int ks = 0; ks < 8; ++ks) {
                const bf16x8 ah = *(const LAS bf16x8*)(hp + 16 * ks), al = *(const LAS bf16x8*)(lp + 16 * ks);
                const bf16x8 b0h = *(const bf16x8*)(w0h + 16 * ks), b1h = *(const bf16x8*)(w1h + 16 * ks), b0l = *(const bf16x8*)(w0l + 16 * ks), b1l = *(const bf16x8*)(w1l + 16 * ks);
                a0 = MFMA32(ah, b0h, a0); a1 = MFMA32(ah, b1h, a1);
                a0 = MFMA32(al, b0h, a0); a1 = MFMA32(al, b1h, a1);
                a0 = MFMA32(ah, b0l, a0); a1 = MFMA32(ah, b1l, a1);
            }
        }
        __syncthreads();
#pragma unroll
        for (int i = 0; i < 16; ++i) { const int tk = crow(i, hh); H2F[(wave * 32 + tk) * 64 + r] = a0[i]; H2F[(wave * 32 + tk) * 64 + 32 + r] = a1[i]; }
        __syncthreads();
#if RT_PROBE == 2
        RT_AMP();
#endif
#if RT_PROBE == 4
        RT_T0();
#endif
        LAS unsigned* lcnt = (LAS unsigned*)(F.lds + MISC_OFF + 2048);
        if (F.tid < 64) lcnt[F.tid] = 0u;
        __syncthreads();
        int myj[4]; unsigned mylp[4]; float myw[4];
#pragma unroll
        for (int rr = 0; rr < 4; ++rr) {
            const int row = 4 * wave + rr, t = ps * 32 + row;
            myj[rr] = -1; mylp[rr] = 0u; myw[rr] = 0.f;
            if (t >= M) continue;
            float logit = 0.f;
#pragma unroll
            for (int w = 0; w < 8; ++w) logit += H2F[(w * 32 + row) * 64 + lane];
            const float score = sigmoidf_(logit), sel = score + brt;
            const float g1 = grp8_max(sel);
            const unsigned long long bm = __ballot(sel == g1);
            const unsigned gm = (unsigned)((bm >> (lane & ~7)) & 0xffull);
            const int first = __builtin_ctz(gm);
            const float g2 = grp8_max(((lane & 7) == first) ? -INFINITY : sel);
            const float gs = g1 + g2; const int g = lane >> 3;
            int grank = 0;
#pragma unroll
            for (int j = 0; j < 8; ++j) { const float o = readlane_f(gs, 8 * j); grank += (o > gs || (o == gs && j < g)) ? 1 : 0; }
            const bool gsel = grank < 4;
            const float ms = gsel ? sel : -INFINITY;
            unsigned long long cb = 0ull; float cur = ms;
#pragma unroll
            for (int rnd = 0; rnd < TOPK; ++rnd) {
                float mx = cur; mx = fmaxf(mx, dpp_f<0xB1>(mx)); mx = fmaxf(mx, dpp_f<0x4E>(mx)); mx = fmaxf(mx, dpp_f<0x141>(mx)); mx = fmaxf(mx, dpp_f<0x140>(mx));
                const float wm = fmaxf(fmaxf(readlane_f(mx, 0), readlane_f(mx, 16)), fmaxf(readlane_f(mx, 32), readlane_f(mx, 48)));
                const unsigned long long bm2 = __ballot(cur == wm);
                const int ls = __builtin_ctzll(bm2);
                cb |= 1ull << ls;
                if (lane == ls) cur = -INFINITY;
            }
            const bool chosen = (cb >> lane) & 1ull;
            const float ssum = wave_sum(chosen ? score : 0.f);
            if (chosen) {
                const int j = __builtin_popcountll(cb & ((1ull << lane) - 1ull));
                if (j < 8) { myj[rr] = j; mylp[rr] = __hip_atomic_fetch_add(&lcnt[lane], 1u, __ATOMIC_RELAXED, __HIP_MEMORY_SCOPE_WORKGROUP); myw[rr] = score * __builtin_amdgcn_rcpf(ssum) * 2.5f; }
            }
        }
#if RT_PROBE == 4
        RT_AMP();
#endif
        __syncthreads();
#if RT_PROBE == 5
        RT_T0();
#endif
        if (F.tid < 64) { const unsigned c = lcnt[F.tid]; lcnt[64 + F.tid] = c ? atomicAdd(cnt + F.tid * 64, c) : 0u; }
        __syncthreads();
#pragma unroll
        for (int rr = 0; rr < 4; ++rr) {
            const int t = ps * 32 + 4 * wave + rr;
            if (myj[rr] >= 0) { const size_t o = (size_t)t * 8 + myj[rr]; const int slot = (int)(lcnt[64 + lane] + mylp[rr]); toke[o] = lane; tokp[o] = slot; tokw[o] = myw[rr]; if (!DRY) rowl[(size_t)lane * RCAP + slot] = t; }
            if (!DRY && lane == 0 && t < M) rowl[(size_t)NE * RCAP + t] = t;
        }
#if RT_PROBE == 5
        RT_AMP();
#endif
    }
    __syncthreads();
}
#ifndef MOE_TABLES_EVERY_PHASE
#define MOE_TABLES_EVERY_PHASE 0
#endif
DI void moe_tables(const Frame& F, int l, int M) {
    LAS int* tb = (LAS int*)(F.lds + MISC_OFF + 64); LAS int* rb = tb + 72; LAS int* cn = rb + 72;
    const unsigned* cnt = (const unsigned*)(F.ws + WS_CTL) + CW_CNT + 4096 * l;
    __syncthreads();
    if (F.wave == 0) {
        const int ln = lane_id_();
        const int c = (int)__hip_atomic_load(cnt + ln * 64, __ATOMIC_RELAXED, __HIP_MEMORY_SCOPE_AGENT);
        int st = (c + 255) >> 8, sr = c;
#pragma unroll
        for (int d = 1; d < 64; d <<= 1) {
            const int ot = __builtin_amdgcn_ds_bpermute((ln - d) << 2, st), orw = __builtin_amdgcn_ds_bpermute((ln - d) << 2, sr);
            if (ln >= d) { st += ot; sr += orw; }
        }
        cn[ln] = c; tb[ln] = st - ((c + 255) >> 8); rb[ln] = sr - c;
        if (ln == 63) { cn[NE] = M; tb[NE] = st; rb[NE] = sr; tb[NEX] = st + ((M + 255) >> 8); }
    }
    __syncthreads();
    LAS unsigned char* te = (LAS unsigned char*)(cn + 72);
    if (F.tid < NEX) { const int t0 = tb[F.tid], t1 = tb[F.tid + 1]; for (int t = t0; t < t1; ++t) te[t] = (unsigned char)F.tid; }
    __syncthreads();
}
DI void phase_route_tables(const Frame& F, int l, int M) {
    moe_tables(F, l, M);
    const LAS int* rb = (const LAS int*)(F.lds + MISC_OFF + 64) + 72;
    const int* toke = (const int*)(F.ws + WS_TOKE); const int* tokp = (const int*)(F.ws + WS_TOKP);
    int* tokr = (int*)(F.ws + WS_TOKR); int* rowl = (int*)(F.ws + WS_ROWL);
    for (int i = F.bid * 512 + F.tid; i < M * 8; i += F.G * 512) { const int row = rb[toke[i]] + tokp[i]; tokr[i] = row; rowl[row] = i >> 3; }
    const int shb = rb[NE];
    for (int i = F.bid * 512 + F.tid; i < M + 256; i += F.G * 512) rowl[shb + i] = (i < M) ? i : 0;
}
template <bool DRY = false> DI void phase_combine(const Frame& F, int l, int M) {
    if (MOE_TABLES_EVERY_PHASE) moe_tables(F, l, M);
    const LAS int* rb = (const LAS int*)(F.lds + MISC_OFF + 64) + 72;
    const int shb = rb[NE];
    const int gw = F.bid * 8 + F.wave, lane = F.lane;
    const unsigned char* OS_ = (const unsigned char*)(F.ws + WS_R1);
    const int* toke = (const int*)(F.ws + WS_TOKE); const int* tokp = (const int*)(F.ws + WS_TOKP); const float* tokw = (const float*)(F.ws + WS_TOKW);
    float* xres = F.out; float* cres = (float*)(F.ws + WS_CTXS);
    bf16_t* H = (bf16_t*)(F.ws + WS_R2 + (DRY ? (size_t)40 * 1024 * 1024 : 0));
    bf16_t* HB = (bf16_t*)(F.ws + WS_R2 + (W8A8 ? (size_t)40 * 1024 * 1024 : 0));
    const int per = M / (GRID * 8);
    const int tbeg = gw * per;
    int mr_cur = -1;
    float g2v[16], shv[16], scv[16], gnv[16];
    if (l == 0) load_row_f32(F.in[I_G1] + D, lane, gnv); else load_row_f32(F.in[I_GF], lane, gnv);
    int4 ne0, ne1, nr0, nr1; f32x4 nw0, nw1; float xn[16];
    { const int t = tbeg; ne0 = *(const int4*)(toke + (size_t)t * 8); ne1 = *(const int4*)(toke + (size_t)t * 8 + 4); nr0 = *(const int4*)(tokp + (size_t)t * 8); nr1 = *(const int4*)(tokp + (size_t)t * 8 + 4); nw0 = *(const f32x4*)(tokw + (size_t)t * 8); nw1 = *(const f32x4*)(tokw + (size_t)t * 8 + 4);
      load_row_f32(t >= TL ? cres + (size_t)(t - TL) * D : xres + (size_t)t * D, lane, xn); }
#pragma unroll 1
    for (int k = 0; k < per; ++k) {
        const int t = tbeg + k;
        const bool isctx = t >= TL; const int mr = isctx ? 8 : t / SEQ;
        if (mr != mr_cur) { mr_cur = mr; load_row_f32(modp(F, l, mr, 5), lane, g2v); if (l == 0) { load_row_f32(modp(F, 1, mr, 0), lane, shv); load_row_f32(modp(F, 1, mr, 1), lane, scv); } }
        const int rows[8] = {rb[ne0.x] + nr0.x, rb[ne0.y] + nr0.y, rb[ne0.z] + nr0.z, rb[ne0.w] + nr0.w, rb[ne1.x] + nr1.x, rb[ne1.y] + nr1.y, rb[ne1.z] + nr1.z, rb[ne1.w] + nr1.w};
        const float wts[8] = {nw0[0], nw0[1], nw0[2], nw0[3], nw1[0], nw1[1], nw1[2], nw1[3]};
        float x[16];
#pragma unroll
        for (int i = 0; i < 16; ++i) x[i] = xn[i];
        u32x2 v[9][2];
#pragma unroll
        for (int i = 0; i < 2; ++i) v[8][i] = *(const u32x2*)(OS_ + (size_t)(shb + t) * D + 8 * lane + 512 * i);
#pragma unroll
        for (int j = 0; j < 8; ++j)
#pragma unroll
            for (int i = 0; i < 2; ++i) v[j][i] = *(const u32x2*)(OS_ + (size_t)rows[j] * D + 8 * lane + 512 * i);
        if (k + 1 < per) { const int tn = t + 1; ne0 = *(const int4*)(toke + (size_t)tn * 8); ne1 = *(const int4*)(toke + (size_t)tn * 8 + 4); nr0 = *(const int4*)(tokp + (size_t)tn * 8); nr1 = *(const int4*)(tokp + (size_t)tn * 8 + 4); nw0 = *(const f32x4*)(tokw + (size_t)tn * 8); nw1 = *(const f32x4*)(tokw + (size_t)tn * 8 + 4);
            load_row_f32(tn >= TL ? cres + (size_t)(tn - TL) * D : xres + (size_t)tn * D, lane, xn); }
        float y[16];
#pragma unroll
        for (int i = 0; i < 2; ++i) { const u32x2 a = v[8][i];
            y[8 * i + 0] = __builtin_amdgcn_cvt_f32_fp8((int)a.x, 0); y[8 * i + 1] = __builtin_amdgcn_cvt_f32_fp8((int)a.x, 1); y[8 * i + 2] = __builtin_amdgcn_cvt_f32_fp8((int)a.x, 2); y[8 * i + 3] = __builtin_amdgcn_cvt_f32_fp8((int)a.x, 3);
            y[8 * i + 4] = __builtin_amdgcn_cvt_f32_fp8((int)a.y, 0); y[8 * i + 5] = __builtin_amdgcn_cvt_f32_fp8((int)a.y, 1); y[8 * i + 6] = __builtin_amdgcn_cvt_f32_fp8((int)a.y, 2); y[8 * i + 7] = __builtin_amdgcn_cvt_f32_fp8((int)a.y, 3); }
#pragma unroll
        for (int j = 0; j < DBG_NROUTED; ++j) { const float w = wts[j];
#pragma unroll
            for (int i = 0; i < 2; ++i) { const u32x2 a = v[j][i];
                y[8 * i + 0] += w * __builtin_amdgcn_cvt_f32_fp8((int)a.x, 0); y[8 * i + 1] += w * __builtin_amdgcn_cvt_f32_fp8((int)a.x, 1); y[8 * i + 2] += w * __builtin_amdgcn_cvt_f32_fp8((int)a.x, 2); y[8 * i + 3] += w * __builtin_amdgcn_cvt_f32_fp8((int)a.x, 3);
                y[8 * i + 4] += w * __builtin_amdgcn_cvt_f32_fp8((int)a.y, 0); y[8 * i + 5] += w * __builtin_amdgcn_cvt_f32_fp8((int)a.y, 1); y[8 * i + 6] += w * __builtin_amdgcn_cvt_f32_fp8((int)a.y, 2); y[8 * i + 7] += w * __builtin_amdgcn_cvt_f32_fp8((int)a.y, 3); } }
        float* xr = isctx ? cres + (size_t)(t - TL) * D : xres + (size_t)t * D;
#pragma unroll
        for (int i = 0; i < 16; ++i) x[i] += g2v[i] * y[i];
        float ss = 0.f;
#pragma unroll
        for (int i = 0; i < 16; ++i) ss += x[i] * x[i];
        const float rstd = rsqrtf(wave_sum(ss) * (1.0f / D) + RMS_EPS);
        if (l == 0) {
            if (!DRY) store_row_f32(xr, lane, x);
            float h[16];
#pragma unroll
            for (int i = 0; i < 16; ++i) h[i] = x[i] * rstd * gnv[i] * (1.0f + scv[i]) + shv[i];
            store_row_bf16(HB + (size_t)t * D, lane, h);
        } else {
#pragma unroll
            for (int i = 0; i < 16; ++i) x[i] = x[i] * rstd * gnv[i];
            if (!DRY) store_row_f32(xr, lane, x); else store_row_bf16(H + (size_t)t * D, lane, x);
        }
    }
#if W8A8
    if (l == 0) {
        asm volatile("s_waitcnt vmcnt(0)" ::: "memory");
        unsigned char* H8 = (unsigned char*)(F.ws + WS_R2);
        unsigned hb[9][2][4];
#pragma unroll
        for (int k = 0; k < 9; ++k)
#pragma unroll
            for (int i = 0; i < 2; ++i) { const unsigned* sp = (const unsigned*)(HB + (size_t)(tbeg + (k < per ? k : 0)) * D + 8 * lane + 512 * i);
#pragma unroll
                for (int j = 0; j < 4; ++j) hb[k][i][j] = __hip_atomic_load(sp + j, __ATOMIC_RELAXED, __HIP_MEMORY_SCOPE_AGENT); }
#pragma unroll
        for (int k = 0; k < 9; ++k) {
            if (k < per) {
                const int t = tbeg + k;
#pragma unroll
                for (int i = 0; i < 2; ++i) { const unsigned a0 = hb[k][i][0], a1 = hb[k][i][1], a2 = hb[k][i][2], a3 = hb[k][i][3];
                    u32x2 w; w.x = pg8::pk4_fp8c(bf_lo(a0) * H8_SCALE, bf_hi(a0) * H8_SCALE, bf_lo(a1) * H8_SCALE, bf_hi(a1) * H8_SCALE);
                    w.y = pg8::pk4_fp8c(bf_lo(a2) * H8_SCALE, bf_hi(a2) * H8_SCALE, bf_lo(a3) * H8_SCALE, bf_hi(a3) * H8_SCALE);
                    *(u32x2*)(H8 + (size_t)t * D + 8 * lane + 512 * i) = w; }
            }
        }
    }
#endif
}

constexpr int PH_PER_LAYER = 10, N_PHASES = 2 + 2 * PH_PER_LAYER;
template <class T> DI T* opaque_ptr(T* p) {
    unsigned long long v = (unsigned long long)p; unsigned lo = (unsigned)v, hi = (unsigned)(v >> 32);
    asm volatile("" : "+s"(lo), "+s"(hi)); return (T*)(__attribute__((address_space(1))) T*)(((unsigned long long)hi << 32) | lo);
}
template <int KIND> DI void run_phase(const Frame& F0, const int l0) {
    Frame F = F0; int l = l0; asm volatile("" : "+s"(l));
    F.ws = opaque_ptr(F0.ws); F.out = opaque_ptr(F0.out);
    { int t = F0.wave * 64 + lane_id_(); asm volatile("" : "+v"(t)); F.tid = t; F.lane = t & 63; F.wave = __builtin_amdgcn_readfirstlane(t >> 6); }
    unsigned char* const ws = F.ws;
    const bool ctx_out = (l == 0);
    const int M = ctx_out ? TA : TL;
    if constexpr (KIND == 0) { mod_vectors(F); conv_router(F); conv_gate_w(F); build_na_tab(F); conv_small(F, 0); }
    if constexpr (KIND == 1) { phase_norm1_first(F); }
    if constexpr (KIND == 2) {
        const char* A8 = (const char*)(ws + WS_R2); const char* AB = (const char*)(ws + WS_R2 + (size_t)40 * 1024 * 1024);
        {
            pg8::RectSchedR S{A8, (const char*)(l == 0 ? ws + WS_W8L0 : ws + wbs_base(1) + WB_WIN), D / 2, D / 2, ctx_out ? 72 : 64, ctx_out ? 0 : 8, ctx_out ? 0 : 11, 64, F.G, F.bid,
                              ctx_out ? 37 - MIX_NT : 37, ctx_out ? MIX_T0 : (1 << 30), ctx_out ? MIX_NT : 0};
            pg8::EpiStoreBf16T<true> E{(bf16_t*)(ws + WS_R1), ZS, 1.0f / (H8_SCALE * W8_SCALE)};
            pg8::gemm_phase<false>(F.lds, F.wave * 64 + lane_id_(), D / 2, D / 2, D / 2, S, E);
        }
        if (l == 0) {
            pg8::RectSched<MIX_NT> S{AB, (const char*)(ws + wbs_base(0) + WB_WIN), D, D, 72, 0, 0, 64, F.G, F.bid}; S.skip_from = 0; S.skip_n = MIX_T0;
            pg8::EpiStoreBf16T<false> E{(bf16_t*)(ws + WS_R1), ZS, 1.0f};
            pg8::gemm_phase<false>(F.lds, F.wave * 64 + lane_id_(), D, D, D, S, E);
        }
    }
    if constexpr (KIND == 3) {
        int rot = (F.bid >> 3) & 1; asm volatile("" : "+s"(rot));
#pragma unroll 1
        for (int step = 0; step < 2; ++step) {
            if (step == rot) phase_na(F, l, ctx_out);
            else {
#pragma unroll 1
                for (int t = (F.bid + 128) & 255; t < NB * 4 * 36; t += F.G) gla_prep(F, l, t);
                phase_conv(F, l, M);
            }
        }
    }
    if constexpr (KIND == 12) {
#pragma unroll 1
        for (int ch = F.bid; ch < 256; ch += F.G) gla_chain(F, l, ch, ctx_out);
    }
    if constexpr (KIND == 4) { phase_gla_fin(F, l, M); }
    if constexpr (KIND == 5) {
        const char* Ob = (const char*)(ws + WS_R1 + R1_O); bf16_t* Y = (bf16_t*)(ws + WS_R2); const bf16_t* Zb = (const bf16_t*)(ws + WS_R1);
        unsigned* hflg = (unsigned*)(ws + WS_CTL) + 8192 + 8;
#if ONA8
        { pg8::RectSched<4> S{Ob, (const char*)(ws + wbs_base(l) + WB_WNA), OS, 256, M / 256, 0, 0, 0, F.G, F.bid}; pg8::EpiGate<0, true> E{Y, Zb, C_MERGE, 1.0f / (ONA8_SCALE * W8_SCALE)}; S.r2shift = 0; E.flg = hflg; E.sbase = 0;
          pg8::gemm_phase<false>(F.lds, F.wave * 64 + lane_id_(), 256, OS, 256, S, E); }
#else
        { pg8::RectSched<4> S{Ob, (const char*)(ws + wbs_base(l) + WB_WNA), OS, 512, M / 256, 0, 0, 0, F.G, F.bid}; pg8::EpiGate<0> E{Y, Zb, C_MERGE}; pg8::gemm_phase<false>(F.lds, F.wave * 64 + lane_id_(), 512, OS, 512, S, E); }
#endif
        { pg8::RectSched<4> S{Ob + 512 * 2, (const char*)(ws + wbs_base(l) + WB_WSC), OS, 512, M / 256, 0, 0, 0, F.G, F.bid}; pg8::EpiGate<1> E{Y, Zb, C_MERGE + 1024}; S.r2shift = 32; E.flg = hflg; E.wbase = 0; E.sbase = 32; pg8::gemm_phase<false>(F.lds, F.wave * 64 + lane_id_(), 512, OS, 512, S, E); }
#if OG8
        { pg8::RectSched<4> S{(const char*)Zb, (const char*)(ws + wbs_base(l) + WB_WGLA), ZS, D / 2, M / 256, 0, 0, 0, F.G, F.bid}; pg8::EpiGate<1, true> E{Y, Zb, C_MERGE + 2048, 1.0f / (OG8_SCALE * W8_SCALE)}; S.r2shift = 64; E.flg = hflg; E.wbase = 32;
          pg8::gemm_phase<false>(F.lds, F.wave * 64 + lane_id_(), D / 2, ZS, D / 2, S, E); }
#else
        { pg8::RectSched<4> S{Ob + 1024 * 2, (const char*)(ws + wbs_base(l) + WB_WGLA), OS, D, M / 256, 0, 0, 0, F.G, F.bid}; pg8::EpiGate<1> E{Y, Zb, C_MERGE + 2048}; pg8::gemm_phase<false>(F.lds, F.wave * 64 + lane_id_(), D, OS, D, S, E); }
#endif
        if (l == 0) { Frame F2 = F; const int t2 = F.wave * 64 + lane_id_(); F2.tid = t2; F2.lane = t2 & 63; conv_small(F2, 1, 96); }
    }
    if constexpr (KIND == 6) {
        pg8::RectSched<4> S{(const char*)(ws + WS_R2), (const char*)(ws + wbs_base(l) + WB_WOUT), D, D, M / 256, 0, 0, 0, F.G, F.bid};
        pg8::EpiResid E{l == 0 ? F.in[I_X] : F.out, F.out, l == 0 ? F.in[I_CTX] : (const float*)(ws + WS_CTXS), (float*)(ws + WS_CTXS), modp(F, l, 0, 2)};
        pg8::gemm_phase<false>(F.lds, F.tid, D, D, D, S, E);
        if (l == 0) conv_gu(F, 0, (bf16_t*)(ws + WS_R1), 32);
    }
    if constexpr (KIND == 7) {
#if REPEAT_KIND == 71
        phase_router<true>(F, l, M);
#endif
        const int early = __builtin_amdgcn_readfirstlane((l != 0 && ((F.bid >> 3) & 1)) ? 1 : 0);
        if (early) { conv_gu(F, l, (bf16_t*)(ws + WS_R1)); conv_down(F, l, (bf16_t*)(ws + WS_WBS + WB_WD)); __syncthreads(); }
        phase_router(F, l, M);
        if (l == 0) conv_down(F, 0, (bf16_t*)(ws + WS_WBS + WB_WD), 64);
        if (l != 0 && !early) { conv_gu(F, l, (bf16_t*)(ws + WS_R1)); conv_down(F, l, (bf16_t*)(ws + WS_WBS + WB_WD)); }
#if REPEAT_KIND == 72
        conv_gu(F, l, (bf16_t*)(ws + WS_R1));
#endif
    }
    if constexpr (KIND == 8) { phase_route_tables(F, l, M); }
    if constexpr (KIND == 9) {
        moe_tables(F, l, M);
        const LAS int* tb = (const LAS int*)(F.lds + MISC_OFF + 64);
        pg8::MoeSched<true, 2> S{tb, tb + 72, tb + 144, (const char*)(ws + WS_R1 + R1_H2), (const int*)(ws + WS_ROWL), (const char*)(ws + WS_R1), (size_t)512 * D * 2, D, D, F.G, F.bid};
        pg8::EpiSwiGLU E{(bf16_t*)(ws + WS_R2)};
        pg8::gemm_phase<true>(F.lds, F.tid, D, D, D, S, E);
    }
    if constexpr (KIND == 10) {
        if (MOE_TABLES_EVERY_PHASE) moe_tables(F, l, M);
        const LAS int* tb = (const LAS int*)(F.lds + MISC_OFF + 64);
        pg8::MoeSched<false, 4> S{tb, tb + 72, tb + 144, (const char*)(ws + WS_R2), nullptr, (const char*)(ws + WS_WBS + WB_WD), (size_t)D * FF * 2, FF, FF, F.G, F.bid};
        pg8::EpiDown E{(unsigned char*)(ws + WS_R1), 0x7fffffff};
        pg8::gemm_phase<false>(F.lds, F.tid, FF, FF, FF, S, E);
    }
    if constexpr (KIND == 11) {
#if REPEAT_KIND == 111
        phase_combine<true>(F, l, M);
#endif
        phase_combine(F, l, M);
    }
}
DI void make_frame(Frame& F, const Args& args, unsigned char* lds_raw) {
    F.lds = (LAS unsigned char*)lds_raw; F.ws = args.ws; F.in = args.in; F.out = args.out;
    F.tid = threadIdx.x; F.lane = F.tid & 63; F.wave = __builtin_amdgcn_readfirstlane(F.tid >> 6); F.G = GRID; F.bid = blockIdx.x;
}
template <int KIND> __global__ void __launch_bounds__(512, 2) fwd_k(Args args) {
    extern __shared__ __attribute__((aligned(16))) unsigned char lds_raw[];
    Frame F; make_frame(F, args, lds_raw);
    run_phase<KIND>(F, args.ph_lo);
}
#if MK_ONE_LAUNCH
#ifndef TPROBE_KIND
#define TPROBE_KIND -1
#endif
#ifndef TPROBE_LAYER
#define TPROBE_LAYER -1
#endif
#define TPROBE_MULT 4
#define PHASE(k, lyr) do { unsigned long long _t0 = 0; const bool _pr = (TPROBE_KIND == (k)) && (TPROBE_LAYER < 0 || TPROBE_LAYER == (lyr)); if (_pr) _t0 = __builtin_amdgcn_s_memrealtime(); \
        run_phase<k>(F, lyr); if (!((k) == 11 && (lyr) == 1 && TPROBE_KIND < 0 && REPEAT_KIND < 0)) xcd_barrier(bar, F.wave);        \
        if (_pr) { const unsigned long long _dt = __builtin_amdgcn_s_memrealtime() - _t0; while (__builtin_amdgcn_s_memrealtime() - _t0 < (TPROBE_MULT + 1) * _dt) __builtin_amdgcn_s_sleep(16); } \
        if (REPEAT_KIND == (k)) { run_phase<k>(F, lyr); xcd_barrier(bar, F.wave); } } while (0)
__global__ void __launch_bounds__(512, 2) fwd(Args args) {
    extern __shared__ __attribute__((aligned(16))) unsigned char lds_raw[];
    Frame F; make_frame(F, args, lds_raw);
    volatile LAS unsigned* MISC = (volatile LAS unsigned*)(F.lds + MISC_OFF);
    if (F.tid < 4) MISC[F.tid] = 0u;
    __syncthreads();
    XcdBarrier bar = xcd_barrier_post((unsigned*)(F.ws + WS_CTL) + CW_BAR, MISC);
    PHASE(0, 0);
    PHASE(1, 0);
#pragma unroll 1
    for (int l = 0; l < 2; ++l) {
        PHASE(2, l); PHASE(3, l); PHASE(12, l); PHASE(4, l); PHASE(5, l); PHASE(6, l); PHASE(7, l); PHASE(9, l); PHASE(10, l); PHASE(11, l);
    }
}
#endif

template <int KIND> static bool prep_kernel() { return hipFuncSetAttribute((const void*)fwd_k<KIND>, hipFuncAttributeMaxDynamicSharedMemorySize, LDS_BYTES) == hipSuccess; }
template <int KIND> static void launch_k(int grid, hipStream_t stream, Args a, int l) { a.ph_lo = l; a.ph_hi = KIND; hipLaunchKernelGGL(fwd_k<KIND>, dim3(grid), dim3(512), LDS_BYTES, stream, a); }
extern "C" void kernel_launch(void* const* d_in, const int* in_sizes, int n_in, void* d_out, int out_size, void* d_ws, size_t ws_size, hipStream_t stream) {
    static int grid = 0;
    if (grid == 0) {
        if (n_in != N_INPUTS || ws_size < WS_END) { fprintf(stderr, "kernel_launch: need %d inputs and %zu bytes of workspace; got %d, %zu\n", N_INPUTS, (size_t)WS_END, n_in, ws_size); grid = -1; return; }
        int dev = 0, cus = 0;
        if (hipGetDevice(&dev) != hipSuccess || hipDeviceGetAttribute(&cus, hipDeviceAttributeMultiprocessorCount, dev) != hipSuccess) { grid = -1; return; }
#if MK_ONE_LAUNCH
        if (hipFuncSetAttribute((const void*)fwd, hipFuncAttributeMaxDynamicSharedMemorySize, LDS_BYTES) != hipSuccess) { grid = -1; return; }
#else
        bool ok = prep_kernel<0>() && prep_kernel<1>() && prep_kernel<2>() && prep_kernel<3>() && prep_kernel<4>() && prep_kernel<5>() && prep_kernel<6>() && prep_kernel<7>() && prep_kernel<8>() && prep_kernel<9>() && prep_kernel<10>() && prep_kernel<11>() && prep_kernel<12>();
        if (!ok) { fprintf(stderr, "kernel_launch: hipFuncSetAttribute failed\n"); grid = -1; return; }
#endif
        (void)hipGetLastError();
        if (cus < GRID) { fprintf(stderr, "kernel_launch: built for a %d-CU device, found %d CUs\n", GRID, cus); grid = -1; return; }
        grid = GRID;
    }
    if (grid < 0) return;
    if (hipMemsetAsync((char*)d_ws + WS_CTL, 0, ZERO_BYTES, stream) != hipSuccess) return;
    Args a{};
    for (int i = 0; i < N_INPUTS; ++i) a.in[i] = (const float*)d_in[i];
    a.out = (float*)d_out; a.ws = (unsigned char*)d_ws;
#if MK_ONE_LAUNCH
    a.ph_lo = 0; a.ph_hi = N_PHASES;
    hipLaunchKernelGGL(fwd, dim3(grid), dim3(512), LDS_BYTES, stream, a);
#else
    launch_k<0>(grid, stream, a, 0); launch_k<1>(grid, stream, a, 0);
    for (int l = 0; l < 2; ++l) {
        launch_k<2>(grid, stream, a, l); launch_k<3>(grid, stream, a, l); launch_k<12>(grid, stream, a, l); launch_k<4>(grid, stream, a, l); launch_k<5>(grid, stream, a, l); launch_k<6>(grid, stream, a, l);
#ifdef DBG_STOP6
        break;
#endif
        launch_k<7>(grid, stream, a, l); launch_k<8>(grid, stream, a, l); launch_k<9>(grid, stream, a, l); launch_k<10>(grid, stream, a, l); launch_k<11>(grid, stream, a, l);
#ifdef DBG_STOP11
        break;
#endif
    }
#endif
}
```
